# Optimizing an MI355X kernel written in HIP

```python
import math
import jax, jax.numpy as jnp
from jax import lax
import numpy as np

D_MODEL = 1024
BATCH = 16
SEQ = 4096
DEPTH = 2

CHUNK = 64
HEAD_DIM = 64
EPS = 1e-6
A_WIDTH = D_MODEL // 2
A_HEADS = A_WIDTH // HEAD_DIM
A_LEFT_CHUNKS = 8
A_BAND = (A_LEFT_CHUNKS + 1) * CHUNK
A_MAX_REL = 128
B_WIDTH = D_MODEL - A_WIDTH
B_GROUP = 16
B_GROUPS = B_WIDTH // B_GROUP
B_STATE = 64
DT_MIN = 1e-3
DT_MAX = 1e-1
C_WIDTH = D_MODEL // 2
C_HEADS = 4
C_HEAD_DIM = C_WIDTH // C_HEADS
ROPE_BASE = 10000.0
D_WIDTH = D_MODEL - C_WIDTH
D_HEADS = D_WIDTH // HEAD_DIM
SB_BLOCK = 128
FF_HIDDEN = ((-(-8 * D_MODEL // 3)) + 255) // 256 * 256
N_EVEN = (DEPTH + 1) // 2
N_ODD = DEPTH // 2
EVEN_IN = 3 * A_WIDTH + B_WIDTH
ODD_IN = 4 * C_WIDTH + 3 * D_WIDTH

kernel_name = "hybrid_streaming_encoder_block"


def rms_norm(x, g):
    xf = x.astype(jnp.float32)
    y = xf * lax.rsqrt(jnp.mean(xf * xf, axis=-1, keepdims=True) + EPS)
    return (y * g.astype(jnp.float32)).astype(x.dtype)


def modulate(h, shift, scale):
    return h * (1.0 + scale[:, None, :]) + shift[:, None, :]


def swiglu(h, w_in, w_out):
    gate, up = jnp.split(h @ w_in, 2, axis=-1)
    return (jax.nn.silu(gate) * up) @ w_out


def rotary(x, pos):
    half = x.shape[-1] // 2
    freqs = ROPE_BASE ** (-jnp.arange(half, dtype=jnp.float32) / half)
    ang = pos.astype(jnp.float32)[:, None] * freqs[None, :]
    cos = jnp.cos(ang)[None, :, None, :]
    sin = jnp.sin(ang)[None, :, None, :]
    x1, x2 = x[..., :half], x[..., half:]
    return jnp.concatenate([x1 * cos - x2 * sin, x1 * sin + x2 * cos], axis=-1)


def chunked_relpos_attention(q, k, v, q_gain, k_gain, rel_bias):
    bsz, L, H, dh = q.shape
    n_chunks = L // CHUNK
    pad = A_LEFT_CHUNKS * CHUNK
    q = rms_norm(q, q_gain)
    k = rms_norm(k, k_gain)
    kp = jnp.pad(k, ((0, 0), (pad, 0), (0, 0), (0, 0)))
    vp = jnp.pad(v, ((0, 0), (pad, 0), (0, 0), (0, 0)))
    qc = q.reshape(bsz, n_chunks, CHUNK, H, dh)
    rel = (pad + jnp.arange(CHUNK))[:, None] - jnp.arange(A_BAND)[None, :]
    idx = jnp.clip(rel, -A_MAX_REL, A_MAX_REL) + A_MAX_REL
    bias = rel_bias.astype(jnp.float32)[:, idx]
    scale = dh ** -0.5

    def one_chunk(ci):
        kb = lax.dynamic_slice_in_dim(kp, ci * CHUNK, A_BAND, axis=1)
        vb = lax.dynamic_slice_in_dim(vp, ci * CHUNK, A_BAND, axis=1)
        qb = lax.dynamic_index_in_dim(qc, ci, axis=1, keepdims=False)
        s = jnp.einsum('bqhd,bkhd->bhqk', qb, kb).astype(jnp.float32) * scale + bias
        valid = (ci * CHUNK - pad + jnp.arange(A_BAND)) >= 0
        s = jnp.where(valid[None, None, None, :], s, -1e30)
        p = jax.nn.softmax(s, axis=-1).astype(vb.dtype)
        return jnp.einsum('bhqk,bkhd->bqhd', p, vb)

    out = lax.map(one_chunk, jnp.arange(n_chunks))
    return out.transpose(1, 0, 2, 3, 4).reshape(bsz, L, H * dh)


def s5_mixer(u, lam_re, lam_im, log_dt, b_re, b_im, c_re, c_im, d_skip, w_glu, b_glu):
    f32 = jnp.float32
    bsz, L, _ = u.shape
    ug = u.astype(f32).reshape(bsz, L, B_GROUPS, B_GROUP)
    lam_re = lam_re.astype(f32)
    lam_im = lam_im.astype(f32)
    b_re = b_re.astype(f32)
    b_im = b_im.astype(f32)
    dt = jnp.exp(log_dt.astype(f32))[:, None]
    mag = jnp.exp(lam_re * dt)
    ang = lam_im * dt
    abar_re = mag * jnp.cos(ang)
    abar_im = mag * jnp.sin(ang)
    den = lam_re * lam_re + lam_im * lam_im
    f_re = ((abar_re - 1.0) * lam_re + abar_im * lam_im) / den
    f_im = (abar_im * lam_re - (abar_re - 1.0) * lam_im) / den
    bbar_re = f_re[..., None] * b_re - f_im[..., None] * b_im
    bbar_im = f_re[..., None] * b_im + f_im[..., None] * b_re
    bu_re = jnp.einsum('blgh,gph->lbgp', ug, bbar_re)
    bu_im = jnp.einsum('blgh,gph->lbgp', ug, bbar_im)
    a_re = jnp.broadcast_to(abar_re[None, None], (L, 1, B_GROUPS, B_STATE))
    a_im = jnp.broadcast_to(abar_im[None, None], (L, 1, B_GROUPS, B_STATE))

    def combine(e1, e2):
        a1r, a1i, b1r, b1i = e1
        a2r, a2i, b2r, b2i = e2
        ar = a1r * a2r - a1i * a2i
        ai = a1r * a2i + a1i * a2r
        br = a2r * b1r - a2i * b1i + b2r
        bi = a2r * b1i + a2i * b1r + b2i
        return ar, ai, br, bi

    _, _, xr, xi = lax.associative_scan(combine, (a_re, a_im, bu_re, bu_im), axis=0)
    y = (jnp.einsum('lbgp,ghp->blgh', xr, c_re.astype(f32))
         - jnp.einsum('lbgp,ghp->blgh', xi, c_im.astype(f32))
         + d_skip.astype(f32) * ug)
    y = jax.nn.gelu(y.reshape(bsz, L, B_WIDTH))
    gate = jax.nn.sigmoid(y @ w_glu.astype(f32) + b_glu.astype(f32))
    return (y * gate).astype(u.dtype)


def retention_mixer(q, k, v, g, norm_g):
    f32 = jnp.float32
    bsz, L, _ = q.shape
    n_chunks = L // CHUNK
    pos = jnp.arange(L)
    shp = (bsz, L, C_HEADS, C_HEAD_DIM)
    q = rotary(q.astype(f32).reshape(shp), pos)
    k = rotary(k.astype(f32).reshape(shp), pos) * (C_HEAD_DIM ** -0.5)
    v = v.astype(f32).reshape(shp)
    log_gamma = jnp.log(1.0 - 2.0 ** (-5.0 - jnp.arange(C_HEADS, dtype=f32)))
    idx = jnp.arange(CHUNK, dtype=f32)
    intra_decay = jnp.exp(log_gamma[:, None, None] * jnp.abs(idx[:, None] - idx[None, :]))
    q_decay = jnp.exp(log_gamma[:, None] * (idx + 1.0))
    k_decay = jnp.exp(log_gamma[:, None] * (CHUNK - 1.0 - idx))
    chunk_decay = jnp.exp(log_gamma * CHUNK)

    def to_chunks(t):
        return t.reshape(bsz, n_chunks, CHUNK, C_HEADS, C_HEAD_DIM).transpose(1, 0, 3, 2, 4)

    def step(state, inp):
        qn, kn, vn = inp
        scores = jnp.einsum('bhid,bhjd->bhij', qn, kn) * intra_decay
        out = (jnp.einsum('bhij,bhjd->bhid', scores, vn)
               + jnp.einsum('bhid,bhde->bhie', qn * q_decay[:, :, None], state))
        state = (state * chunk_decay[:, None, None]
                 + jnp.einsum('bhjd,bhje->bhde', kn * k_decay[:, :, None], vn))
        return state, out

    state0 = jnp.zeros((bsz, C_HEADS, C_HEAD_DIM, C_HEAD_DIM), f32)
    _, o = lax.scan(step, state0, (to_chunks(q), to_chunks(k), to_chunks(v)))
    o = o.transpose(1, 0, 3, 2, 4).reshape(shp)
    mu = jnp.mean(o, axis=-1, keepdims=True)
    var = jnp.mean(jnp.square(o - mu), axis=-1, keepdims=True)
    o = ((o - mu) * lax.rsqrt(var + EPS)).reshape(bsz, L, C_WIDTH) * norm_g.astype(f32)
    return (jax.nn.silu(g.astype(f32)) * o).astype(g.dtype)


def stick_breaking_mixer(q, k, v):
    bsz, L, _ = q.shape
    shp = (bsz, L, D_HEADS, HEAD_DIM)
    q, k, v = q.reshape(shp), k.reshape(shp), v.reshape(shp)
    scale = HEAD_DIM ** -0.5
    outs = []
    for blk in range(L // SB_BLOCK):
        t0 = blk * SB_BLOCK
        t1 = t0 + SB_BLOCK
        z = jnp.einsum('bqhd,bkhd->bhqk', q[:, t0:t1], k[:, :t1]).astype(jnp.float32) * scale
        causal = jnp.arange(t1)[None, :] < (t0 + jnp.arange(SB_BLOCK))[:, None]
        log_1m_beta = jnp.where(causal, -jax.nn.softplus(z), 0.0)
        between = lax.cumsum(log_1m_beta, axis=3, reverse=True) - log_1m_beta
        w = jnp.where(causal, jnp.exp(jax.nn.log_sigmoid(z) + between), 0.0)
        outs.append(jnp.einsum('bhqk,bkhd->bqhd', w.astype(v.dtype), v[:, :t1]))
    return jnp.concatenate(outs, axis=1).reshape(bsz, L, D_WIDTH)


def even_mixer(h, w_in, w_out, q_gain, k_gain, rel_bias, lam_re, lam_im, log_dt,
               b_re, b_im, c_re, c_im, d_skip, w_glu, b_glu):
    bsz, L, _ = h.shape
    q, k, v, u = jnp.split(h @ w_in, [A_WIDTH, 2 * A_WIDTH, 3 * A_WIDTH], axis=-1)
    shp = (bsz, L, A_HEADS, HEAD_DIM)
    a_out = chunked_relpos_attention(q.reshape(shp), k.reshape(shp), v.reshape(shp),
                                     q_gain, k_gain, rel_bias)
    b_out = s5_mixer(u, lam_re, lam_im, log_dt, b_re, b_im, c_re, c_im, d_skip, w_glu, b_glu)
    return jnp.concatenate([a_out, b_out], axis=-1) @ w_out


def odd_mixer(h, w_in, w_out, norm_g):
    offs = [C_WIDTH, 2 * C_WIDTH, 3 * C_WIDTH, 4 * C_WIDTH,
            4 * C_WIDTH + D_WIDTH, 4 * C_WIDTH + 2 * D_WIDTH]
    cq, ck, cv, cg, dq, dk, dv = jnp.split(h @ w_in, offs, axis=-1)
    c_out = retention_mixer(cq, ck, cv, cg, norm_g)
    d_out = stick_breaking_mixer(dq, dk, dv)
    return jnp.concatenate([c_out, d_out], axis=-1) @ w_out


def setup_inputs(seed: int = 0) -> dict:
    key = jax.random.key(seed)
    ks = jax.random.split(key, 26)
    f32 = jnp.float32
    D = D_MODEL

    def nrm(k, shape, s):
        return jax.random.normal(k, shape, f32) * s

    return {
        "x": nrm(ks[0], (BATCH, SEQ, D), 1.0),
        "c": nrm(ks[1], (BATCH, D), 1.0),
        "ada_w": nrm(ks[2], (DEPTH, D, 6 * D), 0.5 * D ** -0.5),
        "ada_b": nrm(ks[3], (DEPTH, 6 * D), 0.01),
        "ln_mix_g": 1.0 + nrm(ks[4], (DEPTH, D), 0.01),
        "ln_ffn_g": 1.0 + nrm(ks[5], (DEPTH, D), 0.01),
        "ffn_w_in": nrm(ks[6], (DEPTH, D, 2 * FF_HIDDEN), D ** -0.5),
        "ffn_w_out": nrm(ks[7], (DEPTH, FF_HIDDEN, D), FF_HIDDEN ** -0.5),
        "ab_w_in": nrm(ks[8], (N_EVEN, D, EVEN_IN), D ** -0.5),
        "ab_w_out": nrm(ks[9], (N_EVEN, A_WIDTH + B_WIDTH, D), (A_WIDTH + B_WIDTH) ** -0.5),
        "a_q_gain": 1.0 + nrm(ks[10], (N_EVEN, HEAD_DIM), 0.01),
        "a_k_gain": 1.0 + nrm(ks[11], (N_EVEN, HEAD_DIM), 0.01),
        "a_rel_bias": nrm(ks[12], (N_EVEN, A_HEADS, 2 * A_MAX_REL + 1), 0.5),
        "s5_lambda_re": -0.5 + nrm(ks[13], (N_EVEN, B_GROUPS, B_STATE), 0.01),
        "s5_lambda_im": math.pi * jnp.arange(B_STATE, dtype=f32) + nrm(ks[14], (N_EVEN, B_GROUPS, B_STATE), 0.01),
        "s5_log_dt": jax.random.uniform(ks[15], (N_EVEN, B_GROUPS), f32, math.log(DT_MIN), math.log(DT_MAX)),
        "s5_b_re": nrm(ks[16], (N_EVEN, B_GROUPS, B_STATE, B_GROUP), (2 * B_GROUP) ** -0.5),
        "s5_b_im": nrm(ks[17], (N_EVEN, B_GROUPS, B_STATE, B_GROUP), (2 * B_GROUP) ** -0.5),
        "s5_c_re": nrm(ks[18], (N_EVEN, B_GROUPS, B_GROUP, B_STATE), 2.0 * B_STATE ** -0.5),
        "s5_c_im": nrm(ks[19], (N_EVEN, B_GROUPS, B_GROUP, B_STATE), 2.0 * B_STATE ** -0.5),
        "s5_d": nrm(ks[20], (N_EVEN, B_GROUPS, B_GROUP), 0.5),
        "s5_w_glu": nrm(ks[21], (N_EVEN, B_WIDTH, B_WIDTH), B_WIDTH ** -0.5),
        "s5_b_glu": nrm(ks[22], (N_EVEN, B_WIDTH), 0.01),
        "cd_w_in": nrm(ks[23], (N_ODD, D, ODD_IN), D ** -0.5),
        "cd_w_out": nrm(ks[24], (N_ODD, C_WIDTH + D_WIDTH, D), (C_WIDTH + D_WIDTH) ** -0.5),
        "ret_norm_g": 1.0 + nrm(ks[25], (N_ODD, C_WIDTH), 0.01),
    }


def reference(x, c, ada_w, ada_b, ln_mix_g, ln_ffn_g, ffn_w_in, ffn_w_out,
              ab_w_in, ab_w_out, a_q_gain, a_k_gain, a_rel_bias,
              s5_lambda_re, s5_lambda_im, s5_log_dt, s5_b_re, s5_b_im, s5_c_re, s5_c_im,
              s5_d, s5_w_glu, s5_b_glu, cd_w_in, cd_w_out, ret_norm_g):
    cond = jax.nn.silu(c)
    for layer in range(DEPTH):
        mod = cond @ ada_w[layer] + ada_b[layer]
        sh1, sc1, g1, sh2, sc2, g2 = jnp.split(mod, 6, axis=-1)
        h = modulate(rms_norm(x, ln_mix_g[layer]), sh1, sc1)
        i = layer // 2
        if layer % 2 == 0:
            mix = even_mixer(h, ab_w_in[i], ab_w_out[i], a_q_gain[i], a_k_gain[i], a_rel_bias[i],
                             s5_lambda_re[i], s5_lambda_im[i], s5_log_dt[i], s5_b_re[i], s5_b_im[i],
                             s5_c_re[i], s5_c_im[i], s5_d[i], s5_w_glu[i], s5_b_glu[i])
        else:
            mix = odd_mixer(h, cd_w_in[i], cd_w_out[i], ret_norm_g[i])
        x = x + g1[:, None, :] * mix
        h = modulate(rms_norm(x, ln_ffn_g[layer]), sh2, sc2)
        x = x + g2[:, None, :] * swiglu(h, ffn_w_in[layer], ffn_w_out[layer])
    return x
```

```cpp
#include <hip/hip_runtime.h>
#include <hip/hip_cooperative_groups.h>
#include <cstdio>
namespace cg = cooperative_groups;

#define LAS __attribute__((address_space(3)))
typedef unsigned short bf16_t;
typedef short bf16x8 __attribute__((ext_vector_type(8)));
typedef short s16x4 __attribute__((ext_vector_type(4)));
typedef float f32x4 __attribute__((ext_vector_type(4)));
typedef float f32x2 __attribute__((ext_vector_type(2)));
typedef unsigned u32x4 __attribute__((ext_vector_type(4)));
typedef unsigned u32x2 __attribute__((ext_vector_type(2)));

constexpr int NB = 16, SEQ = 4096, DM = 1024, MTOK = NB * SEQ, FFH = 2816;
constexpr int NTHR = 512;
constexpr int LDS_BYTES = 135168;

constexpr size_t al256(size_t x) { return (x + 255) & ~(size_t)255; }
constexpr size_t WS_W_ABIN = 0;
constexpr size_t WS_W_ABOUT = WS_W_ABIN + (size_t)2048 * 1024 * 2;
constexpr size_t WS_W_GLU = WS_W_ABOUT + (size_t)1024 * 1024 * 2;
constexpr size_t WS_W_FFIN = WS_W_GLU + (size_t)512 * 512 * 2;
constexpr size_t WS_W_FFOUT = WS_W_FFIN + (size_t)2 * 5632 * 1024 * 2;
constexpr size_t WS_W_CDIN = WS_W_FFOUT + (size_t)2 * 1024 * 2816 * 2;
constexpr size_t WS_W_CDOUT = WS_W_CDIN + (size_t)3584 * 1024 * 2;
constexpr size_t WS_MOD = WS_W_CDOUT + (size_t)1024 * 1024 * 2;
constexpr size_t WS_ROPE = WS_MOD + (size_t)2 * 16 * 6144 * 4;
constexpr size_t WS_KERN = WS_ROPE + (size_t)4096 * 64 * 8;
constexpr size_t WS_S5M = WS_KERN + (size_t)32 * 64 * 256 * 2;
constexpr size_t WS_S5G = WS_S5M + (size_t)32 * 128 * 1024 * 2;
constexpr size_t WS_A64 = WS_S5G + (size_t)32 * 1024 * 128 * 2;
constexpr size_t WS_S5E = WS_A64 + (size_t)32 * 64 * 8;
constexpr size_t WS_S5X = WS_S5E + (size_t)64 * 32 * 16 * 128 * 4;
constexpr size_t WS_Y5 = WS_S5X + (size_t)64 * 32 * 16 * 128 * 2;
constexpr size_t WS_H = WS_Y5 + (size_t)MTOK * 512 * 2;
constexpr size_t WS_MIX = WS_H + (size_t)MTOK * 1024 * 2;
constexpr size_t WS_R1 = WS_MIX + (size_t)MTOK * 1024 * 2;
constexpr size_t WS_END = WS_R1 + (size_t)MTOK * 3584 * 2;

struct Params {
    const float* in[26];
    float* out;
    unsigned char* ws;
    int ph_lo, ph_hi;
};

__device__ __forceinline__ float bf2f(unsigned short b) { return __uint_as_float(((unsigned)b) << 16); }
typedef __bf16 bf16x2_t __attribute__((ext_vector_type(2)));
__device__ __forceinline__ unsigned pk2(float lo, float hi) { const f32x2 v = {lo, hi}; return __builtin_bit_cast(unsigned, __builtin_convertvector(v, bf16x2_t)); }
__device__ __forceinline__ bf16_t f2bf(float f) { return (bf16_t)(pk2(f, 0.f) & 0xffffu); }
__device__ __forceinline__ float lo_f(unsigned u) { return __uint_as_float(u << 16); }
__device__ __forceinline__ float hi_f(unsigned u) { return __uint_as_float(u & 0xffff0000u); }
__device__ __forceinline__ bf16x8 as_frag(u32x4 u) { return __builtin_bit_cast(bf16x8, u); }
__device__ __forceinline__ f32x4 mfma16(bf16x8 a, bf16x8 b, f32x4 c) { return __builtin_amdgcn_mfma_f32_16x16x32_bf16(a, b, c, 0, 0, 0); }
__device__ __forceinline__ float silu_f(float x) { return x / (1.f + __expf(-x)); }
__device__ __forceinline__ float sigm_f(float x) { return 1.f / (1.f + __expf(-x)); }
__device__ __forceinline__ float gelu_tanh(float x) {
    const float u = 0.7978845608028654f * (x + 0.044715f * x * x * x);
    const float t = 1.f - 2.f / (1.f + __expf(2.f * u));
    return 0.5f * x * (1.f + t);
}
__device__ __forceinline__ bf16x8 tr_pair(LAS bf16_t* base, int stride, int row0, int row1, int col0, int li) {
    const int q = li >> 2, pq = li & 3;
    s16x4 a = __builtin_amdgcn_ds_read_tr16_b64_v4i16((LAS s16x4*)(base + (row0 + q) * stride + col0 + 4 * pq));
    s16x4 b = __builtin_amdgcn_ds_read_tr16_b64_v4i16((LAS s16x4*)(base + (row1 + q) * stride + col0 + 4 * pq));
    bf16x8 r = {a[0], a[1], a[2], a[3], b[0], b[1], b[2], b[3]};
    return r;
}
__device__ __forceinline__ int tid_opaque() { int t = threadIdx.x; asm volatile("" : "+v"(t)); return t; }
__device__ __forceinline__ void wave_lds_fence() { asm volatile("s_waitcnt lgkmcnt(0)" ::: "memory"); __builtin_amdgcn_wave_barrier(); }

namespace pg8 {
constexpr int BM = 256, BK = 64, HALF = 128, HTB = HALF * BK * 2, STAGE_BYTES = 8 * HTB, NXCD = 8, WGM = 8;
__device__ __forceinline__ int lds_byte(int r, int c) { const int st = (r >> 4) * 2 + (c >> 5), rr = r & 15, cc = c & 31, ob = rr * 64 + cc * 2; return st * 1024 + (ob ^ (((ob >> 9) & 1) << 5)); }
__device__ __forceinline__ void stage_rc(int b, int& R, int& C) { const int st = b / 1024, sb = b % 1024, swz = sb ^ (((sb >> 9) & 1) << 5); R = (st >> 1) * 16 + swz / 64; C = (st & 1) * 32 + (swz % 64) / 2; }
__device__ __forceinline__ int perm32(int rho) { const int n = rho >> 4, i = rho & 15; return 8 * (i >> 2) + 4 * n + (i & 3); }
struct Unit { int pm, pn; };
struct Gemm { const bf16_t* A; const bf16_t* Bt; int M, N, K; };
struct StaticOrder {
    int nM, nN, nwg, G, c;
    __device__ void init(int M, int N, int G_, int c_) { nM = M / BM; nN = N / BM; nwg = nM * nN; G = G_; c = c_; }
    __device__ bool next(int i, Unit& u) const {
        const long L = (long)i * G + c; if (L >= nwg) return false;
        int wgid = (int)L; { const int q = nwg / NXCD, r = nwg % NXCD, xcd = wgid % NXCD, off = wgid / NXCD; wgid = (xcd < r ? xcd * (q + 1) : r * (q + 1) + (xcd - r) * q) + off; }
        const int nig = WGM * nN, gid = wgid / nig, fm = gid * WGM, gsz = (nM - fm) < WGM ? (nM - fm) : WGM;
        u.pm = fm + ((wgid % nig) % gsz); u.pn = (wgid % nig) / gsz; return true;
    }
};

template <class Epi>
__device__ __forceinline__ void gemm_phase(LAS unsigned char* lds, const Gemm g, const StaticOrder& S, const Epi& E) {
    const int tid = tid_opaque(), wid = __builtin_amdgcn_readfirstlane(tid >> 6), lane = tid & 63, wr = wid >> 2, wc = wid & 3, fr = lane & 15, fq = lane >> 4;
    const int K = g.K, nt = K / BK;
    unsigned voffA[2], voffB[2];
#pragma unroll
    for (int i = 0; i < 2; ++i) { int R, C; stage_rc(tid * 16 + i * 8192, R, C); const int Rb = Epi::PERM ? ((R & ~31) + perm32(R & 31)) : R;
        voffA[i] = (unsigned)(R * K + C) * 2u; voffB[i] = (unsigned)(Rb * K + C) * 2u; }
    const size_t kstep = (size_t)(BK * 2);
    const size_t hstep = (size_t)HALF * K * 2;
    const size_t tstep = 2 * hstep;
    const unsigned ldsw = (unsigned)wid * 1024u;
    const int aoff = lds_byte(wr * 64 + fr, fq * 8), boff = lds_byte(wc * 32 + fr, fq * 8);
#define PG8_SA(b, h) (((b) * 2 + (h)) * HTB)
#define PG8_SB(b, h) ((4 + (b) * 2 + (h)) * HTB)
#define PG8_STAGE(bufoff, gbase, voff) do { _Pragma("unroll") for (int _i = 0; _i < 2; ++_i) \
        __builtin_amdgcn_global_load_lds((const unsigned*)((const char*)(gbase) + (voff)[_i]), (LAS unsigned*)(lds + (bufoff) + ldsw + _i * 8192), 16, 0, 0); } while (0)
#define PG8_LDA(dst, b, h) do { _Pragma("unroll") for (int m = 0; m < 4; ++m) _Pragma("unroll") for (int k = 0; k < 2; ++k) dst[m][k] = *(const LAS bf16x8*)(lds + PG8_SA(b, h) + aoff + m * 2048 + k * 1024); } while (0)
#define PG8_LDB(dst, b, h) do { _Pragma("unroll") for (int n = 0; n < 2; ++n) _Pragma("unroll") for (int k = 0; k < 2; ++k) dst[n][k] = *(const LAS bf16x8*)(lds + PG8_SB(b, h) + boff + n * 2048 + k * 1024); } while (0)
#define PG8_MMA(ai, bj, At, Bt) do { __builtin_amdgcn_s_setprio(1); _Pragma("unroll") for (int m = 0; m < 4; ++m) _Pragma("unroll") for (int n = 0; n < 2; ++n) _Pragma("unroll") for (int k = 0; k < 2; ++k) \
        acc[ai][bj][m][n] = __builtin_amdgcn_mfma_f32_16x16x32_bf16(Bt[n][k], At[m][k], acc[ai][bj][m][n], 0, 0, 0); __builtin_amdgcn_s_setprio(0); } while (0)
#define PG8_WAIT_V(n) asm volatile("s_waitcnt vmcnt(" #n ")" ::: "memory")
#define PG8_WAIT_L(n) asm volatile("s_waitcnt lgkmcnt(" #n ")" ::: "memory")
#define PG8_BAR __builtin_amdgcn_s_barrier()
#define PG8_SCHED __builtin_amdgcn_sched_barrier(0)
    Unit cur, nxt; int ui = 0;
    if (!S.next(0, cur)) return;
    f32x4 acc[2][2][4][2];
#pragma unroll
    for (int a = 0; a < 2; ++a)
#pragma unroll
        for (int b = 0; b < 2; ++b)
#pragma unroll
            for (int m = 0; m < 4; ++m)
#pragma unroll
                for (int n = 0; n < 2; ++n) acc[a][b][m][n] = (f32x4){0.f, 0.f, 0.f, 0.f};
    bf16x8 At[4][2], B0[2][2], B1[2][2];
    const char* cA = (const char*)g.A + (size_t)cur.pm * tstep; const char* cB = (const char*)g.Bt + (size_t)cur.pn * tstep;
    PG8_STAGE(PG8_SB(0, 0), cB, voffB); PG8_STAGE(PG8_SA(0, 0), cA, voffA); PG8_STAGE(PG8_SB(0, 1), cB + hstep, voffB); PG8_STAGE(PG8_SA(0, 1), cA + hstep, voffA);
    if (wr == 1) PG8_BAR;
    PG8_WAIT_V(4); PG8_BAR;
    PG8_STAGE(PG8_SB(1, 0), cB + kstep, voffB); PG8_STAGE(PG8_SA(1, 0), cA + kstep, voffA); PG8_STAGE(PG8_SB(1, 1), cB + hstep + kstep, voffB);
    PG8_WAIT_V(6); PG8_BAR;
    for (;;) {
        const bool has_next = S.next(ui + 1, nxt);
        const char* nA = has_next ? (const char*)g.A + (size_t)nxt.pm * tstep : cA; const char* nB = has_next ? (const char*)g.Bt + (size_t)nxt.pn * tstep : cB;
        for (int t = 0; t < nt; t += 2) {
            const bool last = (t == nt - 2);
            const char* a1 = cA + (size_t)(t + 1) * kstep;
            const char* a2 = last ? nA : cA + (size_t)(t + 2) * kstep; const char* b2 = last ? nB : cB + (size_t)(t + 2) * kstep;
            const char* a3 = a2 + kstep; const char* b3 = b2 + kstep;
            PG8_LDB(B0, 0, 0); PG8_SCHED; PG8_LDA(At, 0, 0); PG8_STAGE(PG8_SA(1, 1), a1 + hstep, voffA);
            PG8_WAIT_L(8); PG8_BAR; PG8_WAIT_L(0); PG8_MMA(0, 0, At, B0); PG8_BAR; PG8_SCHED;
            PG8_LDB(B1, 0, 1); PG8_STAGE(PG8_SB(0, 0), b2, voffB);
            PG8_BAR; PG8_WAIT_L(0); PG8_MMA(0, 1, At, B1); PG8_BAR;
            PG8_LDA(At, 0, 1); PG8_STAGE(PG8_SA(0, 0), a2, voffA);
            PG8_BAR; PG8_WAIT_L(0); PG8_MMA(1, 0, At, B0); PG8_BAR; PG8_SCHED;
            PG8_STAGE(PG8_SB(0, 1), b2 + hstep, voffB);
            PG8_WAIT_V(6); PG8_BAR; PG8_MMA(1, 1, At, B1); PG8_BAR;
            PG8_LDB(B0, 1, 0); PG8_SCHED; PG8_LDA(At, 1, 0); PG8_STAGE(PG8_SA(0, 1), a2 + hstep, voffA);
            PG8_WAIT_L(8); PG8_BAR; PG8_WAIT_L(0); PG8_MMA(0, 0, At, B0); PG8_BAR; PG8_SCHED;
            PG8_LDB(B1, 1, 1); PG8_STAGE(PG8_SB(1, 0), b3, voffB);
            PG8_BAR; PG8_WAIT_L(0); PG8_MMA(0, 1, At, B1); PG8_BAR;
            PG8_LDA(At, 1, 1); PG8_STAGE(PG8_SA(1, 0), a3, voffA);
            PG8_BAR; PG8_WAIT_L(0); PG8_MMA(1, 0, At, B0); PG8_BAR; PG8_SCHED;
            PG8_STAGE(PG8_SB(1, 1), b3 + hstep, voffB);
            PG8_WAIT_V(6); PG8_BAR; PG8_MMA(1, 1, At, B1); PG8_BAR;
        }
        E(acc, cur, wr, wc, fr, fq);
        if (!has_next) break;
#pragma unroll
        for (int a = 0; a < 2; ++a)
#pragma unroll
            for (int b = 0; b < 2; ++b)
#pragma unroll
                for (int m = 0; m < 4; ++m)
#pragma unroll
                    for (int n = 0; n < 2; ++n) acc[a][b][m][n] = (f32x4){0.f, 0.f, 0.f, 0.f};
        cur = nxt; cA = nA; cB = nB; ++ui;
    }
    PG8_WAIT_V(0);
    if (wr == 0) PG8_BAR;
    PG8_BAR;
#undef PG8_SA
#undef PG8_SB
#undef PG8_STAGE
#undef PG8_LDA
#undef PG8_LDB
#undef PG8_MMA
#undef PG8_WAIT_V
#undef PG8_WAIT_L
#undef PG8_BAR
#undef PG8_SCHED
}

struct EpiStore {
    static constexpr bool PERM = true;
    bf16_t* O; int ldc;
    __device__ __forceinline__ void operator()(const f32x4 (&acc)[2][2][4][2], const Unit& u, int wr, int wc, int fr, int fq) const {
        const int row0 = u.pm * BM + wr * 64 + fr, col0 = u.pn * BM + wc * 32 + 8 * fq;
#pragma unroll
        for (int ai = 0; ai < 2; ++ai)
#pragma unroll
            for (int m = 0; m < 4; ++m) { bf16_t* rowp = O + (size_t)(row0 + ai * HALF + m * 16) * ldc + col0;
#pragma unroll
                for (int bj = 0; bj < 2; ++bj) { const f32x4 v0 = acc[ai][bj][m][0], v1 = acc[ai][bj][m][1];
                    u32x4 w; w.x = pk2(v0[0], v0[1]); w.y = pk2(v0[2], v0[3]); w.z = pk2(v1[0], v1[1]); w.w = pk2(v1[2], v1[3]);
                    *(u32x4*)(rowp + bj * HALF) = w; } }
    }
};
struct EpiSwiglu {
    static constexpr bool PERM = true;
    bf16_t* O;
    __device__ __forceinline__ void operator()(const f32x4 (&acc)[2][2][4][2], const Unit& u, int wr, int wc, int fr, int fq) const {
        const int row0 = u.pm * BM + wr * 64 + fr, col0 = u.pn * HALF + wc * 32 + 8 * fq;
#pragma unroll
        for (int ai = 0; ai < 2; ++ai)
#pragma unroll
            for (int m = 0; m < 4; ++m) { bf16_t* rowp = O + (size_t)(row0 + ai * HALF + m * 16) * FFH + col0;
                float r[8];
#pragma unroll
                for (int n = 0; n < 2; ++n)
#pragma unroll
                    for (int j = 0; j < 4; ++j) r[n * 4 + j] = silu_f(acc[ai][0][m][n][j]) * acc[ai][1][m][n][j];
                u32x4 w; w.x = pk2(r[0], r[1]); w.y = pk2(r[2], r[3]); w.z = pk2(r[4], r[5]); w.w = pk2(r[6], r[7]);
                *(u32x4*)rowp = w; }
    }
};
struct EpiGlu {
    static constexpr bool PERM = true;
    const bf16_t* Y; const float* bias; bf16_t* O;
    __device__ __forceinline__ void operator()(const f32x4 (&acc)[2][2][4][2], const Unit& u, int wr, int wc, int fr, int fq) const {
        const int row0 = u.pm * BM + wr * 64 + fr, col0 = u.pn * BM + wc * 32 + 8 * fq;
#pragma unroll
        for (int bj = 0; bj < 2; ++bj) {
            const int col = col0 + bj * HALF;
            const f32x4 b0 = *(const f32x4*)(bias + col), b1 = *(const f32x4*)(bias + col + 4);
#pragma unroll
            for (int ai = 0; ai < 2; ++ai)
#pragma unroll
                for (int m = 0; m < 4; ++m) { const size_t row = (size_t)(row0 + ai * HALF + m * 16);
                    const u32x4 yv = *(const u32x4*)(Y + row * 512 + col);
                    const f32x4 v0 = acc[ai][bj][m][0] + b0, v1 = acc[ai][bj][m][1] + b1;
                    float r[8];
                    r[0] = lo_f(yv.x) * sigm_f(v0[0]); r[1] = hi_f(yv.x) * sigm_f(v0[1]); r[2] = lo_f(yv.y) * sigm_f(v0[2]); r[3] = hi_f(yv.y) * sigm_f(v0[3]);
                    r[4] = lo_f(yv.z) * sigm_f(v1[0]); r[5] = hi_f(yv.z) * sigm_f(v1[1]); r[6] = lo_f(yv.w) * sigm_f(v1[2]); r[7] = hi_f(yv.w) * sigm_f(v1[3]);
                    u32x4 w; w.x = pk2(r[0], r[1]); w.y = pk2(r[2], r[3]); w.z = pk2(r[4], r[5]); w.w = pk2(r[6], r[7]);
                    *(u32x4*)(O + row * 1024 + 512 + col) = w; }
        }
    }
};
struct EpiResid {
    static constexpr bool PERM = false;
    const float* res; float* out; const float* gate;
    __device__ __forceinline__ void operator()(const f32x4 (&acc)[2][2][4][2], const Unit& u, int wr, int wc, int fr, int fq) const {
        const int row0 = u.pm * BM + wr * 64 + fr, col0 = u.pn * BM + wc * 32 + 4 * fq;
        const int bidx = (u.pm * BM) >> 12;
        f32x4 gv[2][2];
#pragma unroll
        for (int bj = 0; bj < 2; ++bj)
#pragma unroll
            for (int n = 0; n < 2; ++n) gv[bj][n] = *(const f32x4*)(gate + (size_t)bidx * 6144 + col0 + bj * HALF + n * 16);
#pragma unroll
        for (int ai = 0; ai < 2; ++ai)
#pragma unroll
            for (int m = 0; m < 4; ++m) { const size_t ro = (size_t)(row0 + ai * HALF + m * 16) * 1024 + col0;
#pragma unroll
                for (int bj = 0; bj < 2; ++bj)
#pragma unroll
                    for (int n = 0; n < 2; ++n) { const f32x4 rv = *(const f32x4*)(res + ro + bj * HALF + n * 16);
                        *(f32x4*)(out + ro + bj * HALF + n * 16) = rv + gv[bj][n] * acc[ai][bj][m][n]; } }
    }
};
}

__device__ __forceinline__ void transpose_cvt(LAS float* tile, const float* __restrict__ W, int K, int N, bf16_t* __restrict__ Wt, int mode) {
    const int tid = tid_opaque();
    const int tilesN = N / 64, tilesK = K / 64, ntl = tilesN * tilesK;
    for (int t = blockIdx.x; t < ntl; t += gridDim.x) {
        const int tn = t % tilesN, tk = t / tilesN;
        const int n0d = tn * 64; int n0s = n0d;
        if (mode == 1) { const int tt = n0d >> 8, r0 = n0d & 255; n0s = (r0 < 128) ? tt * 128 + r0 : FFH + tt * 128 + (r0 - 128); }
        const int k0 = tk * 64;
#pragma unroll
        for (int r = 0; r < 8; ++r) { const int kk = (tid >> 6) + 8 * r; tile[kk * 65 + (tid & 63)] = W[(size_t)(k0 + kk) * N + n0s + (tid & 63)]; }
        __syncthreads();
        { const int nn = tid >> 3, kc = (tid & 7) * 8; float v[8];
#pragma unroll
          for (int j = 0; j < 8; ++j) v[j] = tile[(kc + j) * 65 + nn];
          u32x4 w; w.x = pk2(v[0], v[1]); w.y = pk2(v[2], v[3]); w.z = pk2(v[4], v[5]); w.w = pk2(v[6], v[7]);
          *(u32x4*)(Wt + (size_t)(n0d + nn) * K + k0 + kc) = w; }
        __syncthreads();
    }
}

struct S5gp { float lrdt, lidt, fre, fim; };
__device__ __forceinline__ S5gp s5_gp(const Params& p, int g, int pp) {
    S5gp r; const float dt = expf(p.in[15][g]); const float lr = p.in[13][g * 64 + pp], li = p.in[14][g * 64 + pp];
    r.lrdt = lr * dt; r.lidt = li * dt;
    const float mag = expf(r.lrdt), are = mag * cosf(r.lidt), aim = mag * sinf(r.lidt), den = lr * lr + li * li;
    r.fre = ((are - 1.f) * lr + aim * li) / den; r.fim = (aim * lr - (are - 1.f) * li) / den;
    return r;
}
__device__ __forceinline__ f32x2 s5_apow(const S5gp& q, float n) { const float m = expf(n * q.lrdt), a = n * q.lidt; return (f32x2){m * cosf(a), m * sinf(a)}; }

__device__ __forceinline__ void prep_phase(const Params& p, LAS unsigned char* lds) {
    const int tid = tid_opaque();
    unsigned char* ws = p.ws;
    LAS float* tile = (LAS float*)lds;
    transpose_cvt(tile, p.in[8], 1024, 2048, (bf16_t*)(ws + WS_W_ABIN), 0);
    transpose_cvt(tile, p.in[9], 1024, 1024, (bf16_t*)(ws + WS_W_ABOUT), 0);
    transpose_cvt(tile, p.in[21], 512, 512, (bf16_t*)(ws + WS_W_GLU), 0);
    for (int l = 0; l < 2; ++l) {
        transpose_cvt(tile, p.in[6] + (size_t)l * 1024 * 5632, 1024, 5632, (bf16_t*)(ws + WS_W_FFIN) + (size_t)l * 5632 * 1024, 1);
        transpose_cvt(tile, p.in[7] + (size_t)l * FFH * 1024, FFH, 1024, (bf16_t*)(ws + WS_W_FFOUT) + (size_t)l * 1024 * FFH, 0);
    }
    transpose_cvt(tile, p.in[23], 1024, 3584, (bf16_t*)(ws + WS_W_CDIN), 0);
    transpose_cvt(tile, p.in[24], 1024, 1024, (bf16_t*)(ws + WS_W_CDOUT), 0);
    if (blockIdx.x < 192) {
        LAS float* sc = (LAS float*)lds; LAS float* red = (LAS float*)(lds + 65536);
        for (int idx = tid; idx < 16384; idx += NTHR) { const float v = p.in[1][idx]; sc[idx] = v / (1.f + expf(-v)); }
        __syncthreads();
        for (int item = blockIdx.x; item < 192; item += gridDim.x) {
            const int l = item / 96, cb = item % 96, cl = tid & 63, ksl = tid >> 6;
            float acc[16];
#pragma unroll
            for (int b = 0; b < 16; ++b) acc[b] = 0.f;
            const float* w = p.in[2] + (size_t)l * 1024 * 6144 + cb * 64 + cl;
            for (int k = ksl * 128; k < ksl * 128 + 128; ++k) { const float wv = w[(size_t)k * 6144];
#pragma unroll
                for (int b = 0; b < 16; ++b) acc[b] += sc[b * 1024 + k] * wv; }
#pragma unroll
            for (int b = 0; b < 16; ++b) red[(ksl * 16 + b) * 64 + cl] = acc[b];
            __syncthreads();
            for (int o = tid; o < 1024; o += NTHR) { const int b = o >> 6, cc = o & 63; float s = 0.f;
#pragma unroll
                for (int k8 = 0; k8 < 8; ++k8) s += red[(k8 * 16 + b) * 64 + cc];
                ((float*)(ws + WS_MOD))[(size_t)(l * 16 + b) * 6144 + cb * 64 + cc] = s + p.in[3][l * 6144 + cb * 64 + cc]; }
            __syncthreads();
        }
    }
    __syncthreads();
    const int gtid = blockIdx.x * NTHR + tid, nthr = gridDim.x * NTHR;
    for (int idx = gtid; idx < 4096 * 64; idx += nthr) { const int pos = idx >> 6, f = idx & 63;
        const float freq = powf(10000.f, -(float)f / 64.f), ang = (float)pos * freq;
        ((f32x2*)(ws + WS_ROPE))[idx] = (f32x2){cosf(ang), sinf(ang)}; }
    { bf16_t* Mt = (bf16_t*)(ws + WS_S5M); bf16_t* Gt = (bf16_t*)(ws + WS_S5G);
      for (int idx = gtid; idx < 32 * 64 * 64; idx += nthr) { const int g = idx >> 12, pp = (idx >> 6) & 63, s = idx & 63;
          const S5gp q = s5_gp(p, g, pp);
          { const f32x2 a = s5_apow(q, (float)(63 - s));
            unsigned wr_[8], wi_[8];
#pragma unroll
            for (int h2 = 0; h2 < 8; ++h2) { float vr[2], vi[2];
#pragma unroll
                for (int e = 0; e < 2; ++e) { const int h = h2 * 2 + e; const float br = p.in[16][(g * 64 + pp) * 16 + h], bi = p.in[17][(g * 64 + pp) * 16 + h];
                    const float bbr = q.fre * br - q.fim * bi, bbi = q.fre * bi + q.fim * br;
                    vr[e] = a.x * bbr - a.y * bbi; vi[e] = a.x * bbi + a.y * bbr; }
                wr_[h2] = pk2(vr[0], vr[1]); wi_[h2] = pk2(vi[0], vi[1]); }
            u32x4* dr = (u32x4*)(Mt + (size_t)(g * 128 + 2 * pp) * 1024 + s * 16); u32x4* di = (u32x4*)(Mt + (size_t)(g * 128 + 2 * pp + 1) * 1024 + s * 16);
            dr[0] = (u32x4){wr_[0], wr_[1], wr_[2], wr_[3]}; dr[1] = (u32x4){wr_[4], wr_[5], wr_[6], wr_[7]};
            di[0] = (u32x4){wi_[0], wi_[1], wi_[2], wi_[3]}; di[1] = (u32x4){wi_[4], wi_[5], wi_[6], wi_[7]}; }
          { const int t = s; const f32x2 a = s5_apow(q, (float)(t + 1));
#pragma unroll
            for (int h = 0; h < 16; ++h) { const float cr = p.in[18][(g * 16 + h) * 64 + pp], ci = p.in[19][(g * 16 + h) * 64 + pp];
                const float gr = cr * a.x - ci * a.y, gi = cr * a.y + ci * a.x;
                *(unsigned*)(Gt + (size_t)(g * 1024 + t * 16 + h) * 128 + 2 * pp) = pk2(gr, -gi); } }
          if (s == 0) ((f32x2*)(ws + WS_A64))[g * 64 + pp] = s5_apow(q, 64.f);
      }
      LAS f32x2* tp = (LAS f32x2*)lds;
      bf16_t* Kt = (bf16_t*)(ws + WS_KERN);
      for (int item = blockIdx.x; item < 32 * 64; item += gridDim.x) { const int g = item >> 6, tau = item & 63;
          if (tid < 64) { const S5gp q = s5_gp(p, g, tid); const f32x2 a = s5_apow(q, (float)tau); tp[tid] = (f32x2){a.x * q.fre - a.y * q.fim, a.x * q.fim + a.y * q.fre}; }
          __syncthreads();
          if (tid < 256) { const int h = tid >> 4, h2 = tid & 15; float acc = 0.f;
              for (int pp = 0; pp < 64; ++pp) { const f32x2 t = tp[pp]; const float cr = p.in[18][(g * 16 + h) * 64 + pp], ci = p.in[19][(g * 16 + h) * 64 + pp];
                  const float ur = cr * t.x - ci * t.y, ui = cr * t.y + ci * t.x;
                  acc += ur * p.in[16][(g * 64 + pp) * 16 + h2] - ui * p.in[17][(g * 64 + pp) * 16 + h2]; }
              Kt[(size_t)((g * 64 + tau) * 16 + h) * 16 + h2] = f2bf(acc); }
          __syncthreads();
      }
    }
}

__device__ __forceinline__ void norm_phase(const float* __restrict__ x, const float* __restrict__ gw, const float* __restrict__ shift, const float* __restrict__ scale, bf16_t* __restrict__ H) {
    const int tid = tid_opaque(); const int lane = tid & 63, wv = blockIdx.x * 8 + (tid >> 6), nw = gridDim.x * 8;
    for (int row = wv; row < MTOK; row += nw) {
        const int b = row >> 12;
        f32x4 v[4]; float ss = 0.f;
#pragma unroll
        for (int c4 = 0; c4 < 4; ++c4) { v[c4] = *(const f32x4*)(x + (size_t)row * 1024 + c4 * 256 + lane * 4); ss += v[c4][0] * v[c4][0] + v[c4][1] * v[c4][1] + v[c4][2] * v[c4][2] + v[c4][3] * v[c4][3]; }
#pragma unroll
        for (int o = 1; o < 64; o <<= 1) ss += __shfl_xor(ss, o);
        const float r = rsqrtf(ss * (1.f / 1024.f) + 1e-6f);
#pragma unroll
        for (int c4 = 0; c4 < 4; ++c4) { const int col = c4 * 256 + lane * 4;
            const f32x4 g = *(const f32x4*)(gw + col), sc = *(const f32x4*)(scale + (size_t)b * 6144 + col), sh = *(const f32x4*)(shift + (size_t)b * 6144 + col);
            f32x4 o = v[c4] * r * g * (sc + 1.f) + sh;
            *(u32x2*)(H + (size_t)row * 1024 + col) = (u32x2){pk2(o[0], o[1]), pk2(o[2], o[3])}; }
    }
}

__device__ __forceinline__ void load_norm2(const bf16_t* rowp, int g4, const float* gain, float scale, bf16x8 (&out)[2]) {
    const u32x4 r0 = *(const u32x4*)(rowp + 8 * g4), r1 = *(const u32x4*)(rowp + 32 + 8 * g4);
    float v[16];
    v[0] = lo_f(r0.x); v[1] = hi_f(r0.x); v[2] = lo_f(r0.y); v[3] = hi_f(r0.y); v[4] = lo_f(r0.z); v[5] = hi_f(r0.z); v[6] = lo_f(r0.w); v[7] = hi_f(r0.w);
    v[8] = lo_f(r1.x); v[9] = hi_f(r1.x); v[10] = lo_f(r1.y); v[11] = hi_f(r1.y); v[12] = lo_f(r1.z); v[13] = hi_f(r1.z); v[14] = lo_f(r1.w); v[15] = hi_f(r1.w);
    float ss = 0.f;
#pragma unroll
    for (int j = 0; j < 16; ++j) ss += v[j] * v[j];
    ss += __shfl_xor(ss, 16); ss += __shfl_xor(ss, 32);
    const float r = rsqrtf(ss * (1.f / 64.f) + 1e-6f) * scale;
    const f32x4 ga = *(const f32x4*)(gain + 8 * g4), gb = *(const f32x4*)(gain + 8 * g4 + 4), gc = *(const f32x4*)(gain + 32 + 8 * g4), gd = *(const f32x4*)(gain + 36 + 8 * g4);
    u32x4 o0, o1;
    o0.x = pk2(v[0] * r * ga[0], v[1] * r * ga[1]); o0.y = pk2(v[2] * r * ga[2], v[3] * r * ga[3]); o0.z = pk2(v[4] * r * gb[0], v[5] * r * gb[1]); o0.w = pk2(v[6] * r * gb[2], v[7] * r * gb[3]);
    o1.x = pk2(v[8] * r * gc[0], v[9] * r * gc[1]); o1.y = pk2(v[10] * r * gc[2], v[11] * r * gc[3]); o1.z = pk2(v[12] * r * gd[0], v[13] * r * gd[1]); o1.w = pk2(v[14] * r * gd[2], v[15] * r * gd[3]);
    out[0] = as_frag(o0); out[1] = as_frag(o1);
}

constexpr int VS = 72;
constexpr int VL_BYTES = 64 * VS * 2;

__device__ __forceinline__ void attnA_phase(const Params& p, LAS unsigned char* lds) {
    const int tid = tid_opaque(), wid = tid >> 6, lane = tid & 63, li = lane & 15, g4 = lane >> 4;
    const bf16_t* QKV = (const bf16_t*)(p.ws + WS_R1);
    bf16_t* MIX = (bf16_t*)(p.ws + WS_MIX);
    LAS bf16_t* Vl = (LAS bf16_t*)(lds + wid * VL_BYTES);
    LAS float* bl = (LAS float*)(lds + 8 * VL_BYTES);
    for (int idx = tid; idx < 8 * 257; idx += NTHR) bl[(idx / 257) * 260 + (idx % 257)] = p.in[12][idx];
    __syncthreads();
    const int h = wid;
    LAS float* bh = bl + h * 260;
    for (int item2 = blockIdx.x; item2 < 2048; item2 += gridDim.x) {
        const int item = item2 >> 1, qh = item2 & 1;
        const int b = item >> 6, ci = item & 63;
        const size_t rowbase = (size_t)b * SEQ + ci * 64 + qh * 32;
        bf16x8 qf[2][2];
#pragma unroll
        for (int qt = 0; qt < 2; ++qt) load_norm2(QKV + (rowbase + qt * 16 + li) * 2048 + h * 64, g4, p.in[10], 0.125f, qf[qt]);
        f32x4 o[4][2]; float mrun[2], lsum[2];
#pragma unroll
        for (int qt = 0; qt < 2; ++qt) { mrun[qt] = -1e30f; lsum[qt] = 0.f;
#pragma unroll
            for (int dt = 0; dt < 4; ++dt) o[dt][qt] = (f32x4){0.f, 0.f, 0.f, 0.f}; }
        const int kb0 = ci >= 8 ? 0 : 8 - ci;
        for (int kb = kb0; kb <= 8; ++kb) {
            const size_t krow = (size_t)b * SEQ + (size_t)(ci - 8 + kb) * 64;
#pragma unroll
            for (int r = 0; r < 8; ++r) { const int row = r * 8 + (lane >> 3), c8 = lane & 7;
                *(LAS u32x4*)(Vl + row * VS + c8 * 8) = *(const u32x4*)(QKV + (krow + row) * 2048 + 1024 + h * 64 + c8 * 8); }
            f32x4 s[4][2];
#pragma unroll
            for (int kt = 0; kt < 4; ++kt) { bf16x8 kf[2]; load_norm2(QKV + (krow + kt * 16 + li) * 2048 + 512 + h * 64, g4, p.in[11], 1.f, kf);
#pragma unroll
                for (int qt = 0; qt < 2; ++qt) { f32x4 z = (f32x4){0.f, 0.f, 0.f, 0.f}; z = mfma16(kf[0], qf[qt][0], z); z = mfma16(kf[1], qf[qt][1], z); s[kt][qt] = z; } }
            wave_lds_fence();
#pragma unroll
            for (int qt = 0; qt < 2; ++qt) {
                float mx = -1e30f;
#pragma unroll
                for (int kt = 0; kt < 4; ++kt)
#pragma unroll
                    for (int jj = 0; jj < 4; ++jj) { int rel = 512 + qh * 32 + qt * 16 + li - kb * 64 - (kt * 16 + 4 * g4 + jj); rel = rel > 128 ? 128 : (rel < -128 ? -128 : rel);
                        const float v = s[kt][qt][jj] + bh[rel + 128]; s[kt][qt][jj] = v; mx = fmaxf(mx, v); }
                mx = fmaxf(mx, __shfl_xor(mx, 16)); mx = fmaxf(mx, __shfl_xor(mx, 32));
                const float mnew = fmaxf(mrun[qt], mx), alpha = __expf(mrun[qt] - mnew);
                mrun[qt] = mnew; float ps = 0.f;
#pragma unroll
                for (int kt = 0; kt < 4; ++kt)
#pragma unroll
                    for (int jj = 0; jj < 4; ++jj) { const float e = __expf(s[kt][qt][jj] - mnew); s[kt][qt][jj] = e; ps += e; }
                lsum[qt] = lsum[qt] * alpha + ps;
#pragma unroll
                for (int dt = 0; dt < 4; ++dt) o[dt][qt] *= alpha;
#pragma unroll
                for (int kk = 0; kk < 2; ++kk) { u32x4 w; w.x = pk2(s[2 * kk][qt][0], s[2 * kk][qt][1]); w.y = pk2(s[2 * kk][qt][2], s[2 * kk][qt][3]);
                    w.z = pk2(s[2 * kk + 1][qt][0], s[2 * kk + 1][qt][1]); w.w = pk2(s[2 * kk + 1][qt][2], s[2 * kk + 1][qt][3]); const bf16x8 pfr = as_frag(w);
#pragma unroll
                    for (int dt = 0; dt < 4; ++dt) { const bf16x8 vf = tr_pair(Vl, VS, 32 * kk + 4 * g4, 32 * kk + 16 + 4 * g4, dt * 16, li); o[dt][qt] = mfma16(vf, pfr, o[dt][qt]); } }
            }
            wave_lds_fence();
        }
#pragma unroll
        for (int qt = 0; qt < 2; ++qt) { float l = lsum[qt]; l += __shfl_xor(l, 16); l += __shfl_xor(l, 32); const float inv = 1.f / l;
#pragma unroll
            for (int dt = 0; dt < 4; ++dt) { const f32x4 v = o[dt][qt] * inv;
                *(u32x2*)(MIX + (rowbase + qt * 16 + li) * 1024 + h * 64 + dt * 16 + 4 * g4) = (u32x2){pk2(v[0], v[1]), pk2(v[2], v[3])}; } }
    }
}

__device__ __forceinline__ void s5a_phase(const Params& p) {
    const int tid = tid_opaque(); const int lane = tid & 63, li = lane & 15, g4 = lane >> 4;
    const bf16_t* QKV = (const bf16_t*)(p.ws + WS_R1);
    const bf16_t* Mt = (const bf16_t*)(p.ws + WS_S5M);
    float* E = (float*)(p.ws + WS_S5E);
    const int wv = blockIdx.x * 8 + (tid >> 6), nw = gridDim.x * 8;
    for (int item = wv; item < 2048; item += nw) {
        const int g = item & 31, c = item >> 5;
        f32x4 acc[8];
#pragma unroll
        for (int pt = 0; pt < 8; ++pt) acc[pt] = (f32x4){0.f, 0.f, 0.f, 0.f};
        const bf16_t* ub = QKV + ((size_t)li * SEQ + c * 64 + (g4 >> 1)) * 2048 + 1536 + g * 16 + 8 * (g4 & 1);
        const bf16_t* mb = Mt + (size_t)(g * 128 + li) * 1024 + 8 * g4;
        for (int ks = 0; ks < 32; ++ks) {
            const bf16x8 bfr = *(const bf16x8*)(ub + (size_t)(2 * ks) * 2048);
#pragma unroll
            for (int pt = 0; pt < 8; ++pt) { const bf16x8 afr = *(const bf16x8*)(mb + (size_t)pt * 16 * 1024 + 32 * ks); acc[pt] = mfma16(afr, bfr, acc[pt]); }
        }
#pragma unroll
        for (int pt = 0; pt < 8; ++pt) *(f32x4*)(E + ((size_t)(c * 32 + g) * 16 + li) * 128 + pt * 16 + 4 * g4) = acc[pt];
    }
}
__device__ __forceinline__ void s5scan_phase(const Params& p) {
    const float* E = (const float*)(p.ws + WS_S5E);
    bf16_t* X = (bf16_t*)(p.ws + WS_S5X);
    const f32x2* A64 = (const f32x2*)(p.ws + WS_A64);
    const int gtid = blockIdx.x * NTHR + tid_opaque();
    if (gtid < 32 * 16 * 64) {
        const int pp = gtid & 63, b = (gtid >> 6) & 15, g = gtid >> 10;
        const f32x2 a = A64[g * 64 + pp];
        float xr = 0.f, xi = 0.f;
        for (int c0 = 0; c0 < 64; c0 += 8) {
            f32x2 e[8];
#pragma unroll
            for (int k = 0; k < 8; ++k) e[k] = *(const f32x2*)(E + ((size_t)((c0 + k) * 32 + g) * 16 + b) * 128 + 2 * pp);
#pragma unroll
            for (int k = 0; k < 8; ++k) {
                *(unsigned*)(X + ((size_t)((c0 + k) * 32 + g) * 16 + b) * 128 + 2 * pp) = pk2(xr, xi);
                const float nr = a.x * xr - a.y * xi + e[k].x, ni = a.x * xi + a.y * xr + e[k].y; xr = nr; xi = ni; }
        }
    }
}
__device__ __forceinline__ void s5c_phase(const Params& p, LAS unsigned char* lds) {
    const int tid = tid_opaque(), wid = tid >> 6, lane = tid & 63, li = lane & 15, g4 = lane >> 4;
    const bf16_t* QKV = (const bf16_t*)(p.ws + WS_R1);
    const bf16_t* Kt = (const bf16_t*)(p.ws + WS_KERN);
    const bf16_t* Gt = (const bf16_t*)(p.ws + WS_S5G);
    const bf16_t* X = (const bf16_t*)(p.ws + WS_S5X);
    bf16_t* Y5 = (bf16_t*)(p.ws + WS_Y5);
    LAS bf16_t* kl = (LAS bf16_t*)lds;
    LAS bf16_t* ul = (LAS bf16_t*)(lds + 32768);
    int gl = -1;
    for (int item = blockIdx.x; item < 2048; item += gridDim.x) {
        const int g = item & 31, c = item >> 5;
        __syncthreads();
        if (g != gl) { for (int idx = tid; idx < 2048; idx += NTHR) *(LAS u32x4*)(kl + idx * 8) = *(const u32x4*)(Kt + (size_t)g * 16384 + idx * 8); gl = g; }
        for (int idx = tid; idx < 2048; idx += NTHR) { const int hh = idx & 1, b = (idx >> 1) & 15, s = idx >> 5;
            *(LAS u32x4*)(ul + (s * 16 + b) * 16 + hh * 8) = *(const u32x4*)(QKV + ((size_t)b * SEQ + c * 64 + s) * 2048 + 1536 + g * 16 + hh * 8); }
        bf16x8 xf[4];
#pragma unroll
        for (int ks = 0; ks < 4; ++ks) xf[ks] = *(const bf16x8*)(X + ((size_t)(c * 32 + g) * 16 + li) * 128 + 32 * ks + 8 * g4);
        __syncthreads();
        const f32x4 dsk = *(const f32x4*)(p.in[20] + g * 16 + 4 * g4);
        for (int tt = 0; tt < 8; ++tt) {
            const int t = wid + 8 * tt;
            f32x4 acc = (f32x4){0.f, 0.f, 0.f, 0.f};
#pragma unroll
            for (int ks = 0; ks < 4; ++ks) { const bf16x8 afr = *(const bf16x8*)(Gt + (size_t)(g * 1024 + t * 16 + li) * 128 + 32 * ks + 8 * g4); acc = mfma16(afr, xf[ks], acc); }
            const int nks = (t >> 1) + 1;
            for (int ks = 0; ks < nks; ++ks) {
                const int s = 2 * ks + (g4 >> 1); int tau = t - s; const bool ok = tau >= 0; tau = ok ? tau : 0;
                u32x4 av = *(const LAS u32x4*)(kl + (tau * 16 + li) * 16 + 8 * (g4 & 1));
                if (!ok) av = (u32x4){0u, 0u, 0u, 0u};
                const bf16x8 bfr = *(const LAS bf16x8*)(ul + (s * 16 + li) * 16 + 8 * (g4 & 1));
                acc = mfma16(as_frag(av), bfr, acc);
            }
            const u32x2 uu = *(const LAS u32x2*)(ul + (t * 16 + li) * 16 + 4 * g4);
            float y0 = acc[0] + dsk[0] * lo_f(uu.x), y1 = acc[1] + dsk[1] * hi_f(uu.x), y2 = acc[2] + dsk[2] * lo_f(uu.y), y3 = acc[3] + dsk[3] * hi_f(uu.y);
            y0 = gelu_tanh(y0); y1 = gelu_tanh(y1); y2 = gelu_tanh(y2); y3 = gelu_tanh(y3);
            *(u32x2*)(Y5 + ((size_t)li * SEQ + c * 64 + t) * 512 + g * 16 + 4 * g4) = (u32x2){pk2(y0, y1), pk2(y2, y3)};
        }
    }
}

#ifndef SB_EARLY_EXIT
#define SB_EARLY_EXIT 0
#endif
__device__ __forceinline__ void sb_phase(const Params& p, LAS unsigned char* lds) {
    const int tid = tid_opaque(), wid = tid >> 6, lane = tid & 63, li = lane & 15, g4 = lane >> 4;
    const bf16_t* QKV = (const bf16_t*)(p.ws + WS_R1);
    bf16_t* MIX = (bf16_t*)(p.ws + WS_MIX);
    LAS bf16_t* Vl = (LAS bf16_t*)(lds + wid * VL_BYTES);
    const int wv = blockIdx.x * 8 + wid, nw = gridDim.x * 8;
    const unsigned ONES = 0x3F803F80u;
    u32x2 dpat; dpat.x = ((4 * g4 + 0 > li) ? 0x3F80u : 0u) | ((4 * g4 + 1 > li) ? 0x3F800000u : 0u); dpat.y = ((4 * g4 + 2 > li) ? 0x3F80u : 0u) | ((4 * g4 + 3 > li) ? 0x3F800000u : 0u);
    for (int it = wv; it < 8192; it += nw) {
        const int bh = it >> 6, pr = it & 63, b = bh >> 3, h = bh & 7;
        for (int half = 0; half < 2; ++half) {
            const int qtile = half ? 127 - pr : pr, t0 = qtile * 32, kbd = t0 >> 6;
            const bf16_t* qb = QKV + ((size_t)b * SEQ + t0) * 3584 + 2048 + h * 64;
            bf16x8 qf[2][2];
#pragma unroll
            for (int qt = 0; qt < 2; ++qt)
#pragma unroll
                for (int ks = 0; ks < 2; ++ks) qf[qt][ks] = *(const bf16x8*)(qb + (size_t)(qt * 16 + li) * 3584 + 32 * ks + 8 * g4);
            f32x4 o[4][2]; float R[2];
#pragma unroll
            for (int qt = 0; qt < 2; ++qt) { R[qt] = 0.f;
#pragma unroll
                for (int dt = 0; dt < 4; ++dt) o[dt][qt] = (f32x4){0.f, 0.f, 0.f, 0.f}; }
            for (int kb = kbd; kb >= 0; --kb) {
                const bf16_t* kbase = QKV + ((size_t)b * SEQ + kb * 64) * 3584 + 2560 + h * 64;
#pragma unroll
                for (int r = 0; r < 8; ++r) { const int row = r * 8 + (lane >> 3), c8 = lane & 7;
                    *(LAS u32x4*)(Vl + row * VS + c8 * 8) = *(const u32x4*)(kbase + (size_t)row * 3584 + 512 + c8 * 8); }
                bf16x8 kf[4][2];
#pragma unroll
                for (int kt = 0; kt < 4; ++kt)
#pragma unroll
                    for (int ks = 0; ks < 2; ++ks) kf[kt][ks] = *(const bf16x8*)(kbase + (size_t)(kt * 16 + li) * 3584 + 32 * ks + 8 * g4);
                wave_lds_fence();
                const bool diag = (kb == kbd);
                const int kpos0 = kb * 64 + 4 * g4;
#pragma unroll
                for (int qt = 0; qt < 2; ++qt) {
                    const int qpos = t0 + qt * 16 + li;
                    f32x4 z[4];
#pragma unroll
                    for (int kt = 0; kt < 4; ++kt) { f32x4 a = (f32x4){0.f, 0.f, 0.f, 0.f}; a = mfma16(kf[kt][0], qf[qt][0], a); a = mfma16(kf[kt][1], qf[qt][1], a); z[kt] = a; }
                    float T = 0.f; unsigned hi[4][2], lo[4][2];
#pragma unroll
                    for (int kt = 0; kt < 4; ++kt) { float Lv[4];
#pragma unroll
                        for (int jj = 0; jj < 4; ++jj) { const float zz = z[kt][jj] * 0.125f;
                            const bool valid = !diag || (kpos0 + kt * 16 + jj < qpos);
                            const float sp = fmaxf(zz, 0.f) + __logf(1.f + __expf(-fabsf(zz)));
                            Lv[jj] = valid ? -sp : 0.f; T += Lv[jj];
                            z[kt][jj] = valid ? (zz - sp) : -1e30f; }
                        hi[kt][0] = pk2(Lv[0], Lv[1]); hi[kt][1] = pk2(Lv[2], Lv[3]);
                        lo[kt][0] = pk2(Lv[0] - lo_f(hi[kt][0]), Lv[1] - hi_f(hi[kt][0])); lo[kt][1] = pk2(Lv[2] - lo_f(hi[kt][1]), Lv[3] - hi_f(hi[kt][1])); }
                    T += __shfl_xor(T, 16); T += __shfl_xor(T, 32);
                    bf16x8 Lh[2], Ll[2];
#pragma unroll
                    for (int kk = 0; kk < 2; ++kk) { Lh[kk] = as_frag((u32x4){hi[2 * kk][0], hi[2 * kk][1], hi[2 * kk + 1][0], hi[2 * kk + 1][1]});
                        Ll[kk] = as_frag((u32x4){lo[2 * kk][0], lo[2 * kk][1], lo[2 * kk + 1][0], lo[2 * kk + 1][1]}); }
                    unsigned pw[4][2];
#pragma unroll
                    for (int st = 0; st < 4; ++st) { f32x4 ce = (f32x4){0.f, 0.f, 0.f, 0.f};
#pragma unroll
                        for (int kk = 0; kk < 2; ++kk) { if (2 * kk + 1 >= st) {
                            u32x4 ua;
                            { const int k0 = 2 * kk, k1 = 2 * kk + 1;
                              ua.x = k0 > st ? ONES : (k0 == st ? dpat.x : 0u); ua.y = k0 > st ? ONES : (k0 == st ? dpat.y : 0u);
                              ua.z = k1 > st ? ONES : (k1 == st ? dpat.x : 0u); ua.w = k1 > st ? ONES : (k1 == st ? dpat.y : 0u); }
                            ce = mfma16(as_frag(ua), Lh[kk], ce); ce = mfma16(as_frag(ua), Ll[kk], ce); } }
                        float w[4];
#pragma unroll
                        for (int jj = 0; jj < 4; ++jj) w[jj] = __expf(z[st][jj] + R[qt] + ce[jj]);
                        pw[st][0] = pk2(w[0], w[1]); pw[st][1] = pk2(w[2], w[3]); }
                    R[qt] += T;
#pragma unroll
                    for (int kk = 0; kk < 2; ++kk) { const bf16x8 pfr = as_frag((u32x4){pw[2 * kk][0], pw[2 * kk][1], pw[2 * kk + 1][0], pw[2 * kk + 1][1]});
#pragma unroll
                        for (int dt = 0; dt < 4; ++dt) { const bf16x8 vf = tr_pair(Vl, VS, 32 * kk + 4 * g4, 32 * kk + 16 + 4 * g4, dt * 16, li); o[dt][qt] = mfma16(vf, pfr, o[dt][qt]); } }
                }
                wave_lds_fence();
#if SB_EARLY_EXIT
                { const float rm = fmaxf(R[0], R[1]); if (__all(rm < -120.f)) break; }
#endif
            }
#pragma unroll
            for (int qt = 0; qt < 2; ++qt)
#pragma unroll
                for (int dt = 0; dt < 4; ++dt) { const f32x4 v = o[dt][qt];
                    *(u32x2*)(MIX + ((size_t)b * SEQ + t0 + qt * 16 + li) * 1024 + 512 + h * 64 + dt * 16 + 4 * g4) = (u32x2){pk2(v[0], v[1]), pk2(v[2], v[3])}; }
        }
    }
}

constexpr int RS = 136;
__device__ __forceinline__ float ret_log_gamma(int h) { return logf(1.f - exp2f(-5.f - (float)h)); }
template <int MODE  >
__device__ __forceinline__ void ret_load_rot(LAS bf16_t* dst, const bf16_t* src  , const f32x2* rope, int pos0, float lg, float scl) {
    const int tid = tid_opaque(), j = tid >> 3, part = tid & 7;
    const u32x4 a = *(const u32x4*)(src + (size_t)j * 3584 + part * 8), bq = *(const u32x4*)(src + (size_t)j * 3584 + 64 + part * 8);
    const f32x2* cs = rope + (size_t)(pos0 + j) * 64 + part * 8;
    float x1[8] = {lo_f(a.x), hi_f(a.x), lo_f(a.y), hi_f(a.y), lo_f(a.z), hi_f(a.z), lo_f(a.w), hi_f(a.w)};
    float x2[8] = {lo_f(bq.x), hi_f(bq.x), lo_f(bq.y), hi_f(bq.y), lo_f(bq.z), hi_f(bq.z), lo_f(bq.w), hi_f(bq.w)};
    const float rsc = MODE == 0 ? scl * __expf(lg * (63.f - (float)j)) : scl;
    float o1[8], o2[8];
#pragma unroll
    for (int e = 0; e < 8; ++e) { const f32x2 c = cs[e]; o1[e] = (x1[e] * c.x - x2[e] * c.y) * rsc; o2[e] = (x1[e] * c.y + x2[e] * c.x) * rsc; }
    *(LAS u32x4*)(dst + j * RS + part * 8) = (u32x4){pk2(o1[0], o1[1]), pk2(o1[2], o1[3]), pk2(o1[4], o1[5]), pk2(o1[6], o1[7])};
    *(LAS u32x4*)(dst + j * RS + 64 + part * 8) = (u32x4){pk2(o2[0], o2[1]), pk2(o2[2], o2[3]), pk2(o2[4], o2[5]), pk2(o2[6], o2[7])};
}
__device__ __forceinline__ void ret_load_plain(LAS bf16_t* dst, const bf16_t* src) {
    const int tid = tid_opaque(), j = tid >> 3, part = tid & 7;
    *(LAS u32x4*)(dst + j * RS + part * 16) = *(const u32x4*)(src + (size_t)j * 3584 + part * 16);
    *(LAS u32x4*)(dst + j * RS + part * 16 + 8) = *(const u32x4*)(src + (size_t)j * 3584 + part * 16 + 8);
}
__device__ __forceinline__ void reta_phase(const Params& p, LAS unsigned char* lds) {
    const int tid = tid_opaque(), wid = tid >> 6, lane = tid & 63, li = lane & 15, g4 = lane >> 4;
    const bf16_t* QKV = (const bf16_t*)(p.ws + WS_R1);
    const f32x2* rope = (const f32x2*)(p.ws + WS_ROPE);
    bf16_t* RET = (bf16_t*)(p.ws + WS_H);
    LAS bf16_t* Kl = (LAS bf16_t*)lds; LAS bf16_t* Vl = (LAS bf16_t*)(lds + 64 * RS * 2);
    for (int item = blockIdx.x; item < 4096; item += gridDim.x) {
        const int c = item & 63, hh = (item >> 6) & 3, b = item >> 8;
        const float lg = ret_log_gamma(hh);
        const bf16_t* base = QKV + ((size_t)b * SEQ + c * 64) * 3584 + hh * 128;
        __syncthreads();
        ret_load_rot<0>(Kl, base + 512, rope, c * 64, lg, 0.08838834764831845f);
        ret_load_plain(Vl, base + 1024);
        __syncthreads();
        f32x4 acc[8];
#pragma unroll
        for (int et = 0; et < 8; ++et) acc[et] = (f32x4){0.f, 0.f, 0.f, 0.f};
#pragma unroll
        for (int kk = 0; kk < 2; ++kk) { const bf16x8 af = tr_pair(Kl, RS, 32 * kk + 8 * g4, 32 * kk + 8 * g4 + 4, wid * 16, li);
#pragma unroll
            for (int et = 0; et < 8; ++et) { const bf16x8 bfr = tr_pair(Vl, RS, 32 * kk + 8 * g4, 32 * kk + 8 * g4 + 4, et * 16, li); acc[et] = mfma16(af, bfr, acc[et]); } }
        const size_t sid = (size_t)((b * 4 + hh) * 64 + c);
#pragma unroll
        for (int et = 0; et < 8; ++et) *(u32x2*)(RET + (sid * 128 + et * 16 + li) * 128 + wid * 16 + 4 * g4) = (u32x2){pk2(acc[et][0], acc[et][1]), pk2(acc[et][2], acc[et][3])};
    }
}
__device__ __forceinline__ void retscan_phase(const Params& p) {
    bf16_t* RET = (bf16_t*)(p.ws + WS_H);
    const int gtid = blockIdx.x * NTHR + tid_opaque(), nthr = gridDim.x * NTHR;
    for (int w = gtid; w < 64 * 2048; w += nthr) {
        const int bhh = w >> 11, e8 = w & 2047, hh = bhh & 3;
        const float cd = __expf(64.f * ret_log_gamma(hh));
        float S[8];
#pragma unroll
        for (int e = 0; e < 8; ++e) S[e] = 0.f;
        bf16_t* base = RET + (size_t)bhh * 64 * 16384 + e8 * 8;
        for (int c0 = 0; c0 < 64; c0 += 4) {
            u32x4 kv[4];
#pragma unroll
            for (int k = 0; k < 4; ++k) kv[k] = *(const u32x4*)(base + (size_t)(c0 + k) * 16384);
#pragma unroll
            for (int k = 0; k < 4; ++k) {
                *(u32x4*)(base + (size_t)(c0 + k) * 16384) = (u32x4){pk2(S[0], S[1]), pk2(S[2], S[3]), pk2(S[4], S[5]), pk2(S[6], S[7])};
                S[0] = S[0] * cd + lo_f(kv[k].x); S[1] = S[1] * cd + hi_f(kv[k].x); S[2] = S[2] * cd + lo_f(kv[k].y); S[3] = S[3] * cd + hi_f(kv[k].y);
                S[4] = S[4] * cd + lo_f(kv[k].z); S[5] = S[5] * cd + hi_f(kv[k].z); S[6] = S[6] * cd + lo_f(kv[k].w); S[7] = S[7] * cd + hi_f(kv[k].w); }
        }
    }
}
__device__ __forceinline__ void retc_phase(const Params& p, LAS unsigned char* lds) {
    const int tid = tid_opaque(), wid = tid >> 6, lane = tid & 63, li = lane & 15, g4 = lane >> 4;
    const bf16_t* QKV = (const bf16_t*)(p.ws + WS_R1);
    const f32x2* rope = (const f32x2*)(p.ws + WS_ROPE);
    const bf16_t* RET = (const bf16_t*)(p.ws + WS_H);
    bf16_t* MIX = (bf16_t*)(p.ws + WS_MIX);
    LAS bf16_t* Ql = (LAS bf16_t*)lds; LAS bf16_t* Kl = (LAS bf16_t*)(lds + 17408); LAS bf16_t* Vl = (LAS bf16_t*)(lds + 34816);
    LAS bf16_t* Sl = (LAS bf16_t*)(lds + 52224);
    LAS f32x2* stl = (LAS f32x2*)(lds + 61440);
    for (int item = blockIdx.x; item < 4096; item += gridDim.x) {
        const int c = item & 63, hh = (item >> 6) & 3, b = item >> 8;
        const float lg = ret_log_gamma(hh);
        const size_t row0 = (size_t)b * SEQ + c * 64;
        const bf16_t* base = QKV + row0 * 3584 + hh * 128;
        __syncthreads();
        ret_load_rot<1>(Ql, base, rope, c * 64, lg, 1.f);
        ret_load_rot<1>(Kl, base + 512, rope, c * 64, lg, 0.08838834764831845f);
        ret_load_plain(Vl, base + 1024);
        __syncthreads();
        { const int jt = wid >> 1;
#pragma unroll
          for (int e2 = 0; e2 < 2; ++e2) { const int itq = 2 * (wid & 1) + e2; f32x4 sacc = (f32x4){0.f, 0.f, 0.f, 0.f};
#pragma unroll
              for (int ks = 0; ks < 4; ++ks) { const bf16x8 af = *(const LAS bf16x8*)(Kl + (jt * 16 + li) * RS + 32 * ks + 8 * g4); const bf16x8 bfr = *(const LAS bf16x8*)(Ql + (itq * 16 + li) * RS + 32 * ks + 8 * g4); sacc = mfma16(af, bfr, sacc); }
              float sv[4];
#pragma unroll
              for (int jj = 0; jj < 4; ++jj) { const int j = jt * 16 + 4 * g4 + jj, iq = itq * 16 + li; const int dd = iq > j ? iq - j : j - iq; sv[jj] = sacc[jj] * __expf(lg * (float)dd); }
              *(LAS u32x2*)(Sl + (itq * 16 + li) * VS + jt * 16 + 4 * g4) = (u32x2){pk2(sv[0], sv[1]), pk2(sv[2], sv[3])}; } }
        __syncthreads();
        f32x4 oa[4];
#pragma unroll
        for (int itq = 0; itq < 4; ++itq) oa[itq] = (f32x4){0.f, 0.f, 0.f, 0.f};
        const size_t sid = (size_t)((b * 4 + hh) * 64 + c);
#pragma unroll
        for (int ks = 0; ks < 4; ++ks) { const bf16x8 af = *(const bf16x8*)(RET + (sid * 128 + wid * 16 + li) * 128 + 32 * ks + 8 * g4);
#pragma unroll
            for (int itq = 0; itq < 4; ++itq) { const bf16x8 bfr = *(const LAS bf16x8*)(Ql + (itq * 16 + li) * RS + 32 * ks + 8 * g4); oa[itq] = mfma16(af, bfr, oa[itq]); } }
#pragma unroll
        for (int itq = 0; itq < 4; ++itq) oa[itq] *= __expf(lg * (float)(itq * 16 + li + 1));
#pragma unroll
        for (int kk = 0; kk < 2; ++kk) { const bf16x8 af = tr_pair(Vl, RS, 32 * kk + 8 * g4, 32 * kk + 8 * g4 + 4, wid * 16, li);
#pragma unroll
            for (int itq = 0; itq < 4; ++itq) { const bf16x8 bfr = *(const LAS bf16x8*)(Sl + (itq * 16 + li) * VS + 32 * kk + 8 * g4); oa[itq] = mfma16(af, bfr, oa[itq]); } }
#pragma unroll
        for (int itq = 0; itq < 4; ++itq) { float s1 = oa[itq][0] + oa[itq][1] + oa[itq][2] + oa[itq][3];
            float s2 = oa[itq][0] * oa[itq][0] + oa[itq][1] * oa[itq][1] + oa[itq][2] * oa[itq][2] + oa[itq][3] * oa[itq][3];
            s1 += __shfl_xor(s1, 16); s1 += __shfl_xor(s1, 32); s2 += __shfl_xor(s2, 16); s2 += __shfl_xor(s2, 32);
            if (g4 == 0) stl[wid * 64 + itq * 16 + li] = (f32x2){s1, s2}; }
        __syncthreads();
        const f32x4 ng = *(const f32x4*)(p.in[25] + hh * 128 + wid * 16 + 4 * g4);
#pragma unroll
        for (int itq = 0; itq < 4; ++itq) { float s1 = 0.f, s2 = 0.f;
#pragma unroll
            for (int w8 = 0; w8 < 8; ++w8) { const f32x2 t = stl[w8 * 64 + itq * 16 + li]; s1 += t.x; s2 += t.y; }
            const float mu = s1 * (1.f / 128.f), var = fmaxf(s2 * (1.f / 128.f) - mu * mu, 0.f), rs = rsqrtf(var + 1e-6f);
            const size_t row = row0 + itq * 16 + li;
            const u32x2 gg = *(const u32x2*)(QKV + row * 3584 + 1536 + hh * 128 + wid * 16 + 4 * g4);
            const float r0 = (oa[itq][0] - mu) * rs * ng[0] * silu_f(lo_f(gg.x)), r1 = (oa[itq][1] - mu) * rs * ng[1] * silu_f(hi_f(gg.x));
            const float r2 = (oa[itq][2] - mu) * rs * ng[2] * silu_f(lo_f(gg.y)), r3 = (oa[itq][3] - mu) * rs * ng[3] * silu_f(hi_f(gg.y));
            *(u32x2*)(MIX + row * 1024 + hh * 128 + wid * 16 + 4 * g4) = (u32x2){pk2(r0, r1), pk2(r2, r3)}; }
    }
}

constexpr int N_PHASES = 20;
__global__ void __launch_bounds__(NTHR, 2) mega_fwd(Params p) {
    extern __shared__ __attribute__((aligned(16))) unsigned char lds_raw[];
    LAS unsigned char* lds = (LAS unsigned char*)lds_raw;
    cg::grid_group grid = cg::this_grid();
    unsigned char* ws = p.ws;
    const float* MOD = (const float*)(ws + WS_MOD);
    bf16_t* H = (bf16_t*)(ws + WS_H); bf16_t* MIX = (bf16_t*)(ws + WS_MIX); bf16_t* R1 = (bf16_t*)(ws + WS_R1);
    float* XA = p.out;
    pg8::StaticOrder S;
    for (int ph = p.ph_lo; ph < p.ph_hi; ++ph) {
        const int layer = ph >= 11 ? 1 : 0;
        const float* modl = MOD + (size_t)layer * 16 * 6144;
        switch (ph) {
        case 0: prep_phase(p, lds); break;
        case 1: case 8: case 11: case 17: {
            const bool ffn = (ph == 8 || ph == 17);
            const float* xin = (ph == 1) ? p.in[0] : XA;
            norm_phase(xin, (ffn ? p.in[5] : p.in[4]) + layer * 1024, modl + (ffn ? 3072 : 0), modl + (ffn ? 4096 : 1024), H);
        } break;
        case 2: case 12: {
            const int N = layer ? 3584 : 2048;
            pg8::Gemm g{H, (const bf16_t*)(ws + (layer ? WS_W_CDIN : WS_W_ABIN)), MTOK, N, 1024};
            S.init(MTOK, N, gridDim.x, blockIdx.x);
            pg8::EpiStore E{R1, N};
            pg8::gemm_phase(lds, g, S, E);
        } break;
        case 3: attnA_phase(p, lds); s5a_phase(p); break;
        case 4: s5scan_phase(p); break;
        case 5: s5c_phase(p, lds); break;
        case 6: {
            pg8::Gemm g{(const bf16_t*)(ws + WS_Y5), (const bf16_t*)(ws + WS_W_GLU), MTOK, 512, 512};
            S.init(MTOK, 512, gridDim.x, blockIdx.x);
            pg8::EpiGlu E{(const bf16_t*)(ws + WS_Y5), p.in[22], MIX};
            pg8::gemm_phase(lds, g, S, E);
        } break;
        case 7: case 16: case 10: case 19: {
            const bool ffn = (ph == 10 || ph == 19);
            const bf16_t* A = ffn ? R1 : MIX;
            const bf16_t* Bt = ffn ? (const bf16_t*)(ws + WS_W_FFOUT) + (size_t)layer * 1024 * FFH : (const bf16_t*)(ws + (layer ? WS_W_CDOUT : WS_W_ABOUT));
            pg8::Gemm g{A, Bt, MTOK, 1024, ffn ? FFH : 1024};
            S.init(MTOK, 1024, gridDim.x, blockIdx.x);
            pg8::EpiResid E{(ph == 7) ? p.in[0] : XA, XA, modl + (ffn ? 5120 : 2048)};
            pg8::gemm_phase(lds, g, S, E);
        } break;
        case 9: case 18: {
            pg8::Gemm g{H, (const bf16_t*)(ws + WS_W_FFIN) + (size_t)layer * 5632 * 1024, MTOK, 5632, 1024};
            S.init(MTOK, 5632, gridDim.x, blockIdx.x);
            pg8::EpiSwiglu E{R1};
            pg8::gemm_phase(lds, g, S, E);
        } break;
        case 13: reta_phase(p, lds); __syncthreads(); sb_phase(p, lds); break;
        case 14: retscan_phase(p); break;
        case 15: retc_phase(p, lds); break;
        default: break;
        }
        if (ph + 1 < p.ph_hi) { __threadfence(); asm volatile("s_waitcnt vmcnt(0) lgkmcnt(0)" ::: "memory"); grid.sync(); __threadfence(); asm volatile("s_waitcnt vmcnt(0) lgkmcnt(0)" ::: "memory"); }
    }
}


#ifndef DIAG
#define DIAG 0
#endif
#if DIAG
__global__ void diag_fold(Params p) {
    const size_t n = (size_t)MTOK * 1024; unsigned char* ws = p.ws;
    for (size_t i = (size_t)blockIdx.x * blockDim.x + threadIdx.x; i < n; i += (size_t)gridDim.x * blockDim.x) {
        const size_t row = i >> 10; const int col = (int)(i & 1023); float v = 0.f;
#if DIAG == 30
        v = col < 512 ? bf2f(((const bf16_t*)(ws + WS_MIX))[i]) : 0.f;
#elif DIAG == 31
        v = ((const float*)(ws + WS_S5E))[i & 4194303];
#elif DIAG == 3
        v = col < 512 ? bf2f(((const bf16_t*)(ws + WS_MIX))[i]) : ((const float*)(ws + WS_S5E))[(row * 512 + col - 512) & 4194303];
#elif DIAG == 2
        v = bf2f(((const bf16_t*)(ws + WS_R1))[2 * i]) + bf2f(((const bf16_t*)(ws + WS_R1))[2 * i + 1]);
#elif DIAG == 1
        v = bf2f(((const bf16_t*)(ws + WS_H))[i]);
#elif DIAG == 5
        v = bf2f(((const bf16_t*)(ws + WS_Y5))[i >> 1]);
#elif DIAG == 6
        v = bf2f(((const bf16_t*)(ws + WS_MIX))[i]);
#endif
        p.out[i] = v;
    }
}
#endif
#ifndef MK_MULTI
#define MK_MULTI 0
#endif
extern "C" void kernel_launch(void* const* d_in, const int* in_sizes, int n_in, void* d_out, int out_size, void* d_ws, size_t ws_size, hipStream_t stream) {
    static int grid = 0;
    if (grid == 0) {
        if (n_in != 26 || out_size != MTOK * DM || ws_size < WS_END) { fprintf(stderr, "kernel_launch: unexpected shapes (n_in %d out %d ws %zu need %zu)\n", n_in, out_size, ws_size, (size_t)WS_END); grid = -1; return; }
        int dev = 0, cus = 0, per_cu = 0;
        hipGetDevice(&dev); hipDeviceGetAttribute(&cus, hipDeviceAttributeMultiprocessorCount, dev);
        if (hipFuncSetAttribute((const void*)mega_fwd, hipFuncAttributeMaxDynamicSharedMemorySize, LDS_BYTES) != hipSuccess) { fprintf(stderr, "kernel_launch: hipFuncSetAttribute failed\n"); grid = -1; return; }
        if (hipOccupancyMaxActiveBlocksPerMultiprocessor(&per_cu, (const void*)mega_fwd, NTHR, LDS_BYTES) != hipSuccess || per_cu < 1) { fprintf(stderr, "kernel_launch: occupancy query says %d\n", per_cu); per_cu = 1; }
        (void)hipGetLastError();
        grid = cus * 1;
    }
    if (grid < 0) return;
    Params p{};
    for (int i = 0; i < 26; ++i) p.in[i] = (const float*)d_in[i];
    p.out = (float*)d_out; p.ws = (unsigned char*)d_ws;
#if MK_MULTI
#if DIAG
    for (int ph = 0; ph <= (DIAG >= 30 ? DIAG / 10 : DIAG); ++ph) { p.ph_lo = ph; p.ph_hi = ph + 1; hipLaunchKernelGGL(mega_fwd, dim3(grid), dim3(NTHR), LDS_BYTES, stream, p); }
    hipLaunchKernelGGL(diag_fold, dim3(2048), dim3(256), 0, stream, p);
#else
    for (int ph = 0; ph < N_PHASES; ++ph) { p.ph_lo = ph; p.ph_hi = ph + 1; hipLaunchKernelGGL(mega_fwd, dim3(grid), dim3(NTHR), LDS_BYTES, stream, p); }
#endif
#else
    p.ph_lo = 0; p.ph_hi = N_PHASES;
    void* args[] = {&p};
    hipError_t e = hipLaunchCooperativeKernel((const void*)mega_fwd, dim3(grid), dim3(NTHR), args, LDS_BYTES, stream);
    if (e != hipSuccess) fprintf(stderr, "cooperative launch failed: %s (grid %d)\n", hipGetErrorString(e), grid);
#endif
}
```

```cpp
#include <hip/hip_runtime.h>
#include <hip/hip_cooperative_groups.h>
#include <cstdio>
namespace cg = cooperative_groups;

#define LAS __attribute__((address_space(3)))
typedef unsigned short bf16_t;
typedef short bf16x8 __attribute__((ext_vector_type(8)));
typedef short s16x4 __attribute__((ext_vector_type(4)));
typedef float f32x4 __attribute__((ext_vector_type(4)));
typedef float f32x2 __attribute__((ext_vector_type(2)));
typedef unsigned u32x4 __attribute__((ext_vector_type(4)));
typedef unsigned u32x2 __attribute__((ext_vector_type(2)));

constexpr int NB = 16, SEQ = 4096, DM = 1024, MTOK = NB * SEQ, FFH = 2816;
constexpr int NTHR = 512;
constexpr int LDS_BYTES = 135168;

constexpr size_t al256(size_t x) { return (x + 255) & ~(size_t)255; }
constexpr size_t WS_W_ABIN = 0;
constexpr size_t WS_W_ABOUT = WS_W_ABIN + (size_t)2048 * 1024 * 2;
constexpr size_t WS_W_GLU = WS_W_ABOUT + (size_t)1024 * 1024 * 2;
constexpr size_t WS_W_FFIN = WS_W_GLU + (size_t)512 * 512 * 2;
constexpr size_t WS_W_FFOUT = WS_W_FFIN + (size_t)2 * 5632 * 1024 * 2;
constexpr size_t WS_W_CDIN = WS_W_FFOUT + (size_t)2 * 1024 * 2816 * 2;
constexpr size_t WS_W_CDOUT = WS_W_CDIN + (size_t)3584 * 1024 * 2;
constexpr size_t WS_MOD = WS_W_CDOUT + (size_t)1024 * 1024 * 2;
constexpr size_t WS_ROPE = WS_MOD + (size_t)2 * 16 * 6144 * 4;
constexpr size_t WS_KERN = WS_ROPE + (size_t)4096 * 64 * 8;
constexpr size_t WS_S5M = WS_KERN + (size_t)32 * 64 * 256 * 2;
constexpr size_t WS_S5G = WS_S5M + (size_t)32 * 128 * 1024 * 2;
constexpr size_t WS_A64 = WS_S5G + (size_t)32 * 1024 * 128 * 2;
constexpr size_t WS_S5E = WS_A64 + (size_t)32 * 64 * 8;
constexpr size_t WS_S5X = WS_S5E + (size_t)64 * 32 * 16 * 128 * 4;
constexpr size_t WS_Y5 = WS_S5X + (size_t)64 * 32 * 16 * 128 * 2;
constexpr size_t WS_H = WS_Y5 + (size_t)MTOK * 512 * 2;
constexpr size_t WS_MIX = WS_H + (size_t)MTOK * 1024 * 2;
constexpr size_t WS_R1 = WS_MIX + (size_t)MTOK * 1024 * 2;
constexpr size_t WS_END = WS_R1 + (size_t)MTOK * 3584 * 2;

struct Params {
    const float* in[26];
    float* out;
    unsigned char* ws;
    int ph_lo, ph_hi;
};

__device__ __forceinline__ float bf2f(unsigned short b) { return __uint_as_float(((unsigned)b) << 16); }
typedef __bf16 bf16x2_t __attribute__((ext_vector_type(2)));
__device__ __forceinline__ unsigned pk2(float lo, float hi) { const f32x2 v = {lo, hi}; return __builtin_bit_cast(unsigned, __builtin_convertvector(v, bf16x2_t)); }
__device__ __forceinline__ bf16_t f2bf(float f) { return (bf16_t)(pk2(f, 0.f) & 0xffffu); }
__device__ __forceinline__ float lo_f(unsigned u) { return __uint_as_float(u << 16); }
__device__ __forceinline__ float hi_f(unsigned u) { return __uint_as_float(u & 0xffff0000u); }
__device__ __forceinline__ bf16x8 as_frag(u32x4 u) { return __builtin_bit_cast(bf16x8, u); }
__device__ __forceinline__ f32x4 mfma16(bf16x8 a, bf16x8 b, f32x4 c) { return __builtin_amdgcn_mfma_f32_16x16x32_bf16(a, b, c, 0, 0, 0); }
__device__ __forceinline__ float silu_f(float x) { return x / (1.f + __expf(-x)); }
__device__ __forceinline__ float sigm_f(float x) { return 1.f / (1.f + __expf(-x)); }
__device__ __forceinline__ float gelu_tanh(float x) {
    const float u = 0.7978845608028654f * (x + 0.044715f * x * x * x);
    const float t = 1.f - 2.f / (1.f + __expf(2.f * u));
    return 0.5f * x * (1.f + t);
}
__device__ __forceinline__ bf16x8 tr_pair(LAS bf16_t* base, int stride, int row0, int row1, int col0, int li) {
    const int q = li >> 2, pq = li & 3;
    s16x4 a = __builtin_amdgcn_ds_read_tr16_b64_v4i16((LAS s16x4*)(base + (row0 + q) * stride + col0 + 4 * pq));
    s16x4 b = __builtin_amdgcn_ds_read_tr16_b64_v4i16((LAS s16x4*)(base + (row1 + q) * stride + col0 + 4 * pq));
    bf16x8 r = {a[0], a[1], a[2], a[3], b[0], b[1], b[2], b[3]};
    return r;
}
__device__ __forceinline__ int tid_opaque() { int t = threadIdx.x; asm volatile("" : "+v"(t)); return t; }
__device__ __forceinline__ void wave_lds_fence() { asm volatile("s_waitcnt lgkmcnt(0)" ::: "memory"); __builtin_amdgcn_wave_barrier(); }

namespace pg8 {
constexpr int BM = 256, BK = 64, HALF = 128, HTB = HALF * BK * 2, STAGE_BYTES = 8 * HTB, NXCD = 8, WGM = 8;
__device__ __forceinline__ int lds_byte(int r, int c) { const int st = (r >> 4) * 2 + (c >> 5), rr = r & 15, cc = c & 31, ob = rr * 64 + cc * 2; return st * 1024 + (ob ^ (((ob >> 9) & 1) << 5)); }
__device__ __forceinline__ void stage_rc(int b, int& R, int& C) { const int st = b / 1024, sb = b % 1024, swz = sb ^ (((sb >> 9) & 1) << 5); R = (st >> 1) * 16 + swz / 64; C = (st & 1) * 32 + (swz % 64) / 2; }
__device__ __forceinline__ int perm32(int rho) { const int n = rho >> 4, i = rho & 15; return 8 * (i >> 2) + 4 * n + (i & 3); }
struct Unit { int pm, pn; };
struct Gemm { const bf16_t* A; const bf16_t* Bt; int M, N, K; };
struct StaticOrder {
    int nM, nN, nwg, G, c;
    __device__ void init(int M, int N, int G_, int c_) { nM = M / BM; nN = N / BM; nwg = nM * nN; G = G_; c = c_; }
    __device__ bool next(int i, Unit& u) const {
        const long L = (long)i * G + c; if (L >= nwg) return false;
        int wgid = (int)L; { const int q = nwg / NXCD, r = nwg % NXCD, xcd = wgid % NXCD, off = wgid / NXCD; wgid = (xcd < r ? xcd * (q + 1) : r * (q + 1) + (xcd - r) * q) + off; }
        const int nig = WGM * nN, gid = wgid / nig, fm = gid * WGM, gsz = (nM - fm) < WGM ? (nM - fm) : WGM;
        u.pm = fm + ((wgid % nig) % gsz); u.pn = (wgid % nig) / gsz; return true;
    }
};

template <class Epi>
__device__ __forceinline__ void gemm_phase(LAS unsigned char* lds, const Gemm g, const StaticOrder& S, const Epi& E) {
    const int tid = tid_opaque(), wid = __builtin_amdgcn_readfirstlane(tid >> 6), lane = tid & 63, wr = wid >> 2, wc = wid & 3, fr = lane & 15, fq = lane >> 4;
    const int K = g.K, nt = K / BK;
    unsigned voffA[2], voffB[2];
#pragma unroll
    for (int i = 0; i < 2; ++i) { int R, C; stage_rc(tid * 16 + i * 8192, R, C); const int Rb = Epi::PERM ? ((R & ~31) + perm32(R & 31)) : R;
        voffA[i] = (unsigned)(R * K + C) * 2u; voffB[i] = (unsigned)(Rb * K + C) * 2u; }
    const size_t kstep = (size_t)(BK * 2);
    const size_t hstep = (size_t)HALF * K * 2;
    const size_t tstep = 2 * hstep;
    const unsigned ldsw = (unsigned)wid * 1024u;
    const int aoff = lds_byte(wr * 64 + fr, fq * 8), boff = lds_byte(wc * 32 + fr, fq * 8);
#define PG8_SA(b, h) (((b) * 2 + (h)) * HTB)
#define PG8_SB(b, h) ((4 + (b) * 2 + (h)) * HTB)
#define PG8_STAGE(bufoff, gbase, voff) do { _Pragma("unroll") for (int _i = 0; _i < 2; ++_i) \
        __builtin_amdgcn_global_load_lds((const unsigned*)((const char*)(gbase) + (voff)[_i]), (LAS unsigned*)(lds + (bufoff) + ldsw + _i * 8192), 16, 0, 0); } while (0)
#define PG8_LDA(dst, b, h) do { _Pragma("unroll") for (int m = 0; m < 4; ++m) _Pragma("unroll") for (int k = 0; k < 2; ++k) dst[m][k] = *(const LAS bf16x8*)(lds + PG8_SA(b, h) + aoff + m * 2048 + k * 1024); } while (0)
#define PG8_LDB(dst, b, h) do { _Pragma("unroll") for (int n = 0; n < 2; ++n) _Pragma("unroll") for (int k = 0; k < 2; ++k) dst[n][k] = *(const LAS bf16x8*)(lds + PG8_SB(b, h) + boff + n * 2048 + k * 1024); } while (0)
#define PG8_MMA(ai, bj, At, Bt) do { __builtin_amdgcn_s_setprio(1); _Pragma("unroll") for (int m = 0; m < 4; ++m) _Pragma("unroll") for (int n = 0; n < 2; ++n) _Pragma("unroll") for (int k = 0; k < 2; ++k) \
        acc[ai][bj][m][n] = __builtin_amdgcn_mfma_f32_16x16x32_bf16(Bt[n][k], At[m][k], acc[ai][bj][m][n], 0, 0, 0); __builtin_amdgcn_s_setprio(0); } while (0)
#define PG8_WAIT_V(n) asm volatile("s_waitcnt vmcnt(" #n ")" ::: "memory")
#define PG8_WAIT_L(n) asm volatile("s_waitcnt lgkmcnt(" #n ")" ::: "memory")
#define PG8_BAR __builtin_amdgcn_s_barrier()
#define PG8_SCHED __builtin_amdgcn_sched_barrier(0)
    Unit cur, nxt; int ui = 0;
    if (!S.next(0, cur)) return;
    f32x4 acc[2][2][4][2];
#pragma unroll
    for (int a = 0; a < 2; ++a)
#pragma unroll
        for (int b = 0; b < 2; ++b)
#pragma unroll
            for (int m = 0; m < 4; ++m)
#pragma unroll
                for (int n = 0; n < 2; ++n) acc[a][b][m][n] = (f32x4){0.f, 0.f, 0.f, 0.f};
    bf16x8 At[4][2], B0[2][2], B1[2][2];
    const char* cA = (const char*)g.A + (size_t)cur.pm * tstep; const char* cB = (const char*)g.Bt + (size_t)cur.pn * tstep;
    PG8_STAGE(PG8_SB(0, 0), cB, voffB); PG8_STAGE(PG8_SA(0, 0), cA, voffA); PG8_STAGE(PG8_SB(0, 1), cB + hstep, voffB); PG8_STAGE(PG8_SA(0, 1), cA + hstep, voffA);
    if (wr == 1) PG8_BAR;
    PG8_WAIT_V(4); PG8_BAR;
    PG8_STAGE(PG8_SB(1, 0), cB + kstep, voffB); PG8_STAGE(PG8_SA(1, 0), cA + kstep, voffA); PG8_STAGE(PG8_SB(1, 1), cB + hstep + kstep, voffB);
    PG8_WAIT_V(6); PG8_BAR;
    for (;;) {
        const bool has_next = S.next(ui + 1, nxt);
        const char* nA = has_next ? (const char*)g.A + (size_t)nxt.pm * tstep : cA; const char* nB = has_next ? (const char*)g.Bt + (size_t)nxt.pn * tstep : cB;
        for (int t = 0; t < nt; t += 2) {
            const bool last = (t == nt - 2);
            const char* a1 = cA + (size_t)(t + 1) * kstep;
            const char* a2 = last ? nA : cA + (size_t)(t + 2) * kstep; const char* b2 = last ? nB : cB + (size_t)(t + 2) * kstep;
            const char* a3 = a2 + kstep; const char* b3 = b2 + kstep;
            PG8_LDB(B0, 0, 0); PG8_SCHED; PG8_LDA(At, 0, 0); PG8_STAGE(PG8_SA(1, 1), a1 + hstep, voffA);
            PG8_WAIT_L(8); PG8_BAR; PG8_WAIT_L(0); PG8_MMA(0, 0, At, B0); PG8_BAR; PG8_SCHED;
            PG8_LDB(B1, 0, 1); PG8_STAGE(PG8_SB(0, 0), b2, voffB);
            PG8_BAR; PG8_WAIT_L(0); PG8_MMA(0, 1, At, B1); PG8_BAR;
            PG8_LDA(At, 0, 1); PG8_STAGE(PG8_SA(0, 0), a2, voffA);
            PG8_BAR; PG8_WAIT_L(0); PG8_MMA(1, 0, At, B0); PG8_BAR; PG8_SCHED;
            PG8_STAGE(PG8_SB(0, 1), b2 + hstep, voffB);
            PG8_WAIT_V(6); PG8_BAR; PG8_MMA(1, 1, At, B1); PG8_BAR;
            PG8_LDB(B0, 1, 0); PG8_SCHED; PG8_LDA(At, 1, 0); PG8_STAGE(PG8_SA(0, 1), a2 + hstep, voffA);
            PG8_WAIT_L(8); PG8_BAR; PG8_WAIT_L(0); PG8_MMA(0, 0, At, B0); PG8_BAR; PG8_SCHED;
            PG8_LDB(B1, 1, 1); PG8_STAGE(PG8_SB(1, 0), b3, voffB);
            PG8_BAR; PG8_WAIT_L(0); PG8_MMA(0, 1, At, B1); PG8_BAR;
            PG8_LDA(At, 1, 1); PG8_STAGE(PG8_SA(1, 0), a3, voffA);
            PG8_BAR; PG8_WAIT_L(0); PG8_MMA(1, 0, At, B0); PG8_BAR; PG8_SCHED;
            PG8_STAGE(PG8_SB(1, 1), b3 + hstep, voffB);
            PG8_WAIT_V(6); PG8_BAR; PG8_MMA(1, 1, At, B1); PG8_BAR;
        }
        E(acc, cur, wr, wc, fr, fq);
        if (!has_next) break;
#pragma unroll
        for (int a = 0; a < 2; ++a)
#pragma unroll
            for (int b = 0; b < 2; ++b)
#pragma unroll
                for (int m = 0; m < 4; ++m)
#pragma unroll
                    for (int n = 0; n < 2; ++n) acc[a][b][m][n] = (f32x4){0.f, 0.f, 0.f, 0.f};
        cur = nxt; cA = nA; cB = nB; ++ui;
    }
    PG8_WAIT_V(0);
    if (wr == 0) PG8_BAR;
    PG8_BAR;
#undef PG8_SA
#undef PG8_SB
#undef PG8_STAGE
#undef PG8_LDA
#undef PG8_LDB
#undef PG8_MMA
#undef PG8_WAIT_V
#undef PG8_WAIT_L
#undef PG8_BAR
#undef PG8_SCHED
}

struct EpiStore {
    static constexpr bool PERM = true;
    bf16_t* O; int ldc;
    __device__ __forceinline__ void operator()(const f32x4 (&acc)[2][2][4][2], const Unit& u, int wr, int wc, int fr, int fq) const {
        const int row0 = u.pm * BM + wr * 64 + fr, col0 = u.pn * BM + wc * 32 + 8 * fq;
#pragma unroll
        for (int ai = 0; ai < 2; ++ai)
#pragma unroll
            for (int m = 0; m < 4; ++m) { bf16_t* rowp = O + (size_t)(row0 + ai * HALF + m * 16) * ldc + col0;
#pragma unroll
                for (int bj = 0; bj < 2; ++bj) { const f32x4 v0 = acc[ai][bj][m][0], v1 = acc[ai][bj][m][1];
                    u32x4 w; w.x = pk2(v0[0], v0[1]); w.y = pk2(v0[2], v0[3]); w.z = pk2(v1[0], v1[1]); w.w = pk2(v1[2], v1[3]);
                    *(u32x4*)(rowp + bj * HALF) = w; } }
    }
};
struct EpiSwiglu {
    static constexpr bool PERM = true;
    bf16_t* O;
    __device__ __forceinline__ void operator()(const f32x4 (&acc)[2][2][4][2], const Unit& u, int wr, int wc, int fr, int fq) const {
        const int row0 = u.pm * BM + wr * 64 + fr, col0 = u.pn * HALF + wc * 32 + 8 * fq;
#pragma unroll
        for (int ai = 0; ai < 2; ++ai)
#pragma unroll
            for (int m = 0; m < 4; ++m) { bf16_t* rowp = O + (size_t)(row0 + ai * HALF + m * 16) * FFH + col0;
                float r[8];
#pragma unroll
                for (int n = 0; n < 2; ++n)
#pragma unroll
                    for (int j = 0; j < 4; ++j) r[n * 4 + j] = silu_f(acc[ai][0][m][n][j]) * acc[ai][1][m][n][j];
                u32x4 w; w.x = pk2(r[0], r[1]); w.y = pk2(r[2], r[3]); w.z = pk2(r[4], r[5]); w.w = pk2(r[6], r[7]);
                *(u32x4*)rowp = w; }
    }
};
struct EpiGlu {
    static constexpr bool PERM = true;
    const bf16_t* Y; const float* bias; bf16_t* O;
    __device__ __forceinline__ void operator()(const f32x4 (&acc)[2][2][4][2], const Unit& u, int wr, int wc, int fr, int fq) const {
        const int row0 = u.pm * BM + wr * 64 + fr, col0 = u.pn * BM + wc * 32 + 8 * fq;
#pragma unroll
        for (int bj = 0; bj < 2; ++bj) {
            const int col = col0 + bj * HALF;
            const f32x4 b0 = *(const f32x4*)(bias + col), b1 = *(const f32x4*)(bias + col + 4);
#pragma unroll
            for (int ai = 0; ai < 2; ++ai)
#pragma unroll
                for (int m = 0; m < 4; ++m) { const size_t row = (size_t)(row0 + ai * HALF + m * 16);
                    const u32x4 yv = *(const u32x4*)(Y + row * 512 + col);
                    const f32x4 v0 = acc[ai][bj][m][0] + b0, v1 = acc[ai][bj][m][1] + b1;
                    float r[8];
                    r[0] = lo_f(yv.x) * sigm_f(v0[0]); r[1] = hi_f(yv.x) * sigm_f(v0[1]); r[2] = lo_f(yv.y) * sigm_f(v0[2]); r[3] = hi_f(yv.y) * sigm_f(v0[3]);
                    r[4] = lo_f(yv.z) * sigm_f(v1[0]); r[5] = hi_f(yv.z) * sigm_f(v1[1]); r[6] = lo_f(yv.w) * sigm_f(v1[2]); r[7] = hi_f(yv.w) * sigm_f(v1[3]);
                    u32x4 w; w.x = pk2(r[0], r[1]); w.y = pk2(r[2], r[3]); w.z = pk2(r[4], r[5]); w.w = pk2(r[6], r[7]);
                    *(u32x4*)(O + row * 1024 + 512 + col) = w; }
        }
    }
};
struct EpiResid {
    static constexpr bool PERM = false;
    const float* res; float* out; const float* gate;
    __device__ __forceinline__ void operator()(const f32x4 (&acc)[2][2][4][2], const Unit& u, int wr, int wc, int fr, int fq) const {
        const int row0 = u.pm * BM + wr * 64 + fr, col0 = u.pn * BM + wc * 32 + 4 * fq;
        const int bidx = (u.pm * BM) >> 12;
        f32x4 gv[2][2];
#pragma unroll
        for (int bj = 0; bj < 2; ++bj)
#pragma unroll
            for (int n = 0; n < 2; ++n) gv[bj][n] = *(const f32x4*)(gate + (size_t)bidx * 6144 + col0 + bj * HALF + n * 16);
#pragma unroll
        for (int ai = 0; ai < 2; ++ai)
#pragma unroll
            for (int m = 0; m < 4; ++m) { const size_t ro = (size_t)(row0 + ai * HALF + m * 16) * 1024 + col0;
#pragma unroll
                for (int bj = 0; bj < 2; ++bj)
#pragma unroll
                    for (int n = 0; n < 2; ++n) { const f32x4 rv = *(const f32x4*)(res + ro + bj * HALF + n * 16);
                        *(f32x4*)(out + ro + bj * HALF + n * 16) = rv + gv[bj][n] * acc[ai][bj][m][n]; } }
    }
};
}

__device__ __forceinline__ void transpose_cvt(LAS float* tile, const float* __restrict__ W, int K, int N, bf16_t* __restrict__ Wt, int mode) {
    const int tid = tid_opaque();
    const int tilesN = N / 64, tilesK = K / 64, ntl = tilesN * tilesK;
    for (int t = blockIdx.x; t < ntl; t += gridDim.x) {
        const int tn = t % tilesN, tk = t / tilesN;
        const int n0d = tn * 64; int n0s = n0d;
        if (mode == 1) { const int tt = n0d >> 8, r0 = n0d & 255; n0s = (r0 < 128) ? tt * 128 + r0 : FFH + tt * 128 + (r0 - 128); }
        const int k0 = tk * 64;
#pragma unroll
        for (int r = 0; r < 8; ++r) { const int kk = (tid >> 6) + 8 * r; tile[kk * 65 + (tid & 63)] = W[(size_t)(k0 + kk) * N + n0s + (tid & 63)]; }
        __syncthreads();
        { const int nn = tid >> 3, kc = (tid & 7) * 8; float v[8];
#pragma unroll
          for (int j = 0; j < 8; ++j) v[j] = tile[(kc + j) * 65 + nn];
          u32x4 w; w.x = pk2(v[0], v[1]); w.y = pk2(v[2], v[3]); w.z = pk2(v[4], v[5]); w.w = pk2(v[6], v[7]);
          *(u32x4*)(Wt + (size_t)(n0d + nn) * K + k0 + kc) = w; }
        __syncthreads();
    }
}

struct S5gp { float lrdt, lidt, fre, fim; };
__device__ __forceinline__ S5gp s5_gp(const Params& p, int g, int pp) {
    S5gp r; const float dt = expf(p.in[15][g]); const float lr = p.in[13][g * 64 + pp], li = p.in[14][g * 64 + pp];
    r.lrdt = lr * dt; r.lidt = li * dt;
    const float mag = expf(r.lrdt), are = mag * cosf(r.lidt), aim = mag * sinf(r.lidt), den = lr * lr + li * li;
    r.fre = ((are - 1.f) * lr + aim * li) / den; r.fim = (aim * lr - (are - 1.f) * li) / den;
    return r;
}
__device__ __forceinline__ f32x2 s5_apow(const S5gp& q, float n) { const float m = expf(n * q.lrdt), a = n * q.lidt; return (f32x2){m * cosf(a), m * sinf(a)}; }

__device__ __forceinline__ void prep_phase(const Params& p, LAS unsigned char* lds) {
    const int tid = tid_opaque();
    unsigned char* ws = p.ws;
    LAS float* tile = (LAS float*)lds;
    transpose_cvt(tile, p.in[8], 1024, 2048, (bf16_t*)(ws + WS_W_ABIN), 0);
    transpose_cvt(tile, p.in[9], 1024, 1024, (bf16_t*)(ws + WS_W_ABOUT), 0);
    transpose_cvt(tile, p.in[21], 512, 512, (bf16_t*)(ws + WS_W_GLU), 0);
    for (int l = 0; l < 2; ++l) {
        transpose_cvt(tile, p.in[6] + (size_t)l * 1024 * 5632, 1024, 5632, (bf16_t*)(ws + WS_W_FFIN) + (size_t)l * 5632 * 1024, 1);
        transpose_cvt(tile, p.in[7] + (size_t)l * FFH * 1024, FFH, 1024, (bf16_t*)(ws + WS_W_FFOUT) + (size_t)l * 1024 * FFH, 0);
    }
    transpose_cvt(tile, p.in[23], 1024, 3584, (bf16_t*)(ws + WS_W_CDIN), 0);
    transpose_cvt(tile, p.in[24], 1024, 1024, (bf16_t*)(ws + WS_W_CDOUT), 0);
    if (blockIdx.x < 192) {
        LAS float* sc = (LAS float*)lds; LAS float* red = (LAS float*)(lds + 65536);
        for (int idx = tid; idx < 16384; idx += NTHR) { const float v = p.in[1][idx]; sc[idx] = v / (1.f + expf(-v)); }
        __syncthreads();
        for (int item = blockIdx.x; item < 192; item += gridDim.x) {
            const int l = item / 96, cb = item % 96, cl = tid & 63, ksl = tid >> 6;
            float acc[16];
#pragma unroll
            for (int b = 0; b < 16; ++b) acc[b] = 0.f;
            const float* w = p.in[2] + (size_t)l * 1024 * 6144 + cb * 64 + cl;
            for (int k = ksl * 128; k < ksl * 128 + 128; ++k) { const float wv = w[(size_t)k * 6144];
#pragma unroll
                for (int b = 0; b < 16; ++b) acc[b] += sc[b * 1024 + k] * wv; }
#pragma unroll
            for (int b = 0; b < 16; ++b) red[(ksl * 16 + b) * 64 + cl] = acc[b];
            __syncthreads();
            for (int o = tid; o < 1024; o += NTHR) { const int b = o >> 6, cc = o & 63; float s = 0.f;
#pragma unroll
                for (int k8 = 0; k8 < 8; ++k8) s += red[(k8 * 16 + b) * 64 + cc];
                ((float*)(ws + WS_MOD))[(size_t)(l * 16 + b) * 6144 + cb * 64 + cc] = s + p.in[3][l * 6144 + cb * 64 + cc]; }
            __syncthreads();
        }
    }
    __syncthreads();
    const int gtid = blockIdx.x * NTHR + tid, nthr = gridDim.x * NTHR;
    for (int idx = gtid; idx < 4096 * 64; idx += nthr) { const int pos = idx >> 6, f = idx & 63;
        const float freq = powf(10000.f, -(float)f / 64.f), ang = (float)pos * freq;
        ((f32x2*)(ws + WS_ROPE))[idx] = (f32x2){cosf(ang), sinf(ang)}; }
    { bf16_t* Mt = (bf16_t*)(ws + WS_S5M); bf16_t* Gt = (bf16_t*)(ws + WS_S5G);
      for (int idx = gtid; idx < 32 * 64 * 64; idx += nthr) { const int g = idx >> 12, pp = (idx >> 6) & 63, s = idx & 63;
          const S5gp q = s5_gp(p, g, pp);
          { const f32x2 a = s5_apow(q, (float)(63 - s));
            unsigned wr_[8], wi_[8];
#pragma unroll
            for (int h2 = 0; h2 < 8; ++h2) { float vr[2], vi[2];
#pragma unroll
                for (int e = 0; e < 2; ++e) { const int h = h2 * 2 + e; const float br = p.in[16][(g * 64 + pp) * 16 + h], bi = p.in[17][(g * 64 + pp) * 16 + h];
                    const float bbr = q.fre * br - q.fim * bi, bbi = q.fre * bi + q.fim * br;
                    vr[e] = a.x * bbr - a.y * bbi; vi[e] = a.x * bbi + a.y * bbr; }
                wr_[h2] = pk2(vr[0], vr[1]); wi_[h2] = pk2(vi[0], vi[1]); }
            u32x4* dr = (u32x4*)(Mt + (size_t)(g * 128 + 2 * pp) * 1024 + s * 16); u32x4* di = (u32x4*)(Mt + (size_t)(g * 128 + 2 * pp + 1) * 1024 + s * 16);
            dr[0] = (u32x4){wr_[0], wr_[1], wr_[2], wr_[3]}; dr[1] = (u32x4){wr_[4], wr_[5], wr_[6], wr_[7]};
            di[0] = (u32x4){wi_[0], wi_[1], wi_[2], wi_[3]}; di[1] = (u32x4){wi_[4], wi_[5], wi_[6], wi_[7]}; }
          { const int t = s; const f32x2 a = s5_apow(q, (float)(t + 1));
#pragma unroll
            for (int h = 0; h < 16; ++h) { const float cr = p.in[18][(g * 16 + h) * 64 + pp], ci = p.in[19][(g * 16 + h) * 64 + pp];
                const float gr = cr * a.x - ci * a.y, gi = cr * a.y + ci * a.x;
                *(unsigned*)(Gt + (size_t)(g * 1024 + t * 16 + h) * 128 + 2 * pp) = pk2(gr, -gi); } }
          if (s == 0) ((f32x2*)(ws + WS_A64))[g * 64 + pp] = s5_apow(q, 64.f);
      }
      LAS f32x2* tp = (LAS f32x2*)lds;
      bf16_t* Kt = (bf16_t*)(ws + WS_KERN);
      for (int item = blockIdx.x; item < 32 * 64; item += gridDim.x) { const int g = item >> 6, tau = item & 63;
          if (tid < 64) { const S5gp q = s5_gp(p, g, tid); const f32x2 a = s5_apow(q, (float)tau); tp[tid] = (f32x2){a.x * q.fre - a.y * q.fim, a.x * q.fim + a.y * q.fre}; }
          __syncthreads();
          if (tid < 256) { const int h = tid >> 4, h2 = tid & 15; float acc = 0.f;
              for (int pp = 0; pp < 64; ++pp) { const f32x2 t = tp[pp]; const float cr = p.in[18][(g * 16 + h) * 64 + pp], ci = p.in[19][(g * 16 + h) * 64 + pp];
                  const float ur = cr * t.x - ci * t.y, ui = cr * t.y + ci * t.x;
                  acc += ur * p.in[16][(g * 64 + pp) * 16 + h2] - ui * p.in[17][(g * 64 + pp) * 16 + h2]; }
              Kt[(size_t)((g * 64 + tau) * 16 + h) * 16 + h2] = f2bf(acc); }
          __syncthreads();
      }
    }
}

__device__ __forceinline__ void norm_phase(const float* __restrict__ x, const float* __restrict__ gw, const float* __restrict__ shift, const float* __restrict__ scale, bf16_t* __restrict__ H) {
    const int tid = tid_opaque(); const int lane = tid & 63, wv = blockIdx.x * 8 + (tid >> 6), nw = gridDim.x * 8;
    for (int row = wv; row < MTOK; row += nw) {
        const int b = row >> 12;
        f32x4 v[4]; float ss = 0.f;
#pragma unroll
        for (int c4 = 0; c4 < 4; ++c4) { v[c4] = *(const f32x4*)(x + (size_t)row * 1024 + c4 * 256 + lane * 4); ss += v[c4][0] * v[c4][0] + v[c4][1] * v[c4][1] + v[c4][2] * v[c4][2] + v[c4][3] * v[c4][3]; }
#pragma unroll
        for (int o = 1; o < 64; o <<= 1) ss += __shfl_xor(ss, o);
        const float r = rsqrtf(ss * (1.f / 1024.f) + 1e-6f);
#pragma unroll
        for (int c4 = 0; c4 < 4; ++c4) { const int col = c4 * 256 + lane * 4;
            const f32x4 g = *(const f32x4*)(gw + col), sc = *(const f32x4*)(scale + (size_t)b * 6144 + col), sh = *(const f32x4*)(shift + (size_t)b * 6144 + col);
            f32x4 o = v[c4] * r * g * (sc + 1.f) + sh;
            *(u32x2*)(H + (size_t)row * 1024 + col) = (u32x2){pk2(o[0], o[1]), pk2(o[2], o[3])}; }
    }
}

__device__ __forceinline__ void load_norm2(const bf16_t* rowp, int g4, const float* gain, float scale, bf16x8 (&out)[2]) {
    const u32x4 r0 = *(const u32x4*)(rowp + 8 * g4), r1 = *(const u32x4*)(rowp + 32 + 8 * g4);
    float v[16];
    v[0] = lo_f(r0.x); v[1] = hi_f(r0.x); v[2] = lo_f(r0.y); v[3] = hi_f(r0.y); v[4] = lo_f(r0.z); v[5] = hi_f(r0.z); v[6] = lo_f(r0.w); v[7] = hi_f(r0.w);
    v[8] = lo_f(r1.x); v[9] = hi_f(r1.x); v[10] = lo_f(r1.y); v[11] = hi_f(r1.y); v[12] = lo_f(r1.z); v[13] = hi_f(r1.z); v[14] = lo_f(r1.w); v[15] = hi_f(r1.w);
    float ss = 0.f;
#pragma unroll
    for (int j = 0; j < 16; ++j) ss += v[j] * v[j];
    ss += __shfl_xor(ss, 16); ss += __shfl_xor(ss, 32);
    const float r = rsqrtf(ss * (1.f / 64.f) + 1e-6f) * scale;
    const f32x4 ga = *(const f32x4*)(gain + 8 * g4), gb = *(const f32x4*)(gain + 8 * g4 + 4), gc = *(const f32x4*)(gain + 32 + 8 * g4), gd = *(const f32x4*)(gain + 36 + 8 * g4);
    u32x4 o0, o1;
    o0.x = pk2(v[0] * r * ga[0], v[1] * r * ga[1]); o0.y = pk2(v[2] * r * ga[2], v[3] * r * ga[3]); o0.z = pk2(v[4] * r * gb[0], v[5] * r * gb[1]); o0.w = pk2(v[6] * r * gb[2], v[7] * r * gb[3]);
    o1.x = pk2(v[8] * r * gc[0], v[9] * r * gc[1]); o1.y = pk2(v[10] * r * gc[2], v[11] * r * gc[3]); o1.z = pk2(v[12] * r * gd[0], v[13] * r * gd[1]); o1.w = pk2(v[14] * r * gd[2], v[15] * r * gd[3]);
    out[0] = as_frag(o0); out[1] = as_frag(o1);
}

constexpr int VS = 72;
constexpr int VL_BYTES = 64 * VS * 2;

__device__ __forceinline__ void attnA_phase(const Params& p, LAS unsigned char* lds) {
    const int tid = tid_opaque(), wid = tid >> 6, lane = tid & 63, li = lane & 15, g4 = lane >> 4;
    const bf16_t* QKV = (const bf16_t*)(p.ws + WS_R1);
    bf16_t* MIX = (bf16_t*)(p.ws + WS_MIX);
    LAS bf16_t* Vl = (LAS bf16_t*)(lds + wid * VL_BYTES);
    LAS float* bl = (LAS float*)(lds + 8 * VL_BYTES);
    for (int idx = tid; idx < 8 * 257; idx += NTHR) bl[(idx / 257) * 260 + (idx % 257)] = p.in[12][idx];
    __syncthreads();
    const int h = wid;
    LAS float* bh = bl + h * 260;
    for (int item2 = blockIdx.x; item2 < 2048; item2 += gridDim.x) {
        const int item = item2 >> 1, qh = item2 & 1;
        const int b = item >> 6, ci = item & 63;
        const size_t rowbase = (size_t)b * SEQ + ci * 64 + qh * 32;
        bf16x8 qf[2][2];
#pragma unroll
        for (int qt = 0; qt < 2; ++qt) load_norm2(QKV + (rowbase + qt * 16 + li) * 2048 + h * 64, g4, p.in[10], 0.125f, qf[qt]);
        f32x4 o[4][2]; float mrun[2], lsum[2];
#pragma unroll
        for (int qt = 0; qt < 2; ++qt) { mrun[qt] = -1e30f; lsum[qt] = 0.f;
#pragma unroll
            for (int dt = 0; dt < 4; ++dt) o[dt][qt] = (f32x4){0.f, 0.f, 0.f, 0.f}; }
        const int kb0 = ci >= 8 ? 0 : 8 - ci;
        for (int kb = kb0; kb <= 8; ++kb) {
            const size_t krow = (size_t)b * SEQ + (size_t)(ci - 8 + kb) * 64;
#pragma unroll
            for (int r = 0; r < 8; ++r) { const int row = r * 8 + (lane >> 3), c8 = lane & 7;
                *(LAS u32x4*)(Vl + row * VS + c8 * 8) = *(const u32x4*)(QKV + (krow + row) * 2048 + 1024 + h * 64 + c8 * 8); }
            f32x4 s[4][2];
#pragma unroll
            for (int kt = 0; kt < 4; ++kt) { bf16x8 kf[2]; load_norm2(QKV + (krow + kt * 16 + li) * 2048 + 512 + h * 64, g4, p.in[11], 1.f, kf);
#pragma unroll
                for (int qt = 0; qt < 2; ++qt) { f32x4 z = (f32x4){0.f, 0.f, 0.f, 0.f}; z = mfma16(kf[0], qf[qt][0], z); z = mfma16(kf[1], qf[qt][1], z); s[kt][qt] = z; } }
            wave_lds_fence();
#pragma unroll
            for (int qt = 0; qt < 2; ++qt) {
                float mx = -1e30f;
#pragma unroll
                for (int kt = 0; kt < 4; ++kt)
#pragma unroll
                    for (int jj = 0; jj < 4; ++jj) { int rel = 512 + qh * 32 + qt * 16 + li - kb * 64 - (kt * 16 + 4 * g4 + jj); rel = rel > 128 ? 128 : (rel < -128 ? -128 : rel);
                        const float v = s[kt][qt][jj] + bh[rel + 128]; s[kt][qt][jj] = v; mx = fmaxf(mx, v); }
                mx = fmaxf(mx, __shfl_xor(mx, 16)); mx = fmaxf(mx, __shfl_xor(mx, 32));
                const float mnew = fmaxf(mrun[qt], mx), alpha = __expf(mrun[qt] - mnew);
                mrun[qt] = mnew; float ps = 0.f;
#pragma unroll
                for (int kt = 0; kt < 4; ++kt)
#pragma unroll
                    for (int jj = 0; jj < 4; ++jj) { const float e = __expf(s[kt][qt][jj] - mnew); s[kt][qt][jj] = e; ps += e; }
                lsum[qt] = lsum[qt] * alpha + ps;
#pragma unroll
                for (int dt = 0; dt < 4; ++dt) o[dt][qt] *= alpha;
#pragma unroll
                for (int kk = 0; kk < 2; ++kk) { u32x4 w; w.x = pk2(s[2 * kk][qt][0], s[2 * kk][qt][1]); w.y = pk2(s[2 * kk][qt][2], s[2 * kk][qt][3]);
                    w.z = pk2(s[2 * kk + 1][qt][0], s[2 * kk + 1][qt][1]); w.w = pk2(s[2 * kk + 1][qt][2], s[2 * kk + 1][qt][3]); const bf16x8 pfr = as_frag(w);
#pragma unroll
                    for (int dt = 0; dt < 4; ++dt) { const bf16x8 vf = tr_pair(Vl, VS, 32 * kk + 4 * g4, 32 * kk + 16 + 4 * g4, dt * 16, li); o[dt][qt] = mfma16(vf, pfr, o[dt][qt]); } }
            }
            wave_lds_fence();
        }
#pragma unroll
        for (int qt = 0; qt < 2; ++qt) { float l = lsum[qt]; l += __shfl_xor(l, 16); l += __shfl_xor(l, 32); const float inv = 1.f / l;
#pragma unroll
            for (int dt = 0; dt < 4; ++dt) { const f32x4 v = o[dt][qt] * inv;
                *(u32x2*)(MIX + (rowbase + qt * 16 + li) * 1024 + h * 64 + dt * 16 + 4 * g4) = (u32x2){pk2(v[0], v[1]), pk2(v[2], v[3])}; } }
    }
}

__device__ __forceinline__ void s5a_phase(const Params& p) {
    const int tid = tid_opaque(); const int lane = tid & 63, li = lane & 15, g4 = lane >> 4;
    const bf16_t* QKV = (const bf16_t*)(p.ws + WS_R1);
    const bf16_t* Mt = (const bf16_t*)(p.ws + WS_S5M);
    float* E = (float*)(p.ws + WS_S5E);
    const int wv = blockIdx.x * 8 + (tid >> 6), nw = gridDim.x * 8;
    for (int item = wv; item < 2048; item += nw) {
        const int g = item & 31, c = item >> 5;
        f32x4 acc[8];
#pragma unroll
        for (int pt = 0; pt < 8; ++pt) acc[pt] = (f32x4){0.f, 0.f, 0.f, 0.f};
        const bf16_t* ub = QKV + ((size_t)li * SEQ + c * 64 + (g4 >> 1)) * 2048 + 1536 + g * 16 + 8 * (g4 & 1);
        const bf16_t* mb = Mt + (size_t)(g * 128 + li) * 1024 + 8 * g4;
        for (int ks = 0; ks < 32; ++ks) {
            const bf16x8 bfr = *(const bf16x8*)(ub + (size_t)(2 * ks) * 2048);
#pragma unroll
            for (int pt = 0; pt < 8; ++pt) { const bf16x8 afr = *(const bf16x8*)(mb + (size_t)pt * 16 * 1024 + 32 * ks); acc[pt] = mfma16(afr, bfr, acc[pt]); }
        }
#pragma unroll
        for (int pt = 0; pt < 8; ++pt) *(f32x4*)(E + ((size_t)(c * 32 + g) * 16 + li) * 128 + pt * 16 + 4 * g4) = acc[pt];
    }
}
__device__ __forceinline__ void s5scan_phase(const Params& p) {
    const float* E = (const float*)(p.ws + WS_S5E);
    bf16_t* X = (bf16_t*)(p.ws + WS_S5X);
    const f32x2* A64 = (const f32x2*)(p.ws + WS_A64);
    const int gtid = blockIdx.x * NTHR + tid_opaque();
    if (gtid < 32 * 16 * 64) {
        const int pp = gtid & 63, b = (gtid >> 6) & 15, g = gtid >> 10;
        const f32x2 a = A64[g * 64 + pp];
        float xr = 0.f, xi = 0.f;
        for (int c0 = 0; c0 < 64; c0 += 8) {
            f32x2 e[8];
#pragma unroll
            for (int k = 0; k < 8; ++k) e[k] = *(const f32x2*)(E + ((size_t)((c0 + k) * 32 + g) * 16 + b) * 128 + 2 * pp);
#pragma unroll
            for (int k = 0; k < 8; ++k) {
                *(unsigned*)(X + ((size_t)((c0 + k) * 32 + g) * 16 + b) * 128 + 2 * pp) = pk2(xr, xi);
                const float nr = a.x * xr - a.y * xi + e[k].x, ni = a.x * xi + a.y * xr + e[k].y; xr = nr; xi = ni; }
        }
    }
}
__device__ __forceinline__ void s5c_phase(const Params& p, LAS unsigned char* lds) {
    const int tid = tid_opaque(), wid = tid >> 6, lane = tid & 63, li = lane & 15, g4 = lane >> 4;
    const bf16_t* QKV = (const bf16_t*)(p.ws + WS_R1);
    const bf16_t* Kt = (const bf16_t*)(p.ws + WS_KERN);
    const bf16_t* Gt = (const bf16_t*)(p.ws + WS_S5G);
    const bf16_t* X = (const bf16_t*)(p.ws + WS_S5X);
    bf16_t* Y5 = (bf16_t*)(p.ws + WS_Y5);
    LAS bf16_t* kl = (LAS bf16_t*)lds;
    LAS bf16_t* ul = (LAS bf16_t*)(lds + 32768);
    int gl = -1;
    for (int item = blockIdx.x; item < 2048; item += gridDim.x) {
        const int g = item & 31, c = item >> 5;
        __syncthreads();
        if (g != gl) { for (int idx = tid; idx < 2048; idx += NTHR) *(LAS u32x4*)(kl + idx * 8) = *(const u32x4*)(Kt + (size_t)g * 16384 + idx * 8); gl = g; }
        for (int idx = tid; idx < 2048; idx += NTHR) { const int hh = idx & 1, b = (idx >> 1) & 15, s = idx >> 5;
            *(LAS u32x4*)(ul + (s * 16 + b) * 16 + hh * 8) = *(const u32x4*)(QKV + ((size_t)b * SEQ + c * 64 + s) * 2048 + 1536 + g * 16 + hh * 8); }
        bf16x8 xf[4];
#pragma unroll
        for (int ks = 0; ks < 4; ++ks) xf[ks] = *(const bf16x8*)(X + ((size_t)(c * 32 + g) * 16 + li) * 128 + 32 * ks + 8 * g4);
        __syncthreads();
        const f32x4 dsk = *(const f32x4*)(p.in[20] + g * 16 + 4 * g4);
        for (int tt = 0; tt < 8; ++tt) {
            const int t = wid + 8 * tt;
            f32x4 acc = (f32x4){0.f, 0.f, 0.f, 0.f};
#pragma unroll
            for (int ks = 0; ks < 4; ++ks) { const bf16x8 afr = *(const bf16x8*)(Gt + (size_t)(g * 1024 + t * 16 + li) * 128 + 32 * ks + 8 * g4); acc = mfma16(afr, xf[ks], acc); }
            const int nks = (t >> 1) + 1;
            for (int ks = 0; ks < nks; ++ks) {
                const int s = 2 * ks + (g4 >> 1); int tau = t - s; const bool ok = tau >= 0; tau = ok ? tau : 0;
                u32x4 av = *(const LAS u32x4*)(kl + (tau * 16 + li) * 16 + 8 * (g4 & 1));
                if (!ok) av = (u32x4){0u, 0u, 0u, 0u};
                const bf16x8 bfr = *(const LAS bf16x8*)(ul + (s * 16 + li) * 16 + 8 * (g4 & 1));
                acc = mfma16(as_frag(av), bfr, acc);
            }
            const u32x2 uu = *(const LAS u32x2*)(ul + (t * 16 + li) * 16 + 4 * g4);
            float y0 = acc[0] + dsk[0] * lo_f(uu.x), y1 = acc[1] + dsk[1] * hi_f(uu.x), y2 = acc[2] + dsk[2] * lo_f(uu.y), y3 = acc[3] + dsk[3] * hi_f(uu.y);
            y0 = gelu_tanh(y0); y1 = gelu_tanh(y1); y2 = gelu_tanh(y2); y3 = gelu_tanh(y3);
            *(u32x2*)(Y5 + ((size_t)li * SEQ + c * 64 + t) * 512 + g * 16 + 4 * g4) = (u32x2){pk2(y0, y1), pk2(y2, y3)};
        }
    }
}

#ifndef SB_EARLY_EXIT
#define SB_EARLY_EXIT 1
#endif
__device__ __forceinline__ void sb_phase(const Params& p, LAS unsigned char* lds) {
    const int tid = tid_opaque(), wid = tid >> 6, lane = tid & 63, li = lane & 15, g4 = lane >> 4;
    const bf16_t* QKV = (const bf16_t*)(p.ws + WS_R1);
    bf16_t* MIX = (bf16_t*)(p.ws + WS_MIX);
    LAS bf16_t* Vl = (LAS bf16_t*)(lds + wid * VL_BYTES);
    const int wv = blockIdx.x * 8 + wid, nw = gridDim.x * 8;
    const unsigned ONES = 0x3F803F80u;
    u32x2 dpat; dpat.x = ((4 * g4 + 0 > li) ? 0x3F80u : 0u) | ((4 * g4 + 1 > li) ? 0x3F800000u : 0u); dpat.y = ((4 * g4 + 2 > li) ? 0x3F80u : 0u) | ((4 * g4 + 3 > li) ? 0x3F800000u : 0u);
    for (int it = wv; it < 8192; it += nw) {
        const int bh = it >> 6, pr = it & 63, b = bh >> 3, h = bh & 7;
        for (int half = 0; half < 2; ++half) {
            const int qtile = half ? 127 - pr : pr, t0 = qtile * 32, kbd = t0 >> 6;
            const bf16_t* qb = QKV + ((size_t)b * SEQ + t0) * 3584 + 2048 + h * 64;
            bf16x8 qf[2][2];
#pragma unroll
            for (int qt = 0; qt < 2; ++qt)
#pragma unroll
                for (int ks = 0; ks < 2; ++ks) qf[qt][ks] = *(const bf16x8*)(qb + (size_t)(qt * 16 + li) * 3584 + 32 * ks + 8 * g4);
            f32x4 o[4][2]; float R[2];
#pragma unroll
            for (int qt = 0; qt < 2; ++qt) { R[qt] = 0.f;
#pragma unroll
                for (int dt = 0; dt < 4; ++dt) o[dt][qt] = (f32x4){0.f, 0.f, 0.f, 0.f}; }
            for (int kb = kbd; kb >= 0; --kb) {
                const bf16_t* kbase = QKV + ((size_t)b * SEQ + kb * 64) * 3584 + 2560 + h * 64;
#pragma unroll
                for (int r = 0; r < 8; ++r) { const int row = r * 8 + (lane >> 3), c8 = lane & 7;
                    *(LAS u32x4*)(Vl + row * VS + c8 * 8) = *(const u32x4*)(kbase + (size_t)row * 3584 + 512 + c8 * 8); }
                bf16x8 kf[4][2];
#pragma unroll
                for (int kt = 0; kt < 4; ++kt)
#pragma unroll
                    for (int ks = 0; ks < 2; ++ks) kf[kt][ks] = *(const bf16x8*)(kbase + (size_t)(kt * 16 + li) * 3584 + 32 * ks + 8 * g4);
                wave_lds_fence();
                const bool diag = (kb == kbd);
                const int kpos0 = kb * 64 + 4 * g4;
#pragma unroll
                for (int qt = 0; qt < 2; ++qt) {
                    const int qpos = t0 + qt * 16 + li;
                    f32x4 z[4];
#pragma unroll
                    for (int kt = 0; kt < 4; ++kt) { f32x4 a = (f32x4){0.f, 0.f, 0.f, 0.f}; a = mfma16(kf[kt][0], qf[qt][0], a); a = mfma16(kf[kt][1], qf[qt][1], a); z[kt] = a; }
                    float T = 0.f; unsigned hi[4][2], lo[4][2];
#pragma unroll
                    for (int kt = 0; kt < 4; ++kt) { float Lv[4];
#pragma unroll
                        for (int jj = 0; jj < 4; ++jj) { const float zz = z[kt][jj] * 0.125f;
                            const bool valid = !diag || (kpos0 + kt * 16 + jj < qpos);
                            const float sp = fmaxf(zz, 0.f) + __logf(1.f + __expf(-fabsf(zz)));
                            Lv[jj] = valid ? -sp : 0.f; T += Lv[jj];
                            z[kt][jj] = valid ? (zz - sp) : -1e30f; }
                        hi[kt][0] = pk2(Lv[0], Lv[1]); hi[kt][1] = pk2(Lv[2], Lv[3]);
                        lo[kt][0] = pk2(Lv[0] - lo_f(hi[kt][0]), Lv[1] - hi_f(hi[kt][0])); lo[kt][1] = pk2(Lv[2] - lo_f(hi[kt][1]), Lv[3] - hi_f(hi[kt][1])); }
                    T += __shfl_xor(T, 16); T += __shfl_xor(T, 32);
                    bf16x8 Lh[2], Ll[2];
#pragma unroll
                    for (int kk = 0; kk < 2; ++kk) { Lh[kk] = as_frag((u32x4){hi[2 * kk][0], hi[2 * kk][1], hi[2 * kk + 1][0], hi[2 * kk + 1][1]});
                        Ll[kk] = as_frag((u32x4){lo[2 * kk][0], lo[2 * kk][1], lo[2 * kk + 1][0], lo[2 * kk + 1][1]}); }
                    unsigned pw[4][2];
#pragma unroll
                    for (int st = 0; st < 4; ++st) { f32x4 ce = (f32x4){0.f, 0.f, 0.f, 0.f};
#pragma unroll
                        for (int kk = 0; kk < 2; ++kk) { if (2 * kk + 1 >= st) {
                            u32x4 ua;
                            { const int k0 = 2 * kk, k1 = 2 * kk + 1;
                              ua.x = k0 > st ? ONES : (k0 == st ? dpat.x : 0u); ua.y = k0 > st ? ONES : (k0 == st ? dpat.y : 0u);
                              ua.z = k1 > st ? ONES : (k1 == st ? dpat.x : 0u); ua.w = k1 > st ? ONES : (k1 == st ? dpat.y : 0u); }
                            ce = mfma16(as_frag(ua), Lh[kk], ce); ce = mfma16(as_frag(ua), Ll[kk], ce); } }
                        float w[4];
#pragma unroll
                        for (int jj = 0; jj < 4; ++jj) w[jj] = __expf(z[st][jj] + R[qt] + ce[jj]);
                        pw[st][0] = pk2(w[0], w[1]); pw[st][1] = pk2(w[2], w[3]); }
                    R[qt] += T;
#pragma unroll
                    for (int kk = 0; kk < 2; ++kk) { const bf16x8 pfr = as_frag((u32x4){pw[2 * kk][0], pw[2 * kk][1], pw[2 * kk + 1][0], pw[2 * kk + 1][1]});
#pragma unroll
                        for (int dt = 0; dt < 4; ++dt) { const bf16x8 vf = tr_pair(Vl, VS, 32 * kk + 4 * g4, 32 * kk + 16 + 4 * g4, dt * 16, li); o[dt][qt] = mfma16(vf, pfr, o[dt][qt]); } }
                }
                wave_lds_fence();
#if SB_EARLY_EXIT
                { const float rm = fmaxf(R[0], R[1]); if (__all(rm < -120.f)) break; }
#endif
            }
#pragma unroll
            for (int qt = 0; qt < 2; ++qt)
#pragma unroll
                for (int dt = 0; dt < 4; ++dt) { const f32x4 v = o[dt][qt];
                    *(u32x2*)(MIX + ((size_t)b * SEQ + t0 + qt * 16 + li) * 1024 + 512 + h * 64 + dt * 16 + 4 * g4) = (u32x2){pk2(v[0], v[1]), pk2(v[2], v[3])}; }
        }
    }
}

constexpr int RS = 136;
__device__ __forceinline__ float ret_log_gamma(int h) { return logf(1.f - exp2f(-5.f - (float)h)); }
template <int MODE  >
__device__ __forceinline__ void ret_load_rot(LAS bf16_t* dst, const bf16_t* src  , const f32x2* rope, int pos0, float lg, float scl) {
    const int tid = tid_opaque(), j = tid >> 3, part = tid & 7;
    const u32x4 a = *(const u32x4*)(src + (size_t)j * 3584 + part * 8), bq = *(const u32x4*)(src + (size_t)j * 3584 + 64 + part * 8);
    const f32x2* cs = rope + (size_t)(pos0 + j) * 64 + part * 8;
    float x1[8] = {lo_f(a.x), hi_f(a.x), lo_f(a.y), hi_f(a.y), lo_f(a.z), hi_f(a.z), lo_f(a.w), hi_f(a.w)};
    float x2[8] = {lo_f(bq.x), hi_f(bq.x), lo_f(bq.y), hi_f(bq.y), lo_f(bq.z), hi_f(bq.z), lo_f(bq.w), hi_f(bq.w)};
    const float rsc = MODE == 0 ? scl * __expf(lg * (63.f - (float)j)) : scl;
    float o1[8], o2[8];
#pragma unroll
    for (int e = 0; e < 8; ++e) { const f32x2 c = cs[e]; o1[e] = (x1[e] * c.x - x2[e] * c.y) * rsc; o2[e] = (x1[e] * c.y + x2[e] * c.x) * rsc; }
    *(LAS u32x4*)(dst + j * RS + part * 8) = (u32x4){pk2(o1[0], o1[1]), pk2(o1[2], o1[3]), pk2(o1[4], o1[5]), pk2(o1[6], o1[7])};
    *(LAS u32x4*)(dst + j * RS + 64 + part * 8) = (u32x4){pk2(o2[0], o2[1]), pk2(o2[2], o2[3]), pk2(o2[4], o2[5]), pk2(o2[6], o2[7])};
}
__device__ __forceinline__ void ret_load_plain(LAS bf16_t* dst, const bf16_t* src) {
    const int tid = tid_opaque(), j = tid >> 3, part = tid & 7;
    *(LAS u32x4*)(dst + j * RS + part * 16) = *(const u32x4*)(src + (size_t)j * 3584 + part * 16);
    *(LAS u32x4*)(dst + j * RS + part * 16 + 8) = *(const u32x4*)(src + (size_t)j * 3584 + part * 16 + 8);
}
__device__ __forceinline__ void reta_phase(const Params& p, LAS unsigned char* lds) {
    const int tid = tid_opaque(), wid = tid >> 6, lane = tid & 63, li = lane & 15, g4 = lane >> 4;
    const bf16_t* QKV = (const bf16_t*)(p.ws + WS_R1);
    const f32x2* rope = (const f32x2*)(p.ws + WS_ROPE);
    bf16_t* RET = (bf16_t*)(p.ws + WS_H);
    LAS bf16_t* Kl = (LAS bf16_t*)lds; LAS bf16_t* Vl = (LAS bf16_t*)(lds + 64 * RS * 2);
    for (int item = blockIdx.x; item < 4096; item += gridDim.x) {
        const int c = item & 63, hh = (item >> 6) & 3, b = item >> 8;
        const float lg = ret_log_gamma(hh);
        const bf16_t* base = QKV + ((size_t)b * SEQ + c * 64) * 3584 + hh * 128;
        __syncthreads();
        ret_load_rot<0>(Kl, base + 512, rope, c * 64, lg, 0.08838834764831845f);
        ret_load_plain(Vl, base + 1024);
        __syncthreads();
        f32x4 acc[8];
#pragma unroll
        for (int et = 0; et < 8; ++et) acc[et] = (f32x4){0.f, 0.f, 0.f, 0.f};
#pragma unroll
        for (int kk = 0; kk < 2; ++kk) { const bf16x8 af = tr_pair(Kl, RS, 32 * kk + 8 * g4, 32 * kk + 8 * g4 + 4, wid * 16, li);
#pragma unroll
            for (int et = 0; et < 8; ++et) { const bf16x8 bfr = tr_pair(Vl, RS, 32 * kk + 8 * g4, 32 * kk + 8 * g4 + 4, et * 16, li); acc[et] = mfma16(af, bfr, acc[et]); } }
        const size_t sid = (size_t)((b * 4 + hh) * 64 + c);
#pragma unroll
        for (int et = 0; et < 8; ++et) *(u32x2*)(RET + (sid * 128 + et * 16 + li) * 128 + wid * 16 + 4 * g4) = (u32x2){pk2(acc[et][0], acc[et][1]), pk2(acc[et][2], acc[et][3])};
    }
}
__device__ __forceinline__ void retscan_phase(const Params& p) {
    bf16_t* RET = (bf16_t*)(p.ws + WS_H);
    const int gtid = blockIdx.x * NTHR + tid_opaque(), nthr = gridDim.x * NTHR;
    for (int w = gtid; w < 64 * 2048; w += nthr) {
        const int bhh = w >> 11, e8 = w & 2047, hh = bhh & 3;
        const float cd = __expf(64.f * ret_log_gamma(hh));
        float S[8];
#pragma unroll
        for (int e = 0; e < 8; ++e) S[e] = 0.f;
        bf16_t* base = RET + (size_t)bhh * 64 * 16384 + e8 * 8;
        for (int c0 = 0; c0 < 64; c0 += 4) {
            u32x4 kv[4];
#pragma unroll
            for (int k = 0; k < 4; ++k) kv[k] = *(const u32x4*)(base + (size_t)(c0 + k) * 16384);
#pragma unroll
            for (int k = 0; k < 4; ++k) {
                *(u32x4*)(base + (size_t)(c0 + k) * 16384) = (u32x4){pk2(S[0], S[1]), pk2(S[2], S[3]), pk2(S[4], S[5]), pk2(S[6], S[7])};
                S[0] = S[0] * cd + lo_f(kv[k].x); S[1] = S[1] * cd + hi_f(kv[k].x); S[2] = S[2] * cd + lo_f(kv[k].y); S[3] = S[3] * cd + hi_f(kv[k].y);
                S[4] = S[4] * cd + lo_f(kv[k].z); S[5] = S[5] * cd + hi_f(kv[k].z); S[6] = S[6] * cd + lo_f(kv[k].w); S[7] = S[7] * cd + hi_f(kv[k].w); }
        }
    }
}
__device__ __forceinline__ void retc_phase(const Params& p, LAS unsigned char* lds) {
    const int tid = tid_opaque(), wid = tid >> 6, lane = tid & 63, li = lane & 15, g4 = lane >> 4;
    const bf16_t* QKV = (const bf16_t*)(p.ws + WS_R1);
    const f32x2* rope = (const f32x2*)(p.ws + WS_ROPE);
    const bf16_t* RET = (const bf16_t*)(p.ws + WS_H);
    bf16_t* MIX = (bf16_t*)(p.ws + WS_MIX);
    LAS bf16_t* Ql = (LAS bf16_t*)lds; LAS bf16_t* Kl = (LAS bf16_t*)(lds + 17408); LAS bf16_t* Vl = (LAS bf16_t*)(lds + 34816);
    LAS bf16_t* Sl = (LAS bf16_t*)(lds + 52224);
    LAS f32x2* stl = (LAS f32x2*)(lds + 61440);
    for (int item = blockIdx.x; item < 4096; item += gridDim.x) {
        const int c = item & 63, hh = (item >> 6) & 3, b = item >> 8;
        const float lg = ret_log_gamma(hh);
        const size_t row0 = (size_t)b * SEQ + c * 64;
        const bf16_t* base = QKV + row0 * 3584 + hh * 128;
        __syncthreads();
        ret_load_rot<1>(Ql, base, rope, c * 64, lg, 1.f);
        ret_load_rot<1>(Kl, base + 512, rope, c * 64, lg, 0.08838834764831845f);
        ret_load_plain(Vl, base + 1024);
        __syncthreads();
        { const int jt = wid >> 1;
#pragma unroll
          for (int e2 = 0; e2 < 2; ++e2) { const int itq = 2 * (wid & 1) + e2; f32x4 sacc = (f32x4){0.f, 0.f, 0.f, 0.f};
#pragma unroll
              for (int ks = 0; ks < 4; ++ks) { const bf16x8 af = *(const LAS bf16x8*)(Kl + (jt * 16 + li) * RS + 32 * ks + 8 * g4); const bf16x8 bfr = *(const LAS bf16x8*)(Ql + (itq * 16 + li) * RS + 32 * ks + 8 * g4); sacc = mfma16(af, bfr, sacc); }
              float sv[4];
#pragma unroll
              for (int jj = 0; jj < 4; ++jj) { const int j = jt * 16 + 4 * g4 + jj, iq = itq * 16 + li; const int dd = iq > j ? iq - j : j - iq; sv[jj] = sacc[jj] * __expf(lg * (float)dd); }
              *(LAS u32x2*)(Sl + (itq * 16 + li) * VS + jt * 16 + 4 * g4) = (u32x2){pk2(sv[0], sv[1]), pk2(sv[2], sv[3])}; } }
        __syncthreads();
        f32x4 oa[4];
#pragma unroll
        for (int itq = 0; itq < 4; ++itq) oa[itq] = (f32x4){0.f, 0.f, 0.f, 0.f};
        const size_t sid = (size_t)((b * 4 + hh) * 64 + c);
#pragma unroll
        for (int ks = 0; ks < 4; ++ks) { const bf16x8 af = *(const bf16x8*)(RET + (sid * 128 + wid * 16 + li) * 128 + 32 * ks + 8 * g4);
#pragma unroll
            for (int itq = 0; itq < 4; ++itq) { const bf16x8 bfr = *(const LAS bf16x8*)(Ql + (itq * 16 + li) * RS + 32 * ks + 8 * g4); oa[itq] = mfma16(af, bfr, oa[itq]); } }
#pragma unroll
        for (int itq = 0; itq < 4; ++itq) oa[itq] *= __expf(lg * (float)(itq * 16 + li + 1));
#pragma unroll
        for (int kk = 0; kk < 2; ++kk) { const bf16x8 af = tr_pair(Vl, RS, 32 * kk + 8 * g4, 32 * kk + 8 * g4 + 4, wid * 16, li);
#pragma unroll
            for (int itq = 0; itq < 4; ++itq) { const bf16x8 bfr = *(const LAS bf16x8*)(Sl + (itq * 16 + li) * VS + 32 * kk + 8 * g4); oa[itq] = mfma16(af, bfr, oa[itq]); } }
#pragma unroll
        for (int itq = 0; itq < 4; ++itq) { float s1 = oa[itq][0] + oa[itq][1] + oa[itq][2] + oa[itq][3];
            float s2 = oa[itq][0] * oa[itq][0] + oa[itq][1] * oa[itq][1] + oa[itq][2] * oa[itq][2] + oa[itq][3] * oa[itq][3];
            s1 += __shfl_xor(s1, 16); s1 += __shfl_xor(s1, 32); s2 += __shfl_xor(s2, 16); s2 += __shfl_xor(s2, 32);
            if (g4 == 0) stl[wid * 64 + itq * 16 + li] = (f32x2){s1, s2}; }
        __syncthreads();
        const f32x4 ng = *(const f32x4*)(p.in[25] + hh * 128 + wid * 16 + 4 * g4);
#pragma unroll
        for (int itq = 0; itq < 4; ++itq) { float s1 = 0.f, s2 = 0.f;
#pragma unroll
            for (int w8 = 0; w8 < 8; ++w8) { const f32x2 t = stl[w8 * 64 + itq * 16 + li]; s1 += t.x; s2 += t.y; }
            const float mu = s1 * (1.f / 128.f), var = fmaxf(s2 * (1.f / 128.f) - mu * mu, 0.f), rs = rsqrtf(var + 1e-6f);
            const size_t row = row0 + itq * 16 + li;
            const u32x2 gg = *(const u32x2*)(QKV + row * 3584 + 1536 + hh * 128 + wid * 16 + 4 * g4);
            const float r0 = (oa[itq][0] - mu) * rs * ng[0] * silu_f(lo_f(gg.x)), r1 = (oa[itq][1] - mu) * rs * ng[1] * silu_f(hi_f(gg.x));
            const float r2 = (oa[itq][2] - mu) * rs * ng[2] * silu_f(lo_f(gg.y)), r3 = (oa[itq][3] - mu) * rs * ng[3] * silu_f(hi_f(gg.y));
            *(u32x2*)(MIX + row * 1024 + hh * 128 + wid * 16 + 4 * g4) = (u32x2){pk2(r0, r1), pk2(r2, r3)}; }
    }
}

constexpr int N_PHASES = 20;
__global__ void __launch_bounds__(NTHR, 2) mega_fwd(Params p) {
    extern __shared__ __attribute__((aligned(16))) unsigned char lds_raw[];
    LAS unsigned char* lds = (LAS unsigned char*)lds_raw;
    cg::grid_group grid = cg::this_grid();
    unsigned char* ws = p.ws;
    const float* MOD = (const float*)(ws + WS_MOD);
    bf16_t* H = (bf16_t*)(ws + WS_H); bf16_t* MIX = (bf16_t*)(ws + WS_MIX); bf16_t* R1 = (bf16_t*)(ws + WS_R1);
    float* XA = p.out;
    pg8::StaticOrder S;
    for (int ph = p.ph_lo; ph < p.ph_hi; ++ph) {
        const int layer = ph >= 11 ? 1 : 0;
        const float* modl = MOD + (size_t)layer * 16 * 6144;
        switch (ph) {
        case 0: prep_phase(p, lds); break;
        case 1: case 8: case 11: case 17: {
            const bool ffn = (ph == 8 || ph == 17);
            const float* xin = (ph == 1) ? p.in[0] : XA;
            norm_phase(xin, (ffn ? p.in[5] : p.in[4]) + layer * 1024, modl + (ffn ? 3072 : 0), modl + (ffn ? 4096 : 1024), H);
        } break;
        case 2: case 12: {
            const int N = layer ? 3584 : 2048;
            pg8::Gemm g{H, (const bf16_t*)(ws + (layer ? WS_W_CDIN : WS_W_ABIN)), MTOK, N, 1024};
            S.init(MTOK, N, gridDim.x, blockIdx.x);
            pg8::EpiStore E{R1, N};
            pg8::gemm_phase(lds, g, S, E);
        } break;
        case 3: attnA_phase(p, lds); s5a_phase(p); break;
        case 4: s5scan_phase(p); break;
        case 5: s5c_phase(p, lds); break;
        case 6: {
            pg8::Gemm g{(const bf16_t*)(ws + WS_Y5), (const bf16_t*)(ws + WS_W_GLU), MTOK, 512, 512};
            S.init(MTOK, 512, gridDim.x, blockIdx.x);
            pg8::EpiGlu E{(const bf16_t*)(ws + WS_Y5), p.in[22], MIX};
            pg8::gemm_phase(lds, g, S, E);
        } break;
        case 7: case 16: case 10: case 19: {
            const bool ffn = (ph == 10 || ph == 19);
            const bf16_t* A = ffn ? R1 : MIX;
            const bf16_t* Bt = ffn ? (const bf16_t*)(ws + WS_W_FFOUT) + (size_t)layer * 1024 * FFH : (const bf16_t*)(ws + (layer ? WS_W_CDOUT : WS_W_ABOUT));
            pg8::Gemm g{A, Bt, MTOK, 1024, ffn ? FFH : 1024};
            S.init(MTOK, 1024, gridDim.x, blockIdx.x);
            pg8::EpiResid E{(ph == 7) ? p.in[0] : XA, XA, modl + (ffn ? 5120 : 2048)};
            pg8::gemm_phase(lds, g, S, E);
        } break;
        case 9: case 18: {
            pg8::Gemm g{H, (const bf16_t*)(ws + WS_W_FFIN) + (size_t)layer * 5632 * 1024, MTOK, 5632, 1024};
            S.init(MTOK, 5632, gridDim.x, blockIdx.x);
            pg8::EpiSwiglu E{R1};
            pg8::gemm_phase(lds, g, S, E);
        } break;
        case 13: reta_phase(p, lds); __syncthreads(); sb_phase(p, lds); break;
        case 14: retscan_phase(p); break;
        case 15: retc_phase(p, lds); break;
        default: break;
        }
        if (ph + 1 < p.ph_hi) { __threadfence(); asm volatile("s_waitcnt vmcnt(0) lgkmcnt(0)" ::: "memory"); grid.sync(); __threadfence(); asm volatile("s_waitcnt vmcnt(0) lgkmcnt(0)" ::: "memory"); }
    }
}


#ifndef DIAG
#define DIAG 0
#endif
#if DIAG
__global__ void diag_fold(Params p) {
    const size_t n = (size_t)MTOK * 1024; unsigned char* ws = p.ws;
    for (size_t i = (size_t)blockIdx.x * blockDim.x + threadIdx.x; i < n; i += (size_t)gridDim.x * blockDim.x) {
        const size_t row = i >> 10; const int col = (int)(i & 1023); float v = 0.f;
#if DIAG == 30
        v = col < 512 ? bf2f(((const bf16_t*)(ws + WS_MIX))[i]) : 0.f;
#elif DIAG == 31
        v = ((const float*)(ws + WS_S5E))[i & 4194303];
#elif DIAG == 3
        v = col < 512 ? bf2f(((const bf16_t*)(ws + WS_MIX))[i]) : ((const float*)(ws + WS_S5E))[(row * 512 + col - 512) & 4194303];
#elif DIAG == 2
        v = bf2f(((const bf16_t*)(ws + WS_R1))[2 * i]) + bf2f(((const bf16_t*)(ws + WS_R1))[2 * i + 1]);
#elif DIAG == 1
        v = bf2f(((const bf16_t*)(ws + WS_H))[i]);
#elif DIAG == 5
        v = bf2f(((const bf16_t*)(ws + WS_Y5))[i >> 1]);
#elif DIAG == 6
        v = bf2f(((const bf16_t*)(ws + WS_MIX))[i]);
#endif
        p.out[i] = v;
    }
}
#endif
#ifndef MK_MULTI
#define MK_MULTI 0
#endif
extern "C" void kernel_launch(void* const* d_in, const int* in_sizes, int n_in, void* d_out, int out_size, void* d_ws, size_t ws_size, hipStream_t stream) {
    static int grid = 0;
    if (grid == 0) {
        if (n_in != 26 || out_size != MTOK * DM || ws_size < WS_END) { fprintf(stderr, "kernel_launch: unexpected shapes (n_in %d out %d ws %zu need %zu)\n", n_in, out_size, ws_size, (size_t)WS_END); grid = -1; return; }
        int dev = 0, cus = 0, per_cu = 0;
        hipGetDevice(&dev); hipDeviceGetAttribute(&cus, hipDeviceAttributeMultiprocessorCount, dev);
        if (hipFuncSetAttribute((const void*)mega_fwd, hipFuncAttributeMaxDynamicSharedMemorySize, LDS_BYTES) != hipSuccess) { fprintf(stderr, "kernel_launch: hipFuncSetAttribute failed\n"); grid = -1; return; }
        if (hipOccupancyMaxActiveBlocksPerMultiprocessor(&per_cu, (const void*)mega_fwd, NTHR, LDS_BYTES) != hipSuccess || per_cu < 1) { fprintf(stderr, "kernel_launch: occupancy query says %d\n", per_cu); per_cu = 1; }
        (void)hipGetLastError();
        grid = cus * 1;
    }
    if (grid < 0) return;
    Params p{};
    for (int i = 0; i < 26; ++i) p.in[i] = (const float*)d_in[i];
    p.out = (float*)d_out; p.ws = (unsigned char*)d_ws;
#if MK_MULTI
#if DIAG
    for (int ph = 0; ph <= (DIAG >= 30 ? DIAG / 10 : DIAG); ++ph) { p.ph_lo = ph; p.ph_hi = ph + 1; hipLaunchKernelGGL(mega_fwd, dim3(grid), dim3(NTHR), LDS_BYTES, stream, p); }
    hipLaunchKernelGGL(diag_fold, dim3(2048), dim3(256), 0, stream, p);
#else
    for (int ph = 0; ph < N_PHASES; ++ph) { p.ph_lo = ph; p.ph_hi = ph + 1; hipLaunchKernelGGL(mega_fwd, dim3(grid), dim3(NTHR), LDS_BYTES, stream, p); }
#endif
#else
    p.ph_lo = 0; p.ph_hi = N_PHASES;
    void* args[] = {&p};
    hipError_t e = hipLaunchCooperativeKernel((const void*)mega_fwd, dim3(grid), dim3(NTHR), args, LDS_BYTES, stream);
    if (e != hipSuccess) fprintf(stderr, "cooperative launch failed: %s (grid %d)\n", hipGetErrorString(e), grid);
#endif
}
```

```cpp
#include <hip/hip_runtime.h>
#include <hip/hip_cooperative_groups.h>
#include <cstdio>
namespace cg = cooperative_groups;

#define LAS __attribute__((address_space(3)))
typedef unsigned short bf16_t;
typedef short bf16x8 __attribute__((ext_vector_type(8)));
typedef short s16x4 __attribute__((ext_vector_type(4)));
typedef float f32x4 __attribute__((ext_vector_type(4)));
typedef float f32x2 __attribute__((ext_vector_type(2)));
typedef unsigned u32x4 __attribute__((ext_vector_type(4)));
typedef unsigned u32x2 __attribute__((ext_vector_type(2)));

constexpr int NB = 16, SEQ = 4096, DM = 1024, MTOK = NB * SEQ, FFH = 2816;
constexpr int NTHR = 512;
constexpr int LDS_BYTES = 135168;

constexpr size_t al256(size_t x) { return (x + 255) & ~(size_t)255; }
constexpr size_t WS_CTL = 0;
constexpr size_t WS_W_ABIN = 4096;
constexpr size_t WS_W_ABOUT = WS_W_ABIN + (size_t)2048 * 1024 * 2;
constexpr size_t WS_W_GLU = WS_W_ABOUT + (size_t)1024 * 1024 * 2;
constexpr size_t WS_W_FFIN = WS_W_GLU + (size_t)512 * 512 * 2;
constexpr size_t WS_W_FFOUT = WS_W_FFIN + (size_t)2 * 5632 * 1024 * 2;
constexpr size_t WS_W_CDIN = WS_W_FFOUT + (size_t)2 * 1024 * 2816 * 2;
constexpr size_t WS_W_CDOUT = WS_W_CDIN + (size_t)3584 * 1024 * 2;
constexpr size_t WS_MOD = WS_W_CDOUT + (size_t)1024 * 1024 * 2;
constexpr size_t WS_ROPE = WS_MOD + (size_t)2 * 16 * 6144 * 4;
constexpr size_t WS_KERN = WS_ROPE + (size_t)4096 * 64 * 8;
constexpr size_t WS_S5M = WS_KERN + (size_t)32 * 64 * 256 * 2;
constexpr size_t WS_S5G = WS_S5M + (size_t)32 * 128 * 1024 * 2;
constexpr size_t WS_A64 = WS_S5G + (size_t)32 * 1024 * 128 * 2;
constexpr size_t WS_S5E = WS_A64 + (size_t)32 * 64 * 8;
constexpr size_t WS_S5X = WS_S5E + (size_t)64 * 32 * 16 * 128 * 4;
constexpr size_t WS_Y5 = WS_S5X + (size_t)64 * 32 * 16 * 128 * 2;
constexpr size_t WS_H = WS_Y5 + (size_t)MTOK * 512 * 2;
constexpr size_t WS_MIX = WS_H + (size_t)MTOK * 1024 * 2;
constexpr size_t WS_R1 = WS_MIX + (size_t)MTOK * 1024 * 2;
constexpr size_t WS_END = WS_R1 + (size_t)MTOK * 3584 * 2;

struct Params {
    const float* in[26];
    float* out;
    unsigned char* ws;
    int ph_lo, ph_hi;
};

__device__ __forceinline__ float bf2f(unsigned short b) { return __uint_as_float(((unsigned)b) << 16); }
typedef __bf16 bf16x2_t __attribute__((ext_vector_type(2)));
__device__ __forceinline__ unsigned pk2(float lo, float hi) { const f32x2 v = {lo, hi}; return __builtin_bit_cast(unsigned, __builtin_convertvector(v, bf16x2_t)); }
__device__ __forceinline__ bf16_t f2bf(float f) { return (bf16_t)(pk2(f, 0.f) & 0xffffu); }
__device__ __forceinline__ float lo_f(unsigned u) { return __uint_as_float(u << 16); }
__device__ __forceinline__ float hi_f(unsigned u) { return __uint_as_float(u & 0xffff0000u); }
__device__ __forceinline__ bf16x8 as_frag(u32x4 u) { return __builtin_bit_cast(bf16x8, u); }
__device__ __forceinline__ f32x4 mfma16(bf16x8 a, bf16x8 b, f32x4 c) { return __builtin_amdgcn_mfma_f32_16x16x32_bf16(a, b, c, 0, 0, 0); }
__device__ __forceinline__ float silu_f(float x) { return x * __builtin_amdgcn_rcpf(1.f + __expf(-x)); }
__device__ __forceinline__ float sigm_f(float x) { return __builtin_amdgcn_rcpf(1.f + __expf(-x)); }
__device__ __forceinline__ float gelu_tanh(float x) {
    const float u = 0.7978845608028654f * (x + 0.044715f * x * x * x);
    const float t = 1.f - 2.f * __builtin_amdgcn_rcpf(1.f + __expf(2.f * u));
    return 0.5f * x * (1.f + t);
}
__device__ __forceinline__ bf16x8 tr_pair(LAS bf16_t* base, int stride, int row0, int row1, int col0, int li) {
    const int q = li >> 2, pq = li & 3;
    s16x4 a = __builtin_amdgcn_ds_read_tr16_b64_v4i16((LAS s16x4*)(base + (row0 + q) * stride + col0 + 4 * pq));
    s16x4 b = __builtin_amdgcn_ds_read_tr16_b64_v4i16((LAS s16x4*)(base + (row1 + q) * stride + col0 + 4 * pq));
    bf16x8 r = {a[0], a[1], a[2], a[3], b[0], b[1], b[2], b[3]};
    return r;
}
__device__ __forceinline__ int tid_opaque() { int t = threadIdx.x; asm volatile("" : "+v"(t)); return t; }
__device__ __forceinline__ int vblock() { const int G = gridDim.x, bx = blockIdx.x; return (G % 8 == 0) ? (bx % 8) * (G / 8) + bx / 8 : bx; }
__device__ __forceinline__ void wave_lds_fence() { asm volatile("s_waitcnt lgkmcnt(0)" ::: "memory"); __builtin_amdgcn_wave_barrier(); }


__device__ __forceinline__ void grid_barrier(unsigned* w, unsigned& gen) {
    asm volatile("s_waitcnt vmcnt(0) lgkmcnt(0)" ::: "memory");
    __syncthreads();
    if (threadIdx.x == 0) {
        __builtin_amdgcn_fence(__ATOMIC_RELEASE, "agent");
        asm volatile("s_waitcnt vmcnt(0) lgkmcnt(0)" ::: "memory");
        const unsigned G = gridDim.x, grp = blockIdx.x & 7u, ngrp = (G - grp + 7u) / 8u, ngroups = G < 8u ? G : 8u;
        const unsigned old = __hip_atomic_fetch_add(w + 32 * grp, 1u, __ATOMIC_RELAXED, __HIP_MEMORY_SCOPE_AGENT);
        if (old + 1u == ngrp * (gen + 1u)) {
            const unsigned old2 = __hip_atomic_fetch_add(w + 256, 1u, __ATOMIC_RELAXED, __HIP_MEMORY_SCOPE_AGENT);
            if (old2 + 1u == ngroups * (gen + 1u)) __hip_atomic_fetch_add(w + 288, 1u, __ATOMIC_RELAXED, __HIP_MEMORY_SCOPE_AGENT);
        }
        while (__hip_atomic_load(w + 288, __ATOMIC_RELAXED, __HIP_MEMORY_SCOPE_AGENT) == gen) __builtin_amdgcn_s_sleep(2);
        __builtin_amdgcn_fence(__ATOMIC_ACQUIRE, "agent");
        asm volatile("s_waitcnt vmcnt(0) lgkmcnt(0)" ::: "memory");
    }
    ++gen;
    __syncthreads();
}

namespace pg8 {
constexpr int BM = 256, BK = 64, HALF = 128, HTB = HALF * BK * 2, STAGE_BYTES = 8 * HTB, NXCD = 8, WGM = 8;
__device__ __forceinline__ int lds_byte(int r, int c) { const int st = (r >> 4) * 2 + (c >> 5), rr = r & 15, cc = c & 31, ob = rr * 64 + cc * 2; return st * 1024 + (ob ^ (((ob >> 9) & 1) << 5)); }
__device__ __forceinline__ void stage_rc(int b, int& R, int& C) { const int st = b / 1024, sb = b % 1024, swz = sb ^ (((sb >> 9) & 1) << 5); R = (st >> 1) * 16 + swz / 64; C = (st & 1) * 32 + (swz % 64) / 2; }
__device__ __forceinline__ int perm32(int rho) { const int n = rho >> 4, i = rho & 15; return 8 * (i >> 2) + 4 * n + (i & 3); }
struct Unit { int pm, pn; };
struct Gemm { const bf16_t* A; const bf16_t* Bt; int M, N, K; };
struct StaticOrder {
    int nM, nN, nwg, G, c;
    __device__ void init(int M, int N, int G_, int c_) { nM = M / BM; nN = N / BM; nwg = nM * nN; G = G_; c = c_; }
    __device__ bool next(int i, Unit& u) const {
        const long L = (long)i * G + c; if (L >= nwg) return false;
        int wgid = (int)L; { const int q = nwg / NXCD, r = nwg % NXCD, xcd = wgid % NXCD, off = wgid / NXCD; wgid = (xcd < r ? xcd * (q + 1) : r * (q + 1) + (xcd - r) * q) + off; }
        const int nig = WGM * nN, gid = wgid / nig, fm = gid * WGM, gsz = (nM - fm) < WGM ? (nM - fm) : WGM;
        u.pm = fm + ((wgid % nig) % gsz); u.pn = (wgid % nig) / gsz; return true;
    }
};

template <class Epi>
__device__ __forceinline__ void gemm_phase(LAS unsigned char* lds, const Gemm g, const StaticOrder& S, const Epi& E) {
    const int tid = tid_opaque(), wid = __builtin_amdgcn_readfirstlane(tid >> 6), lane = tid & 63, wr = wid >> 2, wc = wid & 3, fr = lane & 15, fq = lane >> 4;
    const int K = g.K, nt = K / BK;
    unsigned voffA[2], voffB[2];
#pragma unroll
    for (int i = 0; i < 2; ++i) { int R, C; stage_rc(tid * 16 + i * 8192, R, C); const int Rb = Epi::PERM ? ((R & ~31) + perm32(R & 31)) : R;
        voffA[i] = (unsigned)(R * K + C) * 2u; voffB[i] = (unsigned)(Rb * K + C) * 2u; }
    const size_t kstep = (size_t)(BK * 2);
    const size_t hstep = (size_t)HALF * K * 2;
    const size_t tstep = 2 * hstep;
    const unsigned ldsw = (unsigned)wid * 1024u;
    const int aoff = lds_byte(wr * 64 + fr, fq * 8), boff = lds_byte(wc * 32 + fr, fq * 8);
#define PG8_SA(b, h) (((b) * 2 + (h)) * HTB)
#define PG8_SB(b, h) ((4 + (b) * 2 + (h)) * HTB)
#define PG8_STAGE(bufoff, gbase, voff) do { _Pragma("unroll") for (int _i = 0; _i < 2; ++_i) \
        __builtin_amdgcn_global_load_lds((const unsigned*)((const char*)(gbase) + (voff)[_i]), (LAS unsigned*)(lds + (bufoff) + ldsw + _i * 8192), 16, 0, 0); } while (0)
#define PG8_LDA(dst, b, h) do { _Pragma("unroll") for (int m = 0; m < 4; ++m) _Pragma("unroll") for (int k = 0; k < 2; ++k) dst[m][k] = *(const LAS bf16x8*)(lds + PG8_SA(b, h) + aoff + m * 2048 + k * 1024); } while (0)
#define PG8_LDB(dst, b, h) do { _Pragma("unroll") for (int n = 0; n < 2; ++n) _Pragma("unroll") for (int k = 0; k < 2; ++k) dst[n][k] = *(const LAS bf16x8*)(lds + PG8_SB(b, h) + boff + n * 2048 + k * 1024); } while (0)
#define PG8_MMA(ai, bj, At, Bt) do { __builtin_amdgcn_s_setprio(1); _Pragma("unroll") for (int m = 0; m < 4; ++m) _Pragma("unroll") for (int n = 0; n < 2; ++n) _Pragma("unroll") for (int k = 0; k < 2; ++k) \
        acc[ai][bj][m][n] = __builtin_amdgcn_mfma_f32_16x16x32_bf16(Bt[n][k], At[m][k], acc[ai][bj][m][n], 0, 0, 0); __builtin_amdgcn_s_setprio(0); } while (0)
#define PG8_WAIT_V(n) asm volatile("s_waitcnt vmcnt(" #n ")" ::: "memory")
#define PG8_WAIT_L(n) asm volatile("s_waitcnt lgkmcnt(" #n ")" ::: "memory")
#define PG8_BAR __builtin_amdgcn_s_barrier()
#define PG8_SCHED __builtin_amdgcn_sched_barrier(0)
    Unit cur, nxt; int ui = 0;
    if (!S.next(0, cur)) return;
    f32x4 acc[2][2][4][2];
#pragma unroll
    for (int a = 0; a < 2; ++a)
#pragma unroll
        for (int b = 0; b < 2; ++b)
#pragma unroll
            for (int m = 0; m < 4; ++m)
#pragma unroll
                for (int n = 0; n < 2; ++n) acc[a][b][m][n] = (f32x4){0.f, 0.f, 0.f, 0.f};
    bf16x8 At[4][2], B0[2][2], B1[2][2];
    const char* cA = (const char*)g.A + (size_t)cur.pm * tstep; const char* cB = (const char*)g.Bt + (size_t)cur.pn * tstep;
    PG8_STAGE(PG8_SB(0, 0), cB, voffB); PG8_STAGE(PG8_SA(0, 0), cA, voffA); PG8_STAGE(PG8_SB(0, 1), cB + hstep, voffB); PG8_STAGE(PG8_SA(0, 1), cA + hstep, voffA);
    if (wr == 1) PG8_BAR;
    PG8_WAIT_V(4); PG8_BAR;
    PG8_STAGE(PG8_SB(1, 0), cB + kstep, voffB); PG8_STAGE(PG8_SA(1, 0), cA + kstep, voffA); PG8_STAGE(PG8_SB(1, 1), cB + hstep + kstep, voffB);
    PG8_WAIT_V(6); PG8_BAR;
    for (;;) {
        const bool has_next = S.next(ui + 1, nxt);
        const char* nA = has_next ? (const char*)g.A + (size_t)nxt.pm * tstep : cA; const char* nB = has_next ? (const char*)g.Bt + (size_t)nxt.pn * tstep : cB;
        for (int t = 0; t < nt; t += 2) {
            const bool last = (t == nt - 2);
            const char* a1 = cA + (size_t)(t + 1) * kstep;
            const char* a2 = last ? nA : cA + (size_t)(t + 2) * kstep; const char* b2 = last ? nB : cB + (size_t)(t + 2) * kstep;
            const char* a3 = a2 + kstep; const char* b3 = b2 + kstep;
            PG8_LDB(B0, 0, 0); PG8_SCHED; PG8_LDA(At, 0, 0); PG8_STAGE(PG8_SA(1, 1), a1 + hstep, voffA);
            PG8_WAIT_L(8); PG8_BAR; PG8_WAIT_L(0); PG8_MMA(0, 0, At, B0); PG8_BAR; PG8_SCHED;
            PG8_LDB(B1, 0, 1); PG8_STAGE(PG8_SB(0, 0), b2, voffB);
            PG8_BAR; PG8_WAIT_L(0); PG8_MMA(0, 1, At, B1); PG8_BAR;
            PG8_LDA(At, 0, 1); PG8_STAGE(PG8_SA(0, 0), a2, voffA);
            PG8_BAR; PG8_WAIT_L(0); PG8_MMA(1, 0, At, B0); PG8_BAR; PG8_SCHED;
            PG8_STAGE(PG8_SB(0, 1), b2 + hstep, voffB);
            PG8_WAIT_V(6); PG8_BAR; PG8_MMA(1, 1, At, B1); PG8_BAR;
            PG8_LDB(B0, 1, 0); PG8_SCHED; PG8_LDA(At, 1, 0); PG8_STAGE(PG8_SA(0, 1), a2 + hstep, voffA);
            PG8_WAIT_L(8); PG8_BAR; PG8_WAIT_L(0); PG8_MMA(0, 0, At, B0); PG8_BAR; PG8_SCHED;
            PG8_LDB(B1, 1, 1); PG8_STAGE(PG8_SB(1, 0), b3, voffB);
            PG8_BAR; PG8_WAIT_L(0); PG8_MMA(0, 1, At, B1); PG8_BAR;
            PG8_LDA(At, 1, 1); PG8_STAGE(PG8_SA(1, 0), a3, voffA);
            PG8_BAR; PG8_WAIT_L(0); PG8_MMA(1, 0, At, B0); PG8_BAR; PG8_SCHED;
            PG8_STAGE(PG8_SB(1, 1), b3 + hstep, voffB);
            PG8_WAIT_V(6); PG8_BAR; PG8_MMA(1, 1, At, B1); PG8_BAR;
        }
        E(acc, cur, wr, wc, fr, fq);
        if (!has_next) break;
#pragma unroll
        for (int a = 0; a < 2; ++a)
#pragma unroll
            for (int b = 0; b < 2; ++b)
#pragma unroll
                for (int m = 0; m < 4; ++m)
#pragma unroll
                    for (int n = 0; n < 2; ++n) acc[a][b][m][n] = (f32x4){0.f, 0.f, 0.f, 0.f};
        cur = nxt; cA = nA; cB = nB; ++ui;
    }
    PG8_WAIT_V(0);
    if (wr == 0) PG8_BAR;
    PG8_BAR;
#undef PG8_SA
#undef PG8_SB
#undef PG8_STAGE
#undef PG8_LDA
#undef PG8_LDB
#undef PG8_MMA
#undef PG8_WAIT_V
#undef PG8_WAIT_L
#undef PG8_BAR
#undef PG8_SCHED
}

struct EpiStore {
    static constexpr bool PERM = true;
    bf16_t* O; int ldc;
    __device__ __forceinline__ void operator()(const f32x4 (&acc)[2][2][4][2], const Unit& u, int wr, int wc, int fr, int fq) const {
        const int row0 = u.pm * BM + wr * 64 + fr, col0 = u.pn * BM + wc * 32 + 8 * fq;
#pragma unroll
        for (int ai = 0; ai < 2; ++ai)
#pragma unroll
            for (int m = 0; m < 4; ++m) { bf16_t* rowp = O + (size_t)(row0 + ai * HALF + m * 16) * ldc + col0;
#pragma unroll
                for (int bj = 0; bj < 2; ++bj) { const f32x4 v0 = acc[ai][bj][m][0], v1 = acc[ai][bj][m][1];
                    u32x4 w; w.x = pk2(v0[0], v0[1]); w.y = pk2(v0[2], v0[3]); w.z = pk2(v1[0], v1[1]); w.w = pk2(v1[2], v1[3]);
                    __builtin_nontemporal_store(w, (u32x4*)(rowp + bj * HALF)); } }
    }
};
struct EpiStoreQK {
    static constexpr bool PERM = true;
    bf16_t* O; const float* qg; const float* kg;
    __device__ __forceinline__ void operator()(const f32x4 (&acc)[2][2][4][2], const Unit& u, int wr, int wc, int fr, int fq) const {
        const int row0 = u.pm * BM + wr * 64 + fr;
        if (u.pn >= 4) {
            const int col0 = u.pn * BM + wc * 32 + 8 * fq;
#pragma unroll
            for (int ai = 0; ai < 2; ++ai)
#pragma unroll
                for (int m = 0; m < 4; ++m) { bf16_t* rowp = O + (size_t)(row0 + ai * HALF + m * 16) * 2048 + col0;
#pragma unroll
                    for (int bj = 0; bj < 2; ++bj) { const f32x4 v0 = acc[ai][bj][m][0], v1 = acc[ai][bj][m][1];
                        u32x4 w; w.x = pk2(v0[0], v0[1]); w.y = pk2(v0[2], v0[3]); w.z = pk2(v1[0], v1[1]); w.w = pk2(v1[2], v1[3]);
                        __builtin_nontemporal_store(w, (u32x4*)(rowp + bj * HALF)); } }
        } else {
            const float* gp = u.pn < 2 ? qg : kg; const float scl = u.pn < 2 ? 0.125f * 1.4426950408889634f : 1.f;
            f32x4 gn[2][2];
#pragma unroll
            for (int bj = 0; bj < 2; ++bj)
#pragma unroll
                for (int n = 0; n < 2; ++n) gn[bj][n] = *(const f32x4*)(gp + 32 * bj + 8 * fq + 4 * n);
            const int col0 = u.pn * BM + wc * 64 + 8 * fq;
#pragma unroll
            for (int ai = 0; ai < 2; ++ai)
#pragma unroll
                for (int m = 0; m < 4; ++m) { bf16_t* rowp = O + (size_t)(row0 + ai * HALF + m * 16) * 2048 + col0;
                    float ss = 0.f;
#pragma unroll
                    for (int bj = 0; bj < 2; ++bj)
#pragma unroll
                        for (int n = 0; n < 2; ++n) { const f32x4 a = acc[ai][bj][m][n]; ss += a[0] * a[0] + a[1] * a[1] + a[2] * a[2] + a[3] * a[3]; }
                    ss += __shfl_xor(ss, 16); ss += __shfl_xor(ss, 32);
                    const float r = rsqrtf(ss * (1.f / 64.f) + 1e-6f) * scl;
#pragma unroll
                    for (int bj = 0; bj < 2; ++bj) { const f32x4 v0 = acc[ai][bj][m][0] * r * gn[bj][0], v1 = acc[ai][bj][m][1] * r * gn[bj][1];
                        u32x4 w; w.x = pk2(v0[0], v0[1]); w.y = pk2(v0[2], v0[3]); w.z = pk2(v1[0], v1[1]); w.w = pk2(v1[2], v1[3]);
                        __builtin_nontemporal_store(w, (u32x4*)(rowp + 32 * bj)); } }
        }
    }
};
struct EpiSwiglu {
    static constexpr bool PERM = true;
    bf16_t* O;
    __device__ __forceinline__ void operator()(const f32x4 (&acc)[2][2][4][2], const Unit& u, int wr, int wc, int fr, int fq) const {
        const int row0 = u.pm * BM + wr * 64 + fr, col0 = u.pn * HALF + wc * 32 + 8 * fq;
#pragma unroll
        for (int ai = 0; ai < 2; ++ai)
#pragma unroll
            for (int m = 0; m < 4; ++m) { bf16_t* rowp = O + (size_t)(row0 + ai * HALF + m * 16) * FFH + col0;
                float r[8];
#pragma unroll
                for (int n = 0; n < 2; ++n)
#pragma unroll
                    for (int j = 0; j < 4; ++j) r[n * 4 + j] = silu_f(acc[ai][0][m][n][j]) * acc[ai][1][m][n][j];
                u32x4 w; w.x = pk2(r[0], r[1]); w.y = pk2(r[2], r[3]); w.z = pk2(r[4], r[5]); w.w = pk2(r[6], r[7]);
                __builtin_nontemporal_store(w, (u32x4*)rowp); }
    }
};
struct EpiGlu {
    static constexpr bool PERM = true;
    const bf16_t* Y; const float* bias; bf16_t* O;
    __device__ __forceinline__ void operator()(const f32x4 (&acc)[2][2][4][2], const Unit& u, int wr, int wc, int fr, int fq) const {
        const int row0 = u.pm * BM + wr * 64 + fr, col0 = u.pn * BM + wc * 32 + 8 * fq;
#pragma unroll
        for (int bj = 0; bj < 2; ++bj) {
            const int col = col0 + bj * HALF;
            const f32x4 b0 = *(const f32x4*)(bias + col), b1 = *(const f32x4*)(bias + col + 4);
            u32x4 yv[2][4];
#pragma unroll
            for (int ai = 0; ai < 2; ++ai)
#pragma unroll
                for (int m = 0; m < 4; ++m) yv[ai][m] = *(const u32x4*)(Y + (size_t)(row0 + ai * HALF + m * 16) * 512 + col);
#pragma unroll
            for (int ai = 0; ai < 2; ++ai)
#pragma unroll
                for (int m = 0; m < 4; ++m) { const size_t row = (size_t)(row0 + ai * HALF + m * 16);
                    const u32x4 y4 = yv[ai][m];
                    const f32x4 v0 = acc[ai][bj][m][0] + b0, v1 = acc[ai][bj][m][1] + b1;
                    float r[8];
                    r[0] = lo_f(y4.x) * sigm_f(v0[0]); r[1] = hi_f(y4.x) * sigm_f(v0[1]); r[2] = lo_f(y4.y) * sigm_f(v0[2]); r[3] = hi_f(y4.y) * sigm_f(v0[3]);
                    r[4] = lo_f(y4.z) * sigm_f(v1[0]); r[5] = hi_f(y4.z) * sigm_f(v1[1]); r[6] = lo_f(y4.w) * sigm_f(v1[2]); r[7] = hi_f(y4.w) * sigm_f(v1[3]);
                    u32x4 w; w.x = pk2(r[0], r[1]); w.y = pk2(r[2], r[3]); w.z = pk2(r[4], r[5]); w.w = pk2(r[6], r[7]);
                    __builtin_nontemporal_store(w, (u32x4*)(O + row * 1024 + 512 + col)); }
        }
    }
};
struct EpiResid {
    static constexpr bool PERM = false;
    const float* res; float* out; const float* gate;
    __device__ __forceinline__ void operator()(const f32x4 (&acc)[2][2][4][2], const Unit& u, int wr, int wc, int fr, int fq) const {
        const int row0 = u.pm * BM + wr * 64 + fr, col0 = u.pn * BM + wc * 32 + 4 * fq;
        const int bidx = (u.pm * BM) >> 12;
        f32x4 gv[2][2];
#pragma unroll
        for (int bj = 0; bj < 2; ++bj)
#pragma unroll
            for (int n = 0; n < 2; ++n) gv[bj][n] = *(const f32x4*)(gate + (size_t)bidx * 6144 + col0 + bj * HALF + n * 16);
        f32x4 rv[2][2][2][2];
#define EPR_LOAD(buf, q) do { _Pragma("unroll") for (int mm = 0; mm < 2; ++mm) _Pragma("unroll") for (int bj = 0; bj < 2; ++bj) _Pragma("unroll") for (int n = 0; n < 2; ++n) \
            rv[buf][mm][bj][n] = *(const f32x4*)(res + (size_t)(row0 + ((q) >> 1) * HALF + (((q) & 1) * 2 + mm) * 16) * 1024 + col0 + bj * HALF + n * 16); } while (0)
#define EPR_STORE(buf, q) do { _Pragma("unroll") for (int mm = 0; mm < 2; ++mm) _Pragma("unroll") for (int bj = 0; bj < 2; ++bj) _Pragma("unroll") for (int n = 0; n < 2; ++n) \
            __builtin_nontemporal_store(rv[buf][mm][bj][n] + gv[bj][n] * acc[(q) >> 1][bj][((q) & 1) * 2 + mm][n], (f32x4*)(out + (size_t)(row0 + ((q) >> 1) * HALF + (((q) & 1) * 2 + mm) * 16) * 1024 + col0 + bj * HALF + n * 16)); } while (0)
        EPR_LOAD(0, 0); EPR_LOAD(1, 1); EPR_STORE(0, 0); EPR_LOAD(0, 2); EPR_STORE(1, 1); EPR_LOAD(1, 3); EPR_STORE(0, 2); EPR_STORE(1, 3);
#undef EPR_LOAD
#undef EPR_STORE
    }
};
}

__device__ __forceinline__ int wt_src_col(int n, int mode) {
    if (mode == 1) { const int tt = n >> 8, r = n & 255; return r < 128 ? tt * 128 + r : FFH + tt * 128 + (r - 128); }
    if (mode == 2 && n < 1024) { const int lc = n & 255; return (n & ~255) + ((lc >> 5) & 3) * 64 + 32 * (lc >> 7) + (lc & 31); }
    return n;
}
__device__ __forceinline__ void transpose_cvt(LAS float* tile, const float* __restrict__ W, int K, int N, bf16_t* __restrict__ Wt, int mode) {
    const int tid = tid_opaque();
    const int tilesN = N / 64, tilesK = K / 64, ntl = tilesN * tilesK;
    float cur[8];
    if ((int)blockIdx.x < ntl) { const int tn = blockIdx.x % tilesN, tk = blockIdx.x / tilesN; const int nsrc = wt_src_col(tn * 64 + (tid & 63), mode);
#pragma unroll
        for (int r = 0; r < 8; ++r) cur[r] = W[(size_t)(tk * 64 + (tid >> 6) + 8 * r) * N + nsrc]; }
    for (int t = blockIdx.x; t < ntl; t += gridDim.x) {
        const int tn = t % tilesN, tk = t / tilesN;
        const int n0d = tn * 64, k0 = tk * 64;
#pragma unroll
        for (int r = 0; r < 8; ++r) { const int kk = (tid >> 6) + 8 * r; tile[kk * 65 + (tid & 63)] = cur[r]; }
        const int t2 = t + gridDim.x;
        if (t2 < ntl) { const int tn2 = t2 % tilesN, tk2 = t2 / tilesN; const int nsrc = wt_src_col(tn2 * 64 + (tid & 63), mode);
#pragma unroll
            for (int r = 0; r < 8; ++r) cur[r] = W[(size_t)(tk2 * 64 + (tid >> 6) + 8 * r) * N + nsrc]; }
        __syncthreads();
        { const int nn = tid >> 3, kc = (tid & 7) * 8; float v[8];
#pragma unroll
          for (int j = 0; j < 8; ++j) v[j] = tile[(kc + j) * 65 + nn];
          u32x4 w; w.x = pk2(v[0], v[1]); w.y = pk2(v[2], v[3]); w.z = pk2(v[4], v[5]); w.w = pk2(v[6], v[7]);
          *(u32x4*)(Wt + (size_t)(n0d + nn) * K + k0 + kc) = w; }
        __syncthreads();
    }
}

struct S5gp { float lrdt, lidt, fre, fim; };
__device__ __forceinline__ S5gp s5_gp(const Params& p, int g, int pp) {
    S5gp r; const float dt = expf(p.in[15][g]); const float lr = p.in[13][g * 64 + pp], li = p.in[14][g * 64 + pp];
    r.lrdt = lr * dt; r.lidt = li * dt;
    const float mag = expf(r.lrdt), are = mag * cosf(r.lidt), aim = mag * sinf(r.lidt), den = lr * lr + li * li;
    r.fre = ((are - 1.f) * lr + aim * li) / den; r.fim = (aim * lr - (are - 1.f) * li) / den;
    return r;
}
__device__ __forceinline__ f32x2 s5_apow(const S5gp& q, float n) { const float m = expf(n * q.lrdt), a = n * q.lidt; return (f32x2){m * cosf(a), m * sinf(a)}; }

__device__ __forceinline__ void prep_phase(const Params& p, LAS unsigned char* lds) {
    const int tid = tid_opaque();
    unsigned char* ws = p.ws;
    LAS float* tile = (LAS float*)lds;
    transpose_cvt(tile, p.in[8], 1024, 2048, (bf16_t*)(ws + WS_W_ABIN), 2);
    transpose_cvt(tile, p.in[9], 1024, 1024, (bf16_t*)(ws + WS_W_ABOUT), 0);
    transpose_cvt(tile, p.in[21], 512, 512, (bf16_t*)(ws + WS_W_GLU), 0);
    for (int l = 0; l < 2; ++l) {
        transpose_cvt(tile, p.in[6] + (size_t)l * 1024 * 5632, 1024, 5632, (bf16_t*)(ws + WS_W_FFIN) + (size_t)l * 5632 * 1024, 1);
        transpose_cvt(tile, p.in[7] + (size_t)l * FFH * 1024, FFH, 1024, (bf16_t*)(ws + WS_W_FFOUT) + (size_t)l * 1024 * FFH, 0);
    }
    transpose_cvt(tile, p.in[23], 1024, 3584, (bf16_t*)(ws + WS_W_CDIN), 0);
    transpose_cvt(tile, p.in[24], 1024, 1024, (bf16_t*)(ws + WS_W_CDOUT), 0);
    if (blockIdx.x < 192) {
        LAS float* sc = (LAS float*)lds; LAS float* red = (LAS float*)(lds + 65536);
        for (int idx = tid; idx < 16384; idx += NTHR) { const float v = p.in[1][idx]; sc[idx] = v / (1.f + expf(-v)); }
        __syncthreads();
        for (int item = blockIdx.x; item < 192; item += gridDim.x) {
            const int l = item / 96, cb = item % 96, cl = tid & 63, ksl = tid >> 6;
            float acc[16];
#pragma unroll
            for (int b = 0; b < 16; ++b) acc[b] = 0.f;
            const float* w = p.in[2] + (size_t)l * 1024 * 6144 + cb * 64 + cl;
            for (int k0 = ksl * 128; k0 < ksl * 128 + 128; k0 += 8) {
                float wv[8];
#pragma unroll
                for (int j = 0; j < 8; ++j) wv[j] = w[(size_t)(k0 + j) * 6144];
#pragma unroll
                for (int b = 0; b < 16; ++b) { const f32x4 s0 = *(const LAS f32x4*)(sc + b * 1024 + k0), s1 = *(const LAS f32x4*)(sc + b * 1024 + k0 + 4);
                    acc[b] += s0[0] * wv[0] + s0[1] * wv[1] + s0[2] * wv[2] + s0[3] * wv[3] + s1[0] * wv[4] + s1[1] * wv[5] + s1[2] * wv[6] + s1[3] * wv[7]; }
            }
#pragma unroll
            for (int b = 0; b < 16; ++b) red[(ksl * 16 + b) * 64 + cl] = acc[b];
            __syncthreads();
            for (int o = tid; o < 1024; o += NTHR) { const int b = o >> 6, cc = o & 63; float s = 0.f;
#pragma unroll
                for (int k8 = 0; k8 < 8; ++k8) s += red[(k8 * 16 + b) * 64 + cc];
                ((float*)(ws + WS_MOD))[(size_t)(l * 16 + b) * 6144 + cb * 64 + cc] = s + p.in[3][l * 6144 + cb * 64 + cc]; }
            __syncthreads();
        }
    }
    __syncthreads();
    const int gtid = blockIdx.x * NTHR + tid, nthr = gridDim.x * NTHR;
    for (int idx = gtid; idx < 4096 * 64; idx += nthr) { const int pos = idx >> 6, f = idx & 63;
        const float freq = powf(10000.f, -(float)f / 64.f), ang = (float)pos * freq;
        ((f32x2*)(ws + WS_ROPE))[idx] = (f32x2){cosf(ang), sinf(ang)}; }
    { bf16_t* Mt = (bf16_t*)(ws + WS_S5M); bf16_t* Gt = (bf16_t*)(ws + WS_S5G);
      for (int idx = gtid; idx < 32 * 64 * 64; idx += nthr) { const int g = idx >> 12, pp = (idx >> 6) & 63, s = idx & 63;
          const S5gp q = s5_gp(p, g, pp);
          { const f32x2 a = s5_apow(q, (float)(63 - s));
            unsigned wr_[8], wi_[8];
#pragma unroll
            for (int h2 = 0; h2 < 8; ++h2) { float vr[2], vi[2];
#pragma unroll
                for (int e = 0; e < 2; ++e) { const int h = h2 * 2 + e; const float br = p.in[16][(g * 64 + pp) * 16 + h], bi = p.in[17][(g * 64 + pp) * 16 + h];
                    const float bbr = q.fre * br - q.fim * bi, bbi = q.fre * bi + q.fim * br;
                    vr[e] = a.x * bbr - a.y * bbi; vi[e] = a.x * bbi + a.y * bbr; }
                wr_[h2] = pk2(vr[0], vr[1]); wi_[h2] = pk2(vi[0], vi[1]); }
            u32x4* dr = (u32x4*)(Mt + (size_t)(g * 128 + 2 * pp) * 1024 + s * 16); u32x4* di = (u32x4*)(Mt + (size_t)(g * 128 + 2 * pp + 1) * 1024 + s * 16);
            dr[0] = (u32x4){wr_[0], wr_[1], wr_[2], wr_[3]}; dr[1] = (u32x4){wr_[4], wr_[5], wr_[6], wr_[7]};
            di[0] = (u32x4){wi_[0], wi_[1], wi_[2], wi_[3]}; di[1] = (u32x4){wi_[4], wi_[5], wi_[6], wi_[7]}; }
          { const int t = s; const f32x2 a = s5_apow(q, (float)(t + 1));
#pragma unroll
            for (int h = 0; h < 16; ++h) { const float cr = p.in[18][(g * 16 + h) * 64 + pp], ci = p.in[19][(g * 16 + h) * 64 + pp];
                const float gr = cr * a.x - ci * a.y, gi = cr * a.y + ci * a.x;
                *(unsigned*)(Gt + (size_t)(g * 1024 + t * 16 + h) * 128 + 2 * pp) = pk2(gr, -gi); } }
          if (s == 0) ((f32x2*)(ws + WS_A64))[g * 64 + pp] = s5_apow(q, 64.f);
      }
      LAS f32x2* tp = (LAS f32x2*)lds;
      bf16_t* Kt = (bf16_t*)(ws + WS_KERN);
      for (int item = blockIdx.x; item < 32 * 64; item += gridDim.x) { const int g = item >> 6, tau = item & 63;
          if (tid < 64) { const S5gp q = s5_gp(p, g, tid); const f32x2 a = s5_apow(q, (float)tau); tp[tid] = (f32x2){a.x * q.fre - a.y * q.fim, a.x * q.fim + a.y * q.fre}; }
          __syncthreads();
          if (tid < 256) { const int h = tid >> 4, h2 = tid & 15; float acc = 0.f;
#pragma unroll 8
              for (int pp = 0; pp < 64; ++pp) { const f32x2 t = tp[pp]; const float cr = p.in[18][(g * 16 + h) * 64 + pp], ci = p.in[19][(g * 16 + h) * 64 + pp];
                  const float ur = cr * t.x - ci * t.y, ui = cr * t.y + ci * t.x;
                  acc += ur * p.in[16][(g * 64 + pp) * 16 + h2] - ui * p.in[17][(g * 64 + pp) * 16 + h2]; }
              Kt[(size_t)((g * 64 + tau) * 16 + h) * 16 + h2] = f2bf(acc); }
          __syncthreads();
      }
    }
}

__device__ __forceinline__ void norm_phase(const float* __restrict__ x, const float* __restrict__ gw, const float* __restrict__ shift, const float* __restrict__ scale, bf16_t* __restrict__ H) {
    const int tid = tid_opaque(); const int lane = tid & 63, wv = blockIdx.x * 8 + (tid >> 6), nw = gridDim.x * 8;
    constexpr int NR = 8;
    for (int row0 = wv * NR; row0 < MTOK; row0 += nw * NR) {
        const int b = row0 >> 12;
        f32x4 v[NR][4]; float ss[NR];
#pragma unroll
        for (int r = 0; r < NR; ++r)
#pragma unroll
            for (int c4 = 0; c4 < 4; ++c4) v[r][c4] = __builtin_nontemporal_load((const f32x4*)(x + (size_t)(row0 + r) * 1024 + c4 * 256 + lane * 4));
#pragma unroll
        for (int r = 0; r < NR; ++r) { float s = 0.f;
#pragma unroll
            for (int c4 = 0; c4 < 4; ++c4) s += v[r][c4][0] * v[r][c4][0] + v[r][c4][1] * v[r][c4][1] + v[r][c4][2] * v[r][c4][2] + v[r][c4][3] * v[r][c4][3];
            ss[r] = s; }
#pragma unroll
        for (int o = 1; o < 64; o <<= 1)
#pragma unroll
            for (int r = 0; r < NR; ++r) ss[r] += __shfl_xor(ss[r], o);
#pragma unroll
        for (int c4 = 0; c4 < 4; ++c4) { const int col = c4 * 256 + lane * 4;
            const f32x4 g = *(const f32x4*)(gw + col), sc = *(const f32x4*)(scale + (size_t)b * 6144 + col), sh = *(const f32x4*)(shift + (size_t)b * 6144 + col);
            const f32x4 gm = g * (sc + 1.f);
#pragma unroll
            for (int r = 0; r < NR; ++r) { const float rr = rsqrtf(ss[r] * (1.f / 1024.f) + 1e-6f);
                const f32x4 o = v[r][c4] * rr * gm + sh;
                *(u32x2*)(H + (size_t)(row0 + r) * 1024 + col) = (u32x2){pk2(o[0], o[1]), pk2(o[2], o[3])}; } }
    }
}

constexpr int VS = 72;
constexpr int VL_BYTES = 64 * VS * 2;

__device__ __forceinline__ void s5a_phase(const Params& p);
__device__ __forceinline__ void attnA_phase(const Params& p, LAS unsigned char* lds) {
    const int tid = tid_opaque(), wid = __builtin_amdgcn_readfirstlane(tid >> 6), lane = tid & 63, li = lane & 15, g4 = lane >> 4;
    const bf16_t* QKV = (const bf16_t*)(p.ws + WS_R1);
    bf16_t* MIX = (bf16_t*)(p.ws + WS_MIX);
    LAS bf16_t* Vl = (LAS bf16_t*)(lds + wid * VL_BYTES);
    LAS float* bl = (LAS float*)(lds + 8 * VL_BYTES);
    for (int idx = tid; idx < 8 * 257; idx += NTHR) bl[(idx / 257) * 260 + (idx % 257)] = p.in[12][idx] * 1.4426950408889634f;
    __syncthreads();
    if (wid >= 4) s5a_phase(p);
    const int h = wid;
    LAS float* bh = bl + h * 260;
    const float bfar = bh[256];
    const int vrow = lane >> 3, vc8 = (lane & 7) * 8;
    for (int item2 = vblock(); item2 < 2048; item2 += gridDim.x) {
        const int kq = item2 >> 8, rq = item2 & 255, qh = rq & 1;
        const int b = 2 * kq + (rq >> 7), ci = (((rq >> 1) & 63) + 9 * kq) & 63;
        const size_t rowbase = (size_t)b * SEQ + ci * 64 + qh * 32;
        bf16x8 qf[2][2];
#pragma unroll
        for (int qt = 0; qt < 2; ++qt)
#pragma unroll
            for (int ks = 0; ks < 2; ++ks) qf[qt][ks] = *(const bf16x8*)(QKV + (rowbase + qt * 16 + li) * 2048 + h * 64 + 32 * ks + 8 * g4);
        f32x4 o[4][2]; float mrun[2], lsum[2];
#pragma unroll
        for (int qt = 0; qt < 2; ++qt) { mrun[qt] = -1e30f; lsum[qt] = 0.f;
#pragma unroll
            for (int dt = 0; dt < 4; ++dt) o[dt][qt] = (f32x4){0.f, 0.f, 0.f, 0.f}; }
        const int kb0 = ci >= 8 ? 0 : 8 - ci;
        bf16x8 kf[4][2]; u32x4 vr[8];
        { const bf16_t* kbase = QKV + ((size_t)b * SEQ + (size_t)(ci - 8 + kb0) * 64) * 2048 + h * 64;
#pragma unroll
          for (int kt = 0; kt < 4; ++kt)
#pragma unroll
              for (int ks = 0; ks < 2; ++ks) kf[kt][ks] = *(const bf16x8*)(kbase + (size_t)(kt * 16 + li) * 2048 + 512 + 32 * ks + 8 * g4);
#pragma unroll
          for (int r = 0; r < 8; ++r) vr[r] = *(const u32x4*)(kbase + (size_t)(r * 8 + vrow) * 2048 + 1024 + vc8);
          wave_lds_fence();
#pragma unroll
          for (int r = 0; r < 8; ++r) *(LAS u32x4*)(Vl + (r * 8 + vrow) * VS + vc8) = vr[r];
          wave_lds_fence(); }
        for (int kb = kb0; kb <= 8; ++kb) {
            f32x4 s[4][2];
#pragma unroll
            for (int kt = 0; kt < 4; ++kt)
#pragma unroll
                for (int qt = 0; qt < 2; ++qt) { f32x4 z = (f32x4){0.f, 0.f, 0.f, 0.f}; z = mfma16(kf[kt][0], qf[qt][0], z); z = mfma16(kf[kt][1], qf[qt][1], z); s[kt][qt] = z; }
            const bool more = kb < 8;
            if (more) {
                const bf16_t* kbase = QKV + ((size_t)b * SEQ + (size_t)(ci - 8 + kb + 1) * 64) * 2048 + h * 64;
#pragma unroll
                for (int kt = 0; kt < 4; ++kt)
#pragma unroll
                    for (int ks = 0; ks < 2; ++ks) kf[kt][ks] = *(const bf16x8*)(kbase + (size_t)(kt * 16 + li) * 2048 + 512 + 32 * ks + 8 * g4);
#pragma unroll
                for (int r = 0; r < 8; ++r) vr[r] = *(const u32x4*)(kbase + (size_t)(r * 8 + vrow) * 2048 + 1024 + vc8);
            }
            const bool nearb = kb >= 6;
            bf16x8 pfr[2][2];
#pragma unroll
            for (int qt = 0; qt < 2; ++qt) {
                float mx = -1e30f;
                if (nearb) {
#pragma unroll
                    for (int kt = 0; kt < 4; ++kt)
#pragma unroll
                        for (int jj = 0; jj < 4; ++jj) { int rel = 512 + qh * 32 + qt * 16 + li - kb * 64 - (kt * 16 + 4 * g4 + jj); rel = rel > 128 ? 128 : (rel < -128 ? -128 : rel);
                            const float v = s[kt][qt][jj] + bh[rel + 128]; s[kt][qt][jj] = v; mx = fmaxf(mx, v); }
                } else {
#pragma unroll
                    for (int kt = 0; kt < 4; ++kt)
#pragma unroll
                        for (int jj = 0; jj < 4; ++jj) { const float v = s[kt][qt][jj] + bfar; s[kt][qt][jj] = v; mx = fmaxf(mx, v); }
                }
                mx = fmaxf(mx, __shfl_xor(mx, 16)); mx = fmaxf(mx, __shfl_xor(mx, 32));
                const float mnew = fmaxf(mrun[qt], mx), alpha = __builtin_amdgcn_exp2f(mrun[qt] - mnew);
                mrun[qt] = mnew; float ps = 0.f;
#pragma unroll
                for (int kt = 0; kt < 4; ++kt)
#pragma unroll
                    for (int jj = 0; jj < 4; ++jj) { const float e = __builtin_amdgcn_exp2f(s[kt][qt][jj] - mnew); s[kt][qt][jj] = e; ps += e; }
                lsum[qt] = lsum[qt] * alpha + ps;
#pragma unroll
                for (int dt = 0; dt < 4; ++dt) o[dt][qt] *= alpha;
#pragma unroll
                for (int kk = 0; kk < 2; ++kk) { u32x4 w; w.x = pk2(s[2 * kk][qt][0], s[2 * kk][qt][1]); w.y = pk2(s[2 * kk][qt][2], s[2 * kk][qt][3]);
                    w.z = pk2(s[2 * kk + 1][qt][0], s[2 * kk + 1][qt][1]); w.w = pk2(s[2 * kk + 1][qt][2], s[2 * kk + 1][qt][3]); pfr[qt][kk] = as_frag(w); }
            }
            { bf16x8 vf[2][4];
#pragma unroll
              for (int kk = 0; kk < 2; ++kk)
#pragma unroll
                  for (int dt = 0; dt < 4; ++dt) vf[kk][dt] = tr_pair(Vl, VS, 32 * kk + 4 * g4, 32 * kk + 16 + 4 * g4, dt * 16, li);
#pragma unroll
              for (int kk = 0; kk < 2; ++kk)
#pragma unroll
                  for (int dt = 0; dt < 4; ++dt)
#pragma unroll
                      for (int qt = 0; qt < 2; ++qt) o[dt][qt] = mfma16(vf[kk][dt], pfr[qt][kk], o[dt][qt]); }
            wave_lds_fence();
            if (more) {
#pragma unroll
                for (int r = 0; r < 8; ++r) *(LAS u32x4*)(Vl + (r * 8 + vrow) * VS + vc8) = vr[r];
                wave_lds_fence();
            }
        }
#pragma unroll
        for (int qt = 0; qt < 2; ++qt) { float l = lsum[qt]; l += __shfl_xor(l, 16); l += __shfl_xor(l, 32); const float inv = 1.f / l;
#pragma unroll
            for (int dt = 0; dt < 4; ++dt) { const f32x4 v = o[dt][qt] * inv;
                *(u32x2*)(MIX + (rowbase + qt * 16 + li) * 1024 + h * 64 + dt * 16 + 4 * g4) = (u32x2){pk2(v[0], v[1]), pk2(v[2], v[3])}; } }
    }
    if (wid < 4) s5a_phase(p);
}

__device__ __forceinline__ void s5a_phase(const Params& p) {
    const int tid = tid_opaque(); const int lane = tid & 63, li = lane & 15, g4 = lane >> 4;
    const bf16_t* QKV = (const bf16_t*)(p.ws + WS_R1);
    const bf16_t* Mt = (const bf16_t*)(p.ws + WS_S5M);
    float* E = (float*)(p.ws + WS_S5E);
    const int wv = vblock() * 8 + (tid >> 6), nw = gridDim.x * 8;
    for (int item = wv; item < 2048; item += nw) {
        const int g = item & 31, c = item >> 5;
        f32x4 acc[8];
#pragma unroll
        for (int pt = 0; pt < 8; ++pt) acc[pt] = (f32x4){0.f, 0.f, 0.f, 0.f};
        const bf16_t* ub = QKV + ((size_t)li * SEQ + c * 64 + (g4 >> 1)) * 2048 + 1536 + g * 16 + 8 * (g4 & 1);
        const bf16_t* mb = Mt + (size_t)(g * 128 + li) * 1024 + 8 * g4;
#pragma unroll 4
        for (int ks = 0; ks < 32; ++ks) {
            const bf16x8 bfr = *(const bf16x8*)(ub + (size_t)(2 * ks) * 2048);
#pragma unroll
            for (int pt = 0; pt < 8; ++pt) { const bf16x8 afr = *(const bf16x8*)(mb + (size_t)pt * 16 * 1024 + 32 * ks); acc[pt] = mfma16(afr, bfr, acc[pt]); }
        }
#pragma unroll
        for (int pt = 0; pt < 8; ++pt) *(f32x4*)(E + ((size_t)(c * 32 + g) * 16 + li) * 128 + pt * 16 + 4 * g4) = acc[pt];
    }
}
__device__ __forceinline__ void s5scan_phase(const Params& p) {
    const float* E = (const float*)(p.ws + WS_S5E);
    bf16_t* X = (bf16_t*)(p.ws + WS_S5X);
    const f32x2* A64 = (const f32x2*)(p.ws + WS_A64);
    const int gtid = blockIdx.x * NTHR + tid_opaque();
    if (gtid < 32 * 16 * 64) {
        const int pp = gtid & 63, b = (gtid >> 6) & 15, g = gtid >> 10;
        const f32x2 a = A64[g * 64 + pp];
        float xr = 0.f, xi = 0.f;
        for (int c0 = 0; c0 < 64; c0 += 8) {
            f32x2 e[8];
#pragma unroll
            for (int k = 0; k < 8; ++k) e[k] = *(const f32x2*)(E + ((size_t)((c0 + k) * 32 + g) * 16 + b) * 128 + 2 * pp);
#pragma unroll
            for (int k = 0; k < 8; ++k) {
                *(unsigned*)(X + ((size_t)((c0 + k) * 32 + g) * 16 + b) * 128 + 2 * pp) = pk2(xr, xi);
                const float nr = a.x * xr - a.y * xi + e[k].x, ni = a.x * xi + a.y * xr + e[k].y; xr = nr; xi = ni; }
        }
    }
}
__device__ __forceinline__ void s5c_phase(const Params& p, LAS unsigned char* lds) {
    const int tid = tid_opaque(), wid = __builtin_amdgcn_readfirstlane(tid >> 6), lane = tid & 63, li = lane & 15, g4 = lane >> 4;
    const bf16_t* QKV = (const bf16_t*)(p.ws + WS_R1);
    const bf16_t* Kt = (const bf16_t*)(p.ws + WS_KERN);
    const bf16_t* Gt = (const bf16_t*)(p.ws + WS_S5G);
    const bf16_t* X = (const bf16_t*)(p.ws + WS_S5X);
    bf16_t* Y5 = (bf16_t*)(p.ws + WS_Y5);
    LAS bf16_t* kl = (LAS bf16_t*)lds;
    LAS bf16_t* ul = (LAS bf16_t*)(lds + 32768);
    int gl = -1;
    u32x4 ur[4];
    { const int item = vblock(); if (item < 2048) { const int g = item & 31, c = item >> 5;
#pragma unroll
        for (int q = 0; q < 4; ++q) { const int idx = tid + q * NTHR, hh = idx & 1, b = (idx >> 1) & 15, sq = idx >> 5;
            ur[q] = *(const u32x4*)(QKV + ((size_t)b * SEQ + c * 64 + sq) * 2048 + 1536 + g * 16 + hh * 8); } } }
    for (int item = vblock(); item < 2048; item += gridDim.x) {
        const int g = item & 31, c = item >> 5;
        __syncthreads();
        if (g != gl) { for (int idx = tid; idx < 2048; idx += NTHR) *(LAS u32x4*)(kl + idx * 8) = *(const u32x4*)(Kt + (size_t)g * 16384 + idx * 8); gl = g; }
#pragma unroll
        for (int q = 0; q < 4; ++q) { const int idx = tid + q * NTHR, hh = idx & 1, b = (idx >> 1) & 15, sq = idx >> 5;
            *(LAS u32x4*)(ul + (sq * 16 + b) * 16 + hh * 8) = ur[q]; }
        { const int nx = item + gridDim.x; if (nx < 2048) { const int g2 = nx & 31, c2 = nx >> 5;
#pragma unroll
            for (int q = 0; q < 4; ++q) { const int idx = tid + q * NTHR, hh = idx & 1, b = (idx >> 1) & 15, sq = idx >> 5;
                ur[q] = *(const u32x4*)(QKV + ((size_t)b * SEQ + c2 * 64 + sq) * 2048 + 1536 + g2 * 16 + hh * 8); } } }
        bf16x8 xf[4];
#pragma unroll
        for (int ks = 0; ks < 4; ++ks) xf[ks] = *(const bf16x8*)(X + ((size_t)(c * 32 + g) * 16 + li) * 128 + 32 * ks + 8 * g4);
        bf16x8 gf[8][4];
#pragma unroll
        for (int tt = 0; tt < 8; ++tt)
#pragma unroll
            for (int ks = 0; ks < 4; ++ks) gf[tt][ks] = *(const bf16x8*)(Gt + (size_t)(g * 1024 + (wid + 8 * tt) * 16 + li) * 128 + 32 * ks + 8 * g4);
        __syncthreads();
        const f32x4 dsk = *(const f32x4*)(p.in[20] + g * 16 + 4 * g4);
#pragma unroll
        for (int tt = 0; tt < 8; ++tt) {
            const int t = wid + 8 * tt;
            f32x4 acc = (f32x4){0.f, 0.f, 0.f, 0.f};
#pragma unroll
            for (int ks = 0; ks < 4; ++ks) acc = mfma16(gf[tt][ks], xf[ks], acc);
            const int nks = ((t >> 1) + 4) & ~3;
            for (int ks0 = 0; ks0 < nks; ks0 += 4) {
                u32x4 av[4]; bf16x8 bv[4];
#pragma unroll
                for (int q = 0; q < 4; ++q) { const int s = 2 * (ks0 + q) + (g4 >> 1); int tau = t - s; const bool ok = tau >= 0; tau = ok ? tau : 0;
                    av[q] = *(const LAS u32x4*)(kl + (tau * 16 + li) * 16 + 8 * (g4 & 1));
                    if (!ok) av[q] = (u32x4){0u, 0u, 0u, 0u};
                    bv[q] = *(const LAS bf16x8*)(ul + (s * 16 + li) * 16 + 8 * (g4 & 1)); }
#pragma unroll
                for (int q = 0; q < 4; ++q) acc = mfma16(as_frag(av[q]), bv[q], acc);
            }
            const u32x2 uu = *(const LAS u32x2*)(ul + (t * 16 + li) * 16 + 4 * g4);
            float y0 = acc[0] + dsk[0] * lo_f(uu.x), y1 = acc[1] + dsk[1] * hi_f(uu.x), y2 = acc[2] + dsk[2] * lo_f(uu.y), y3 = acc[3] + dsk[3] * hi_f(uu.y);
            y0 = gelu_tanh(y0); y1 = gelu_tanh(y1); y2 = gelu_tanh(y2); y3 = gelu_tanh(y3);
            *(u32x2*)(Y5 + ((size_t)li * SEQ + c * 64 + t) * 512 + g * 16 + 4 * g4) = (u32x2){pk2(y0, y1), pk2(y2, y3)};
        }
    }
}

#ifndef SB_EARLY_EXIT
#define SB_EARLY_EXIT 1
#endif
template <bool MASKED>
__device__ __forceinline__ void sb_qtile(const bf16x8 (&kf)[4][2], const bf16x8 (&qf)[2], float& R, bf16x8 (&pfr)[2], int li, int g4, int kpos0, int qpos, u32x2 dpat) {
    const unsigned ONES = 0x3F803F80u;
    const float SC = 0.125f * 1.4426950408889634f;
    f32x4 z[4];
#pragma unroll
    for (int kt = 0; kt < 4; ++kt) { f32x4 a = (f32x4){0.f, 0.f, 0.f, 0.f}; a = mfma16(kf[kt][0], qf[0], a); a = mfma16(kf[kt][1], qf[1], a); z[kt] = a; }
    float T = 0.f; unsigned hi[4][2];
#pragma unroll
    for (int kt = 0; kt < 4; ++kt) { float Lv[4];
#pragma unroll
        for (int jj = 0; jj < 4; ++jj) { const float zz = z[kt][jj] * SC;
            const float sp = fmaxf(zz, 0.f) + __builtin_amdgcn_logf(1.f + __builtin_amdgcn_exp2f(-fabsf(zz)));
            if (MASKED) { const bool valid = kpos0 + kt * 16 + jj < qpos; Lv[jj] = valid ? -sp : 0.f; z[kt][jj] = valid ? (zz - sp) : -1e30f; }
            else { Lv[jj] = -sp; z[kt][jj] = zz - sp; }
            T += Lv[jj]; }
        hi[kt][0] = pk2(Lv[0], Lv[1]); hi[kt][1] = pk2(Lv[2], Lv[3]); }
    T += __shfl_xor(T, 16); T += __shfl_xor(T, 32);
    bf16x8 Lh[2];
#pragma unroll
    for (int kk = 0; kk < 2; ++kk) Lh[kk] = as_frag((u32x4){hi[2 * kk][0], hi[2 * kk][1], hi[2 * kk + 1][0], hi[2 * kk + 1][1]});
    unsigned pw[4][2];
#pragma unroll
    for (int st = 0; st < 4; ++st) { f32x4 ce = (f32x4){0.f, 0.f, 0.f, 0.f};
#pragma unroll
        for (int kk = 0; kk < 2; ++kk) { if (2 * kk + 1 >= st) {
            u32x4 ua;
            { const int k0 = 2 * kk, k1 = 2 * kk + 1;
              ua.x = k0 > st ? ONES : (k0 == st ? dpat.x : 0u); ua.y = k0 > st ? ONES : (k0 == st ? dpat.y : 0u);
              ua.z = k1 > st ? ONES : (k1 == st ? dpat.x : 0u); ua.w = k1 > st ? ONES : (k1 == st ? dpat.y : 0u); }
            ce = mfma16(as_frag(ua), Lh[kk], ce); } }
        float w[4];
#pragma unroll
        for (int jj = 0; jj < 4; ++jj) w[jj] = __builtin_amdgcn_exp2f(z[st][jj] + R + ce[jj]);
        pw[st][0] = pk2(w[0], w[1]); pw[st][1] = pk2(w[2], w[3]); }
    R += T;
#pragma unroll
    for (int kk = 0; kk < 2; ++kk) pfr[kk] = as_frag((u32x4){pw[2 * kk][0], pw[2 * kk][1], pw[2 * kk + 1][0], pw[2 * kk + 1][1]});
}
__device__ __forceinline__ void sb_phase(const Params& p, LAS unsigned char* lds) {
    const int tid = tid_opaque(), wid = __builtin_amdgcn_readfirstlane(tid >> 6), lane = tid & 63, li = lane & 15, g4 = lane >> 4;
    const bf16_t* QKV = (const bf16_t*)(p.ws + WS_R1);
    bf16_t* MIX = (bf16_t*)(p.ws + WS_MIX);
    LAS bf16_t* Vl = (LAS bf16_t*)(lds + wid * VL_BYTES);
    const int wv = vblock() * 8 + wid, nw = gridDim.x * 8;
    u32x2 dpat; dpat.x = ((4 * g4 + 0 > li) ? 0x3F80u : 0u) | ((4 * g4 + 1 > li) ? 0x3F800000u : 0u); dpat.y = ((4 * g4 + 2 > li) ? 0x3F80u : 0u) | ((4 * g4 + 3 > li) ? 0x3F800000u : 0u);
    for (int it = wv; it < 8192; it += nw) {
        const int bh = it >> 6, pr = it & 63, b = bh >> 3, h = bh & 7;
        for (int half = 0; half < 2; ++half) {
            const int qtile = half ? 127 - pr : pr, t0 = qtile * 32, kbd = t0 >> 6;
            const bf16_t* qb = QKV + ((size_t)b * SEQ + t0) * 3584 + 2048 + h * 64;
            bf16x8 qf[2][2];
#pragma unroll
            for (int qt = 0; qt < 2; ++qt)
#pragma unroll
                for (int ks = 0; ks < 2; ++ks) qf[qt][ks] = *(const bf16x8*)(qb + (size_t)(qt * 16 + li) * 3584 + 32 * ks + 8 * g4);
            f32x4 o[2][4]; float R[2];
#pragma unroll
            for (int qt = 0; qt < 2; ++qt) { R[qt] = 0.f;
#pragma unroll
                for (int dt = 0; dt < 4; ++dt) o[qt][dt] = (f32x4){0.f, 0.f, 0.f, 0.f}; }
            for (int kb = kbd; kb >= 0; --kb) {
                const bf16_t* kbase = QKV + ((size_t)b * SEQ + kb * 64) * 3584 + 2560 + h * 64;
#pragma unroll
                for (int r = 0; r < 8; ++r) { const int row = r * 8 + (lane >> 3), c8 = lane & 7;
                    *(LAS u32x4*)(Vl + row * VS + c8 * 8) = *(const u32x4*)(kbase + (size_t)row * 3584 + 512 + c8 * 8); }
                bf16x8 kf[4][2];
#pragma unroll
                for (int kt = 0; kt < 4; ++kt)
#pragma unroll
                    for (int ks = 0; ks < 2; ++ks) kf[kt][ks] = *(const bf16x8*)(kbase + (size_t)(kt * 16 + li) * 3584 + 32 * ks + 8 * g4);
                wave_lds_fence();
                const int kpos0 = kb * 64 + 4 * g4;
                bf16x8 pfr[2][2];
                if (kb == kbd) {
#pragma unroll
                    for (int qt = 0; qt < 2; ++qt) sb_qtile<true>(kf, qf[qt], R[qt], pfr[qt], li, g4, kpos0, t0 + qt * 16 + li, dpat);
                } else {
#pragma unroll
                    for (int qt = 0; qt < 2; ++qt) sb_qtile<false>(kf, qf[qt], R[qt], pfr[qt], li, g4, kpos0, t0 + qt * 16 + li, dpat);
                }
                { bf16x8 vf[2][4];
#pragma unroll
                  for (int kk = 0; kk < 2; ++kk)
#pragma unroll
                      for (int dt = 0; dt < 4; ++dt) vf[kk][dt] = tr_pair(Vl, VS, 32 * kk + 4 * g4, 32 * kk + 16 + 4 * g4, dt * 16, li);
#pragma unroll
                  for (int kk = 0; kk < 2; ++kk)
#pragma unroll
                      for (int dt = 0; dt < 4; ++dt)
#pragma unroll
                          for (int qt = 0; qt < 2; ++qt) o[qt][dt] = mfma16(vf[kk][dt], pfr[qt][kk], o[qt][dt]); }
                wave_lds_fence();
#if SB_EARLY_EXIT
                { const float rm = fmaxf(R[0], R[1]); if (__all(rm < -152.f)) break; }
#endif
            }
#pragma unroll
            for (int qt = 0; qt < 2; ++qt)
#pragma unroll
                for (int dt = 0; dt < 4; ++dt) { const f32x4 v = o[qt][dt];
                    *(u32x2*)(MIX + ((size_t)b * SEQ + t0 + qt * 16 + li) * 1024 + 512 + h * 64 + dt * 16 + 4 * g4) = (u32x2){pk2(v[0], v[1]), pk2(v[2], v[3])}; }
        }
    }
}

constexpr int RS = 136;
__device__ __forceinline__ float ret_log_gamma(int h) { return logf(1.f - exp2f(-5.f - (float)h)); }
struct RotRegs { u32x4 a, b; };
struct RopeRegs { f32x2 cs[8]; };
struct PlainRegs { u32x4 a, b; };
__device__ __forceinline__ void rot_ld(RotRegs& r, const bf16_t* src  , int j, int part) { r.a = *(const u32x4*)(src + (size_t)j * 3584 + part * 8); r.b = *(const u32x4*)(src + (size_t)j * 3584 + 64 + part * 8); }
__device__ __forceinline__ void rope_ld(RopeRegs& r, const f32x2* rope, int pos, int part) {
#pragma unroll
    for (int e = 0; e < 8; ++e) r.cs[e] = rope[(size_t)pos * 64 + part * 8 + e]; }
__device__ __forceinline__ void plain_ld(PlainRegs& r, const bf16_t* src, int j, int part) { r.a = *(const u32x4*)(src + (size_t)j * 3584 + part * 16); r.b = *(const u32x4*)(src + (size_t)j * 3584 + part * 16 + 8); }
__device__ __forceinline__ void rot_st(const RotRegs& r, const RopeRegs& c, LAS bf16_t* dst, int j, int part, float rsc) {
    const float x1[8] = {lo_f(r.a.x), hi_f(r.a.x), lo_f(r.a.y), hi_f(r.a.y), lo_f(r.a.z), hi_f(r.a.z), lo_f(r.a.w), hi_f(r.a.w)};
    const float x2[8] = {lo_f(r.b.x), hi_f(r.b.x), lo_f(r.b.y), hi_f(r.b.y), lo_f(r.b.z), hi_f(r.b.z), lo_f(r.b.w), hi_f(r.b.w)};
    float o1[8], o2[8];
#pragma unroll
    for (int e = 0; e < 8; ++e) { const f32x2 cc = c.cs[e]; o1[e] = (x1[e] * cc.x - x2[e] * cc.y) * rsc; o2[e] = (x1[e] * cc.y + x2[e] * cc.x) * rsc; }
    *(LAS u32x4*)(dst + j * RS + part * 8) = (u32x4){pk2(o1[0], o1[1]), pk2(o1[2], o1[3]), pk2(o1[4], o1[5]), pk2(o1[6], o1[7])};
    *(LAS u32x4*)(dst + j * RS + 64 + part * 8) = (u32x4){pk2(o2[0], o2[1]), pk2(o2[2], o2[3]), pk2(o2[4], o2[5]), pk2(o2[6], o2[7])};
}
__device__ __forceinline__ void plain_st(const PlainRegs& r, LAS bf16_t* dst, int j, int part) { *(LAS u32x4*)(dst + j * RS + part * 16) = r.a; *(LAS u32x4*)(dst + j * RS + part * 16 + 8) = r.b; }

__device__ __forceinline__ void reta_phase(const Params& p, LAS unsigned char* lds) {
    const int tid = tid_opaque(), wid = __builtin_amdgcn_readfirstlane(tid >> 6), lane = tid & 63, li = lane & 15, g4 = lane >> 4;
    const int j = tid >> 3, part = tid & 7;
    const bf16_t* QKV = (const bf16_t*)(p.ws + WS_R1);
    const f32x2* rope = (const f32x2*)(p.ws + WS_ROPE);
    bf16_t* RET = (bf16_t*)(p.ws + WS_H);
    LAS bf16_t* Kl = (LAS bf16_t*)lds; LAS bf16_t* Vl = (LAS bf16_t*)(lds + 64 * RS * 2);
    RotRegs kr; RopeRegs cr; PlainRegs vr;
    { const int item = blockIdx.x; if (item < 4096) { const int c = item & 63, hh = (item >> 6) & 3, b = item >> 8; const bf16_t* base = QKV + ((size_t)b * SEQ + c * 64) * 3584 + hh * 128;
        rot_ld(kr, base + 512, j, part); rope_ld(cr, rope, c * 64 + j, part); plain_ld(vr, base + 1024, j, part); } }
    for (int item = blockIdx.x; item < 4096; item += gridDim.x) {
        const int c = item & 63, hh = (item >> 6) & 3, b = item >> 8;
        const float lg = ret_log_gamma(hh);
        __syncthreads();
        rot_st(kr, cr, Kl, j, part, 0.08838834764831845f * __expf(lg * (63.f - (float)j)));
        plain_st(vr, Vl, j, part);
        { const int nx = item + gridDim.x; if (nx < 4096) { const int c2 = nx & 63, h2 = (nx >> 6) & 3, b2 = nx >> 8; const bf16_t* base = QKV + ((size_t)b2 * SEQ + c2 * 64) * 3584 + h2 * 128;
            rot_ld(kr, base + 512, j, part); rope_ld(cr, rope, c2 * 64 + j, part); plain_ld(vr, base + 1024, j, part); } }
        __syncthreads();
        f32x4 acc[8];
#pragma unroll
        for (int et = 0; et < 8; ++et) acc[et] = (f32x4){0.f, 0.f, 0.f, 0.f};
#pragma unroll
        for (int kk = 0; kk < 2; ++kk) { const bf16x8 af = tr_pair(Kl, RS, 32 * kk + 8 * g4, 32 * kk + 8 * g4 + 4, wid * 16, li);
#pragma unroll
            for (int et = 0; et < 8; ++et) { const bf16x8 bfr = tr_pair(Vl, RS, 32 * kk + 8 * g4, 32 * kk + 8 * g4 + 4, et * 16, li); acc[et] = mfma16(af, bfr, acc[et]); } }
        const size_t sid = (size_t)((b * 4 + hh) * 64 + c);
#pragma unroll
        for (int et = 0; et < 8; ++et) *(u32x2*)(RET + (sid * 128 + et * 16 + li) * 128 + wid * 16 + 4 * g4) = (u32x2){pk2(acc[et][0], acc[et][1]), pk2(acc[et][2], acc[et][3])};
    }
}
__device__ __forceinline__ void retscan_phase(const Params& p) {
    bf16_t* RET = (bf16_t*)(p.ws + WS_H);
    const int gtid = blockIdx.x * NTHR + tid_opaque(), nthr = gridDim.x * NTHR;
    for (int w = gtid; w < 64 * 2048; w += nthr) {
        const int bhh = w >> 11, e8 = w & 2047, hh = bhh & 3;
        const float cd = __expf(64.f * ret_log_gamma(hh));
        float S[8];
#pragma unroll
        for (int e = 0; e < 8; ++e) S[e] = 0.f;
        bf16_t* base = RET + (size_t)bhh * 64 * 16384 + e8 * 8;
        for (int c0 = 0; c0 < 64; c0 += 4) {
            u32x4 kv[4];
#pragma unroll
            for (int k = 0; k < 4; ++k) kv[k] = *(const u32x4*)(base + (size_t)(c0 + k) * 16384);
#pragma unroll
            for (int k = 0; k < 4; ++k) {
                *(u32x4*)(base + (size_t)(c0 + k) * 16384) = (u32x4){pk2(S[0], S[1]), pk2(S[2], S[3]), pk2(S[4], S[5]), pk2(S[6], S[7])};
                S[0] = S[0] * cd + lo_f(kv[k].x); S[1] = S[1] * cd + hi_f(kv[k].x); S[2] = S[2] * cd + lo_f(kv[k].y); S[3] = S[3] * cd + hi_f(kv[k].y);
                S[4] = S[4] * cd + lo_f(kv[k].z); S[5] = S[5] * cd + hi_f(kv[k].z); S[6] = S[6] * cd + lo_f(kv[k].w); S[7] = S[7] * cd + hi_f(kv[k].w); }
        }
    }
}
__device__ __forceinline__ void retc_phase(const Params& p, LAS unsigned char* lds) {
    const int tid = tid_opaque(), wid = __builtin_amdgcn_readfirstlane(tid >> 6), lane = tid & 63, li = lane & 15, g4 = lane >> 4;
    const bf16_t* QKV = (const bf16_t*)(p.ws + WS_R1);
    const f32x2* rope = (const f32x2*)(p.ws + WS_ROPE);
    const bf16_t* RET = (const bf16_t*)(p.ws + WS_H);
    bf16_t* MIX = (bf16_t*)(p.ws + WS_MIX);
    LAS bf16_t* Ql = (LAS bf16_t*)lds; LAS bf16_t* Kl = (LAS bf16_t*)(lds + 17408); LAS bf16_t* Vl = (LAS bf16_t*)(lds + 34816);
    LAS bf16_t* Sl = (LAS bf16_t*)(lds + 52224);
    LAS f32x2* stl = (LAS f32x2*)(lds + 61440);
    const int j = tid >> 3, part = tid & 7;
    RotRegs qr, kr; RopeRegs cr; PlainRegs vr;
    { const int item = blockIdx.x; if (item < 4096) { const int c = item & 63, hh = (item >> 6) & 3, b = item >> 8; const bf16_t* base = QKV + ((size_t)b * SEQ + c * 64) * 3584 + hh * 128;
        rot_ld(qr, base, j, part); rot_ld(kr, base + 512, j, part); rope_ld(cr, rope, c * 64 + j, part); plain_ld(vr, base + 1024, j, part); } }
    for (int item = blockIdx.x; item < 4096; item += gridDim.x) {
        const int c = item & 63, hh = (item >> 6) & 3, b = item >> 8;
        const float lg = ret_log_gamma(hh);
        const size_t row0 = (size_t)b * SEQ + c * 64;
        const size_t sid = (size_t)((b * 4 + hh) * 64 + c);
        bf16x8 stf[4]; u32x2 gg[4];
#pragma unroll
        for (int ks = 0; ks < 4; ++ks) stf[ks] = *(const bf16x8*)(RET + (sid * 128 + wid * 16 + li) * 128 + 32 * ks + 8 * g4);
#pragma unroll
        for (int itq = 0; itq < 4; ++itq) gg[itq] = *(const u32x2*)(QKV + (row0 + itq * 16 + li) * 3584 + 1536 + hh * 128 + wid * 16 + 4 * g4);
        __syncthreads();
        rot_st(qr, cr, Ql, j, part, 1.f);
        rot_st(kr, cr, Kl, j, part, 0.08838834764831845f);
        plain_st(vr, Vl, j, part);
        { const int nx = item + gridDim.x; if (nx < 4096) { const int c2 = nx & 63, h2 = (nx >> 6) & 3, b2 = nx >> 8; const bf16_t* base = QKV + ((size_t)b2 * SEQ + c2 * 64) * 3584 + h2 * 128;
            rot_ld(qr, base, j, part); rot_ld(kr, base + 512, j, part); rope_ld(cr, rope, c2 * 64 + j, part); plain_ld(vr, base + 1024, j, part); } }
        __syncthreads();
        { const int jt = wid >> 1;
#pragma unroll
          for (int e2 = 0; e2 < 2; ++e2) { const int itq = 2 * (wid & 1) + e2; f32x4 sacc = (f32x4){0.f, 0.f, 0.f, 0.f};
#pragma unroll
              for (int ks = 0; ks < 4; ++ks) { const bf16x8 af = *(const LAS bf16x8*)(Kl + (jt * 16 + li) * RS + 32 * ks + 8 * g4); const bf16x8 bfr = *(const LAS bf16x8*)(Ql + (itq * 16 + li) * RS + 32 * ks + 8 * g4); sacc = mfma16(af, bfr, sacc); }
              float sv[4];
#pragma unroll
              for (int jj = 0; jj < 4; ++jj) { const int j = jt * 16 + 4 * g4 + jj, iq = itq * 16 + li; const int dd = iq > j ? iq - j : j - iq; sv[jj] = sacc[jj] * __expf(lg * (float)dd); }
              *(LAS u32x2*)(Sl + (itq * 16 + li) * VS + jt * 16 + 4 * g4) = (u32x2){pk2(sv[0], sv[1]), pk2(sv[2], sv[3])}; } }
        __syncthreads();
        f32x4 oa[4];
#pragma unroll
        for (int itq = 0; itq < 4; ++itq) oa[itq] = (f32x4){0.f, 0.f, 0.f, 0.f};
#pragma unroll
        for (int ks = 0; ks < 4; ++ks) { const bf16x8 af = stf[ks];
#pragma unroll
            for (int itq = 0; itq < 4; ++itq) { const bf16x8 bfr = *(const LAS bf16x8*)(Ql + (itq * 16 + li) * RS + 32 * ks + 8 * g4); oa[itq] = mfma16(af, bfr, oa[itq]); } }
#pragma unroll
        for (int itq = 0; itq < 4; ++itq) oa[itq] *= __expf(lg * (float)(itq * 16 + li + 1));
#pragma unroll
        for (int kk = 0; kk < 2; ++kk) { const bf16x8 af = tr_pair(Vl, RS, 32 * kk + 8 * g4, 32 * kk + 8 * g4 + 4, wid * 16, li);
#pragma unroll
            for (int itq = 0; itq < 4; ++itq) { const bf16x8 bfr = *(const LAS bf16x8*)(Sl + (itq * 16 + li) * VS + 32 * kk + 8 * g4); oa[itq] = mfma16(af, bfr, oa[itq]); } }
#pragma unroll
        for (int itq = 0; itq < 4; ++itq) { float s1 = oa[itq][0] + oa[itq][1] + oa[itq][2] + oa[itq][3];
            float s2 = oa[itq][0] * oa[itq][0] + oa[itq][1] * oa[itq][1] + oa[itq][2] * oa[itq][2] + oa[itq][3] * oa[itq][3];
            s1 += __shfl_xor(s1, 16); s1 += __shfl_xor(s1, 32); s2 += __shfl_xor(s2, 16); s2 += __shfl_xor(s2, 32);
            if (g4 == 0) stl[wid * 64 + itq * 16 + li] = (f32x2){s1, s2}; }
        __syncthreads();
        const f32x4 ng = *(const f32x4*)(p.in[25] + hh * 128 + wid * 16 + 4 * g4);
#pragma unroll
        for (int itq = 0; itq < 4; ++itq) { float s1 = 0.f, s2 = 0.f;
#pragma unroll
            for (int w8 = 0; w8 < 8; ++w8) { const f32x2 t = stl[w8 * 64 + itq * 16 + li]; s1 += t.x; s2 += t.y; }
            const float mu = s1 * (1.f / 128.f), var = fmaxf(s2 * (1.f / 128.f) - mu * mu, 0.f), rs = rsqrtf(var + 1e-6f);
            const size_t row = row0 + itq * 16 + li;
            const float r0 = (oa[itq][0] - mu) * rs * ng[0] * silu_f(lo_f(gg[itq].x)), r1 = (oa[itq][1] - mu) * rs * ng[1] * silu_f(hi_f(gg[itq].x));
            const float r2 = (oa[itq][2] - mu) * rs * ng[2] * silu_f(lo_f(gg[itq].y)), r3 = (oa[itq][3] - mu) * rs * ng[3] * silu_f(hi_f(gg[itq].y));
            *(u32x2*)(MIX + row * 1024 + hh * 128 + wid * 16 + 4 * g4) = (u32x2){pk2(r0, r1), pk2(r2, r3)}; }
    }
}

constexpr int N_PHASES = 20;
__global__ void __launch_bounds__(NTHR, 2) mega_fwd(Params p) {
    extern __shared__ __attribute__((aligned(16))) unsigned char lds_raw[];
    LAS unsigned char* lds = (LAS unsigned char*)lds_raw;
    cg::grid_group grid = cg::this_grid();
    unsigned char* ws = p.ws;
    const float* MOD = (const float*)(ws + WS_MOD);
    bf16_t* H = (bf16_t*)(ws + WS_H); bf16_t* MIX = (bf16_t*)(ws + WS_MIX); bf16_t* R1 = (bf16_t*)(ws + WS_R1);
    float* XA = p.out;
    pg8::StaticOrder S;
#ifndef PROBE_MASK
#define PROBE_MASK 0u
#endif
    unsigned long long probe_acc = 0ull;
    unsigned bar_gen = 0u;
    for (int ph = p.ph_lo; ph < p.ph_hi; ++ph) {
        const unsigned long long probe_t0 = PROBE_MASK ? __builtin_amdgcn_s_memrealtime() : 0ull;
        const int layer = ph >= 11 ? 1 : 0;
        const float* modl = MOD + (size_t)layer * 16 * 6144;
        switch (ph) {
        case 0: prep_phase(p, lds); break;
        case 1: case 8: case 11: case 17: {
            const bool ffn = (ph == 8 || ph == 17);
            const float* xin = (ph == 1) ? p.in[0] : XA;
            norm_phase(xin, (ffn ? p.in[5] : p.in[4]) + layer * 1024, modl + (ffn ? 3072 : 0), modl + (ffn ? 4096 : 1024), H);
        } break;
        case 2: {
            pg8::Gemm g{H, (const bf16_t*)(ws + WS_W_ABIN), MTOK, 2048, 1024};
            S.init(MTOK, 2048, gridDim.x, blockIdx.x);
            pg8::EpiStoreQK E{R1, p.in[10], p.in[11]};
            pg8::gemm_phase(lds, g, S, E);
        } break;
        case 12: {
            pg8::Gemm g{H, (const bf16_t*)(ws + WS_W_CDIN), MTOK, 3584, 1024};
            S.init(MTOK, 3584, gridDim.x, blockIdx.x);
            pg8::EpiStore E{R1, 3584};
            pg8::gemm_phase(lds, g, S, E);
        } break;
        case 3: attnA_phase(p, lds); break;
        case 4: s5scan_phase(p); break;
        case 5: s5c_phase(p, lds); break;
        case 6: {
            pg8::Gemm g{(const bf16_t*)(ws + WS_Y5), (const bf16_t*)(ws + WS_W_GLU), MTOK, 512, 512};
            S.init(MTOK, 512, gridDim.x, blockIdx.x);
            pg8::EpiGlu E{(const bf16_t*)(ws + WS_Y5), p.in[22], MIX};
            pg8::gemm_phase(lds, g, S, E);
        } break;
        case 7: case 16: case 10: case 19: {
            const bool ffn = (ph == 10 || ph == 19);
            const bf16_t* A = ffn ? R1 : MIX;
            const bf16_t* Bt = ffn ? (const bf16_t*)(ws + WS_W_FFOUT) + (size_t)layer * 1024 * FFH : (const bf16_t*)(ws + (layer ? WS_W_CDOUT : WS_W_ABOUT));
            pg8::Gemm g{A, Bt, MTOK, 1024, ffn ? FFH : 1024};
            S.init(MTOK, 1024, gridDim.x, blockIdx.x);
            pg8::EpiResid E{(ph == 7) ? p.in[0] : XA, XA, modl + (ffn ? 5120 : 2048)};
            pg8::gemm_phase(lds, g, S, E);
        } break;
        case 9: case 18: {
            pg8::Gemm g{H, (const bf16_t*)(ws + WS_W_FFIN) + (size_t)layer * 5632 * 1024, MTOK, 5632, 1024};
            S.init(MTOK, 5632, gridDim.x, blockIdx.x);
            pg8::EpiSwiglu E{R1};
            pg8::gemm_phase(lds, g, S, E);
        } break;
        case 13: reta_phase(p, lds); __syncthreads(); sb_phase(p, lds); break;
        case 14: retscan_phase(p); break;
        case 15: retc_phase(p, lds); break;
        default: break;
        }
        unsigned long long probe_t1 = 0ull;
        if (PROBE_MASK) { __syncthreads(); probe_t1 = __builtin_amdgcn_s_memrealtime(); if ((PROBE_MASK >> ph) & 1u) probe_acc += probe_t1 - probe_t0; }
        if (ph + 1 < p.ph_hi) {
            if (p.ph_hi > 1000) grid.sync();
            grid_barrier((unsigned*)(ws + WS_CTL), bar_gen);
        }
        if (PROBE_MASK && ((PROBE_MASK >> 20) & 1u)) probe_acc += __builtin_amdgcn_s_memrealtime() - probe_t1;
    }
    if (PROBE_MASK && blockIdx.x == 0 && threadIdx.x == 0) { const unsigned long long st = __builtin_amdgcn_s_memrealtime(); while (__builtin_amdgcn_s_memrealtime() - st < probe_acc) __builtin_amdgcn_s_sleep(8); }
}


#ifndef DIAG
#define DIAG 0
#endif
#if DIAG
__global__ void diag_fold(Params p) {
    const size_t n = (size_t)MTOK * 1024; unsigned char* ws = p.ws;
    for (size_t i = (size_t)blockIdx.x * blockDim.x + threadIdx.x; i < n; i += (size_t)gridDim.x * blockDim.x) {
        const size_t row = i >> 10; const int col = (int)(i & 1023); float v = 0.f;
#if DIAG == 30
        v = col < 512 ? bf2f(((const bf16_t*)(ws + WS_MIX))[i]) : 0.f;
#elif DIAG == 31
        v = ((const float*)(ws + WS_S5E))[i & 4194303];
#elif DIAG == 3
        v = col < 512 ? bf2f(((const bf16_t*)(ws + WS_MIX))[i]) : ((const float*)(ws + WS_S5E))[(row * 512 + col - 512) & 4194303];
#elif DIAG == 2
        v = bf2f(((const bf16_t*)(ws + WS_R1))[2 * i]) + bf2f(((const bf16_t*)(ws + WS_R1))[2 * i + 1]);
#elif DIAG == 1
        v = bf2f(((const bf16_t*)(ws + WS_H))[i]);
#elif DIAG == 5
        v = bf2f(((const bf16_t*)(ws + WS_Y5))[i >> 1]);
#elif DIAG == 6
        v = bf2f(((const bf16_t*)(ws + WS_MIX))[i]);
#endif
        p.out[i] = v;
    }
}
#endif
#ifndef MK_MULTI
#define MK_MULTI 0
#endif
extern "C" void kernel_launch(void* const* d_in, const int* in_sizes, int n_in, void* d_out, int out_size, void* d_ws, size_t ws_size, hipStream_t stream) {
    static int grid = 0;
    if (grid == 0) {
        if (n_in != 26 || out_size != MTOK * DM || ws_size < WS_END) { fprintf(stderr, "kernel_launch: unexpected shapes (n_in %d out %d ws %zu need %zu)\n", n_in, out_size, ws_size, (size_t)WS_END); grid = -1; return; }
        int dev = 0, cus = 0, per_cu = 0;
        hipGetDevice(&dev); hipDeviceGetAttribute(&cus, hipDeviceAttributeMultiprocessorCount, dev);
        if (hipFuncSetAttribute((const void*)mega_fwd, hipFuncAttributeMaxDynamicSharedMemorySize, LDS_BYTES) != hipSuccess) { fprintf(stderr, "kernel_launch: hipFuncSetAttribute failed\n"); grid = -1; return; }
        if (hipOccupancyMaxActiveBlocksPerMultiprocessor(&per_cu, (const void*)mega_fwd, NTHR, LDS_BYTES) != hipSuccess || per_cu < 1) { fprintf(stderr, "kernel_launch: occupancy query says %d\n", per_cu); per_cu = 1; }
        (void)hipGetLastError();
        grid = cus * 1;
    }
    if (grid < 0) return;
    Params p{};
    for (int i = 0; i < 26; ++i) p.in[i] = (const float*)d_in[i];
    p.out = (float*)d_out; p.ws = (unsigned char*)d_ws;
#if MK_MULTI
#if DIAG
    for (int ph = 0; ph <= (DIAG >= 30 ? DIAG / 10 : DIAG); ++ph) { p.ph_lo = ph; p.ph_hi = ph + 1; hipLaunchKernelGGL(mega_fwd, dim3(grid), dim3(NTHR), LDS_BYTES, stream, p); }
    hipLaunchKernelGGL(diag_fold, dim3(2048), dim3(256), 0, stream, p);
#else
    for (int ph = 0; ph < N_PHASES; ++ph) { p.ph_lo = ph; p.ph_hi = ph + 1; hipLaunchKernelGGL(mega_fwd, dim3(grid), dim3(NTHR), LDS_BYTES, stream, p); }
#endif
#else
    p.ph_lo = 0; p.ph_hi = N_PHASES;
    (void)hipMemsetAsync((char*)d_ws + WS_CTL, 0, 4096, stream);
    void* args[] = {&p};
    hipError_t e = hipLaunchCooperativeKernel((const void*)mega_fwd, dim3(grid), dim3(NTHR), args, LDS_BYTES, stream);
    if (e != hipSuccess) fprintf(stderr, "cooperative launch failed: %s (grid %d)\n", hipGetErrorString(e), grid);
#endif
}
```

```cpp
#include <hip/hip_runtime.h>
#include <hip/hip_cooperative_groups.h>
#include <cstdio>
namespace cg = cooperative_groups;

#define LAS __attribute__((address_space(3)))
typedef unsigned short bf16_t;
typedef short bf16x8 __attribute__((ext_vector_type(8)));
typedef short s16x4 __attribute__((ext_vector_type(4)));
typedef float f32x4 __attribute__((ext_vector_type(4)));
typedef float f32x2 __attribute__((ext_vector_type(2)));
typedef unsigned u32x4 __attribute__((ext_vector_type(4)));
typedef unsigned u32x2 __attribute__((ext_vector_type(2)));

constexpr int NB = 16, SEQ = 4096, DM = 1024, MTOK = NB * SEQ, FFH = 2816;
constexpr int NTHR = 512;
constexpr int LDS_BYTES = 135168;

constexpr size_t al256(size_t x) { return (x + 255) & ~(size_t)255; }
constexpr size_t WS_CTL = 0;
constexpr size_t WS_W_ABIN = 4096;
constexpr size_t WS_W_ABOUT = WS_W_ABIN + (size_t)2048 * 1024 * 2;
constexpr size_t WS_W_GLU = WS_W_ABOUT + (size_t)1024 * 1024 * 2;
constexpr size_t WS_W_FFIN = WS_W_GLU + (size_t)512 * 512 * 2;
constexpr size_t WS_W_FFOUT = WS_W_FFIN + (size_t)2 * 5632 * 1024 * 2;
constexpr size_t WS_W_CDIN = WS_W_FFOUT + (size_t)2 * 1024 * 2816 * 2;
constexpr size_t WS_W_CDOUT = WS_W_CDIN + (size_t)3584 * 1024 * 2;
constexpr size_t WS_MOD = WS_W_CDOUT + (size_t)1024 * 1024 * 2;
constexpr size_t WS_ROPE = WS_MOD + (size_t)2 * 16 * 6144 * 4;
constexpr size_t WS_KERN = WS_ROPE + (size_t)4096 * 64 * 8;
constexpr size_t WS_S5M = WS_KERN + (size_t)32 * 64 * 256 * 2;
constexpr size_t WS_S5G = WS_S5M + (size_t)32 * 128 * 1024 * 2;
constexpr size_t WS_A64 = WS_S5G + (size_t)32 * 1024 * 128 * 2;
constexpr size_t WS_S5E = WS_A64 + (size_t)32 * 64 * 8;
constexpr size_t WS_S5X = WS_S5E + (size_t)64 * 32 * 16 * 128 * 4;
constexpr size_t WS_Y5 = WS_S5X + (size_t)64 * 32 * 16 * 128 * 2;
constexpr size_t WS_H = WS_Y5 + (size_t)MTOK * 512 * 2;
constexpr size_t WS_MIX = WS_H + (size_t)MTOK * 1024 * 2;
constexpr size_t WS_R1 = WS_MIX + (size_t)MTOK * 1024 * 2;
constexpr size_t WS_END = WS_R1 + (size_t)MTOK * 3584 * 2;

struct Params {
    const float* in[26];
    float* out;
    unsigned char* ws;
    int ph_lo, ph_hi;
};

__device__ __forceinline__ float bf2f(unsigned short b) { return __uint_as_float(((unsigned)b) << 16); }
typedef __bf16 bf16x2_t __attribute__((ext_vector_type(2)));
__device__ __forceinline__ unsigned pk2(float lo, float hi) { const f32x2 v = {lo, hi}; return __builtin_bit_cast(unsigned, __builtin_convertvector(v, bf16x2_t)); }
__device__ __forceinline__ bf16_t f2bf(float f) { return (bf16_t)(pk2(f, 0.f) & 0xffffu); }
__device__ __forceinline__ float lo_f(unsigned u) { return __uint_as_float(u << 16); }
__device__ __forceinline__ float hi_f(unsigned u) { return __uint_as_float(u & 0xffff0000u); }
__device__ __forceinline__ bf16x8 as_frag(u32x4 u) { return __builtin_bit_cast(bf16x8, u); }
__device__ __forceinline__ f32x4 mfma16(bf16x8 a, bf16x8 b, f32x4 c) { return __builtin_amdgcn_mfma_f32_16x16x32_bf16(a, b, c, 0, 0, 0); }
__device__ __forceinline__ float silu_f(float x) { return x * __builtin_amdgcn_rcpf(1.f + __expf(-x)); }
__device__ __forceinline__ float sigm_f(float x) { return __builtin_amdgcn_rcpf(1.f + __expf(-x)); }
__device__ __forceinline__ float gelu_tanh(float x) {
    const float u = 0.7978845608028654f * (x + 0.044715f * x * x * x);
    const float t = 1.f - 2.f * __builtin_amdgcn_rcpf(1.f + __expf(2.f * u));
    return 0.5f * x * (1.f + t);
}
__device__ __forceinline__ bf16x8 tr_pair(LAS bf16_t* base, int stride, int row0, int row1, int col0, int li) {
    const int q = li >> 2, pq = li & 3;
    s16x4 a = __builtin_amdgcn_ds_read_tr16_b64_v4i16((LAS s16x4*)(base + (row0 + q) * stride + col0 + 4 * pq));
    s16x4 b = __builtin_amdgcn_ds_read_tr16_b64_v4i16((LAS s16x4*)(base + (row1 + q) * stride + col0 + 4 * pq));
    bf16x8 r = {a[0], a[1], a[2], a[3], b[0], b[1], b[2], b[3]};
    return r;
}
__device__ __forceinline__ int tid_opaque() { int t = threadIdx.x; asm volatile("" : "+v"(t)); return t; }
__device__ __forceinline__ int vblock() { const int G = gridDim.x, bx = blockIdx.x; return (G % 8 == 0) ? (bx % 8) * (G / 8) + bx / 8 : bx; }
__device__ __forceinline__ void wave_lds_fence() { asm volatile("s_waitcnt lgkmcnt(0)" ::: "memory"); __builtin_amdgcn_wave_barrier(); }


__device__ __forceinline__ void grid_barrier(unsigned* w, unsigned& gen) {
    asm volatile("s_waitcnt vmcnt(0) lgkmcnt(0)" ::: "memory");
    __syncthreads();
    if (threadIdx.x == 0) {
        __builtin_amdgcn_fence(__ATOMIC_RELEASE, "agent");
        asm volatile("s_waitcnt vmcnt(0) lgkmcnt(0)" ::: "memory");
        const unsigned G = gridDim.x, grp = blockIdx.x & 7u, ngrp = (G - grp + 7u) / 8u, ngroups = G < 8u ? G : 8u;
        const unsigned old = __hip_atomic_fetch_add(w + 32 * grp, 1u, __ATOMIC_RELAXED, __HIP_MEMORY_SCOPE_AGENT);
        if (old + 1u == ngrp * (gen + 1u)) {
            const unsigned old2 = __hip_atomic_fetch_add(w + 256, 1u, __ATOMIC_RELAXED, __HIP_MEMORY_SCOPE_AGENT);
            if (old2 + 1u == ngroups * (gen + 1u)) __hip_atomic_fetch_add(w + 288, 1u, __ATOMIC_RELAXED, __HIP_MEMORY_SCOPE_AGENT);
        }
        while (__hip_atomic_load(w + 288, __ATOMIC_RELAXED, __HIP_MEMORY_SCOPE_AGENT) == gen) __builtin_amdgcn_s_sleep(2);
        __builtin_amdgcn_fence(__ATOMIC_ACQUIRE, "agent");
        asm volatile("s_waitcnt vmcnt(0) lgkmcnt(0)" ::: "memory");
    }
    ++gen;
    __syncthreads();
}

namespace pg8 {
constexpr int BM = 256, BK = 64, HALF = 128, HTB = HALF * BK * 2, STAGE_BYTES = 8 * HTB, NXCD = 8, WGM = 4;
__device__ __forceinline__ int lds_byte(int r, int c) { const int st = (r >> 4) * 2 + (c >> 5), rr = r & 15, cc = c & 31, ob = rr * 64 + cc * 2; return st * 1024 + (ob ^ (((ob >> 9) & 1) << 5)); }
__device__ __forceinline__ void stage_rc(int b, int& R, int& C) { const int st = b / 1024, sb = b % 1024, swz = sb ^ (((sb >> 9) & 1) << 5); R = (st >> 1) * 16 + swz / 64; C = (st & 1) * 32 + (swz % 64) / 2; }
__device__ __forceinline__ int perm32(int rho) { const int n = rho >> 4, i = rho & 15; return 8 * (i >> 2) + 4 * n + (i & 3); }
struct Unit { int pm, pn; };
struct Gemm { const bf16_t* A; const bf16_t* Bt; int M, N, K; };
struct StaticOrder {
    int nM, nN, nwg, G, c;
    __device__ void init(int M, int N, int G_, int c_) { nM = M / BM; nN = N / BM; nwg = nM * nN; G = G_; c = c_; }
    __device__ bool next(int i, Unit& u) const {
        const long L = (long)i * G + c; if (L >= nwg) return false;
        int wgid = (int)L; { const int q = nwg / NXCD, r = nwg % NXCD, xcd = wgid % NXCD, off = wgid / NXCD; wgid = (xcd < r ? xcd * (q + 1) : r * (q + 1) + (xcd - r) * q) + off; }
        const int nig = WGM * nN, gid = wgid / nig, fm = gid * WGM, gsz = (nM - fm) < WGM ? (nM - fm) : WGM;
        u.pm = fm + ((wgid % nig) % gsz); u.pn = (wgid % nig) / gsz; return true;
    }
};

template <class Epi>
__device__ __forceinline__ void gemm_phase(LAS unsigned char* lds, const Gemm g, const StaticOrder& S, const Epi& E) {
    const int tid = tid_opaque(), wid = __builtin_amdgcn_readfirstlane(tid >> 6), lane = tid & 63, wr = wid >> 2, wc = wid & 3, fr = lane & 15, fq = lane >> 4;
    const int K = g.K, nt = K / BK;
    unsigned voffA[2], voffB[2];
#pragma unroll
    for (int i = 0; i < 2; ++i) { int R, C; stage_rc(tid * 16 + i * 8192, R, C); const int Rb = Epi::PERM ? ((R & ~31) + perm32(R & 31)) : R;
        voffA[i] = (unsigned)(R * K + C) * 2u; voffB[i] = (unsigned)(Rb * K + C) * 2u; }
    const size_t kstep = (size_t)(BK * 2);
    const size_t hstep = (size_t)HALF * K * 2;
    const size_t tstep = 2 * hstep;
    const unsigned ldsw = (unsigned)wid * 1024u;
    const int aoff = lds_byte(wr * 64 + fr, fq * 8), boff = lds_byte(wc * 32 + fr, fq * 8);
#define PG8_SA(b, h) (((b) * 2 + (h)) * HTB)
#define PG8_SB(b, h) ((4 + (b) * 2 + (h)) * HTB)
#define PG8_STAGE(bufoff, gbase, voff) do { _Pragma("unroll") for (int _i = 0; _i < 2; ++_i) \
        __builtin_amdgcn_global_load_lds((const unsigned*)((const char*)(gbase) + (voff)[_i]), (LAS unsigned*)(lds + (bufoff) + ldsw + _i * 8192), 16, 0, 0); } while (0)
#define PG8_LDA(dst, b, h) do { _Pragma("unroll") for (int m = 0; m < 4; ++m) _Pragma("unroll") for (int k = 0; k < 2; ++k) dst[m][k] = *(const LAS bf16x8*)(lds + PG8_SA(b, h) + aoff + m * 2048 + k * 1024); } while (0)
#define PG8_LDB(dst, b, h) do { _Pragma("unroll") for (int n = 0; n < 2; ++n) _Pragma("unroll") for (int k = 0; k < 2; ++k) dst[n][k] = *(const LAS bf16x8*)(lds + PG8_SB(b, h) + boff + n * 2048 + k * 1024); } while (0)
#define PG8_MMA(ai, bj, At, Bt) do { __builtin_amdgcn_s_setprio(1); _Pragma("unroll") for (int m = 0; m < 4; ++m) _Pragma("unroll") for (int n = 0; n < 2; ++n) _Pragma("unroll") for (int k = 0; k < 2; ++k) \
        acc[ai][bj][m][n] = __builtin_amdgcn_mfma_f32_16x16x32_bf16(Bt[n][k], At[m][k], acc[ai][bj][m][n], 0, 0, 0); __builtin_amdgcn_s_setprio(0); } while (0)
#define PG8_WAIT_V(n) asm volatile("s_waitcnt vmcnt(" #n ")" ::: "memory")
#define PG8_WAIT_L(n) asm volatile("s_waitcnt lgkmcnt(" #n ")" ::: "memory")
#define PG8_BAR __builtin_amdgcn_s_barrier()
#define PG8_SCHED __builtin_amdgcn_sched_barrier(0)
    Unit cur, nxt; int ui = 0;
    if (!S.next(0, cur)) return;
    f32x4 acc[2][2][4][2];
#pragma unroll
    for (int a = 0; a < 2; ++a)
#pragma unroll
        for (int b = 0; b < 2; ++b)
#pragma unroll
            for (int m = 0; m < 4; ++m)
#pragma unroll
                for (int n = 0; n < 2; ++n) acc[a][b][m][n] = (f32x4){0.f, 0.f, 0.f, 0.f};
    bf16x8 At[4][2], B0[2][2], B1[2][2];
    const char* cA = (const char*)g.A + (size_t)cur.pm * tstep; const char* cB = (const char*)g.Bt + (size_t)cur.pn * tstep;
    PG8_STAGE(PG8_SB(0, 0), cB, voffB); PG8_STAGE(PG8_SA(0, 0), cA, voffA); PG8_STAGE(PG8_SB(0, 1), cB + hstep, voffB); PG8_STAGE(PG8_SA(0, 1), cA + hstep, voffA);
    if (wr == 1) PG8_BAR;
    PG8_WAIT_V(4); PG8_BAR;
    PG8_STAGE(PG8_SB(1, 0), cB + kstep, voffB); PG8_STAGE(PG8_SA(1, 0), cA + kstep, voffA); PG8_STAGE(PG8_SB(1, 1), cB + hstep + kstep, voffB);
    PG8_WAIT_V(6); PG8_BAR;
    for (;;) {
        const bool has_next = S.next(ui + 1, nxt);
        const char* nA = has_next ? (const char*)g.A + (size_t)nxt.pm * tstep : cA; const char* nB = has_next ? (const char*)g.Bt + (size_t)nxt.pn * tstep : cB;
        for (int t = 0; t < nt; t += 2) {
            const bool last = (t == nt - 2);
            const char* a1 = cA + (size_t)(t + 1) * kstep;
            const char* a2 = last ? nA : cA + (size_t)(t + 2) * kstep; const char* b2 = last ? nB : cB + (size_t)(t + 2) * kstep;
            const char* a3 = a2 + kstep; const char* b3 = b2 + kstep;
            PG8_LDB(B0, 0, 0); PG8_SCHED; PG8_LDA(At, 0, 0); PG8_STAGE(PG8_SA(1, 1), a1 + hstep, voffA);
            PG8_WAIT_L(8); PG8_BAR; PG8_WAIT_L(0); PG8_MMA(0, 0, At, B0); PG8_BAR; PG8_SCHED;
            PG8_LDB(B1, 0, 1); PG8_STAGE(PG8_SB(0, 0), b2, voffB);
            PG8_BAR; PG8_WAIT_L(0); PG8_MMA(0, 1, At, B1); PG8_BAR;
            PG8_LDA(At, 0, 1); PG8_STAGE(PG8_SA(0, 0), a2, voffA);
            PG8_BAR; PG8_WAIT_L(0); PG8_MMA(1, 0, At, B0); PG8_BAR; PG8_SCHED;
            PG8_STAGE(PG8_SB(0, 1), b2 + hstep, voffB);
            PG8_WAIT_V(6); PG8_BAR; PG8_MMA(1, 1, At, B1); PG8_BAR;
            PG8_LDB(B0, 1, 0); PG8_SCHED; PG8_LDA(At, 1, 0); PG8_STAGE(PG8_SA(0, 1), a2 + hstep, voffA);
            PG8_WAIT_L(8); PG8_BAR; PG8_WAIT_L(0); PG8_MMA(0, 0, At, B0); PG8_BAR; PG8_SCHED;
            PG8_LDB(B1, 1, 1); PG8_STAGE(PG8_SB(1, 0), b3, voffB);
            PG8_BAR; PG8_WAIT_L(0); PG8_MMA(0, 1, At, B1); PG8_BAR;
            PG8_LDA(At, 1, 1); PG8_STAGE(PG8_SA(1, 0), a3, voffA);
            PG8_BAR; PG8_WAIT_L(0); PG8_MMA(1, 0, At, B0); PG8_BAR; PG8_SCHED;
            PG8_STAGE(PG8_SB(1, 1), b3 + hstep, voffB);
            PG8_WAIT_V(6); PG8_BAR; PG8_MMA(1, 1, At, B1); PG8_BAR;
        }
        E(acc, cur, wr, wc, fr, fq);
        if (!has_next) break;
#pragma unroll
        for (int a = 0; a < 2; ++a)
#pragma unroll
            for (int b = 0; b < 2; ++b)
#pragma unroll
                for (int m = 0; m < 4; ++m)
#pragma unroll
                    for (int n = 0; n < 2; ++n) acc[a][b][m][n] = (f32x4){0.f, 0.f, 0.f, 0.f};
        cur = nxt; cA = nA; cB = nB; ++ui;
    }
    PG8_WAIT_V(0);
    if (wr == 0) PG8_BAR;
    PG8_BAR;
#undef PG8_SA
#undef PG8_SB
#undef PG8_STAGE
#undef PG8_LDA
#undef PG8_LDB
#undef PG8_MMA
#undef PG8_WAIT_V
#undef PG8_WAIT_L
#undef PG8_BAR
#undef PG8_SCHED
}

struct EpiStore {
    static constexpr bool PERM = true;
    bf16_t* O; int ldc;
    __device__ __forceinline__ void operator()(const f32x4 (&acc)[2][2][4][2], const Unit& u, int wr, int wc, int fr, int fq) const {
        const int row0 = u.pm * BM + wr * 64 + fr, col0 = u.pn * BM + wc * 32 + 8 * fq;
#pragma unroll
        for (int ai = 0; ai < 2; ++ai)
#pragma unroll
            for (int m = 0; m < 4; ++m) { bf16_t* rowp = O + (size_t)(row0 + ai * HALF + m * 16) * ldc + col0;
#pragma unroll
                for (int bj = 0; bj < 2; ++bj) { const f32x4 v0 = acc[ai][bj][m][0], v1 = acc[ai][bj][m][1];
                    u32x4 w; w.x = pk2(v0[0], v0[1]); w.y = pk2(v0[2], v0[3]); w.z = pk2(v1[0], v1[1]); w.w = pk2(v1[2], v1[3]);
                    __builtin_nontemporal_store(w, (u32x4*)(rowp + bj * HALF)); } }
    }
};
struct EpiStoreQK {
    static constexpr bool PERM = true;
    bf16_t* O; const float* qg; const float* kg;
    __device__ __forceinline__ void operator()(const f32x4 (&acc)[2][2][4][2], const Unit& u, int wr, int wc, int fr, int fq) const {
        const int row0 = u.pm * BM + wr * 64 + fr;
        if (u.pn >= 4) {
            const int col0 = u.pn * BM + wc * 32 + 8 * fq;
#pragma unroll
            for (int ai = 0; ai < 2; ++ai)
#pragma unroll
                for (int m = 0; m < 4; ++m) { bf16_t* rowp = O + (size_t)(row0 + ai * HALF + m * 16) * 2048 + col0;
#pragma unroll
                    for (int bj = 0; bj < 2; ++bj) { const f32x4 v0 = acc[ai][bj][m][0], v1 = acc[ai][bj][m][1];
                        u32x4 w; w.x = pk2(v0[0], v0[1]); w.y = pk2(v0[2], v0[3]); w.z = pk2(v1[0], v1[1]); w.w = pk2(v1[2], v1[3]);
                        __builtin_nontemporal_store(w, (u32x4*)(rowp + bj * HALF)); } }
        } else {
            const float* gp = u.pn < 2 ? qg : kg; const float scl = u.pn < 2 ? 0.125f * 1.4426950408889634f : 1.f;
            f32x4 gn[2][2];
#pragma unroll
            for (int bj = 0; bj < 2; ++bj)
#pragma unroll
                for (int n = 0; n < 2; ++n) gn[bj][n] = *(const f32x4*)(gp + 32 * bj + 8 * fq + 4 * n);
            const int col0 = u.pn * BM + wc * 64 + 8 * fq;
#pragma unroll
            for (int ai = 0; ai < 2; ++ai)
#pragma unroll
                for (int m = 0; m < 4; ++m) { bf16_t* rowp = O + (size_t)(row0 + ai * HALF + m * 16) * 2048 + col0;
                    float ss = 0.f;
#pragma unroll
                    for (int bj = 0; bj < 2; ++bj)
#pragma unroll
                        for (int n = 0; n < 2; ++n) { const f32x4 a = acc[ai][bj][m][n]; ss += a[0] * a[0] + a[1] * a[1] + a[2] * a[2] + a[3] * a[3]; }
                    ss += __shfl_xor(ss, 16); ss += __shfl_xor(ss, 32);
                    const float r = rsqrtf(ss * (1.f / 64.f) + 1e-6f) * scl;
#pragma unroll
                    for (int bj = 0; bj < 2; ++bj) { const f32x4 v0 = acc[ai][bj][m][0] * r * gn[bj][0], v1 = acc[ai][bj][m][1] * r * gn[bj][1];
                        u32x4 w; w.x = pk2(v0[0], v0[1]); w.y = pk2(v0[2], v0[3]); w.z = pk2(v1[0], v1[1]); w.w = pk2(v1[2], v1[3]);
                        __builtin_nontemporal_store(w, (u32x4*)(rowp + 32 * bj)); } }
        }
    }
};
struct EpiSwiglu {
    static constexpr bool PERM = true;
    bf16_t* O;
    __device__ __forceinline__ void operator()(const f32x4 (&acc)[2][2][4][2], const Unit& u, int wr, int wc, int fr, int fq) const {
        const int row0 = u.pm * BM + wr * 64 + fr, col0 = u.pn * HALF + wc * 32 + 8 * fq;
#pragma unroll
        for (int ai = 0; ai < 2; ++ai)
#pragma unroll
            for (int m = 0; m < 4; ++m) { bf16_t* rowp = O + (size_t)(row0 + ai * HALF + m * 16) * FFH + col0;
                float r[8];
#pragma unroll
                for (int n = 0; n < 2; ++n)
#pragma unroll
                    for (int j = 0; j < 4; ++j) r[n * 4 + j] = silu_f(acc[ai][0][m][n][j]) * acc[ai][1][m][n][j];
                u32x4 w; w.x = pk2(r[0], r[1]); w.y = pk2(r[2], r[3]); w.z = pk2(r[4], r[5]); w.w = pk2(r[6], r[7]);
                __builtin_nontemporal_store(w, (u32x4*)rowp); }
    }
};
struct EpiGlu {
    static constexpr bool PERM = true;
    const bf16_t* Y; const float* bias; bf16_t* O;
    __device__ __forceinline__ void operator()(const f32x4 (&acc)[2][2][4][2], const Unit& u, int wr, int wc, int fr, int fq) const {
        const int row0 = u.pm * BM + wr * 64 + fr, col0 = u.pn * BM + wc * 32 + 8 * fq;
#pragma unroll
        for (int bj = 0; bj < 2; ++bj) {
            const int col = col0 + bj * HALF;
            const f32x4 b0 = *(const f32x4*)(bias + col), b1 = *(const f32x4*)(bias + col + 4);
            u32x4 yv[2][4];
#pragma unroll
            for (int ai = 0; ai < 2; ++ai)
#pragma unroll
                for (int m = 0; m < 4; ++m) yv[ai][m] = *(const u32x4*)(Y + (size_t)(row0 + ai * HALF + m * 16) * 512 + col);
#pragma unroll
            for (int ai = 0; ai < 2; ++ai)
#pragma unroll
                for (int m = 0; m < 4; ++m) { const size_t row = (size_t)(row0 + ai * HALF + m * 16);
                    const u32x4 y4 = yv[ai][m];
                    const f32x4 v0 = acc[ai][bj][m][0] + b0, v1 = acc[ai][bj][m][1] + b1;
                    float r[8];
                    r[0] = lo_f(y4.x) * sigm_f(v0[0]); r[1] = hi_f(y4.x) * sigm_f(v0[1]); r[2] = lo_f(y4.y) * sigm_f(v0[2]); r[3] = hi_f(y4.y) * sigm_f(v0[3]);
                    r[4] = lo_f(y4.z) * sigm_f(v1[0]); r[5] = hi_f(y4.z) * sigm_f(v1[1]); r[6] = lo_f(y4.w) * sigm_f(v1[2]); r[7] = hi_f(y4.w) * sigm_f(v1[3]);
                    u32x4 w; w.x = pk2(r[0], r[1]); w.y = pk2(r[2], r[3]); w.z = pk2(r[4], r[5]); w.w = pk2(r[6], r[7]);
                    __builtin_nontemporal_store(w, (u32x4*)(O + row * 1024 + 512 + col)); }
        }
    }
};
struct EpiResid {
    static constexpr bool PERM = false;
    const float* res; float* out; const float* gate;
    __device__ __forceinline__ void operator()(const f32x4 (&acc)[2][2][4][2], const Unit& u, int wr, int wc, int fr, int fq) const {
        const int row0 = u.pm * BM + wr * 64 + fr, col0 = u.pn * BM + wc * 32 + 4 * fq;
        const int bidx = (u.pm * BM) >> 12;
        f32x4 gv[2][2];
#pragma unroll
        for (int bj = 0; bj < 2; ++bj)
#pragma unroll
            for (int n = 0; n < 2; ++n) gv[bj][n] = *(const f32x4*)(gate + (size_t)bidx * 6144 + col0 + bj * HALF + n * 16);
        f32x4 rv[2][2][2][2];
#define EPR_LOAD(buf, q) do { _Pragma("unroll") for (int mm = 0; mm < 2; ++mm) _Pragma("unroll") for (int bj = 0; bj < 2; ++bj) _Pragma("unroll") for (int n = 0; n < 2; ++n) \
            rv[buf][mm][bj][n] = *(const f32x4*)(res + (size_t)(row0 + ((q) >> 1) * HALF + (((q) & 1) * 2 + mm) * 16) * 1024 + col0 + bj * HALF + n * 16); } while (0)
#define EPR_STORE(buf, q) do { _Pragma("unroll") for (int mm = 0; mm < 2; ++mm) _Pragma("unroll") for (int bj = 0; bj < 2; ++bj) _Pragma("unroll") for (int n = 0; n < 2; ++n) \
            __builtin_nontemporal_store(rv[buf][mm][bj][n] + gv[bj][n] * acc[(q) >> 1][bj][((q) & 1) * 2 + mm][n], (f32x4*)(out + (size_t)(row0 + ((q) >> 1) * HALF + (((q) & 1) * 2 + mm) * 16) * 1024 + col0 + bj * HALF + n * 16)); } while (0)
        EPR_LOAD(0, 0); EPR_LOAD(1, 1); EPR_STORE(0, 0); EPR_LOAD(0, 2); EPR_STORE(1, 1); EPR_LOAD(1, 3); EPR_STORE(0, 2); EPR_STORE(1, 3);
#undef EPR_LOAD
#undef EPR_STORE
    }
};
}

__device__ __forceinline__ int wt_src_col(int n, int mode) {
    if (mode == 1) { const int tt = n >> 8, r = n & 255; return r < 128 ? tt * 128 + r : FFH + tt * 128 + (r - 128); }
    if (mode == 2 && n < 1024) { const int lc = n & 255; return (n & ~255) + ((lc >> 5) & 3) * 64 + 32 * (lc >> 7) + (lc & 31); }
    return n;
}
__device__ __forceinline__ void transpose_cvt(LAS float* tile, const float* __restrict__ W, int K, int N, bf16_t* __restrict__ Wt, int mode) {
    const int tid = tid_opaque();
    const int tilesN = N / 64, tilesK = K / 64, ntl = tilesN * tilesK;
    float cur[8];
    if ((int)blockIdx.x < ntl) { const int tn = blockIdx.x % tilesN, tk = blockIdx.x / tilesN; const int nsrc = wt_src_col(tn * 64 + (tid & 63), mode);
#pragma unroll
        for (int r = 0; r < 8; ++r) cur[r] = W[(size_t)(tk * 64 + (tid >> 6) + 8 * r) * N + nsrc]; }
    for (int t = blockIdx.x; t < ntl; t += gridDim.x) {
        const int tn = t % tilesN, tk = t / tilesN;
        const int n0d = tn * 64, k0 = tk * 64;
#pragma unroll
        for (int r = 0; r < 8; ++r) { const int kk = (tid >> 6) + 8 * r; tile[kk * 65 + (tid & 63)] = cur[r]; }
        const int t2 = t + gridDim.x;
        if (t2 < ntl) { const int tn2 = t2 % tilesN, tk2 = t2 / tilesN; const int nsrc = wt_src_col(tn2 * 64 + (tid & 63), mode);
#pragma unroll
            for (int r = 0; r < 8; ++r) cur[r] = W[(size_t)(tk2 * 64 + (tid >> 6) + 8 * r) * N + nsrc]; }
        __syncthreads();
        { const int nn = tid >> 3, kc = (tid & 7) * 8; float v[8];
#pragma unroll
          for (int j = 0; j < 8; ++j) v[j] = tile[(kc + j) * 65 + nn];
          u32x4 w; w.x = pk2(v[0], v[1]); w.y = pk2(v[2], v[3]); w.z = pk2(v[4], v[5]); w.w = pk2(v[6], v[7]);
          *(u32x4*)(Wt + (size_t)(n0d + nn) * K + k0 + kc) = w; }
        __syncthreads();
    }
}

struct S5gp { float lrdt, lidt, fre, fim; };
__device__ __forceinline__ S5gp s5_gp(const Params& p, int g, int pp) {
    S5gp r; const float dt = expf(p.in[15][g]); const float lr = p.in[13][g * 64 + pp], li = p.in[14][g * 64 + pp];
    r.lrdt = lr * dt; r.lidt = li * dt;
    const float mag = expf(r.lrdt), are = mag * cosf(r.lidt), aim = mag * sinf(r.lidt), den = lr * lr + li * li;
    r.fre = ((are - 1.f) * lr + aim * li) / den; r.fim = (aim * lr - (are - 1.f) * li) / den;
    return r;
}
__device__ __forceinline__ f32x2 s5_apow(const S5gp& q, float n) { const float m = expf(n * q.lrdt), a = n * q.lidt; return (f32x2){m * cosf(a), m * sinf(a)}; }

__device__ __forceinline__ void prep_phase(const Params& p, LAS unsigned char* lds) {
    const int tid = tid_opaque();
    unsigned char* ws = p.ws;
    LAS float* tile = (LAS float*)lds;
    transpose_cvt(tile, p.in[8], 1024, 2048, (bf16_t*)(ws + WS_W_ABIN), 2);
    transpose_cvt(tile, p.in[9], 1024, 1024, (bf16_t*)(ws + WS_W_ABOUT), 0);
    transpose_cvt(tile, p.in[21], 512, 512, (bf16_t*)(ws + WS_W_GLU), 0);
    for (int l = 0; l < 2; ++l) {
        transpose_cvt(tile, p.in[6] + (size_t)l * 1024 * 5632, 1024, 5632, (bf16_t*)(ws + WS_W_FFIN) + (size_t)l * 5632 * 1024, 1);
        transpose_cvt(tile, p.in[7] + (size_t)l * FFH * 1024, FFH, 1024, (bf16_t*)(ws + WS_W_FFOUT) + (size_t)l * 1024 * FFH, 0);
    }
    transpose_cvt(tile, p.in[23], 1024, 3584, (bf16_t*)(ws + WS_W_CDIN), 0);
    transpose_cvt(tile, p.in[24], 1024, 1024, (bf16_t*)(ws + WS_W_CDOUT), 0);
    if (blockIdx.x < 192) {
        LAS float* sc = (LAS float*)lds; LAS float* red = (LAS float*)(lds + 65536);
        for (int idx = tid; idx < 16384; idx += NTHR) { const float v = p.in[1][idx]; sc[idx] = v / (1.f + expf(-v)); }
        __syncthreads();
        for (int item = blockIdx.x; item < 192; item += gridDim.x) {
            const int l = item / 96, cb = item % 96, cl = tid & 63, ksl = tid >> 6;
            float acc[16];
#pragma unroll
            for (int b = 0; b < 16; ++b) acc[b] = 0.f;
            const float* w = p.in[2] + (size_t)l * 1024 * 6144 + cb * 64 + cl;
            for (int k0 = ksl * 128; k0 < ksl * 128 + 128; k0 += 8) {
                float wv[8];
#pragma unroll
                for (int j = 0; j < 8; ++j) wv[j] = w[(size_t)(k0 + j) * 6144];
#pragma unroll
                for (int b = 0; b < 16; ++b) { const f32x4 s0 = *(const LAS f32x4*)(sc + b * 1024 + k0), s1 = *(const LAS f32x4*)(sc + b * 1024 + k0 + 4);
                    acc[b] += s0[0] * wv[0] + s0[1] * wv[1] + s0[2] * wv[2] + s0[3] * wv[3] + s1[0] * wv[4] + s1[1] * wv[5] + s1[2] * wv[6] + s1[3] * wv[7]; }
            }
#pragma unroll
            for (int b = 0; b < 16; ++b) red[(ksl * 16 + b) * 64 + cl] = acc[b];
            __syncthreads();
            for (int o = tid; o < 1024; o += NTHR) { const int b = o >> 6, cc = o & 63; float s = 0.f;
#pragma unroll
                for (int k8 = 0; k8 < 8; ++k8) s += red[(k8 * 16 + b) * 64 + cc];
                ((float*)(ws + WS_MOD))[(size_t)(l * 16 + b) * 6144 + cb * 64 + cc] = s + p.in[3][l * 6144 + cb * 64 + cc]; }
            __syncthreads();
        }
    }
    __syncthreads();
    const int gtid = blockIdx.x * NTHR + tid, nthr = gridDim.x * NTHR;
    for (int idx = gtid; idx < 4096 * 64; idx += nthr) { const int pos = idx >> 6, f = idx & 63;
        const float freq = powf(10000.f, -(float)f / 64.f), ang = (float)pos * freq;
        ((f32x2*)(ws + WS_ROPE))[idx] = (f32x2){cosf(ang), sinf(ang)}; }
    { bf16_t* Mt = (bf16_t*)(ws + WS_S5M); bf16_t* Gt = (bf16_t*)(ws + WS_S5G);
      for (int idx = gtid; idx < 32 * 64 * 64; idx += nthr) { const int g = idx >> 12, pp = (idx >> 6) & 63, s = idx & 63;
          const S5gp q = s5_gp(p, g, pp);
          { const f32x2 a = s5_apow(q, (float)(63 - s));
            unsigned wr_[8], wi_[8];
#pragma unroll
            for (int h2 = 0; h2 < 8; ++h2) { float vr[2], vi[2];
#pragma unroll
                for (int e = 0; e < 2; ++e) { const int h = h2 * 2 + e; const float br = p.in[16][(g * 64 + pp) * 16 + h], bi = p.in[17][(g * 64 + pp) * 16 + h];
                    const float bbr = q.fre * br - q.fim * bi, bbi = q.fre * bi + q.fim * br;
                    vr[e] = a.x * bbr - a.y * bbi; vi[e] = a.x * bbi + a.y * bbr; }
                wr_[h2] = pk2(vr[0], vr[1]); wi_[h2] = pk2(vi[0], vi[1]); }
            u32x4* dr = (u32x4*)(Mt + (size_t)(g * 128 + 2 * pp) * 1024 + s * 16); u32x4* di = (u32x4*)(Mt + (size_t)(g * 128 + 2 * pp + 1) * 1024 + s * 16);
            dr[0] = (u32x4){wr_[0], wr_[1], wr_[2], wr_[3]}; dr[1] = (u32x4){wr_[4], wr_[5], wr_[6], wr_[7]};
            di[0] = (u32x4){wi_[0], wi_[1], wi_[2], wi_[3]}; di[1] = (u32x4){wi_[4], wi_[5], wi_[6], wi_[7]}; }
          { const int t = s; const f32x2 a = s5_apow(q, (float)(t + 1));
#pragma unroll
            for (int h = 0; h < 16; ++h) { const float cr = p.in[18][(g * 16 + h) * 64 + pp], ci = p.in[19][(g * 16 + h) * 64 + pp];
                const float gr = cr * a.x - ci * a.y, gi = cr * a.y + ci * a.x;
                *(unsigned*)(Gt + (size_t)(g * 1024 + t * 16 + h) * 128 + 2 * pp) = pk2(gr, -gi); } }
          if (s == 0) ((f32x2*)(ws + WS_A64))[g * 64 + pp] = s5_apow(q, 64.f);
      }
      LAS f32x2* tp = (LAS f32x2*)lds;
      bf16_t* Kt = (bf16_t*)(ws + WS_KERN);
      for (int item = blockIdx.x; item < 32 * 64; item += gridDim.x) { const int g = item >> 6, tau = item & 63;
          if (tid < 64) { const S5gp q = s5_gp(p, g, tid); const f32x2 a = s5_apow(q, (float)tau); tp[tid] = (f32x2){a.x * q.fre - a.y * q.fim, a.x * q.fim + a.y * q.fre}; }
          __syncthreads();
          if (tid < 256) { const int h = tid >> 4, h2 = tid & 15; float acc = 0.f;
#pragma unroll 8
              for (int pp = 0; pp < 64; ++pp) { const f32x2 t = tp[pp]; const float cr = p.in[18][(g * 16 + h) * 64 + pp], ci = p.in[19][(g * 16 + h) * 64 + pp];
                  const float ur = cr * t.x - ci * t.y, ui = cr * t.y + ci * t.x;
                  acc += ur * p.in[16][(g * 64 + pp) * 16 + h2] - ui * p.in[17][(g * 64 + pp) * 16 + h2]; }
              Kt[(size_t)((g * 64 + tau) * 16 + h) * 16 + h2] = f2bf(acc); }
          __syncthreads();
      }
    }
}

__device__ __forceinline__ void norm_phase(const float* __restrict__ x, const float* __restrict__ gw, const float* __restrict__ shift, const float* __restrict__ scale, bf16_t* __restrict__ H) {
    const int tid = tid_opaque(); const int lane = tid & 63, wv = blockIdx.x * 8 + (tid >> 6), nw = gridDim.x * 8;
    constexpr int NR = 8;
    for (int row0 = wv * NR; row0 < MTOK; row0 += nw * NR) {
        const int b = row0 >> 12;
        f32x4 v[NR][4]; float ss[NR];
#pragma unroll
        for (int r = 0; r < NR; ++r)
#pragma unroll
            for (int c4 = 0; c4 < 4; ++c4) v[r][c4] = __builtin_nontemporal_load((const f32x4*)(x + (size_t)(row0 + r) * 1024 + c4 * 256 + lane * 4));
#pragma unroll
        for (int r = 0; r < NR; ++r) { float s = 0.f;
#pragma unroll
            for (int c4 = 0; c4 < 4; ++c4) s += v[r][c4][0] * v[r][c4][0] + v[r][c4][1] * v[r][c4][1] + v[r][c4][2] * v[r][c4][2] + v[r][c4][3] * v[r][c4][3];
            ss[r] = s; }
#pragma unroll
        for (int o = 1; o < 64; o <<= 1)
#pragma unroll
            for (int r = 0; r < NR; ++r) ss[r] += __shfl_xor(ss[r], o);
#pragma unroll
        for (int c4 = 0; c4 < 4; ++c4) { const int col = c4 * 256 + lane * 4;
            const f32x4 g = *(const f32x4*)(gw + col), sc = *(const f32x4*)(scale + (size_t)b * 6144 + col), sh = *(const f32x4*)(shift + (size_t)b * 6144 + col);
            const f32x4 gm = g * (sc + 1.f);
#pragma unroll
            for (int r = 0; r < NR; ++r) { const float rr = rsqrtf(ss[r] * (1.f / 1024.f) + 1e-6f);
                const f32x4 o = v[r][c4] * rr * gm + sh;
                *(u32x2*)(H + (size_t)(row0 + r) * 1024 + col) = (u32x2){pk2(o[0], o[1]), pk2(o[2], o[3])}; } }
    }
}

constexpr int VS = 72;
constexpr int VL_BYTES = 64 * VS * 2;

__device__ __forceinline__ void s5a_phase(const Params& p);
__device__ __forceinline__ void attnA_phase(const Params& p, LAS unsigned char* lds) {
    const int tid = tid_opaque(), wid = __builtin_amdgcn_readfirstlane(tid >> 6), lane = tid & 63, li = lane & 15, g4 = lane >> 4;
    const bf16_t* QKV = (const bf16_t*)(p.ws + WS_R1);
    bf16_t* MIX = (bf16_t*)(p.ws + WS_MIX);
    LAS bf16_t* Vl = (LAS bf16_t*)(lds + wid * VL_BYTES);
    LAS float* bl = (LAS float*)(lds + 8 * VL_BYTES);
    for (int idx = tid; idx < 8 * 257; idx += NTHR) bl[(idx / 257) * 260 + (idx % 257)] = p.in[12][idx] * 1.4426950408889634f;
    __syncthreads();
    if (wid >= 4) s5a_phase(p);
    const int h = wid;
    LAS float* bh = bl + h * 260;
    const float bfar = bh[256];
    const int vrow = lane >> 3, vc8 = (lane & 7) * 8;
    for (int item2 = vblock(); item2 < 2048; item2 += gridDim.x) {
        const int kq = item2 >> 8, rq = item2 & 255, qh = rq & 1;
        const int b = 2 * kq + (rq >> 7), ci = (((rq >> 1) & 63) + 9 * kq) & 63;
        const size_t rowbase = (size_t)b * SEQ + ci * 64 + qh * 32;
        bf16x8 qf[2][2];
#pragma unroll
        for (int qt = 0; qt < 2; ++qt)
#pragma unroll
            for (int ks = 0; ks < 2; ++ks) qf[qt][ks] = *(const bf16x8*)(QKV + (rowbase + qt * 16 + li) * 2048 + h * 64 + 32 * ks + 8 * g4);
        f32x4 o[4][2]; float mrun[2], lsum[2];
#pragma unroll
        for (int qt = 0; qt < 2; ++qt) { mrun[qt] = -1e30f; lsum[qt] = 0.f;
#pragma unroll
            for (int dt = 0; dt < 4; ++dt) o[dt][qt] = (f32x4){0.f, 0.f, 0.f, 0.f}; }
        const int kb0 = ci >= 8 ? 0 : 8 - ci;
        bf16x8 kf[4][2]; u32x4 vr[8];
        { const bf16_t* kbase = QKV + ((size_t)b * SEQ + (size_t)(ci - 8 + kb0) * 64) * 2048 + h * 64;
#pragma unroll
          for (int kt = 0; kt < 4; ++kt)
#pragma unroll
              for (int ks = 0; ks < 2; ++ks) kf[kt][ks] = *(const bf16x8*)(kbase + (size_t)(kt * 16 + li) * 2048 + 512 + 32 * ks + 8 * g4);
#pragma unroll
          for (int r = 0; r < 8; ++r) vr[r] = *(const u32x4*)(kbase + (size_t)(r * 8 + vrow) * 2048 + 1024 + vc8);
          wave_lds_fence();
#pragma unroll
          for (int r = 0; r < 8; ++r) *(LAS u32x4*)(Vl + (r * 8 + vrow) * VS + vc8) = vr[r];
          wave_lds_fence(); }
        for (int kb = kb0; kb <= 8; ++kb) {
            f32x4 s[4][2];
#pragma unroll
            for (int kt = 0; kt < 4; ++kt)
#pragma unroll
                for (int qt = 0; qt < 2; ++qt) { f32x4 z = (f32x4){0.f, 0.f, 0.f, 0.f}; z = mfma16(kf[kt][0], qf[qt][0], z); z = mfma16(kf[kt][1], qf[qt][1], z); s[kt][qt] = z; }
            const bool more = kb < 8;
            if (more) {
                const bf16_t* kbase = QKV + ((size_t)b * SEQ + (size_t)(ci - 8 + kb + 1) * 64) * 2048 + h * 64;
#pragma unroll
                for (int kt = 0; kt < 4; ++kt)
#pragma unroll
                    for (int ks = 0; ks < 2; ++ks) kf[kt][ks] = *(const bf16x8*)(kbase + (size_t)(kt * 16 + li) * 2048 + 512 + 32 * ks + 8 * g4);
#pragma unroll
                for (int r = 0; r < 8; ++r) vr[r] = *(const u32x4*)(kbase + (size_t)(r * 8 + vrow) * 2048 + 1024 + vc8);
            }
            const bool nearb = kb >= 6;
            bf16x8 pfr[2][2];
#pragma unroll
            for (int qt = 0; qt < 2; ++qt) {
                float mx = -1e30f;
                if (nearb) {
#pragma unroll
                    for (int kt = 0; kt < 4; ++kt)
#pragma unroll
                        for (int jj = 0; jj < 4; ++jj) { int rel = 512 + qh * 32 + qt * 16 + li - kb * 64 - (kt * 16 + 4 * g4 + jj); rel = rel > 128 ? 128 : (rel < -128 ? -128 : rel);
                            const float v = s[kt][qt][jj] + bh[rel + 128]; s[kt][qt][jj] = v; mx = fmaxf(mx, v); }
                } else {
#pragma unroll
                    for (int kt = 0; kt < 4; ++kt)
#pragma unroll
                        for (int jj = 0; jj < 4; ++jj) { const float v = s[kt][qt][jj] + bfar; s[kt][qt][jj] = v; mx = fmaxf(mx, v); }
                }
                mx = fmaxf(mx, __shfl_xor(mx, 16)); mx = fmaxf(mx, __shfl_xor(mx, 32));
                const float mnew = fmaxf(mrun[qt], mx), alpha = __builtin_amdgcn_exp2f(mrun[qt] - mnew);
                mrun[qt] = mnew; float ps = 0.f;
#pragma unroll
                for (int kt = 0; kt < 4; ++kt)
#pragma unroll
                    for (int jj = 0; jj < 4; ++jj) { const float e = __builtin_amdgcn_exp2f(s[kt][qt][jj] - mnew); s[kt][qt][jj] = e; ps += e; }
                lsum[qt] = lsum[qt] * alpha + ps;
#pragma unroll
                for (int dt = 0; dt < 4; ++dt) o[dt][qt] *= alpha;
#pragma unroll
                for (int kk = 0; kk < 2; ++kk) { u32x4 w; w.x = pk2(s[2 * kk][qt][0], s[2 * kk][qt][1]); w.y = pk2(s[2 * kk][qt][2], s[2 * kk][qt][3]);
                    w.z = pk2(s[2 * kk + 1][qt][0], s[2 * kk + 1][qt][1]); w.w = pk2(s[2 * kk + 1][qt][2], s[2 * kk + 1][qt][3]); pfr[qt][kk] = as_frag(w); }
            }
            { bf16x8 vf[2][4];
#pragma unroll
              for (int kk = 0; kk < 2; ++kk)
#pragma unroll
                  for (int dt = 0; dt < 4; ++dt) vf[kk][dt] = tr_pair(Vl, VS, 32 * kk + 4 * g4, 32 * kk + 16 + 4 * g4, dt * 16, li);
#pragma unroll
              for (int kk = 0; kk < 2; ++kk)
#pragma unroll
                  for (int dt = 0; dt < 4; ++dt)
#pragma unroll
                      for (int qt = 0; qt < 2; ++qt) o[dt][qt] = mfma16(vf[kk][dt], pfr[qt][kk], o[dt][qt]); }
            wave_lds_fence();
            if (more) {
#pragma unroll
                for (int r = 0; r < 8; ++r) *(LAS u32x4*)(Vl + (r * 8 + vrow) * VS + vc8) = vr[r];
                wave_lds_fence();
            }
        }
#pragma unroll
        for (int qt = 0; qt < 2; ++qt) { float l = lsum[qt]; l += __shfl_xor(l, 16); l += __shfl_xor(l, 32); const float inv = 1.f / l;
#pragma unroll
            for (int dt = 0; dt < 4; ++dt) { const f32x4 v = o[dt][qt] * inv;
                *(u32x2*)(MIX + (rowbase + qt * 16 + li) * 1024 + h * 64 + dt * 16 + 4 * g4) = (u32x2){pk2(v[0], v[1]), pk2(v[2], v[3])}; } }
    }
    if (wid < 4) s5a_phase(p);
}

__device__ __forceinline__ void s5a_phase(const Params& p) {
    const int tid = tid_opaque(); const int lane = tid & 63, li = lane & 15, g4 = lane >> 4;
    const bf16_t* QKV = (const bf16_t*)(p.ws + WS_R1);
    const bf16_t* Mt = (const bf16_t*)(p.ws + WS_S5M);
    float* E = (float*)(p.ws + WS_S5E);
    const int wv = vblock() * 8 + (tid >> 6), nw = gridDim.x * 8;
    for (int item = wv; item < 2048; item += nw) {
        const int g = item & 31, c = item >> 5;
        f32x4 acc[8];
#pragma unroll
        for (int pt = 0; pt < 8; ++pt) acc[pt] = (f32x4){0.f, 0.f, 0.f, 0.f};
        const bf16_t* ub = QKV + ((size_t)li * SEQ + c * 64 + (g4 >> 1)) * 2048 + 1536 + g * 16 + 8 * (g4 & 1);
        const bf16_t* mb = Mt + (size_t)(g * 128 + li) * 1024 + 8 * g4;
#pragma unroll 4
        for (int ks = 0; ks < 32; ++ks) {
            const bf16x8 bfr = *(const bf16x8*)(ub + (size_t)(2 * ks) * 2048);
#pragma unroll
            for (int pt = 0; pt < 8; ++pt) { const bf16x8 afr = *(const bf16x8*)(mb + (size_t)pt * 16 * 1024 + 32 * ks); acc[pt] = mfma16(afr, bfr, acc[pt]); }
        }
#pragma unroll
        for (int pt = 0; pt < 8; ++pt) *(f32x4*)(E + ((size_t)(c * 32 + g) * 16 + li) * 128 + pt * 16 + 4 * g4) = acc[pt];
    }
}
__device__ __forceinline__ void s5scan_phase(const Params& p) {
    const float* E = (const float*)(p.ws + WS_S5E);
    bf16_t* X = (bf16_t*)(p.ws + WS_S5X);
    const f32x2* A64 = (const f32x2*)(p.ws + WS_A64);
    const int gtid = blockIdx.x * NTHR + tid_opaque();
    if (gtid < 32 * 16 * 64) {
        const int pp = gtid & 63, b = (gtid >> 6) & 15, g = gtid >> 10;
        const f32x2 a = A64[g * 64 + pp];
        float xr = 0.f, xi = 0.f;
        for (int c0 = 0; c0 < 64; c0 += 8) {
            f32x2 e[8];
#pragma unroll
            for (int k = 0; k < 8; ++k) e[k] = *(const f32x2*)(E + ((size_t)((c0 + k) * 32 + g) * 16 + b) * 128 + 2 * pp);
#pragma unroll
            for (int k = 0; k < 8; ++k) {
                *(unsigned*)(X + ((size_t)((c0 + k) * 32 + g) * 16 + b) * 128 + 2 * pp) = pk2(xr, xi);
                const float nr = a.x * xr - a.y * xi + e[k].x, ni = a.x * xi + a.y * xr + e[k].y; xr = nr; xi = ni; }
        }
    }
}
__device__ __forceinline__ void s5c_phase(const Params& p, LAS unsigned char* lds) {
    const int tid = tid_opaque(), wid = __builtin_amdgcn_readfirstlane(tid >> 6), lane = tid & 63, li = lane & 15, g4 = lane >> 4;
    const bf16_t* QKV = (const bf16_t*)(p.ws + WS_R1);
    const bf16_t* Kt = (const bf16_t*)(p.ws + WS_KERN);
    const bf16_t* Gt = (const bf16_t*)(p.ws + WS_S5G);
    const bf16_t* X = (const bf16_t*)(p.ws + WS_S5X);
    bf16_t* Y5 = (bf16_t*)(p.ws + WS_Y5);
    LAS bf16_t* kl = (LAS bf16_t*)lds;
    LAS bf16_t* ul = (LAS bf16_t*)(lds + 32768);
    int gl = -1;
    u32x4 ur[4];
    { const int item = vblock(); if (item < 2048) { const int g = item & 31, c = item >> 5;
#pragma unroll
        for (int q = 0; q < 4; ++q) { const int idx = tid + q * NTHR, hh = idx & 1, b = (idx >> 1) & 15, sq = idx >> 5;
            ur[q] = *(const u32x4*)(QKV + ((size_t)b * SEQ + c * 64 + sq) * 2048 + 1536 + g * 16 + hh * 8); } } }
    for (int item = vblock(); item < 2048; item += gridDim.x) {
        const int g = item & 31, c = item >> 5;
        __syncthreads();
        if (g != gl) { for (int idx = tid; idx < 2048; idx += NTHR) *(LAS u32x4*)(kl + idx * 8) = *(const u32x4*)(Kt + (size_t)g * 16384 + idx * 8); gl = g; }
#pragma unroll
        for (int q = 0; q < 4; ++q) { const int idx = tid + q * NTHR, hh = idx & 1, b = (idx >> 1) & 15, sq = idx >> 5;
            *(LAS u32x4*)(ul + (sq * 16 + b) * 16 + hh * 8) = ur[q]; }
        { const int nx = item + gridDim.x; if (nx < 2048) { const int g2 = nx & 31, c2 = nx >> 5;
#pragma unroll
            for (int q = 0; q < 4; ++q) { const int idx = tid + q * NTHR, hh = idx & 1, b = (idx >> 1) & 15, sq = idx >> 5;
                ur[q] = *(const u32x4*)(QKV + ((size_t)b * SEQ + c2 * 64 + sq) * 2048 + 1536 + g2 * 16 + hh * 8); } } }
        bf16x8 xf[4];
#pragma unroll
        for (int ks = 0; ks < 4; ++ks) xf[ks] = *(const bf16x8*)(X + ((size_t)(c * 32 + g) * 16 + li) * 128 + 32 * ks + 8 * g4);
        bf16x8 gf[8][4];
#pragma unroll
        for (int tt = 0; tt < 8; ++tt)
#pragma unroll
            for (int ks = 0; ks < 4; ++ks) gf[tt][ks] = *(const bf16x8*)(Gt + (size_t)(g * 1024 + (wid + 8 * tt) * 16 + li) * 128 + 32 * ks + 8 * g4);
        __syncthreads();
        const f32x4 dsk = *(const f32x4*)(p.in[20] + g * 16 + 4 * g4);
#pragma unroll
        for (int tt = 0; tt < 8; ++tt) {
            const int t = wid + 8 * tt;
            f32x4 acc = (f32x4){0.f, 0.f, 0.f, 0.f};
#pragma unroll
            for (int ks = 0; ks < 4; ++ks) acc = mfma16(gf[tt][ks], xf[ks], acc);
            const int nks = ((t >> 1) + 4) & ~3;
            for (int ks0 = 0; ks0 < nks; ks0 += 4) {
                u32x4 av[4]; bf16x8 bv[4];
#pragma unroll
                for (int q = 0; q < 4; ++q) { const int s = 2 * (ks0 + q) + (g4 >> 1); int tau = t - s; const bool ok = tau >= 0; tau = ok ? tau : 0;
                    av[q] = *(const LAS u32x4*)(kl + (tau * 16 + li) * 16 + 8 * (g4 & 1));
                    if (!ok) av[q] = (u32x4){0u, 0u, 0u, 0u};
                    bv[q] = *(const LAS bf16x8*)(ul + (s * 16 + li) * 16 + 8 * (g4 & 1)); }
#pragma unroll
                for (int q = 0; q < 4; ++q) acc = mfma16(as_frag(av[q]), bv[q], acc);
            }
            const u32x2 uu = *(const LAS u32x2*)(ul + (t * 16 + li) * 16 + 4 * g4);
            float y0 = acc[0] + dsk[0] * lo_f(uu.x), y1 = acc[1] + dsk[1] * hi_f(uu.x), y2 = acc[2] + dsk[2] * lo_f(uu.y), y3 = acc[3] + dsk[3] * hi_f(uu.y);
            y0 = gelu_tanh(y0); y1 = gelu_tanh(y1); y2 = gelu_tanh(y2); y3 = gelu_tanh(y3);
            *(u32x2*)(Y5 + ((size_t)li * SEQ + c * 64 + t) * 512 + g * 16 + 4 * g4) = (u32x2){pk2(y0, y1), pk2(y2, y3)};
        }
    }
}

#ifndef SB_EARLY_EXIT
#define SB_EARLY_EXIT 1
#endif
template <bool MASKED>
__device__ __forceinline__ void sb_qtile(const bf16x8 (&kf)[4][2], const bf16x8 (&qf)[2], float& R, bf16x8 (&pfr)[2], int li, int g4, int kpos0, int qpos, u32x2 dpat) {
    const unsigned ONES = 0x3F803F80u;
    const float SC = 0.125f * 1.4426950408889634f;
    f32x4 z[4];
#pragma unroll
    for (int kt = 0; kt < 4; ++kt) { f32x4 a = (f32x4){0.f, 0.f, 0.f, 0.f}; a = mfma16(kf[kt][0], qf[0], a); a = mfma16(kf[kt][1], qf[1], a); z[kt] = a; }
    float T = 0.f; unsigned hi[4][2];
#pragma unroll
    for (int kt = 0; kt < 4; ++kt) { float Lv[4];
#pragma unroll
        for (int jj = 0; jj < 4; ++jj) { const float zz = z[kt][jj] * SC;
            const float sp = fmaxf(zz, 0.f) + __builtin_amdgcn_logf(1.f + __builtin_amdgcn_exp2f(-fabsf(zz)));
            if (MASKED) { const bool valid = kpos0 + kt * 16 + jj < qpos; Lv[jj] = valid ? -sp : 0.f; z[kt][jj] = valid ? (zz - sp) : -1e30f; }
            else { Lv[jj] = -sp; z[kt][jj] = zz - sp; }
            T += Lv[jj]; }
        hi[kt][0] = pk2(Lv[0], Lv[1]); hi[kt][1] = pk2(Lv[2], Lv[3]); }
    T += __shfl_xor(T, 16); T += __shfl_xor(T, 32);
    bf16x8 Lh[2];
#pragma unroll
    for (int kk = 0; kk < 2; ++kk) Lh[kk] = as_frag((u32x4){hi[2 * kk][0], hi[2 * kk][1], hi[2 * kk + 1][0], hi[2 * kk + 1][1]});
    unsigned pw[4][2];
#pragma unroll
    for (int st = 0; st < 4; ++st) { f32x4 ce = (f32x4){0.f, 0.f, 0.f, 0.f};
#pragma unroll
        for (int kk = 0; kk < 2; ++kk) { if (2 * kk + 1 >= st) {
            u32x4 ua;
            { const int k0 = 2 * kk, k1 = 2 * kk + 1;
              ua.x = k0 > st ? ONES : (k0 == st ? dpat.x : 0u); ua.y = k0 > st ? ONES : (k0 == st ? dpat.y : 0u);
              ua.z = k1 > st ? ONES : (k1 == st ? dpat.x : 0u); ua.w = k1 > st ? ONES : (k1 == st ? dpat.y : 0u); }
            ce = mfma16(as_frag(ua), Lh[kk], ce); } }
        float w[4];
#pragma unroll
        for (int jj = 0; jj < 4; ++jj) w[jj] = __builtin_amdgcn_exp2f(z[st][jj] + R + ce[jj]);
        pw[st][0] = pk2(w[0], w[1]); pw[st][1] = pk2(w[2], w[3]); }
    R += T;
#pragma unroll
    for (int kk = 0; kk < 2; ++kk) pfr[kk] = as_frag((u32x4){pw[2 * kk][0], pw[2 * kk][1], pw[2 * kk + 1][0], pw[2 * kk + 1][1]});
}
__device__ __forceinline__ void sb_phase(const Params& p, LAS unsigned char* lds) {
    const int tid = tid_opaque(), wid = __builtin_amdgcn_readfirstlane(tid >> 6), lane = tid & 63, li = lane & 15, g4 = lane >> 4;
    const bf16_t* QKV = (const bf16_t*)(p.ws + WS_R1);
    bf16_t* MIX = (bf16_t*)(p.ws + WS_MIX);
    LAS bf16_t* Vl = (LAS bf16_t*)(lds + wid * VL_BYTES);
    const int wv = blockIdx.x * 8 + wid, nw = gridDim.x * 8;
    u32x2 dpat; dpat.x = ((4 * g4 + 0 > li) ? 0x3F80u : 0u) | ((4 * g4 + 1 > li) ? 0x3F800000u : 0u); dpat.y = ((4 * g4 + 2 > li) ? 0x3F80u : 0u) | ((4 * g4 + 3 > li) ? 0x3F800000u : 0u);
    for (int it = wv; it < 8192; it += nw) {
        const int bh = it >> 6, pr = it & 63, b = bh >> 3, h = bh & 7;
        for (int half = 0; half < 2; ++half) {
            const int qtile = half ? 127 - pr : pr, t0 = qtile * 32, kbd = t0 >> 6;
            const bf16_t* qb = QKV + ((size_t)b * SEQ + t0) * 3584 + 2048 + h * 64;
            bf16x8 qf[2][2];
#pragma unroll
            for (int qt = 0; qt < 2; ++qt)
#pragma unroll
                for (int ks = 0; ks < 2; ++ks) qf[qt][ks] = *(const bf16x8*)(qb + (size_t)(qt * 16 + li) * 3584 + 32 * ks + 8 * g4);
            f32x4 o[2][4]; float R[2];
#pragma unroll
            for (int qt = 0; qt < 2; ++qt) { R[qt] = 0.f;
#pragma unroll
                for (int dt = 0; dt < 4; ++dt) o[qt][dt] = (f32x4){0.f, 0.f, 0.f, 0.f}; }
            for (int kb = kbd; kb >= 0; --kb) {
                const bf16_t* kbase = QKV + ((size_t)b * SEQ + kb * 64) * 3584 + 2560 + h * 64;
#pragma unroll
                for (int r = 0; r < 8; ++r) { const int row = r * 8 + (lane >> 3), c8 = lane & 7;
                    *(LAS u32x4*)(Vl + row * VS + c8 * 8) = *(const u32x4*)(kbase + (size_t)row * 3584 + 512 + c8 * 8); }
                bf16x8 kf[4][2];
#pragma unroll
                for (int kt = 0; kt < 4; ++kt)
#pragma unroll
                    for (int ks = 0; ks < 2; ++ks) kf[kt][ks] = *(const bf16x8*)(kbase + (size_t)(kt * 16 + li) * 3584 + 32 * ks + 8 * g4);
                wave_lds_fence();
                const int kpos0 = kb * 64 + 4 * g4;
                bf16x8 pfr[2][2];
                if (kb == kbd) {
#pragma unroll
                    for (int qt = 0; qt < 2; ++qt) sb_qtile<true>(kf, qf[qt], R[qt], pfr[qt], li, g4, kpos0, t0 + qt * 16 + li, dpat);
                } else {
#pragma unroll
                    for (int qt = 0; qt < 2; ++qt) sb_qtile<false>(kf, qf[qt], R[qt], pfr[qt], li, g4, kpos0, t0 + qt * 16 + li, dpat);
                }
                { bf16x8 vf[2][4];
#pragma unroll
                  for (int kk = 0; kk < 2; ++kk)
#pragma unroll
                      for (int dt = 0; dt < 4; ++dt) vf[kk][dt] = tr_pair(Vl, VS, 32 * kk + 4 * g4, 32 * kk + 16 + 4 * g4, dt * 16, li);
#pragma unroll
                  for (int kk = 0; kk < 2; ++kk)
#pragma unroll
                      for (int dt = 0; dt < 4; ++dt)
#pragma unroll
                          for (int qt = 0; qt < 2; ++qt) o[qt][dt] = mfma16(vf[kk][dt], pfr[qt][kk], o[qt][dt]); }
                wave_lds_fence();
#if SB_EARLY_EXIT
                { const float rm = fmaxf(R[0], R[1]); if (__all(rm < -152.f)) break; }
#endif
            }
#pragma unroll
            for (int qt = 0; qt < 2; ++qt)
#pragma unroll
                for (int dt = 0; dt < 4; ++dt) { const f32x4 v = o[qt][dt];
                    *(u32x2*)(MIX + ((size_t)b * SEQ + t0 + qt * 16 + li) * 1024 + 512 + h * 64 + dt * 16 + 4 * g4) = (u32x2){pk2(v[0], v[1]), pk2(v[2], v[3])}; }
        }
    }
}

constexpr int RS = 136;
__device__ __forceinline__ float ret_log_gamma(int h) { return logf(1.f - exp2f(-5.f - (float)h)); }
struct RotRegs { u32x4 a, b; };
struct RopeRegs { f32x2 cs[8]; };
struct PlainRegs { u32x4 a, b; };
__device__ __forceinline__ void rot_ld(RotRegs& r, const bf16_t* src  , int j, int part) { r.a = *(const u32x4*)(src + (size_t)j * 3584 + part * 8); r.b = *(const u32x4*)(src + (size_t)j * 3584 + 64 + part * 8); }
__device__ __forceinline__ void rope_ld(RopeRegs& r, const f32x2* rope, int pos, int part) {
#pragma unroll
    for (int e = 0; e < 8; ++e) r.cs[e] = rope[(size_t)pos * 64 + part * 8 + e]; }
__device__ __forceinline__ void plain_ld(PlainRegs& r, const bf16_t* src, int j, int part) { r.a = *(const u32x4*)(src + (size_t)j * 3584 + part * 16); r.b = *(const u32x4*)(src + (size_t)j * 3584 + part * 16 + 8); }
__device__ __forceinline__ void rot_st(const RotRegs& r, const RopeRegs& c, LAS bf16_t* dst, int j, int part, float rsc) {
    const float x1[8] = {lo_f(r.a.x), hi_f(r.a.x), lo_f(r.a.y), hi_f(r.a.y), lo_f(r.a.z), hi_f(r.a.z), lo_f(r.a.w), hi_f(r.a.w)};
    const float x2[8] = {lo_f(r.b.x), hi_f(r.b.x), lo_f(r.b.y), hi_f(r.b.y), lo_f(r.b.z), hi_f(r.b.z), lo_f(r.b.w), hi_f(r.b.w)};
    float o1[8], o2[8];
#pragma unroll
    for (int e = 0; e < 8; ++e) { const f32x2 cc = c.cs[e]; o1[e] = (x1[e] * cc.x - x2[e] * cc.y) * rsc; o2[e] = (x1[e] * cc.y + x2[e] * cc.x) * rsc; }
    *(LAS u32x4*)(dst + j * RS + part * 8) = (u32x4){pk2(o1[0], o1[1]), pk2(o1[2], o1[3]), pk2(o1[4], o1[5]), pk2(o1[6], o1[7])};
    *(LAS u32x4*)(dst + j * RS + 64 + part * 8) = (u32x4){pk2(o2[0], o2[1]), pk2(o2[2], o2[3]), pk2(o2[4], o2[5]), pk2(o2[6], o2[7])};
}
__device__ __forceinline__ void plain_st(const PlainRegs& r, LAS bf16_t* dst, int j, int part) { *(LAS u32x4*)(dst + j * RS + part * 16) = r.a; *(LAS u32x4*)(dst + j * RS + part * 16 + 8) = r.b; }

__device__ __forceinline__ void reta_phase(const Params& p, LAS unsigned char* lds) {
    const int tid = tid_opaque(), wid = __builtin_amdgcn_readfirstlane(tid >> 6), lane = tid & 63, li = lane & 15, g4 = lane >> 4;
    const int j = tid >> 3, part = tid & 7;
    const bf16_t* QKV = (const bf16_t*)(p.ws + WS_R1);
    const f32x2* rope = (const f32x2*)(p.ws + WS_ROPE);
    bf16_t* RET = (bf16_t*)(p.ws + WS_H);
    LAS bf16_t* Kl = (LAS bf16_t*)lds; LAS bf16_t* Vl = (LAS bf16_t*)(lds + 64 * RS * 2);
    RotRegs kr; RopeRegs cr; PlainRegs vr;
    { const int item = blockIdx.x; if (item < 4096) { const int c = item & 63, hh = (item >> 6) & 3, b = item >> 8; const bf16_t* base = QKV + ((size_t)b * SEQ + c * 64) * 3584 + hh * 128;
        rot_ld(kr, base + 512, j, part); rope_ld(cr, rope, c * 64 + j, part); plain_ld(vr, base + 1024, j, part); } }
    for (int item = blockIdx.x; item < 4096; item += gridDim.x) {
        const int c = item & 63, hh = (item >> 6) & 3, b = item >> 8;
        const float lg = ret_log_gamma(hh);
        __syncthreads();
        rot_st(kr, cr, Kl, j, part, 0.08838834764831845f * __expf(lg * (63.f - (float)j)));
        plain_st(vr, Vl, j, part);
        { const int nx = item + gridDim.x; if (nx < 4096) { const int c2 = nx & 63, h2 = (nx >> 6) & 3, b2 = nx >> 8; const bf16_t* base = QKV + ((size_t)b2 * SEQ + c2 * 64) * 3584 + h2 * 128;
            rot_ld(kr, base + 512, j, part); rope_ld(cr, rope, c2 * 64 + j, part); plain_ld(vr, base + 1024, j, part); } }
        __syncthreads();
        f32x4 acc[8];
#pragma unroll
        for (int et = 0; et < 8; ++et) acc[et] = (f32x4){0.f, 0.f, 0.f, 0.f};
#pragma unroll
        for (int kk = 0; kk < 2; ++kk) { const bf16x8 af = tr_pair(Kl, RS, 32 * kk + 8 * g4, 32 * kk + 8 * g4 + 4, wid * 16, li);
#pragma unroll
            for (int et = 0; et < 8; ++et) { const bf16x8 bfr = tr_pair(Vl, RS, 32 * kk + 8 * g4, 32 * kk + 8 * g4 + 4, et * 16, li); acc[et] = mfma16(af, bfr, acc[et]); } }
        const size_t sid = (size_t)((b * 4 + hh) * 64 + c);
#pragma unroll
        for (int et = 0; et < 8; ++et) *(u32x2*)(RET + (sid * 128 + et * 16 + li) * 128 + wid * 16 + 4 * g4) = (u32x2){pk2(acc[et][0], acc[et][1]), pk2(acc[et][2], acc[et][3])};
    }
}
__device__ __forceinline__ void retscan_phase(const Params& p) {
    bf16_t* RET = (bf16_t*)(p.ws + WS_H);
    const int gtid = blockIdx.x * NTHR + tid_opaque(), nthr = gridDim.x * NTHR;
    for (int w = gtid; w < 64 * 2048; w += nthr) {
        const int bhh = w >> 11, e8 = w & 2047, hh = bhh & 3;
        const float cd = __expf(64.f * ret_log_gamma(hh));
        float S[8];
#pragma unroll
        for (int e = 0; e < 8; ++e) S[e] = 0.f;
        bf16_t* base = RET + (size_t)bhh * 64 * 16384 + e8 * 8;
        for (int c0 = 0; c0 < 64; c0 += 4) {
            u32x4 kv[4];
#pragma unroll
            for (int k = 0; k < 4; ++k) kv[k] = *(const u32x4*)(base + (size_t)(c0 + k) * 16384);
#pragma unroll
            for (int k = 0; k < 4; ++k) {
                *(u32x4*)(base + (size_t)(c0 + k) * 16384) = (u32x4){pk2(S[0], S[1]), pk2(S[2], S[3]), pk2(S[4], S[5]), pk2(S[6], S[7])};
                S[0] = S[0] * cd + lo_f(kv[k].x); S[1] = S[1] * cd + hi_f(kv[k].x); S[2] = S[2] * cd + lo_f(kv[k].y); S[3] = S[3] * cd + hi_f(kv[k].y);
                S[4] = S[4] * cd + lo_f(kv[k].z); S[5] = S[5] * cd + hi_f(kv[k].z); S[6] = S[6] * cd + lo_f(kv[k].w); S[7] = S[7] * cd + hi_f(kv[k].w); }
        }
    }
}
__device__ __forceinline__ void retc_phase(const Params& p, LAS unsigned char* lds) {
    const int tid = tid_opaque(), wid = __builtin_amdgcn_readfirstlane(tid >> 6), lane = tid & 63, li = lane & 15, g4 = lane >> 4;
    const bf16_t* QKV = (const bf16_t*)(p.ws + WS_R1);
    const f32x2* rope = (const f32x2*)(p.ws + WS_ROPE);
    const bf16_t* RET = (const bf16_t*)(p.ws + WS_H);
    bf16_t* MIX = (bf16_t*)(p.ws + WS_MIX);
    LAS bf16_t* Ql = (LAS bf16_t*)lds; LAS bf16_t* Kl = (LAS bf16_t*)(lds + 17408); LAS bf16_t* Vl = (LAS bf16_t*)(lds + 34816);
    LAS bf16_t* Sl = (LAS bf16_t*)(lds + 52224);
    LAS f32x2* stl = (LAS f32x2*)(lds + 61440);
    const int j = tid >> 3, part = tid & 7;
    RotRegs qr, kr; RopeRegs cr; PlainRegs vr;
    { const int item = blockIdx.x; if (item < 4096) { const int c = item & 63, hh = (item >> 6) & 3, b = item >> 8; const bf16_t* base = QKV + ((size_t)b * SEQ + c * 64) * 3584 + hh * 128;
        rot_ld(qr, base, j, part); rot_ld(kr, base + 512, j, part); rope_ld(cr, rope, c * 64 + j, part); plain_ld(vr, base + 1024, j, part); } }
    for (int item = blockIdx.x; item < 4096; item += gridDim.x) {
        const int c = item & 63, hh = (item >> 6) & 3, b = item >> 8;
        const float lg = ret_log_gamma(hh);
        const size_t row0 = (size_t)b * SEQ + c * 64;
        const size_t sid = (size_t)((b * 4 + hh) * 64 + c);
        bf16x8 stf[4]; u32x2 gg[4];
#pragma unroll
        for (int ks = 0; ks < 4; ++ks) stf[ks] = *(const bf16x8*)(RET + (sid * 128 + wid * 16 + li) * 128 + 32 * ks + 8 * g4);
#pragma unroll
        for (int itq = 0; itq < 4; ++itq) gg[itq] = *(const u32x2*)(QKV + (row0 + itq * 16 + li) * 3584 + 1536 + hh * 128 + wid * 16 + 4 * g4);
        __syncthreads();
        rot_st(qr, cr, Ql, j, part, 1.f);
        rot_st(kr, cr, Kl, j, part, 0.08838834764831845f);
        plain_st(vr, Vl, j, part);
        { const int nx = item + gridDim.x; if (nx < 4096) { const int c2 = nx & 63, h2 = (nx >> 6) & 3, b2 = nx >> 8; const bf16_t* base = QKV + ((size_t)b2 * SEQ + c2 * 64) * 3584 + h2 * 128;
            rot_ld(qr, base, j, part); rot_ld(kr, base + 512, j, part); rope_ld(cr, rope, c2 * 64 + j, part); plain_ld(vr, base + 1024, j, part); } }
        __syncthreads();
        { const int jt = wid >> 1;
#pragma unroll
          for (int e2 = 0; e2 < 2; ++e2) { const int itq = 2 * (wid & 1) + e2; f32x4 sacc = (f32x4){0.f, 0.f, 0.f, 0.f};
#pragma unroll
              for (int ks = 0; ks < 4; ++ks) { const bf16x8 af = *(const LAS bf16x8*)(Kl + (jt * 16 + li) * RS + 32 * ks + 8 * g4); const bf16x8 bfr = *(const LAS bf16x8*)(Ql + (itq * 16 + li) * RS + 32 * ks + 8 * g4); sacc = mfma16(af, bfr, sacc); }
              float sv[4];
#pragma unroll
              for (int jj = 0; jj < 4; ++jj) { const int j = jt * 16 + 4 * g4 + jj, iq = itq * 16 + li; const int dd = iq > j ? iq - j : j - iq; sv[jj] = sacc[jj] * __expf(lg * (float)dd); }
              *(LAS u32x2*)(Sl + (itq * 16 + li) * VS + jt * 16 + 4 * g4) = (u32x2){pk2(sv[0], sv[1]), pk2(sv[2], sv[3])}; } }
        __syncthreads();
        f32x4 oa[4];
#pragma unroll
        for (int itq = 0; itq < 4; ++itq) oa[itq] = (f32x4){0.f, 0.f, 0.f, 0.f};
#pragma unroll
        for (int ks = 0; ks < 4; ++ks) { const bf16x8 af = stf[ks];
#pragma unroll
            for (int itq = 0; itq < 4; ++itq) { const bf16x8 bfr = *(const LAS bf16x8*)(Ql + (itq * 16 + li) * RS + 32 * ks + 8 * g4); oa[itq] = mfma16(af, bfr, oa[itq]); } }
#pragma unroll
        for (int itq = 0; itq < 4; ++itq) oa[itq] *= __expf(lg * (float)(itq * 16 + li + 1));
#pragma unroll
        for (int kk = 0; kk < 2; ++kk) { const bf16x8 af = tr_pair(Vl, RS, 32 * kk + 8 * g4, 32 * kk + 8 * g4 + 4, wid * 16, li);
#pragma unroll
            for (int itq = 0; itq < 4; ++itq) { const bf16x8 bfr = *(const LAS bf16x8*)(Sl + (itq * 16 + li) * VS + 32 * kk + 8 * g4); oa[itq] = mfma16(af, bfr, oa[itq]); } }
#pragma unroll
        for (int itq = 0; itq < 4; ++itq) { float s1 = oa[itq][0] + oa[itq][1] + oa[itq][2] + oa[itq][3];
            float s2 = oa[itq][0] * oa[itq][0] + oa[itq][1] * oa[itq][1] + oa[itq][2] * oa[itq][2] + oa[itq][3] * oa[itq][3];
            s1 += __shfl_xor(s1, 16); s1 += __shfl_xor(s1, 32); s2 += __shfl_xor(s2, 16); s2 += __shfl_xor(s2, 32);
            if (g4 == 0) stl[wid * 64 + itq * 16 + li] = (f32x2){s1, s2}; }
        __syncthreads();
        const f32x4 ng = *(const f32x4*)(p.in[25] + hh * 128 + wid * 16 + 4 * g4);
#pragma unroll
        for (int itq = 0; itq < 4; ++itq) { float s1 = 0.f, s2 = 0.f;
#pragma unroll
            for (int w8 = 0; w8 < 8; ++w8) { const f32x2 t = stl[w8 * 64 + itq * 16 + li]; s1 += t.x; s2 += t.y; }
            const float mu = s1 * (1.f / 128.f), var = fmaxf(s2 * (1.f / 128.f) - mu * mu, 0.f), rs = rsqrtf(var + 1e-6f);
            const size_t row = row0 + itq * 16 + li;
            const float r0 = (oa[itq][0] - mu) * rs * ng[0] * silu_f(lo_f(gg[itq].x)), r1 = (oa[itq][1] - mu) * rs * ng[1] * silu_f(hi_f(gg[itq].x));
            const float r2 = (oa[itq][2] - mu) * rs * ng[2] * silu_f(lo_f(gg[itq].y)), r3 = (oa[itq][3] - mu) * rs * ng[3] * silu_f(hi_f(gg[itq].y));
            *(u32x2*)(MIX + row * 1024 + hh * 128 + wid * 16 + 4 * g4) = (u32x2){pk2(r0, r1), pk2(r2, r3)}; }
    }
}

constexpr int N_PHASES = 20;
__global__ void __launch_bounds__(NTHR, 2) mega_fwd(Params p) {
    extern __shared__ __attribute__((aligned(16))) unsigned char lds_raw[];
    LAS unsigned char* lds = (LAS unsigned char*)lds_raw;
    cg::grid_group grid = cg::this_grid();
    unsigned char* ws = p.ws;
    const float* MOD = (const float*)(ws + WS_MOD);
    bf16_t* H = (bf16_t*)(ws + WS_H); bf16_t* MIX = (bf16_t*)(ws + WS_MIX); bf16_t* R1 = (bf16_t*)(ws + WS_R1);
    float* XA = p.out;
    pg8::StaticOrder S;
#ifndef PROBE_MASK
#define PROBE_MASK 0u
#endif
    unsigned long long probe_acc = 0ull;
    unsigned bar_gen = 0u;
    for (int ph = p.ph_lo; ph < p.ph_hi; ++ph) {
        const unsigned long long probe_t0 = PROBE_MASK ? __builtin_amdgcn_s_memrealtime() : 0ull;
        const int layer = ph >= 11 ? 1 : 0;
        const float* modl = MOD + (size_t)layer * 16 * 6144;
        switch (ph) {
        case 0: prep_phase(p, lds); break;
        case 1: case 8: case 11: case 17: {
            const bool ffn = (ph == 8 || ph == 17);
            const float* xin = (ph == 1) ? p.in[0] : XA;
            norm_phase(xin, (ffn ? p.in[5] : p.in[4]) + layer * 1024, modl + (ffn ? 3072 : 0), modl + (ffn ? 4096 : 1024), H);
        } break;
        case 2: {
            pg8::Gemm g{H, (const bf16_t*)(ws + WS_W_ABIN), MTOK, 2048, 1024};
            S.init(MTOK, 2048, gridDim.x, blockIdx.x);
            pg8::EpiStoreQK E{R1, p.in[10], p.in[11]};
            pg8::gemm_phase(lds, g, S, E);
        } break;
        case 12: {
            pg8::Gemm g{H, (const bf16_t*)(ws + WS_W_CDIN), MTOK, 3584, 1024};
            S.init(MTOK, 3584, gridDim.x, blockIdx.x);
            pg8::EpiStore E{R1, 3584};
            pg8::gemm_phase(lds, g, S, E);
        } break;
        case 3: attnA_phase(p, lds); break;
        case 4: s5scan_phase(p); break;
        case 5: s5c_phase(p, lds); break;
        case 6: {
            pg8::Gemm g{(const bf16_t*)(ws + WS_Y5), (const bf16_t*)(ws + WS_W_GLU), MTOK, 512, 512};
            S.init(MTOK, 512, gridDim.x, blockIdx.x);
            pg8::EpiGlu E{(const bf16_t*)(ws + WS_Y5), p.in[22], MIX};
            pg8::gemm_phase(lds, g, S, E);
        } break;
        case 7: case 16: case 10: case 19: {
            const bool ffn = (ph == 10 || ph == 19);
            const bf16_t* A = ffn ? R1 : MIX;
            const bf16_t* Bt = ffn ? (const bf16_t*)(ws + WS_W_FFOUT) + (size_t)layer * 1024 * FFH : (const bf16_t*)(ws + (layer ? WS_W_CDOUT : WS_W_ABOUT));
            pg8::Gemm g{A, Bt, MTOK, 1024, ffn ? FFH : 1024};
            S.init(MTOK, 1024, gridDim.x, blockIdx.x);
            pg8::EpiResid E{(ph == 7) ? p.in[0] : XA, XA, modl + (ffn ? 5120 : 2048)};
            pg8::gemm_phase(lds, g, S, E);
        } break;
        case 9: case 18: {
            pg8::Gemm g{H, (const bf16_t*)(ws + WS_W_FFIN) + (size_t)layer * 5632 * 1024, MTOK, 5632, 1024};
            S.init(MTOK, 5632, gridDim.x, blockIdx.x);
            pg8::EpiSwiglu E{R1};
            pg8::gemm_phase(lds, g, S, E);
        } break;
        case 13: reta_phase(p, lds); __syncthreads(); sb_phase(p, lds); break;
        case 14: retscan_phase(p); break;
        case 15: retc_phase(p, lds); break;
        default: break;
        }
        unsigned long long probe_t1 = 0ull;
        if (PROBE_MASK) { __syncthreads(); probe_t1 = __builtin_amdgcn_s_memrealtime(); if ((PROBE_MASK >> ph) & 1u) probe_acc += probe_t1 - probe_t0; }
        if (ph + 1 < p.ph_hi) {
            if (p.ph_hi > 1000) grid.sync();
            grid_barrier((unsigned*)(ws + WS_CTL), bar_gen);
        }
        if (PROBE_MASK && ((PROBE_MASK >> 20) & 1u)) probe_acc += __builtin_amdgcn_s_memrealtime() - probe_t1;
    }
    if (PROBE_MASK && blockIdx.x == 0 && threadIdx.x == 0) { const unsigned long long st = __builtin_amdgcn_s_memrealtime(); while (__builtin_amdgcn_s_memrealtime() - st < probe_acc) __builtin_amdgcn_s_sleep(8); }
}


#ifndef DIAG
#define DIAG 0
#endif
#if DIAG
__global__ void diag_fold(Params p) {
    const size_t n = (size_t)MTOK * 1024; unsigned char* ws = p.ws;
    for (size_t i = (size_t)blockIdx.x * blockDim.x + threadIdx.x; i < n; i += (size_t)gridDim.x * blockDim.x) {
        const size_t row = i >> 10; const int col = (int)(i & 1023); float v = 0.f;
#if DIAG == 30
        v = col < 512 ? bf2f(((const bf16_t*)(ws + WS_MIX))[i]) : 0.f;
#elif DIAG == 31
        v = ((const float*)(ws + WS_S5E))[i & 4194303];
#elif DIAG == 3
        v = col < 512 ? bf2f(((const bf16_t*)(ws + WS_MIX))[i]) : ((const float*)(ws + WS_S5E))[(row * 512 + col - 512) & 4194303];
#elif DIAG == 2
        v = bf2f(((const bf16_t*)(ws + WS_R1))[2 * i]) + bf2f(((const bf16_t*)(ws + WS_R1))[2 * i + 1]);
#elif DIAG == 1
        v = bf2f(((const bf16_t*)(ws + WS_H))[i]);
#elif DIAG == 5
        v = bf2f(((const bf16_t*)(ws + WS_Y5))[i >> 1]);
#elif DIAG == 6
        v = bf2f(((const bf16_t*)(ws + WS_MIX))[i]);
#endif
        p.out[i] = v;
    }
}
#endif
#ifndef MK_MULTI
#define MK_MULTI 0
#endif
extern "C" void kernel_launch(void* const* d_in, const int* in_sizes, int n_in, void* d_out, int out_size, void* d_ws, size_t ws_size, hipStream_t stream) {
    static int grid = 0;
    if (grid == 0) {
        if (n_in != 26 || out_size != MTOK * DM || ws_size < WS_END) { fprintf(stderr, "kernel_launch: unexpected shapes (n_in %d out %d ws %zu need %zu)\n", n_in, out_size, ws_size, (size_t)WS_END); grid = -1; return; }
        int dev = 0, cus = 0, per_cu = 0;
        hipGetDevice(&dev); hipDeviceGetAttribute(&cus, hipDeviceAttributeMultiprocessorCount, dev);
        if (hipFuncSetAttribute((const void*)mega_fwd, hipFuncAttributeMaxDynamicSharedMemorySize, LDS_BYTES) != hipSuccess) { fprintf(stderr, "kernel_launch: hipFuncSetAttribute failed\n"); grid = -1; return; }
        if (hipOccupancyMaxActiveBlocksPerMultiprocessor(&per_cu, (const void*)mega_fwd, NTHR, LDS_BYTES) != hipSuccess || per_cu < 1) { fprintf(stderr, "kernel_launch: occupancy query says %d\n", per_cu); per_cu = 1; }
        (void)hipGetLastError();
        grid = cus * 1;
    }
    if (grid < 0) return;
    Params p{};
    for (int i = 0; i < 26; ++i) p.in[i] = (const float*)d_in[i];
    p.out = (float*)d_out; p.ws = (unsigned char*)d_ws;
#if MK_MULTI
#if DIAG
    for (int ph = 0; ph <= (DIAG >= 30 ? DIAG / 10 : DIAG); ++ph) { p.ph_lo = ph; p.ph_hi = ph + 1; hipLaunchKernelGGL(mega_fwd, dim3(grid), dim3(NTHR), LDS_BYTES, stream, p); }
    hipLaunchKernelGGL(diag_fold, dim3(2048), dim3(256), 0, stream, p);
#else
    for (int ph = 0; ph < N_PHASES; ++ph) { p.ph_lo = ph; p.ph_hi = ph + 1; hipLaunchKernelGGL(mega_fwd, dim3(grid), dim3(NTHR), LDS_BYTES, stream, p); }
#endif
#else
    p.ph_lo = 0; p.ph_hi = N_PHASES;
    (void)hipMemsetAsync((char*)d_ws + WS_CTL, 0, 4096, stream);
    void* args[] = {&p};
    hipError_t e = hipLaunchCooperativeKernel((const void*)mega_fwd, dim3(grid), dim3(NTHR), args, LDS_BYTES, stream);
    if (e != hipSuccess) fprintf(stderr, "cooperative launch failed: %s (grid %d)\n", hipGetErrorString(e), grid);
#endif
}
```

```cpp
#include <hip/hip_runtime.h>
#include <hip/hip_cooperative_groups.h>
#include <cstdio>
namespace cg = cooperative_groups;

#define LAS __attribute__((address_space(3)))
typedef unsigned short bf16_t;
typedef short bf16x8 __attribute__((ext_vector_type(8)));
typedef short s16x4 __attribute__((ext_vector_type(4)));
typedef float f32x4 __attribute__((ext_vector_type(4)));
typedef float f32x2 __attribute__((ext_vector_type(2)));
typedef unsigned u32x4 __attribute__((ext_vector_type(4)));
typedef unsigned u32x2 __attribute__((ext_vector_type(2)));

constexpr int NB = 16, SEQ = 4096, DM = 1024, MTOK = NB * SEQ, FFH = 2816;
constexpr int NTHR = 512;
constexpr int LDS_BYTES = 135168;

constexpr size_t al256(size_t x) { return (x + 255) & ~(size_t)255; }
constexpr size_t WS_CTL = 0;
constexpr size_t WS_W_ABIN = 4096;
constexpr size_t WS_W_ABOUT = WS_W_ABIN + (size_t)2048 * 1024 * 2;
constexpr size_t WS_W_GLU = WS_W_ABOUT + (size_t)1024 * 1024 * 2;
constexpr size_t WS_W_FFIN = WS_W_GLU + (size_t)512 * 512 * 2;
constexpr size_t WS_W_FFOUT = WS_W_FFIN + (size_t)2 * 5632 * 1024 * 2;
constexpr size_t WS_W_CDIN = WS_W_FFOUT + (size_t)2 * 1024 * 2816 * 2;
constexpr size_t WS_W_CDOUT = WS_W_CDIN + (size_t)3584 * 1024 * 2;
constexpr size_t WS_MOD = WS_W_CDOUT + (size_t)1024 * 1024 * 2;
constexpr size_t WS_ROPE = WS_MOD + (size_t)2 * 16 * 6144 * 4;
constexpr size_t WS_KERN = WS_ROPE + (size_t)4096 * 64 * 8;
constexpr size_t WS_S5M = WS_KERN + (size_t)32 * 64 * 256 * 2;
constexpr size_t WS_S5G = WS_S5M + (size_t)32 * 128 * 1024 * 2;
constexpr size_t WS_A64 = WS_S5G + (size_t)32 * 1024 * 128 * 2;
constexpr size_t WS_S5E = WS_A64 + (size_t)32 * 64 * 8;
constexpr size_t WS_S5X = WS_S5E + (size_t)64 * 32 * 16 * 128 * 4;
constexpr size_t WS_Y5 = WS_S5X + (size_t)64 * 32 * 16 * 128 * 2;
constexpr size_t WS_H = WS_Y5 + (size_t)MTOK * 512 * 2;
constexpr size_t WS_MIX = WS_H + (size_t)MTOK * 1024 * 2;
constexpr size_t WS_R1 = WS_MIX + (size_t)MTOK * 1024 * 2;
constexpr size_t WS_END = WS_R1 + (size_t)MTOK * 3584 * 2;

struct Params {
    const float* in[26];
    float* out;
    unsigned char* ws;
    int ph_lo, ph_hi;
};

__device__ __forceinline__ float bf2f(unsigned short b) { return __uint_as_float(((unsigned)b) << 16); }
typedef __bf16 bf16x2_t __attribute__((ext_vector_type(2)));
__device__ __forceinline__ unsigned pk2(float lo, float hi) { const f32x2 v = {lo, hi}; return __builtin_bit_cast(unsigned, __builtin_convertvector(v, bf16x2_t)); }
__device__ __forceinline__ bf16_t f2bf(float f) { return (bf16_t)(pk2(f, 0.f) & 0xffffu); }
__device__ __forceinline__ float lo_f(unsigned u) { return __uint_as_float(u << 16); }
__device__ __forceinline__ float hi_f(unsigned u) { return __uint_as_float(u & 0xffff0000u); }
__device__ __forceinline__ bf16x8 as_frag(u32x4 u) { return __builtin_bit_cast(bf16x8, u); }
__device__ __forceinline__ f32x4 mfma16(bf16x8 a, bf16x8 b, f32x4 c) { return __builtin_amdgcn_mfma_f32_16x16x32_bf16(a, b, c, 0, 0, 0); }
__device__ __forceinline__ float silu_f(float x) { return x * __builtin_amdgcn_rcpf(1.f + __expf(-x)); }
__device__ __forceinline__ float sigm_f(float x) { return __builtin_amdgcn_rcpf(1.f + __expf(-x)); }
__device__ __forceinline__ float gelu_tanh(float x) {
    const float u = 0.7978845608028654f * (x + 0.044715f * x * x * x);
    const float t = 1.f - 2.f * __builtin_amdgcn_rcpf(1.f + __expf(2.f * u));
    return 0.5f * x * (1.f + t);
}
__device__ __forceinline__ bf16x8 tr_pair(LAS bf16_t* base, int stride, int row0, int row1, int col0, int li) {
    const int q = li >> 2, pq = li & 3;
    s16x4 a = __builtin_amdgcn_ds_read_tr16_b64_v4i16((LAS s16x4*)(base + (row0 + q) * stride + col0 + 4 * pq));
    s16x4 b = __builtin_amdgcn_ds_read_tr16_b64_v4i16((LAS s16x4*)(base + (row1 + q) * stride + col0 + 4 * pq));
    bf16x8 r = {a[0], a[1], a[2], a[3], b[0], b[1], b[2], b[3]};
    return r;
}
__device__ __forceinline__ int tid_opaque() { int t = threadIdx.x; asm volatile("" : "+v"(t)); return t; }
__device__ __forceinline__ int vblock() { const int G = gridDim.x, bx = blockIdx.x; return (G % 8 == 0) ? (bx % 8) * (G / 8) + bx / 8 : bx; }
__device__ __forceinline__ void wave_lds_fence() { asm volatile("s_waitcnt lgkmcnt(0)" ::: "memory"); __builtin_amdgcn_wave_barrier(); }


__device__ __forceinline__ void grid_barrier(unsigned* w, unsigned& gen) {
    asm volatile("s_waitcnt vmcnt(0) lgkmcnt(0)" ::: "memory");
    __syncthreads();
    if (threadIdx.x == 0) {
        __builtin_amdgcn_fence(__ATOMIC_RELEASE, "agent");
        asm volatile("s_waitcnt vmcnt(0) lgkmcnt(0)" ::: "memory");
        const unsigned G = gridDim.x, grp = blockIdx.x & 7u, ngrp = (G - grp + 7u) / 8u, ngroups = G < 8u ? G : 8u;
        const unsigned old = __hip_atomic_fetch_add(w + 32 * grp, 1u, __ATOMIC_RELAXED, __HIP_MEMORY_SCOPE_AGENT);
        if (old + 1u == ngrp * (gen + 1u)) {
            const unsigned old2 = __hip_atomic_fetch_add(w + 256, 1u, __ATOMIC_RELAXED, __HIP_MEMORY_SCOPE_AGENT);
            if (old2 + 1u == ngroups * (gen + 1u)) __hip_atomic_fetch_add(w + 288, 1u, __ATOMIC_RELAXED, __HIP_MEMORY_SCOPE_AGENT);
        }
        while (__hip_atomic_load(w + 288, __ATOMIC_RELAXED, __HIP_MEMORY_SCOPE_AGENT) == gen) __builtin_amdgcn_s_sleep(2);
        __builtin_amdgcn_fence(__ATOMIC_ACQUIRE, "agent");
        asm volatile("s_waitcnt vmcnt(0) lgkmcnt(0)" ::: "memory");
    }
    ++gen;
    __syncthreads();
}

namespace pg8 {
constexpr int BM = 256, BK = 64, HALF = 128, HTB = HALF * BK * 2, STAGE_BYTES = 8 * HTB, NXCD = 8, WGM = 8;
__device__ __forceinline__ int lds_byte(int r, int c) { const int st = (r >> 4) * 2 + (c >> 5), rr = r & 15, cc = c & 31, ob = rr * 64 + cc * 2; return st * 1024 + (ob ^ (((ob >> 9) & 1) << 5)); }
__device__ __forceinline__ void stage_rc(int b, int& R, int& C) { const int st = b / 1024, sb = b % 1024, swz = sb ^ (((sb >> 9) & 1) << 5); R = (st >> 1) * 16 + swz / 64; C = (st & 1) * 32 + (swz % 64) / 2; }
__device__ __forceinline__ int perm32(int rho) { const int n = rho >> 4, i = rho & 15; return 8 * (i >> 2) + 4 * n + (i & 3); }
struct Unit { int pm, pn; };
struct Gemm { const bf16_t* A; const bf16_t* Bt; int M, N, K; };
struct StaticOrder {
    int nM, nN, nwg, G, c;
    __device__ void init(int M, int N, int G_, int c_) { nM = M / BM; nN = N / BM; nwg = nM * nN; G = G_; c = c_; }
    __device__ bool next(int i, Unit& u) const {
        const long L = (long)i * G + c; if (L >= nwg) return false;
        int wgid = (int)L; { const int q = nwg / NXCD, r = nwg % NXCD, xcd = wgid % NXCD, off = wgid / NXCD; wgid = (xcd < r ? xcd * (q + 1) : r * (q + 1) + (xcd - r) * q) + off; }
        const int nig = WGM * nN, gid = wgid / nig, fm = gid * WGM, gsz = (nM - fm) < WGM ? (nM - fm) : WGM;
        u.pm = fm + ((wgid % nig) % gsz); u.pn = (wgid % nig) / gsz; return true;
    }
};

template <class Epi>
__device__ __forceinline__ void gemm_phase(LAS unsigned char* lds, const Gemm g, const StaticOrder& S, const Epi& E) {
    const int tid = tid_opaque(), wid = __builtin_amdgcn_readfirstlane(tid >> 6), lane = tid & 63, wr = wid >> 2, wc = wid & 3, fr = lane & 15, fq = lane >> 4;
    const int K = g.K, nt = K / BK;
    unsigned voffA[2], voffB[2];
#pragma unroll
    for (int i = 0; i < 2; ++i) { int R, C; stage_rc(tid * 16 + i * 8192, R, C); const int Rb = Epi::PERM ? ((R & ~31) + perm32(R & 31)) : R;
        voffA[i] = (unsigned)(R * K + C) * 2u; voffB[i] = (unsigned)(Rb * K + C) * 2u; }
    const size_t kstep = (size_t)(BK * 2);
    const size_t hstep = (size_t)HALF * K * 2;
    const size_t tstep = 2 * hstep;
    const unsigned ldsw = (unsigned)wid * 1024u;
    const int aoff = lds_byte(wr * 64 + fr, fq * 8), boff = lds_byte(wc * 32 + fr, fq * 8);
#define PG8_SA(b, h) (((b) * 2 + (h)) * HTB)
#define PG8_SB(b, h) ((4 + (b) * 2 + (h)) * HTB)
#define PG8_STAGE(bufoff, gbase, voff) do { _Pragma("unroll") for (int _i = 0; _i < 2; ++_i) \
        __builtin_amdgcn_global_load_lds((const unsigned*)((const char*)(gbase) + (voff)[_i]), (LAS unsigned*)(lds + (bufoff) + ldsw + _i * 8192), 16, 0, 0); } while (0)
#define PG8_LDA(dst, b, h) do { _Pragma("unroll") for (int m = 0; m < 4; ++m) _Pragma("unroll") for (int k = 0; k < 2; ++k) dst[m][k] = *(const LAS bf16x8*)(lds + PG8_SA(b, h) + aoff + m * 2048 + k * 1024); } while (0)
#define PG8_LDB(dst, b, h) do { _Pragma("unroll") for (int n = 0; n < 2; ++n) _Pragma("unroll") for (int k = 0; k < 2; ++k) dst[n][k] = *(const LAS bf16x8*)(lds + PG8_SB(b, h) + boff + n * 2048 + k * 1024); } while (0)
#define PG8_MMA(ai, bj, At, Bt) do { __builtin_amdgcn_s_setprio(1); _Pragma("unroll") for (int m = 0; m < 4; ++m) _Pragma("unroll") for (int n = 0; n < 2; ++n) _Pragma("unroll") for (int k = 0; k < 2; ++k) \
        acc[ai][bj][m][n] = __builtin_amdgcn_mfma_f32_16x16x32_bf16(Bt[n][k], At[m][k], acc[ai][bj][m][n], 0, 0, 0); __builtin_amdgcn_s_setprio(0); } while (0)
#define PG8_WAIT_V(n) asm volatile("s_waitcnt vmcnt(" #n ")" ::: "memory")
#define PG8_WAIT_L(n) asm volatile("s_waitcnt lgkmcnt(" #n ")" ::: "memory")
#define PG8_BAR __builtin_amdgcn_s_barrier()
#define PG8_SCHED __builtin_amdgcn_sched_barrier(0)
    Unit cur, nxt; int ui = 0;
    if (!S.next(0, cur)) return;
    f32x4 acc[2][2][4][2];
#pragma unroll
    for (int a = 0; a < 2; ++a)
#pragma unroll
        for (int b = 0; b < 2; ++b)
#pragma unroll
            for (int m = 0; m < 4; ++m)
#pragma unroll
                for (int n = 0; n < 2; ++n) acc[a][b][m][n] = (f32x4){0.f, 0.f, 0.f, 0.f};
    bf16x8 At[4][2], B0[2][2], B1[2][2];
    const char* cA = (const char*)g.A + (size_t)cur.pm * tstep; const char* cB = (const char*)g.Bt + (size_t)cur.pn * tstep;
    PG8_STAGE(PG8_SB(0, 0), cB, voffB); PG8_STAGE(PG8_SA(0, 0), cA, voffA); PG8_STAGE(PG8_SB(0, 1), cB + hstep, voffB); PG8_STAGE(PG8_SA(0, 1), cA + hstep, voffA);
    if (wr == 1) PG8_BAR;
    PG8_WAIT_V(4); PG8_BAR;
    PG8_STAGE(PG8_SB(1, 0), cB + kstep, voffB); PG8_STAGE(PG8_SA(1, 0), cA + kstep, voffA); PG8_STAGE(PG8_SB(1, 1), cB + hstep + kstep, voffB);
    PG8_WAIT_V(6); PG8_BAR;
    for (;;) {
        const bool has_next = S.next(ui + 1, nxt);
        const char* nA = has_next ? (const char*)g.A + (size_t)nxt.pm * tstep : cA; const char* nB = has_next ? (const char*)g.Bt + (size_t)nxt.pn * tstep : cB;
        for (int t = 0; t < nt; t += 2) {
            const bool last = (t == nt - 2);
            const char* a1 = cA + (size_t)(t + 1) * kstep;
            const char* a2 = last ? nA : cA + (size_t)(t + 2) * kstep; const char* b2 = last ? nB : cB + (size_t)(t + 2) * kstep;
            const char* a3 = a2 + kstep; const char* b3 = b2 + kstep;
            PG8_LDB(B0, 0, 0); PG8_SCHED; PG8_LDA(At, 0, 0); PG8_STAGE(PG8_SA(1, 1), a1 + hstep, voffA);
            PG8_WAIT_L(8); PG8_BAR; PG8_WAIT_L(0); PG8_MMA(0, 0, At, B0); PG8_BAR; PG8_SCHED;
            PG8_LDB(B1, 0, 1); PG8_STAGE(PG8_SB(0, 0), b2, voffB);
            PG8_BAR; PG8_WAIT_L(0); PG8_MMA(0, 1, At, B1); PG8_BAR;
            PG8_LDA(At, 0, 1); PG8_STAGE(PG8_SA(0, 0), a2, voffA);
            PG8_BAR; PG8_WAIT_L(0); PG8_MMA(1, 0, At, B0); PG8_BAR; PG8_SCHED;
            PG8_STAGE(PG8_SB(0, 1), b2 + hstep, voffB);
            PG8_WAIT_V(6); PG8_BAR; PG8_MMA(1, 1, At, B1); PG8_BAR;
            PG8_LDB(B0, 1, 0); PG8_SCHED; PG8_LDA(At, 1, 0); PG8_STAGE(PG8_SA(0, 1), a2 + hstep, voffA);
            PG8_WAIT_L(8); PG8_BAR; PG8_WAIT_L(0); PG8_MMA(0, 0, At, B0); PG8_BAR; PG8_SCHED;
            PG8_LDB(B1, 1, 1); PG8_STAGE(PG8_SB(1, 0), b3, voffB);
            PG8_BAR; PG8_WAIT_L(0); PG8_MMA(0, 1, At, B1); PG8_BAR;
            PG8_LDA(At, 1, 1); PG8_STAGE(PG8_SA(1, 0), a3, voffA);
            PG8_BAR; PG8_WAIT_L(0); PG8_MMA(1, 0, At, B0); PG8_BAR; PG8_SCHED;
            PG8_STAGE(PG8_SB(1, 1), b3 + hstep, voffB);
            PG8_WAIT_V(6); PG8_BAR; PG8_MMA(1, 1, At, B1); PG8_BAR;
        }
        E(acc, cur, wr, wc, fr, fq);
        if (!has_next) break;
#pragma unroll
        for (int a = 0; a < 2; ++a)
#pragma unroll
            for (int b = 0; b < 2; ++b)
#pragma unroll
                for (int m = 0; m < 4; ++m)
#pragma unroll
                    for (int n = 0; n < 2; ++n) acc[a][b][m][n] = (f32x4){0.f, 0.f, 0.f, 0.f};
        cur = nxt; cA = nA; cB = nB; ++ui;
    }
    PG8_WAIT_V(0);
    if (wr == 0) PG8_BAR;
    PG8_BAR;
#undef PG8_SA
#undef PG8_SB
#undef PG8_STAGE
#undef PG8_LDA
#undef PG8_LDB
#undef PG8_MMA
#undef PG8_WAIT_V
#undef PG8_WAIT_L
#undef PG8_BAR
#undef PG8_SCHED
}

struct EpiStore {
    static constexpr bool PERM = true;
    bf16_t* O; int ldc;
    __device__ __forceinline__ void operator()(const f32x4 (&acc)[2][2][4][2], const Unit& u, int wr, int wc, int fr, int fq) const {
        const int row0 = u.pm * BM + wr * 64 + fr, col0 = u.pn * BM + wc * 32 + 8 * fq;
#pragma unroll
        for (int ai = 0; ai < 2; ++ai)
#pragma unroll
            for (int m = 0; m < 4; ++m) { bf16_t* rowp = O + (size_t)(row0 + ai * HALF + m * 16) * ldc + col0;
#pragma unroll
                for (int bj = 0; bj < 2; ++bj) { const f32x4 v0 = acc[ai][bj][m][0], v1 = acc[ai][bj][m][1];
                    u32x4 w; w.x = pk2(v0[0], v0[1]); w.y = pk2(v0[2], v0[3]); w.z = pk2(v1[0], v1[1]); w.w = pk2(v1[2], v1[3]);
                    __builtin_nontemporal_store(w, (u32x4*)(rowp + bj * HALF)); } }
    }
};
struct EpiStoreQK {
    static constexpr bool PERM = true;
    bf16_t* O; const float* qg; const float* kg;
    __device__ __forceinline__ void operator()(const f32x4 (&acc)[2][2][4][2], const Unit& u, int wr, int wc, int fr, int fq) const {
        const int row0 = u.pm * BM + wr * 64 + fr;
        if (u.pn >= 4) {
            const int col0 = u.pn * BM + wc * 32 + 8 * fq;
#pragma unroll
            for (int ai = 0; ai < 2; ++ai)
#pragma unroll
                for (int m = 0; m < 4; ++m) { bf16_t* rowp = O + (size_t)(row0 + ai * HALF + m * 16) * 2048 + col0;
#pragma unroll
                    for (int bj = 0; bj < 2; ++bj) { const f32x4 v0 = acc[ai][bj][m][0], v1 = acc[ai][bj][m][1];
                        u32x4 w; w.x = pk2(v0[0], v0[1]); w.y = pk2(v0[2], v0[3]); w.z = pk2(v1[0], v1[1]); w.w = pk2(v1[2], v1[3]);
                        __builtin_nontemporal_store(w, (u32x4*)(rowp + bj * HALF)); } }
        } else {
            const float* gp = u.pn < 2 ? qg : kg; const float scl = u.pn < 2 ? 0.125f * 1.4426950408889634f : 1.f;
            f32x4 gn[2][2];
#pragma unroll
            for (int bj = 0; bj < 2; ++bj)
#pragma unroll
                for (int n = 0; n < 2; ++n) gn[bj][n] = *(const f32x4*)(gp + 32 * bj + 8 * fq + 4 * n);
            const int col0 = u.pn * BM + wc * 64 + 8 * fq;
#pragma unroll
            for (int ai = 0; ai < 2; ++ai)
#pragma unroll
                for (int m = 0; m < 4; ++m) { bf16_t* rowp = O + (size_t)(row0 + ai * HALF + m * 16) * 2048 + col0;
                    float ss = 0.f;
#pragma unroll
                    for (int bj = 0; bj < 2; ++bj)
#pragma unroll
                        for (int n = 0; n < 2; ++n) { const f32x4 a = acc[ai][bj][m][n]; ss += a[0] * a[0] + a[1] * a[1] + a[2] * a[2] + a[3] * a[3]; }
                    ss += __shfl_xor(ss, 16); ss += __shfl_xor(ss, 32);
                    const float r = rsqrtf(ss * (1.f / 64.f) + 1e-6f) * scl;
#pragma unroll
                    for (int bj = 0; bj < 2; ++bj) { const f32x4 v0 = acc[ai][bj][m][0] * r * gn[bj][0], v1 = acc[ai][bj][m][1] * r * gn[bj][1];
                        u32x4 w; w.x = pk2(v0[0], v0[1]); w.y = pk2(v0[2], v0[3]); w.z = pk2(v1[0], v1[1]); w.w = pk2(v1[2], v1[3]);
                        __builtin_nontemporal_store(w, (u32x4*)(rowp + 32 * bj)); } }
        }
    }
};
struct EpiSwiglu {
    static constexpr bool PERM = true;
    bf16_t* O;
    __device__ __forceinline__ void operator()(const f32x4 (&acc)[2][2][4][2], const Unit& u, int wr, int wc, int fr, int fq) const {
        const int row0 = u.pm * BM + wr * 64 + fr, col0 = u.pn * HALF + wc * 32 + 8 * fq;
#pragma unroll
        for (int ai = 0; ai < 2; ++ai)
#pragma unroll
            for (int m = 0; m < 4; ++m) { bf16_t* rowp = O + (size_t)(row0 + ai * HALF + m * 16) * FFH + col0;
                float r[8];
#pragma unroll
                for (int n = 0; n < 2; ++n)
#pragma unroll
                    for (int j = 0; j < 4; ++j) r[n * 4 + j] = silu_f(acc[ai][0][m][n][j]) * acc[ai][1][m][n][j];
                u32x4 w; w.x = pk2(r[0], r[1]); w.y = pk2(r[2], r[3]); w.z = pk2(r[4], r[5]); w.w = pk2(r[6], r[7]);
                __builtin_nontemporal_store(w, (u32x4*)rowp); }
    }
};
struct EpiGlu {
    static constexpr bool PERM = true;
    const bf16_t* Y; const float* bias; bf16_t* O;
    __device__ __forceinline__ void operator()(const f32x4 (&acc)[2][2][4][2], const Unit& u, int wr, int wc, int fr, int fq) const {
        const int row0 = u.pm * BM + wr * 64 + fr, col0 = u.pn * BM + wc * 32 + 8 * fq;
#pragma unroll
        for (int bj = 0; bj < 2; ++bj) {
            const int col = col0 + bj * HALF;
            const f32x4 b0 = *(const f32x4*)(bias + col), b1 = *(const f32x4*)(bias + col + 4);
            u32x4 yv[2][4];
#pragma unroll
            for (int ai = 0; ai < 2; ++ai)
#pragma unroll
                for (int m = 0; m < 4; ++m) yv[ai][m] = *(const u32x4*)(Y + (size_t)(row0 + ai * HALF + m * 16) * 512 + col);
#pragma unroll
            for (int ai = 0; ai < 2; ++ai)
#pragma unroll
                for (int m = 0; m < 4; ++m) { const size_t row = (size_t)(row0 + ai * HALF + m * 16);
                    const u32x4 y4 = yv[ai][m];
                    const f32x4 v0 = acc[ai][bj][m][0] + b0, v1 = acc[ai][bj][m][1] + b1;
                    float r[8];
                    r[0] = lo_f(y4.x) * sigm_f(v0[0]); r[1] = hi_f(y4.x) * sigm_f(v0[1]); r[2] = lo_f(y4.y) * sigm_f(v0[2]); r[3] = hi_f(y4.y) * sigm_f(v0[3]);
                    r[4] = lo_f(y4.z) * sigm_f(v1[0]); r[5] = hi_f(y4.z) * sigm_f(v1[1]); r[6] = lo_f(y4.w) * sigm_f(v1[2]); r[7] = hi_f(y4.w) * sigm_f(v1[3]);
                    u32x4 w; w.x = pk2(r[0], r[1]); w.y = pk2(r[2], r[3]); w.z = pk2(r[4], r[5]); w.w = pk2(r[6], r[7]);
                    __builtin_nontemporal_store(w, (u32x4*)(O + row * 1024 + 512 + col)); }
        }
    }
};
struct EpiResid {
    static constexpr bool PERM = false;
    const float* res; float* out; const float* gate;
    __device__ __forceinline__ void operator()(const f32x4 (&acc)[2][2][4][2], const Unit& u, int wr, int wc, int fr, int fq) const {
        const int row0 = u.pm * BM + wr * 64 + fr, col0 = u.pn * BM + wc * 32 + 4 * fq;
        const int bidx = (u.pm * BM) >> 12;
        f32x4 gv[2][2];
#pragma unroll
        for (int bj = 0; bj < 2; ++bj)
#pragma unroll
            for (int n = 0; n < 2; ++n) gv[bj][n] = *(const f32x4*)(gate + (size_t)bidx * 6144 + col0 + bj * HALF + n * 16);
        f32x4 rv[2][2][2][2];
#define EPR_LOAD(buf, q) do { _Pragma("unroll") for (int mm = 0; mm < 2; ++mm) _Pragma("unroll") for (int bj = 0; bj < 2; ++bj) _Pragma("unroll") for (int n = 0; n < 2; ++n) \
            rv[buf][mm][bj][n] = *(const f32x4*)(res + (size_t)(row0 + ((q) >> 1) * HALF + (((q) & 1) * 2 + mm) * 16) * 1024 + col0 + bj * HALF + n * 16); } while (0)
#define EPR_STORE(buf, q) do { _Pragma("unroll") for (int mm = 0; mm < 2; ++mm) _Pragma("unroll") for (int bj = 0; bj < 2; ++bj) _Pragma("unroll") for (int n = 0; n < 2; ++n) \
            __builtin_nontemporal_store(rv[buf][mm][bj][n] + gv[bj][n] * acc[(q) >> 1][bj][((q) & 1) * 2 + mm][n], (f32x4*)(out + (size_t)(row0 + ((q) >> 1) * HALF + (((q) & 1) * 2 + mm) * 16) * 1024 + col0 + bj * HALF + n * 16)); } while (0)
        EPR_LOAD(0, 0); EPR_LOAD(1, 1); EPR_STORE(0, 0); EPR_LOAD(0, 2); EPR_STORE(1, 1); EPR_LOAD(1, 3); EPR_STORE(0, 2); EPR_STORE(1, 3);
#undef EPR_LOAD
#undef EPR_STORE
    }
};
}

__device__ __forceinline__ int wt_src_col(int n, int mode) {
    if (mode == 1) { const int tt = n >> 8, r = n & 255; return r < 128 ? tt * 128 + r : FFH + tt * 128 + (r - 128); }
    if (mode == 2 && n < 1024) { const int lc = n & 255; return (n & ~255) + ((lc >> 5) & 3) * 64 + 32 * (lc >> 7) + (lc & 31); }
    return n;
}
__device__ __forceinline__ void transpose_cvt(LAS float* tile, const float* __restrict__ W, int K, int N, bf16_t* __restrict__ Wt, int mode) {
    const int tid = tid_opaque();
    const int tilesN = N / 64, tilesK = K / 64, ntl = tilesN * tilesK;
    float cur[8];
    if ((int)blockIdx.x < ntl) { const int tn = blockIdx.x % tilesN, tk = blockIdx.x / tilesN; const int nsrc = wt_src_col(tn * 64 + (tid & 63), mode);
#pragma unroll
        for (int r = 0; r < 8; ++r) cur[r] = W[(size_t)(tk * 64 + (tid >> 6) + 8 * r) * N + nsrc]; }
    for (int t = blockIdx.x; t < ntl; t += gridDim.x) {
        const int tn = t % tilesN, tk = t / tilesN;
        const int n0d = tn * 64, k0 = tk * 64;
#pragma unroll
        for (int r = 0; r < 8; ++r) { const int kk = (tid >> 6) + 8 * r; tile[kk * 65 + (tid & 63)] = cur[r]; }
        const int t2 = t + gridDim.x;
        if (t2 < ntl) { const int tn2 = t2 % tilesN, tk2 = t2 / tilesN; const int nsrc = wt_src_col(tn2 * 64 + (tid & 63), mode);
#pragma unroll
            for (int r = 0; r < 8; ++r) cur[r] = W[(size_t)(tk2 * 64 + (tid >> 6) + 8 * r) * N + nsrc]; }
        __syncthreads();
        { const int nn = tid >> 3, kc = (tid & 7) * 8; float v[8];
#pragma unroll
          for (int j = 0; j < 8; ++j) v[j] = tile[(kc + j) * 65 + nn];
          u32x4 w; w.x = pk2(v[0], v[1]); w.y = pk2(v[2], v[3]); w.z = pk2(v[4], v[5]); w.w = pk2(v[6], v[7]);
          *(u32x4*)(Wt + (size_t)(n0d + nn) * K + k0 + kc) = w; }
        __syncthreads();
    }
}

struct S5gp { float lrdt, lidt, fre, fim; };
__device__ __forceinline__ S5gp s5_gp(const Params& p, int g, int pp) {
    S5gp r; const float dt = expf(p.in[15][g]); const float lr = p.in[13][g * 64 + pp], li = p.in[14][g * 64 + pp];
    r.lrdt = lr * dt; r.lidt = li * dt;
    const float mag = expf(r.lrdt), are = mag * cosf(r.lidt), aim = mag * sinf(r.lidt), den = lr * lr + li * li;
    r.fre = ((are - 1.f) * lr + aim * li) / den; r.fim = (aim * lr - (are - 1.f) * li) / den;
    return r;
}
__device__ __forceinline__ f32x2 s5_apow(const S5gp& q, float n) { const float m = expf(n * q.lrdt), a = n * q.lidt; return (f32x2){m * cosf(a), m * sinf(a)}; }

__device__ __forceinline__ void prep_phase(const Params& p, LAS unsigned char* lds) {
    const int tid = tid_opaque();
    unsigned char* ws = p.ws;
    LAS float* tile = (LAS float*)lds;
    transpose_cvt(tile, p.in[8], 1024, 2048, (bf16_t*)(ws + WS_W_ABIN), 2);
    transpose_cvt(tile, p.in[9], 1024, 1024, (bf16_t*)(ws + WS_W_ABOUT), 0);
    transpose_cvt(tile, p.in[21], 512, 512, (bf16_t*)(ws + WS_W_GLU), 0);
    for (int l = 0; l < 2; ++l) {
        transpose_cvt(tile, p.in[6] + (size_t)l * 1024 * 5632, 1024, 5632, (bf16_t*)(ws + WS_W_FFIN) + (size_t)l * 5632 * 1024, 1);
        transpose_cvt(tile, p.in[7] + (size_t)l * FFH * 1024, FFH, 1024, (bf16_t*)(ws + WS_W_FFOUT) + (size_t)l * 1024 * FFH, 0);
    }
    transpose_cvt(tile, p.in[23], 1024, 3584, (bf16_t*)(ws + WS_W_CDIN), 0);
    transpose_cvt(tile, p.in[24], 1024, 1024, (bf16_t*)(ws + WS_W_CDOUT), 0);
    if (blockIdx.x < 192) {
        LAS float* sc = (LAS float*)lds; LAS float* red = (LAS float*)(lds + 65536);
        for (int idx = tid; idx < 16384; idx += NTHR) { const float v = p.in[1][idx]; sc[idx] = v / (1.f + expf(-v)); }
        __syncthreads();
        for (int item = blockIdx.x; item < 192; item += gridDim.x) {
            const int l = item / 96, cb = item % 96, cl = tid & 63, ksl = tid >> 6;
            float acc[16];
#pragma unroll
            for (int b = 0; b < 16; ++b) acc[b] = 0.f;
            const float* w = p.in[2] + (size_t)l * 1024 * 6144 + cb * 64 + cl;
            for (int k0 = ksl * 128; k0 < ksl * 128 + 128; k0 += 8) {
                float wv[8];
#pragma unroll
                for (int j = 0; j < 8; ++j) wv[j] = w[(size_t)(k0 + j) * 6144];
#pragma unroll
                for (int b = 0; b < 16; ++b) { const f32x4 s0 = *(const LAS f32x4*)(sc + b * 1024 + k0), s1 = *(const LAS f32x4*)(sc + b * 1024 + k0 + 4);
                    acc[b] += s0[0] * wv[0] + s0[1] * wv[1] + s0[2] * wv[2] + s0[3] * wv[3] + s1[0] * wv[4] + s1[1] * wv[5] + s1[2] * wv[6] + s1[3] * wv[7]; }
            }
#pragma unroll
            for (int b = 0; b < 16; ++b) red[(ksl * 16 + b) * 64 + cl] = acc[b];
            __syncthreads();
            for (int o = tid; o < 1024; o += NTHR) { const int b = o >> 6, cc = o & 63; float s = 0.f;
#pragma unroll
                for (int k8 = 0; k8 < 8; ++k8) s += red[(k8 * 16 + b) * 64 + cc];
                ((float*)(ws + WS_MOD))[(size_t)(l * 16 + b) * 6144 + cb * 64 + cc] = s + p.in[3][l * 6144 + cb * 64 + cc]; }
            __syncthreads();
        }
    }
    __syncthreads();
    const int gtid = blockIdx.x * NTHR + tid, nthr = gridDim.x * NTHR;
    for (int idx = gtid; idx < 4096 * 64; idx += nthr) { const int pos = idx >> 6, f = idx & 63;
        const float freq = powf(10000.f, -(float)f / 64.f), ang = (float)pos * freq;
        ((f32x2*)(ws + WS_ROPE))[idx] = (f32x2){cosf(ang), sinf(ang)}; }
    { bf16_t* Mt = (bf16_t*)(ws + WS_S5M); bf16_t* Gt = (bf16_t*)(ws + WS_S5G);
      for (int idx = gtid; idx < 32 * 64 * 64; idx += nthr) { const int g = idx >> 12, pp = (idx >> 6) & 63, s = idx & 63;
          const S5gp q = s5_gp(p, g, pp);
          { const f32x2 a = s5_apow(q, (float)(63 - s));
            unsigned wr_[8], wi_[8];
#pragma unroll
            for (int h2 = 0; h2 < 8; ++h2) { float vr[2], vi[2];
#pragma unroll
                for (int e = 0; e < 2; ++e) { const int h = h2 * 2 + e; const float br = p.in[16][(g * 64 + pp) * 16 + h], bi = p.in[17][(g * 64 + pp) * 16 + h];
                    const float bbr = q.fre * br - q.fim * bi, bbi = q.fre * bi + q.fim * br;
                    vr[e] = a.x * bbr - a.y * bbi; vi[e] = a.x * bbi + a.y * bbr; }
                wr_[h2] = pk2(vr[0], vr[1]); wi_[h2] = pk2(vi[0], vi[1]); }
            u32x4* dr = (u32x4*)(Mt + (size_t)(g * 128 + 2 * pp) * 1024 + s * 16); u32x4* di = (u32x4*)(Mt + (size_t)(g * 128 + 2 * pp + 1) * 1024 + s * 16);
            dr[0] = (u32x4){wr_[0], wr_[1], wr_[2], wr_[3]}; dr[1] = (u32x4){wr_[4], wr_[5], wr_[6], wr_[7]};
            di[0] = (u32x4){wi_[0], wi_[1], wi_[2], wi_[3]}; di[1] = (u32x4){wi_[4], wi_[5], wi_[6], wi_[7]}; }
          { const int t = s; const f32x2 a = s5_apow(q, (float)(t + 1));
#pragma unroll
            for (int h = 0; h < 16; ++h) { const float cr = p.in[18][(g * 16 + h) * 64 + pp], ci = p.in[19][(g * 16 + h) * 64 + pp];
                const float gr = cr * a.x - ci * a.y, gi = cr * a.y + ci * a.x;
                *(unsigned*)(Gt + (size_t)(g * 1024 + t * 16 + h) * 128 + 2 * pp) = pk2(gr, -gi); } }
          if (s == 0) ((f32x2*)(ws + WS_A64))[g * 64 + pp] = s5_apow(q, 64.f);
      }
      LAS f32x2* tp = (LAS f32x2*)lds;
      bf16_t* Kt = (bf16_t*)(ws + WS_KERN);
      for (int item = blockIdx.x; item < 32 * 64; item += gridDim.x) { const int g = item >> 6, tau = item & 63;
          if (tid < 64) { const S5gp q = s5_gp(p, g, tid); const f32x2 a = s5_apow(q, (float)tau); tp[tid] = (f32x2){a.x * q.fre - a.y * q.fim, a.x * q.fim + a.y * q.fre}; }
          __syncthreads();
          if (tid < 256) { const int h = tid >> 4, h2 = tid & 15; float acc = 0.f;
#pragma unroll 8
              for (int pp = 0; pp < 64; ++pp) { const f32x2 t = tp[pp]; const float cr = p.in[18][(g * 16 + h) * 64 + pp], ci = p.in[19][(g * 16 + h) * 64 + pp];
                  const float ur = cr * t.x - ci * t.y, ui = cr * t.y + ci * t.x;
                  acc += ur * p.in[16][(g * 64 + pp) * 16 + h2] - ui * p.in[17][(g * 64 + pp) * 16 + h2]; }
              Kt[(size_t)((g * 64 + tau) * 16 + h) * 16 + h2] = f2bf(acc); }
          __syncthreads();
      }
    }
}

__device__ __forceinline__ void norm_phase(const float* __restrict__ x, const float* __restrict__ gw, const float* __restrict__ shift, const float* __restrict__ scale, bf16_t* __restrict__ H) {
    const int tid = tid_opaque(); const int lane = tid & 63, wv = blockIdx.x * 8 + (tid >> 6), nw = gridDim.x * 8;
    constexpr int NR = 8;
    for (int row0 = wv * NR; row0 < MTOK; row0 += nw * NR) {
        const int b = row0 >> 12;
        f32x4 v[NR][4]; float ss[NR];
#pragma unroll
        for (int r = 0; r < NR; ++r)
#pragma unroll
            for (int c4 = 0; c4 < 4; ++c4) v[r][c4] = __builtin_nontemporal_load((const f32x4*)(x + (size_t)(row0 + r) * 1024 + c4 * 256 + lane * 4));
#pragma unroll
        for (int r = 0; r < NR; ++r) { float s = 0.f;
#pragma unroll
            for (int c4 = 0; c4 < 4; ++c4) s += v[r][c4][0] * v[r][c4][0] + v[r][c4][1] * v[r][c4][1] + v[r][c4][2] * v[r][c4][2] + v[r][c4][3] * v[r][c4][3];
            ss[r] = s; }
#pragma unroll
        for (int o = 1; o < 64; o <<= 1)
#pragma unroll
            for (int r = 0; r < NR; ++r) ss[r] += __shfl_xor(ss[r], o);
#pragma unroll
        for (int c4 = 0; c4 < 4; ++c4) { const int col = c4 * 256 + lane * 4;
            const f32x4 g = *(const f32x4*)(gw + col), sc = *(const f32x4*)(scale + (size_t)b * 6144 + col), sh = *(const f32x4*)(shift + (size_t)b * 6144 + col);
            const f32x4 gm = g * (sc + 1.f);
#pragma unroll
            for (int r = 0; r < NR; ++r) { const float rr = rsqrtf(ss[r] * (1.f / 1024.f) + 1e-6f);
                const f32x4 o = v[r][c4] * rr * gm + sh;
                *(u32x2*)(H + (size_t)(row0 + r) * 1024 + col) = (u32x2){pk2(o[0], o[1]), pk2(o[2], o[3])}; } }
    }
}

constexpr int VS = 72;
constexpr int VL_BYTES = 64 * VS * 2;

__device__ __forceinline__ void s5a_phase(const Params& p);
__device__ __forceinline__ void attnA_phase(const Params& p, LAS unsigned char* lds) {
    const int tid = tid_opaque(), wid = __builtin_amdgcn_readfirstlane(tid >> 6), lane = tid & 63, li = lane & 15, g4 = lane >> 4;
    const bf16_t* QKV = (const bf16_t*)(p.ws + WS_R1);
    bf16_t* MIX = (bf16_t*)(p.ws + WS_MIX);
    LAS bf16_t* Vl = (LAS bf16_t*)(lds + wid * VL_BYTES);
    LAS float* bl = (LAS float*)(lds + 8 * VL_BYTES);
    for (int idx = tid; idx < 8 * 257; idx += NTHR) bl[(idx / 257) * 260 + (idx % 257)] = p.in[12][idx] * 1.4426950408889634f;
    __syncthreads();
    if (wid >= 4) s5a_phase(p);
    const int h = wid;
    LAS float* bh = bl + h * 260;
    const float bfar = bh[256];
    const int vrow = lane >> 3, vc8 = (lane & 7) * 8;
    for (int item2 = vblock(); item2 < 2048; item2 += gridDim.x) {
        const int kq = item2 >> 8, rq = item2 & 255, qh = rq & 1;
        const int b = 2 * kq + (rq >> 7), ci = (((rq >> 1) & 63) + 9 * kq) & 63;
        const size_t rowbase = (size_t)b * SEQ + ci * 64 + qh * 32;
        bf16x8 qf[2][2];
#pragma unroll
        for (int qt = 0; qt < 2; ++qt)
#pragma unroll
            for (int ks = 0; ks < 2; ++ks) qf[qt][ks] = *(const bf16x8*)(QKV + (rowbase + qt * 16 + li) * 2048 + h * 64 + 32 * ks + 8 * g4);
        f32x4 o[4][2]; float mrun[2], lsum[2];
#pragma unroll
        for (int qt = 0; qt < 2; ++qt) { mrun[qt] = -1e30f; lsum[qt] = 0.f;
#pragma unroll
            for (int dt = 0; dt < 4; ++dt) o[dt][qt] = (f32x4){0.f, 0.f, 0.f, 0.f}; }
        const int kb0 = ci >= 8 ? 0 : 8 - ci;
        bf16x8 kf[4][2]; u32x4 vr[8];
        { const bf16_t* kbase = QKV + ((size_t)b * SEQ + (size_t)(ci - 8 + kb0) * 64) * 2048 + h * 64;
#pragma unroll
          for (int kt = 0; kt < 4; ++kt)
#pragma unroll
              for (int ks = 0; ks < 2; ++ks) kf[kt][ks] = *(const bf16x8*)(kbase + (size_t)(kt * 16 + li) * 2048 + 512 + 32 * ks + 8 * g4);
#pragma unroll
          for (int r = 0; r < 8; ++r) vr[r] = *(const u32x4*)(kbase + (size_t)(r * 8 + vrow) * 2048 + 1024 + vc8);
          wave_lds_fence();
#pragma unroll
          for (int r = 0; r < 8; ++r) *(LAS u32x4*)(Vl + (r * 8 + vrow) * VS + vc8) = vr[r];
          wave_lds_fence(); }
        for (int kb = kb0; kb <= 8; ++kb) {
            f32x4 s[4][2];
#pragma unroll
            for (int kt = 0; kt < 4; ++kt)
#pragma unroll
                for (int qt = 0; qt < 2; ++qt) { f32x4 z = (f32x4){0.f, 0.f, 0.f, 0.f}; z = mfma16(kf[kt][0], qf[qt][0], z); z = mfma16(kf[kt][1], qf[qt][1], z); s[kt][qt] = z; }
            const bool more = kb < 8;
            if (more) {
                const bf16_t* kbase = QKV + ((size_t)b * SEQ + (size_t)(ci - 8 + kb + 1) * 64) * 2048 + h * 64;
#pragma unroll
                for (int kt = 0; kt < 4; ++kt)
#pragma unroll
                    for (int ks = 0; ks < 2; ++ks) kf[kt][ks] = *(const bf16x8*)(kbase + (size_t)(kt * 16 + li) * 2048 + 512 + 32 * ks + 8 * g4);
#pragma unroll
                for (int r = 0; r < 8; ++r) vr[r] = *(const u32x4*)(kbase + (size_t)(r * 8 + vrow) * 2048 + 1024 + vc8);
            }
            const bool nearb = kb >= 6;
            bf16x8 pfr[2][2];
#pragma unroll
            for (int qt = 0; qt < 2; ++qt) {
                float mx = -1e30f;
                if (nearb) {
#pragma unroll
                    for (int kt = 0; kt < 4; ++kt)
#pragma unroll
                        for (int jj = 0; jj < 4; ++jj) { int rel = 512 + qh * 32 + qt * 16 + li - kb * 64 - (kt * 16 + 4 * g4 + jj); rel = rel > 128 ? 128 : (rel < -128 ? -128 : rel);
                            const float v = s[kt][qt][jj] + bh[rel + 128]; s[kt][qt][jj] = v; mx = fmaxf(mx, v); }
                } else {
#pragma unroll
                    for (int kt = 0; kt < 4; ++kt)
#pragma unroll
                        for (int jj = 0; jj < 4; ++jj) { const float v = s[kt][qt][jj] + bfar; s[kt][qt][jj] = v; mx = fmaxf(mx, v); }
                }
                mx = fmaxf(mx, __shfl_xor(mx, 16)); mx = fmaxf(mx, __shfl_xor(mx, 32));
                const float mnew = fmaxf(mrun[qt], mx), alpha = __builtin_amdgcn_exp2f(mrun[qt] - mnew);
                mrun[qt] = mnew; float ps = 0.f;
#pragma unroll
                for (int kt = 0; kt < 4; ++kt)
#pragma unroll
                    for (int jj = 0; jj < 4; ++jj) { const float e = __builtin_amdgcn_exp2f(s[kt][qt][jj] - mnew); s[kt][qt][jj] = e; ps += e; }
                lsum[qt] = lsum[qt] * alpha + ps;
#pragma unroll
                for (int dt = 0; dt < 4; ++dt) o[dt][qt] *= alpha;
#pragma unroll
                for (int kk = 0; kk < 2; ++kk) { u32x4 w; w.x = pk2(s[2 * kk][qt][0], s[2 * kk][qt][1]); w.y = pk2(s[2 * kk][qt][2], s[2 * kk][qt][3]);
                    w.z = pk2(s[2 * kk + 1][qt][0], s[2 * kk + 1][qt][1]); w.w = pk2(s[2 * kk + 1][qt][2], s[2 * kk + 1][qt][3]); pfr[qt][kk] = as_frag(w); }
            }
            { bf16x8 vf[2][4];
#pragma unroll
              for (int kk = 0; kk < 2; ++kk)
#pragma unroll
                  for (int dt = 0; dt < 4; ++dt) vf[kk][dt] = tr_pair(Vl, VS, 32 * kk + 4 * g4, 32 * kk + 16 + 4 * g4, dt * 16, li);
#pragma unroll
              for (int kk = 0; kk < 2; ++kk)
#pragma unroll
                  for (int dt = 0; dt < 4; ++dt)
#pragma unroll
                      for (int qt = 0; qt < 2; ++qt) o[dt][qt] = mfma16(vf[kk][dt], pfr[qt][kk], o[dt][qt]); }
            wave_lds_fence();
            if (more) {
#pragma unroll
                for (int r = 0; r < 8; ++r) *(LAS u32x4*)(Vl + (r * 8 + vrow) * VS + vc8) = vr[r];
                wave_lds_fence();
            }
        }
#pragma unroll
        for (int qt = 0; qt < 2; ++qt) { float l = lsum[qt]; l += __shfl_xor(l, 16); l += __shfl_xor(l, 32); const float inv = 1.f / l;
#pragma unroll
            for (int dt = 0; dt < 4; ++dt) { const f32x4 v = o[dt][qt] * inv;
                *(u32x2*)(MIX + (rowbase + qt * 16 + li) * 1024 + h * 64 + dt * 16 + 4 * g4) = (u32x2){pk2(v[0], v[1]), pk2(v[2], v[3])}; } }
    }
    if (wid < 4) s5a_phase(p);
}

__device__ __forceinline__ void s5a_phase(const Params& p) {
    const int tid = tid_opaque(); const int lane = tid & 63, li = lane & 15, g4 = lane >> 4;
    const bf16_t* QKV = (const bf16_t*)(p.ws + WS_R1);
    const bf16_t* Mt = (const bf16_t*)(p.ws + WS_S5M);
    float* E = (float*)(p.ws + WS_S5E);
    const int wv = blockIdx.x * 8 + (tid >> 6), nw = gridDim.x * 8;
    for (int item = wv; item < 2048; item += nw) {
        const int g = item & 31, c = item >> 5;
        f32x4 acc[8];
#pragma unroll
        for (int pt = 0; pt < 8; ++pt) acc[pt] = (f32x4){0.f, 0.f, 0.f, 0.f};
        const bf16_t* ub = QKV + ((size_t)li * SEQ + c * 64 + (g4 >> 1)) * 2048 + 1536 + g * 16 + 8 * (g4 & 1);
        const bf16_t* mb = Mt + (size_t)(g * 128 + li) * 1024 + 8 * g4;
#pragma unroll 4
        for (int ks = 0; ks < 32; ++ks) {
            const bf16x8 bfr = *(const bf16x8*)(ub + (size_t)(2 * ks) * 2048);
#pragma unroll
            for (int pt = 0; pt < 8; ++pt) { const bf16x8 afr = *(const bf16x8*)(mb + (size_t)pt * 16 * 1024 + 32 * ks); acc[pt] = mfma16(afr, bfr, acc[pt]); }
        }
#pragma unroll
        for (int pt = 0; pt < 8; ++pt) *(f32x4*)(E + ((size_t)(c * 32 + g) * 16 + li) * 128 + pt * 16 + 4 * g4) = acc[pt];
    }
}
__device__ __forceinline__ void s5scan_phase(const Params& p) {
    const float* E = (const float*)(p.ws + WS_S5E);
    bf16_t* X = (bf16_t*)(p.ws + WS_S5X);
    const f32x2* A64 = (const f32x2*)(p.ws + WS_A64);
    const int gtid = blockIdx.x * NTHR + tid_opaque();
    if (gtid < 32 * 16 * 64) {
        const int pp = gtid & 63, b = (gtid >> 6) & 15, g = gtid >> 10;
        const f32x2 a = A64[g * 64 + pp];
        float xr = 0.f, xi = 0.f;
        for (int c0 = 0; c0 < 64; c0 += 8) {
            f32x2 e[8];
#pragma unroll
            for (int k = 0; k < 8; ++k) e[k] = *(const f32x2*)(E + ((size_t)((c0 + k) * 32 + g) * 16 + b) * 128 + 2 * pp);
#pragma unroll
            for (int k = 0; k < 8; ++k) {
                *(unsigned*)(X + ((size_t)((c0 + k) * 32 + g) * 16 + b) * 128 + 2 * pp) = pk2(xr, xi);
                const float nr = a.x * xr - a.y * xi + e[k].x, ni = a.x * xi + a.y * xr + e[k].y; xr = nr; xi = ni; }
        }
    }
}
__device__ __forceinline__ int s5c_item(int vb, int k) {
    if (gridDim.x != 256) return vb + k * (int)gridDim.x;
    const int x = vb >> 5, l = vb & 31; const int g = 8 * (x & 3) + (l & 7), c = 8 * k + 4 * (x >> 2) + (l >> 3);
    return c * 32 + g;
}
__device__ __forceinline__ void s5c_phase(const Params& p, LAS unsigned char* lds) {
    const int tid = tid_opaque(), wid = __builtin_amdgcn_readfirstlane(tid >> 6), lane = tid & 63, li = lane & 15, g4 = lane >> 4;
    const bf16_t* QKV = (const bf16_t*)(p.ws + WS_R1);
    const bf16_t* Kt = (const bf16_t*)(p.ws + WS_KERN);
    const bf16_t* Gt = (const bf16_t*)(p.ws + WS_S5G);
    const bf16_t* X = (const bf16_t*)(p.ws + WS_S5X);
    bf16_t* Y5 = (bf16_t*)(p.ws + WS_Y5);
    LAS bf16_t* kl = (LAS bf16_t*)lds;
    LAS bf16_t* ul = (LAS bf16_t*)(lds + 32768);
    int gl = -1;
    u32x4 ur[4];
    const int vb = vblock(), nrounds = (2048 + (int)gridDim.x - 1) / (int)gridDim.x;
    { const int item = s5c_item(vb, 0); if (item < 2048) { const int g = item & 31, c = item >> 5;
#pragma unroll
        for (int q = 0; q < 4; ++q) { const int idx = tid + q * NTHR, hh = idx & 1, b = (idx >> 1) & 15, sq = idx >> 5;
            ur[q] = *(const u32x4*)(QKV + ((size_t)b * SEQ + c * 64 + sq) * 2048 + 1536 + g * 16 + hh * 8); } } }
    for (int rk = 0; rk < nrounds; ++rk) {
        const int item = s5c_item(vb, rk); if (item >= 2048) break;
        const int g = item & 31, c = item >> 5;
        __syncthreads();
        if (g != gl) { for (int idx = tid; idx < 2048; idx += NTHR) *(LAS u32x4*)(kl + idx * 8) = *(const u32x4*)(Kt + (size_t)g * 16384 + idx * 8); gl = g; }
#pragma unroll
        for (int q = 0; q < 4; ++q) { const int idx = tid + q * NTHR, hh = idx & 1, b = (idx >> 1) & 15, sq = idx >> 5;
            *(LAS u32x4*)(ul + (sq * 16 + b) * 16 + hh * 8) = ur[q]; }
        { const int nx = (rk + 1 < nrounds) ? s5c_item(vb, rk + 1) : 2048; if (nx < 2048) { const int g2 = nx & 31, c2 = nx >> 5;
#pragma unroll
            for (int q = 0; q < 4; ++q) { const int idx = tid + q * NTHR, hh = idx & 1, b = (idx >> 1) & 15, sq = idx >> 5;
                ur[q] = *(const u32x4*)(QKV + ((size_t)b * SEQ + c2 * 64 + sq) * 2048 + 1536 + g2 * 16 + hh * 8); } } }
        bf16x8 xf[4];
#pragma unroll
        for (int ks = 0; ks < 4; ++ks) xf[ks] = *(const bf16x8*)(X + ((size_t)(c * 32 + g) * 16 + li) * 128 + 32 * ks + 8 * g4);
        bf16x8 gf[8][4];
#pragma unroll
        for (int tt = 0; tt < 8; ++tt)
#pragma unroll
            for (int ks = 0; ks < 4; ++ks) gf[tt][ks] = *(const bf16x8*)(Gt + (size_t)(g * 1024 + (wid + 8 * tt) * 16 + li) * 128 + 32 * ks + 8 * g4);
        __syncthreads();
        const f32x4 dsk = *(const f32x4*)(p.in[20] + g * 16 + 4 * g4);
#pragma unroll
        for (int tt = 0; tt < 8; ++tt) {
            const int t = wid + 8 * tt;
            f32x4 acc = (f32x4){0.f, 0.f, 0.f, 0.f};
#pragma unroll
            for (int ks = 0; ks < 4; ++ks) acc = mfma16(gf[tt][ks], xf[ks], acc);
            const int nks = ((t >> 1) + 4) & ~3;
            for (int ks0 = 0; ks0 < nks; ks0 += 4) {
                u32x4 av[4]; bf16x8 bv[4];
#pragma unroll
                for (int q = 0; q < 4; ++q) { const int s = 2 * (ks0 + q) + (g4 >> 1); int tau = t - s; const bool ok = tau >= 0; tau = ok ? tau : 0;
                    av[q] = *(const LAS u32x4*)(kl + (tau * 16 + li) * 16 + 8 * (g4 & 1));
                    if (!ok) av[q] = (u32x4){0u, 0u, 0u, 0u};
                    bv[q] = *(const LAS bf16x8*)(ul + (s * 16 + li) * 16 + 8 * (g4 & 1)); }
#pragma unroll
                for (int q = 0; q < 4; ++q) acc = mfma16(as_frag(av[q]), bv[q], acc);
            }
            const u32x2 uu = *(const LAS u32x2*)(ul + (t * 16 + li) * 16 + 4 * g4);
            float y0 = acc[0] + dsk[0] * lo_f(uu.x), y1 = acc[1] + dsk[1] * hi_f(uu.x), y2 = acc[2] + dsk[2] * lo_f(uu.y), y3 = acc[3] + dsk[3] * hi_f(uu.y);
            y0 = gelu_tanh(y0); y1 = gelu_tanh(y1); y2 = gelu_tanh(y2); y3 = gelu_tanh(y3);
            *(u32x2*)(Y5 + ((size_t)li * SEQ + c * 64 + t) * 512 + g * 16 + 4 * g4) = (u32x2){pk2(y0, y1), pk2(y2, y3)};
        }
    }
}

#ifndef SB_EARLY_EXIT
#define SB_EARLY_EXIT 1
#endif
template <bool MASKED>
__device__ __forceinline__ void sb_qtile(const bf16x8 (&kf)[4][2], const bf16x8 (&qf)[2], float& R, bf16x8 (&pfr)[2], int li, int g4, int kpos0, int qpos, u32x2 dpat) {
    const unsigned ONES = 0x3F803F80u;
    const float SC = 0.125f * 1.4426950408889634f;
    f32x4 z[4];
#pragma unroll
    for (int kt = 0; kt < 4; ++kt) { f32x4 a = (f32x4){0.f, 0.f, 0.f, 0.f}; a = mfma16(kf[kt][0], qf[0], a); a = mfma16(kf[kt][1], qf[1], a); z[kt] = a; }
    float T = 0.f; unsigned hi[4][2];
#pragma unroll
    for (int kt = 0; kt < 4; ++kt) { float Lv[4];
#pragma unroll
        for (int jj = 0; jj < 4; ++jj) { const float zz = z[kt][jj] * SC;
            const float sp = fmaxf(zz, 0.f) + __builtin_amdgcn_logf(1.f + __builtin_amdgcn_exp2f(-fabsf(zz)));
            if (MASKED) { const bool valid = kpos0 + kt * 16 + jj < qpos; Lv[jj] = valid ? -sp : 0.f; z[kt][jj] = valid ? (zz - sp) : -1e30f; }
            else { Lv[jj] = -sp; z[kt][jj] = zz - sp; }
            T += Lv[jj]; }
        hi[kt][0] = pk2(Lv[0], Lv[1]); hi[kt][1] = pk2(Lv[2], Lv[3]); }
    T += __shfl_xor(T, 16); T += __shfl_xor(T, 32);
    bf16x8 Lh[2];
#pragma unroll
    for (int kk = 0; kk < 2; ++kk) Lh[kk] = as_frag((u32x4){hi[2 * kk][0], hi[2 * kk][1], hi[2 * kk + 1][0], hi[2 * kk + 1][1]});
    unsigned pw[4][2];
#pragma unroll
    for (int st = 0; st < 4; ++st) { f32x4 ce = (f32x4){0.f, 0.f, 0.f, 0.f};
#pragma unroll
        for (int kk = 0; kk < 2; ++kk) { if (2 * kk + 1 >= st) {
            u32x4 ua;
            { const int k0 = 2 * kk, k1 = 2 * kk + 1;
              ua.x = k0 > st ? ONES : (k0 == st ? dpat.x : 0u); ua.y = k0 > st ? ONES : (k0 == st ? dpat.y : 0u);
              ua.z = k1 > st ? ONES : (k1 == st ? dpat.x : 0u); ua.w = k1 > st ? ONES : (k1 == st ? dpat.y : 0u); }
            ce = mfma16(as_frag(ua), Lh[kk], ce); } }
        float w[4];
#pragma unroll
        for (int jj = 0; jj < 4; ++jj) w[jj] = __builtin_amdgcn_exp2f(z[st][jj] + R + ce[jj]);
        pw[st][0] = pk2(w[0], w[1]); pw[st][1] = pk2(w[2], w[3]); }
    R += T;
#pragma unroll
    for (int kk = 0; kk < 2; ++kk) pfr[kk] = as_frag((u32x4){pw[2 * kk][0], pw[2 * kk][1], pw[2 * kk + 1][0], pw[2 * kk + 1][1]});
}
__device__ __forceinline__ void sb_phase(const Params& p, LAS unsigned char* lds) {
    const int tid = tid_opaque(), wid = __builtin_amdgcn_readfirstlane(tid >> 6), lane = tid & 63, li = lane & 15, g4 = lane >> 4;
    const bf16_t* QKV = (const bf16_t*)(p.ws + WS_R1);
    bf16_t* MIX = (bf16_t*)(p.ws + WS_MIX);
    LAS bf16_t* Vl = (LAS bf16_t*)(lds + wid * VL_BYTES);
    const int wv = blockIdx.x * 8 + wid, nw = gridDim.x * 8;
    u32x2 dpat; dpat.x = ((4 * g4 + 0 > li) ? 0x3F80u : 0u) | ((4 * g4 + 1 > li) ? 0x3F800000u : 0u); dpat.y = ((4 * g4 + 2 > li) ? 0x3F80u : 0u) | ((4 * g4 + 3 > li) ? 0x3F800000u : 0u);
    for (int it = wv; it < 8192; it += nw) {
        const int bh = it >> 6, pr = it & 63, b = bh >> 3, h = bh & 7;
        for (int half = 0; half < 2; ++half) {
            const int qtile = half ? 127 - pr : pr, t0 = qtile * 32, kbd = t0 >> 6;
            const bf16_t* qb = QKV + ((size_t)b * SEQ + t0) * 3584 + 2048 + h * 64;
            bf16x8 qf[2][2];
#pragma unroll
            for (int qt = 0; qt < 2; ++qt)
#pragma unroll
                for (int ks = 0; ks < 2; ++ks) qf[qt][ks] = *(const bf16x8*)(qb + (size_t)(qt * 16 + li) * 3584 + 32 * ks + 8 * g4);
            f32x4 o[2][4]; float R[2];
#pragma unroll
            for (int qt = 0; qt < 2; ++qt) { R[qt] = 0.f;
#pragma unroll
                for (int dt = 0; dt < 4; ++dt) o[qt][dt] = (f32x4){0.f, 0.f, 0.f, 0.f}; }
            for (int kb = kbd; kb >= 0; --kb) {
                const bf16_t* kbase = QKV + ((size_t)b * SEQ + kb * 64) * 3584 + 2560 + h * 64;
#pragma unroll
                for (int r = 0; r < 8; ++r) { const int row = r * 8 + (lane >> 3), c8 = lane & 7;
                    *(LAS u32x4*)(Vl + row * VS + c8 * 8) = *(const u32x4*)(kbase + (size_t)row * 3584 + 512 + c8 * 8); }
                bf16x8 kf[4][2];
#pragma unroll
                for (int kt = 0; kt < 4; ++kt)
#pragma unroll
                    for (int ks = 0; ks < 2; ++ks) kf[kt][ks] = *(const bf16x8*)(kbase + (size_t)(kt * 16 + li) * 3584 + 32 * ks + 8 * g4);
                wave_lds_fence();
                const int kpos0 = kb * 64 + 4 * g4;
                bf16x8 pfr[2][2];
                if (kb == kbd) {
#pragma unroll
                    for (int qt = 0; qt < 2; ++qt) sb_qtile<true>(kf, qf[qt], R[qt], pfr[qt], li, g4, kpos0, t0 + qt * 16 + li, dpat);
                } else {
#pragma unroll
                    for (int qt = 0; qt < 2; ++qt) sb_qtile<false>(kf, qf[qt], R[qt], pfr[qt], li, g4, kpos0, t0 + qt * 16 + li, dpat);
                }
                { bf16x8 vf[2][4];
#pragma unroll
                  for (int kk = 0; kk < 2; ++kk)
#pragma unroll
                      for (int dt = 0; dt < 4; ++dt) vf[kk][dt] = tr_pair(Vl, VS, 32 * kk + 4 * g4, 32 * kk + 16 + 4 * g4, dt * 16, li);
#pragma unroll
                  for (int kk = 0; kk < 2; ++kk)
#pragma unroll
                      for (int dt = 0; dt < 4; ++dt)
#pragma unroll
                          for (int qt = 0; qt < 2; ++qt) o[qt][dt] = mfma16(vf[kk][dt], pfr[qt][kk], o[qt][dt]); }
                wave_lds_fence();
#if SB_EARLY_EXIT
                { const float rm = fmaxf(R[0], R[1]); if (__all(rm < -152.f)) break; }
#endif
            }
#pragma unroll
            for (int qt = 0; qt < 2; ++qt)
#pragma unroll
                for (int dt = 0; dt < 4; ++dt) { const f32x4 v = o[qt][dt];
                    *(u32x2*)(MIX + ((size_t)b * SEQ + t0 + qt * 16 + li) * 1024 + 512 + h * 64 + dt * 16 + 4 * g4) = (u32x2){pk2(v[0], v[1]), pk2(v[2], v[3])}; }
        }
    }
}

constexpr int RS = 136;
__device__ __forceinline__ float ret_log_gamma(int h) { return logf(1.f - exp2f(-5.f - (float)h)); }
struct RotRegs { u32x4 a, b; };
struct RopeRegs { f32x2 cs[8]; };
struct PlainRegs { u32x4 a, b; };
__device__ __forceinline__ void rot_ld(RotRegs& r, const bf16_t* src  , int j, int part) { r.a = *(const u32x4*)(src + (size_t)j * 3584 + part * 8); r.b = *(const u32x4*)(src + (size_t)j * 3584 + 64 + part * 8); }
__device__ __forceinline__ void rope_ld(RopeRegs& r, const f32x2* rope, int pos, int part) {
#pragma unroll
    for (int e = 0; e < 8; ++e) r.cs[e] = rope[(size_t)pos * 64 + part * 8 + e]; }
__device__ __forceinline__ void plain_ld(PlainRegs& r, const bf16_t* src, int j, int part) { r.a = *(const u32x4*)(src + (size_t)j * 3584 + part * 16); r.b = *(const u32x4*)(src + (size_t)j * 3584 + part * 16 + 8); }
__device__ __forceinline__ void rot_st(const RotRegs& r, const RopeRegs& c, LAS bf16_t* dst, int j, int part, float rsc) {
    const float x1[8] = {lo_f(r.a.x), hi_f(r.a.x), lo_f(r.a.y), hi_f(r.a.y), lo_f(r.a.z), hi_f(r.a.z), lo_f(r.a.w), hi_f(r.a.w)};
    const float x2[8] = {lo_f(r.b.x), hi_f(r.b.x), lo_f(r.b.y), hi_f(r.b.y), lo_f(r.b.z), hi_f(r.b.z), lo_f(r.b.w), hi_f(r.b.w)};
    float o1[8], o2[8];
#pragma unroll
    for (int e = 0; e < 8; ++e) { const f32x2 cc = c.cs[e]; o1[e] = (x1[e] * cc.x - x2[e] * cc.y) * rsc; o2[e] = (x1[e] * cc.y + x2[e] * cc.x) * rsc; }
    *(LAS u32x4*)(dst + j * RS + part * 8) = (u32x4){pk2(o1[0], o1[1]), pk2(o1[2], o1[3]), pk2(o1[4], o1[5]), pk2(o1[6], o1[7])};
    *(LAS u32x4*)(dst + j * RS + 64 + part * 8) = (u32x4){pk2(o2[0], o2[1]), pk2(o2[2], o2[3]), pk2(o2[4], o2[5]), pk2(o2[6], o2[7])};
}
__device__ __forceinline__ void plain_st(const PlainRegs& r, LAS bf16_t* dst, int j, int part) { *(LAS u32x4*)(dst + j * RS + part * 16) = r.a; *(LAS u32x4*)(dst + j * RS + part * 16 + 8) = r.b; }

__device__ __forceinline__ void reta_phase(const Params& p, LAS unsigned char* lds) {
    const int tid = tid_opaque(), wid = __builtin_amdgcn_readfirstlane(tid >> 6), lane = tid & 63, li = lane & 15, g4 = lane >> 4;
    const int j = tid >> 3, part = tid & 7;
    const bf16_t* QKV = (const bf16_t*)(p.ws + WS_R1);
    const f32x2* rope = (const f32x2*)(p.ws + WS_ROPE);
    bf16_t* RET = (bf16_t*)(p.ws + WS_H);
    LAS bf16_t* Kl = (LAS bf16_t*)lds; LAS bf16_t* Vl = (LAS bf16_t*)(lds + 64 * RS * 2);
    RotRegs kr; RopeRegs cr; PlainRegs vr;
    { const int item = blockIdx.x; if (item < 4096) { const int c = item & 63, hh = (item >> 6) & 3, b = item >> 8; const bf16_t* base = QKV + ((size_t)b * SEQ + c * 64) * 3584 + hh * 128;
        rot_ld(kr, base + 512, j, part); rope_ld(cr, rope, c * 64 + j, part); plain_ld(vr, base + 1024, j, part); } }
    for (int item = blockIdx.x; item < 4096; item += gridDim.x) {
        const int c = item & 63, hh = (item >> 6) & 3, b = item >> 8;
        const float lg = ret_log_gamma(hh);
        __syncthreads();
        rot_st(kr, cr, Kl, j, part, 0.08838834764831845f * __expf(lg * (63.f - (float)j)));
        plain_st(vr, Vl, j, part);
        { const int nx = item + gridDim.x; if (nx < 4096) { const int c2 = nx & 63, h2 = (nx >> 6) & 3, b2 = nx >> 8; const bf16_t* base = QKV + ((size_t)b2 * SEQ + c2 * 64) * 3584 + h2 * 128;
            rot_ld(kr, base + 512, j, part); rope_ld(cr, rope, c2 * 64 + j, part); plain_ld(vr, base + 1024, j, part); } }
        __syncthreads();
        f32x4 acc[8];
#pragma unroll
        for (int et = 0; et < 8; ++et) acc[et] = (f32x4){0.f, 0.f, 0.f, 0.f};
#pragma unroll
        for (int kk = 0; kk < 2; ++kk) { const bf16x8 af = tr_pair(Kl, RS, 32 * kk + 8 * g4, 32 * kk + 8 * g4 + 4, wid * 16, li);
#pragma unroll
            for (int et = 0; et < 8; ++et) { const bf16x8 bfr = tr_pair(Vl, RS, 32 * kk + 8 * g4, 32 * kk + 8 * g4 + 4, et * 16, li); acc[et] = mfma16(af, bfr, acc[et]); } }
        const size_t sid = (size_t)((b * 4 + hh) * 64 + c);
#pragma unroll
        for (int et = 0; et < 8; ++et) *(u32x2*)(RET + (sid * 128 + et * 16 + li) * 128 + wid * 16 + 4 * g4) = (u32x2){pk2(acc[et][0], acc[et][1]), pk2(acc[et][2], acc[et][3])};
    }
}
__device__ __forceinline__ void retscan_phase(const Params& p) {
    bf16_t* RET = (bf16_t*)(p.ws + WS_H);
    const int gtid = blockIdx.x * NTHR + tid_opaque(), nthr = gridDim.x * NTHR;
    for (int w = gtid; w < 64 * 2048; w += nthr) {
        const int bhh = w >> 11, e8 = w & 2047, hh = bhh & 3;
        const float cd = __expf(64.f * ret_log_gamma(hh));
        float S[8];
#pragma unroll
        for (int e = 0; e < 8; ++e) S[e] = 0.f;
        bf16_t* base = RET + (size_t)bhh * 64 * 16384 + e8 * 8;
        for (int c0 = 0; c0 < 64; c0 += 4) {
            u32x4 kv[4];
#pragma unroll
            for (int k = 0; k < 4; ++k) kv[k] = *(const u32x4*)(base + (size_t)(c0 + k) * 16384);
#pragma unroll
            for (int k = 0; k < 4; ++k) {
                *(u32x4*)(base + (size_t)(c0 + k) * 16384) = (u32x4){pk2(S[0], S[1]), pk2(S[2], S[3]), pk2(S[4], S[5]), pk2(S[6], S[7])};
                S[0] = S[0] * cd + lo_f(kv[k].x); S[1] = S[1] * cd + hi_f(kv[k].x); S[2] = S[2] * cd + lo_f(kv[k].y); S[3] = S[3] * cd + hi_f(kv[k].y);
                S[4] = S[4] * cd + lo_f(kv[k].z); S[5] = S[5] * cd + hi_f(kv[k].z); S[6] = S[6] * cd + lo_f(kv[k].w); S[7] = S[7] * cd + hi_f(kv[k].w); }
        }
    }
}
__device__ __forceinline__ void retc_phase(const Params& p, LAS unsigned char* lds) {
    const int tid = tid_opaque(), wid = __builtin_amdgcn_readfirstlane(tid >> 6), lane = tid & 63, li = lane & 15, g4 = lane >> 4;
    const bf16_t* QKV = (const bf16_t*)(p.ws + WS_R1);
    const f32x2* rope = (const f32x2*)(p.ws + WS_ROPE);
    const bf16_t* RET = (const bf16_t*)(p.ws + WS_H);
    bf16_t* MIX = (bf16_t*)(p.ws + WS_MIX);
    LAS bf16_t* Ql = (LAS bf16_t*)lds; LAS bf16_t* Kl = (LAS bf16_t*)(lds + 17408); LAS bf16_t* Vl = (LAS bf16_t*)(lds + 34816);
    LAS bf16_t* Sl = (LAS bf16_t*)(lds + 52224);
    LAS f32x2* stl = (LAS f32x2*)(lds + 61440);
    const int j = tid >> 3, part = tid & 7;
    RotRegs qr, kr; RopeRegs cr; PlainRegs vr;
    { const int item = blockIdx.x; if (item < 4096) { const int c = item & 63, hh = (item >> 6) & 3, b = item >> 8; const bf16_t* base = QKV + ((size_t)b * SEQ + c * 64) * 3584 + hh * 128;
        rot_ld(qr, base, j, part); rot_ld(kr, base + 512, j, part); rope_ld(cr, rope, c * 64 + j, part); plain_ld(vr, base + 1024, j, part); } }
    for (int item = blockIdx.x; item < 4096; item += gridDim.x) {
        const int c = item & 63, hh = (item >> 6) & 3, b = item >> 8;
        const float lg = ret_log_gamma(hh);
        const size_t row0 = (size_t)b * SEQ + c * 64;
        const size_t sid = (size_t)((b * 4 + hh) * 64 + c);
        bf16x8 stf[4]; u32x2 gg[4];
#pragma unroll
        for (int ks = 0; ks < 4; ++ks) stf[ks] = *(const bf16x8*)(RET + (sid * 128 + wid * 16 + li) * 128 + 32 * ks + 8 * g4);
#pragma unroll
        for (int itq = 0; itq < 4; ++itq) gg[itq] = *(const u32x2*)(QKV + (row0 + itq * 16 + li) * 3584 + 1536 + hh * 128 + wid * 16 + 4 * g4);
        __syncthreads();
        rot_st(qr, cr, Ql, j, part, 1.f);
        rot_st(kr, cr, Kl, j, part, 0.08838834764831845f);
        plain_st(vr, Vl, j, part);
        { const int nx = item + gridDim.x; if (nx < 4096) { const int c2 = nx & 63, h2 = (nx >> 6) & 3, b2 = nx >> 8; const bf16_t* base = QKV + ((size_t)b2 * SEQ + c2 * 64) * 3584 + h2 * 128;
            rot_ld(qr, base, j, part); rot_ld(kr, base + 512, j, part); rope_ld(cr, rope, c2 * 64 + j, part); plain_ld(vr, base + 1024, j, part); } }
        __syncthreads();
        { const int jt = wid >> 1;
#pragma unroll
          for (int e2 = 0; e2 < 2; ++e2) { const int itq = 2 * (wid & 1) + e2; f32x4 sacc = (f32x4){0.f, 0.f, 0.f, 0.f};
#pragma unroll
              for (int ks = 0; ks < 4; ++ks) { const bf16x8 af = *(const LAS bf16x8*)(Kl + (jt * 16 + li) * RS + 32 * ks + 8 * g4); const bf16x8 bfr = *(const LAS bf16x8*)(Ql + (itq * 16 + li) * RS + 32 * ks + 8 * g4); sacc = mfma16(af, bfr, sacc); }
              float sv[4];
#pragma unroll
              for (int jj = 0; jj < 4; ++jj) { const int j = jt * 16 + 4 * g4 + jj, iq = itq * 16 + li; const int dd = iq > j ? iq - j : j - iq; sv[jj] = sacc[jj] * __expf(lg * (float)dd); }
              *(LAS u32x2*)(Sl + (itq * 16 + li) * VS + jt * 16 + 4 * g4) = (u32x2){pk2(sv[0], sv[1]), pk2(sv[2], sv[3])}; } }
        __syncthreads();
        f32x4 oa[4];
#pragma unroll
        for (int itq = 0; itq < 4; ++itq) oa[itq] = (f32x4){0.f, 0.f, 0.f, 0.f};
#pragma unroll
        for (int ks = 0; ks < 4; ++ks) { const bf16x8 af = stf[ks];
#pragma unroll
            for (int itq = 0; itq < 4; ++itq) { const bf16x8 bfr = *(const LAS bf16x8*)(Ql + (itq * 16 + li) * RS + 32 * ks + 8 * g4); oa[itq] = mfma16(af, bfr, oa[itq]); } }
#pragma unroll
        for (int itq = 0; itq < 4; ++itq) oa[itq] *= __expf(lg * (float)(itq * 16 + li + 1));
#pragma unroll
        for (int kk = 0; kk < 2; ++kk) { const bf16x8 af = tr_pair(Vl, RS, 32 * kk + 8 * g4, 32 * kk + 8 * g4 + 4, wid * 16, li);
#pragma unroll
            for (int itq = 0; itq < 4; ++itq) { const bf16x8 bfr = *(const LAS bf16x8*)(Sl + (itq * 16 + li) * VS + 32 * kk + 8 * g4); oa[itq] = mfma16(af, bfr, oa[itq]); } }
#pragma unroll
        for (int itq = 0; itq < 4; ++itq) { float s1 = oa[itq][0] + oa[itq][1] + oa[itq][2] + oa[itq][3];
            float s2 = oa[itq][0] * oa[itq][0] + oa[itq][1] * oa[itq][1] + oa[itq][2] * oa[itq][2] + oa[itq][3] * oa[itq][3];
            s1 += __shfl_xor(s1, 16); s1 += __shfl_xor(s1, 32); s2 += __shfl_xor(s2, 16); s2 += __shfl_xor(s2, 32);
            if (g4 == 0) stl[wid * 64 + itq * 16 + li] = (f32x2){s1, s2}; }
        __syncthreads();
        const f32x4 ng = *(const f32x4*)(p.in[25] + hh * 128 + wid * 16 + 4 * g4);
#pragma unroll
        for (int itq = 0; itq < 4; ++itq) { float s1 = 0.f, s2 = 0.f;
#pragma unroll
            for (int w8 = 0; w8 < 8; ++w8) { const f32x2 t = stl[w8 * 64 + itq * 16 + li]; s1 += t.x; s2 += t.y; }
            const float mu = s1 * (1.f / 128.f), var = fmaxf(s2 * (1.f / 128.f) - mu * mu, 0.f), rs = rsqrtf(var + 1e-6f);
            const size_t row = row0 + itq * 16 + li;
            const float r0 = (oa[itq][0] - mu) * rs * ng[0] * silu_f(lo_f(gg[itq].x)), r1 = (oa[itq][1] - mu) * rs * ng[1] * silu_f(hi_f(gg[itq].x));
            const float r2 = (oa[itq][2] - mu) * rs * ng[2] * silu_f(lo_f(gg[itq].y)), r3 = (oa[itq][3] - mu) * rs * ng[3] * silu_f(hi_f(gg[itq].y));
            *(u32x2*)(MIX + row * 1024 + hh * 128 + wid * 16 + 4 * g4) = (u32x2){pk2(r0, r1), pk2(r2, r3)}; }
    }
}

constexpr int N_PHASES = 20;
__global__ void __launch_bounds__(NTHR, 2) mega_fwd(Params p) {
    extern __shared__ __attribute__((aligned(16))) unsigned char lds_raw[];
    LAS unsigned char* lds = (LAS unsigned char*)lds_raw;
    cg::grid_group grid = cg::this_grid();
    unsigned char* ws = p.ws;
    const float* MOD = (const float*)(ws + WS_MOD);
    bf16_t* H = (bf16_t*)(ws + WS_H); bf16_t* MIX = (bf16_t*)(ws + WS_MIX); bf16_t* R1 = (bf16_t*)(ws + WS_R1);
    float* XA = p.out;
    pg8::StaticOrder S;
#ifndef PROBE_MASK
#define PROBE_MASK 0u
#endif
    unsigned long long probe_acc = 0ull;
    unsigned bar_gen = 0u;
    for (int ph = p.ph_lo; ph < p.ph_hi; ++ph) {
        const unsigned long long probe_t0 = PROBE_MASK ? __builtin_amdgcn_s_memrealtime() : 0ull;
        const int layer = ph >= 11 ? 1 : 0;
        const float* modl = MOD + (size_t)layer * 16 * 6144;
        switch (ph) {
        case 0: prep_phase(p, lds); break;
        case 1: case 8: case 11: case 17: {
            const bool ffn = (ph == 8 || ph == 17);
            const float* xin = (ph == 1) ? p.in[0] : XA;
            norm_phase(xin, (ffn ? p.in[5] : p.in[4]) + layer * 1024, modl + (ffn ? 3072 : 0), modl + (ffn ? 4096 : 1024), H);
        } break;
        case 2: {
            pg8::Gemm g{H, (const bf16_t*)(ws + WS_W_ABIN), MTOK, 2048, 1024};
            S.init(MTOK, 2048, gridDim.x, blockIdx.x);
            pg8::EpiStoreQK E{R1, p.in[10], p.in[11]};
            pg8::gemm_phase(lds, g, S, E);
        } break;
        case 12: {
            pg8::Gemm g{H, (const bf16_t*)(ws + WS_W_CDIN), MTOK, 3584, 1024};
            S.init(MTOK, 3584, gridDim.x, blockIdx.x);
            pg8::EpiStore E{R1, 3584};
            pg8::gemm_phase(lds, g, S, E);
        } break;
        case 3: attnA_phase(p, lds); break;
        case 4: s5scan_phase(p); break;
        case 5: s5c_phase(p, lds); break;
        case 6: {
            pg8::Gemm g{(const bf16_t*)(ws + WS_Y5), (const bf16_t*)(ws + WS_W_GLU), MTOK, 512, 512};
            S.init(MTOK, 512, gridDim.x, blockIdx.x);
            pg8::EpiGlu E{(const bf16_t*)(ws + WS_Y5), p.in[22], MIX};
            pg8::gemm_phase(lds, g, S, E);
        } break;
        case 7: case 16: case 10: case 19: {
            const bool ffn = (ph == 10 || ph == 19);
            const bf16_t* A = ffn ? R1 : MIX;
            const bf16_t* Bt = ffn ? (const bf16_t*)(ws + WS_W_FFOUT) + (size_t)layer * 1024 * FFH : (const bf16_t*)(ws + (layer ? WS_W_CDOUT : WS_W_ABOUT));
            pg8::Gemm g{A, Bt, MTOK, 1024, ffn ? FFH : 1024};
            S.init(MTOK, 1024, gridDim.x, blockIdx.x);
            pg8::EpiResid E{(ph == 7) ? p.in[0] : XA, XA, modl + (ffn ? 5120 : 2048)};
            pg8::gemm_phase(lds, g, S, E);
        } break;
        case 9: case 18: {
            pg8::Gemm g{H, (const bf16_t*)(ws + WS_W_FFIN) + (size_t)layer * 5632 * 1024, MTOK, 5632, 1024};
            S.init(MTOK, 5632, gridDim.x, blockIdx.x);
            pg8::EpiSwiglu E{R1};
            pg8::gemm_phase(lds, g, S, E);
        } break;
        case 13: reta_phase(p, lds); __syncthreads(); sb_phase(p, lds); break;
        case 14: retscan_phase(p); break;
        case 15: retc_phase(p, lds); break;
        default: break;
        }
        unsigned long long probe_t1 = 0ull;
        if (PROBE_MASK) { __syncthreads(); probe_t1 = __builtin_amdgcn_s_memrealtime(); if ((PROBE_MASK >> ph) & 1u) probe_acc += probe_t1 - probe_t0; }
        if (ph + 1 < p.ph_hi) {
            if (p.ph_hi > 1000) grid.sync();
            grid_barrier((unsigned*)(ws + WS_CTL), bar_gen);
        }
        if (PROBE_MASK && ((PROBE_MASK >> 20) & 1u)) probe_acc += __builtin_amdgcn_s_memrealtime() - probe_t1;
    }
    if (PROBE_MASK && blockIdx.x == 0 && threadIdx.x == 0) { const unsigned long long st = __builtin_amdgcn_s_memrealtime(); while (__builtin_amdgcn_s_memrealtime() - st < probe_acc) __builtin_amdgcn_s_sleep(8); }
}


#ifndef DIAG
#define DIAG 0
#endif
#if DIAG
__global__ void diag_fold(Params p) {
    const size_t n = (size_t)MTOK * 1024; unsigned char* ws = p.ws;
    for (size_t i = (size_t)blockIdx.x * blockDim.x + threadIdx.x; i < n; i += (size_t)gridDim.x * blockDim.x) {
        const size_t row = i >> 10; const int col = (int)(i & 1023); float v = 0.f;
#if DIAG == 30
        v = col < 512 ? bf2f(((const bf16_t*)(ws + WS_MIX))[i]) : 0.f;
#elif DIAG == 31
        v = ((const float*)(ws + WS_S5E))[i & 4194303];
#elif DIAG == 3
        v = col < 512 ? bf2f(((const bf16_t*)(ws + WS_MIX))[i]) : ((const float*)(ws + WS_S5E))[(row * 512 + col - 512) & 4194303];
#elif DIAG == 2
        v = bf2f(((const bf16_t*)(ws + WS_R1))[2 * i]) + bf2f(((const bf16_t*)(ws + WS_R1))[2 * i + 1]);
#elif DIAG == 1
        v = bf2f(((const bf16_t*)(ws + WS_H))[i]);
#elif DIAG == 5
        v = bf2f(((const bf16_t*)(ws + WS_Y5))[i >> 1]);
#elif DIAG == 6
        v = bf2f(((const bf16_t*)(ws + WS_MIX))[i]);
#endif
        p.out[i] = v;
    }
}
#endif
#ifndef MK_MULTI
#define MK_MULTI 0
#endif
extern "C" void kernel_launch(void* const* d_in, const int* in_sizes, int n_in, void* d_out, int out_size, void* d_ws, size_t ws_size, hipStream_t stream) {
    static int grid = 0;
    if (grid == 0) {
        if (n_in != 26 || out_size != MTOK * DM || ws_size < WS_END) { fprintf(stderr, "kernel_launch: unexpected shapes (n_in %d out %d ws %zu need %zu)\n", n_in, out_size, ws_size, (size_t)WS_END); grid = -1; return; }
        int dev = 0, cus = 0, per_cu = 0;
        hipGetDevice(&dev); hipDeviceGetAttribute(&cus, hipDeviceAttributeMultiprocessorCount, dev);
        if (hipFuncSetAttribute((const void*)mega_fwd, hipFuncAttributeMaxDynamicSharedMemorySize, LDS_BYTES) != hipSuccess) { fprintf(stderr, "kernel_launch: hipFuncSetAttribute failed\n"); grid = -1; return; }
        if (hipOccupancyMaxActiveBlocksPerMultiprocessor(&per_cu, (const void*)mega_fwd, NTHR, LDS_BYTES) != hipSuccess || per_cu < 1) { fprintf(stderr, "kernel_launch: occupancy query says %d\n", per_cu); per_cu = 1; }
        (void)hipGetLastError();
        grid = cus * 1;
    }
    if (grid < 0) return;
    Params p{};
    for (int i = 0; i < 26; ++i) p.in[i] = (const float*)d_in[i];
    p.out = (float*)d_out; p.ws = (unsigned char*)d_ws;
#if MK_MULTI
#if DIAG
    for (int ph = 0; ph <= (DIAG >= 30 ? DIAG / 10 : DIAG); ++ph) { p.ph_lo = ph; p.ph_hi = ph + 1; hipLaunchKernelGGL(mega_fwd, dim3(grid), dim3(NTHR), LDS_BYTES, stream, p); }
    hipLaunchKernelGGL(diag_fold, dim3(2048), dim3(256), 0, stream, p);
#else
    for (int ph = 0; ph < N_PHASES; ++ph) { p.ph_lo = ph; p.ph_hi = ph + 1; hipLaunchKernelGGL(mega_fwd, dim3(grid), dim3(NTHR), LDS_BYTES, stream, p); }
#endif
#else
    p.ph_lo = 0; p.ph_hi = N_PHASES;
    (void)hipMemsetAsync((char*)d_ws + WS_CTL, 0, 4096, stream);
    void* args[] = {&p};
    hipError_t e = hipLaunchCooperativeKernel((const void*)mega_fwd, dim3(grid), dim3(NTHR), args, LDS_BYTES, stream);
    if (e != hipSuccess) fprintf(stderr, "cooperative launch failed: %s (grid %d)\n", hipGetErrorString(e), grid);
#endif
}
```

```cpp
#include <hip/hip_runtime.h>
#include <hip/hip_cooperative_groups.h>
#include <cstdio>
namespace cg = cooperative_groups;

#define LAS __attribute__((address_space(3)))
typedef unsigned short bf16_t;
typedef short bf16x8 __attribute__((ext_vector_type(8)));
typedef short s16x4 __attribute__((ext_vector_type(4)));
typedef float f32x4 __attribute__((ext_vector_type(4)));
typedef float f32x2 __attribute__((ext_vector_type(2)));
typedef unsigned u32x4 __attribute__((ext_vector_type(4)));
typedef unsigned u32x2 __attribute__((ext_vector_type(2)));

constexpr int NB = 16, SEQ = 4096, DM = 1024, MTOK = NB * SEQ, FFH = 2816;
constexpr int NTHR = 512;
constexpr int LDS_BYTES = 135168;

constexpr size_t al256(size_t x) { return (x + 255) & ~(size_t)255; }
constexpr size_t WS_CTL = 0;
constexpr size_t WS_W_ABIN = 4096;
constexpr size_t WS_W_ABOUT = WS_W_ABIN + (size_t)2048 * 1024 * 2;
constexpr size_t WS_W_GLU = WS_W_ABOUT + (size_t)1024 * 1024 * 2;
constexpr size_t WS_W_FFIN = WS_W_GLU + (size_t)512 * 512 * 2;
constexpr size_t WS_W_FFOUT = WS_W_FFIN + (size_t)2 * 5632 * 1024 * 2;
constexpr size_t WS_W_CDIN = WS_W_FFOUT + (size_t)2 * 1024 * 2816 * 2;
constexpr size_t WS_W_CDOUT = WS_W_CDIN + (size_t)3584 * 1024 * 2;
constexpr size_t WS_MOD = WS_W_CDOUT + (size_t)1024 * 1024 * 2;
constexpr size_t WS_ROPE = WS_MOD + (size_t)2 * 16 * 6144 * 4;
constexpr size_t WS_KERN = WS_ROPE + (size_t)4096 * 64 * 8;
constexpr size_t WS_S5M = WS_KERN + (size_t)32 * 64 * 256 * 2;
constexpr size_t WS_S5G = WS_S5M + (size_t)32 * 128 * 1024 * 2;
constexpr size_t WS_A64 = WS_S5G + (size_t)32 * 1024 * 128 * 2;
constexpr size_t WS_S5E = WS_A64 + (size_t)32 * 64 * 8;
constexpr size_t WS_S5X = WS_S5E + (size_t)64 * 32 * 16 * 128 * 4;
constexpr size_t WS_Y5 = WS_S5X + (size_t)64 * 32 * 16 * 128 * 2;
constexpr size_t WS_H = WS_Y5 + (size_t)MTOK * 512 * 2;
constexpr size_t WS_MIX = WS_H + (size_t)MTOK * 1024 * 2;
constexpr size_t WS_R1 = WS_MIX + (size_t)MTOK * 1024 * 2;
constexpr size_t WS_END = WS_R1 + (size_t)MTOK * 3584 * 2;

struct Params {
    const float* in[26];
    float* out;
    unsigned char* ws;
    int ph_lo, ph_hi;
};

__device__ __forceinline__ float bf2f(unsigned short b) { return __uint_as_float(((unsigned)b) << 16); }
typedef __bf16 bf16x2_t __attribute__((ext_vector_type(2)));
__device__ __forceinline__ unsigned pk2(float lo, float hi) { const f32x2 v = {lo, hi}; return __builtin_bit_cast(unsigned, __builtin_convertvector(v, bf16x2_t)); }
__device__ __forceinline__ bf16_t f2bf(float f) { return (bf16_t)(pk2(f, 0.f) & 0xffffu); }
__device__ __forceinline__ float lo_f(unsigned u) { return __uint_as_float(u << 16); }
__device__ __forceinline__ float hi_f(unsigned u) { return __uint_as_float(u & 0xffff0000u); }
__device__ __forceinline__ bf16x8 as_frag(u32x4 u) { return __builtin_bit_cast(bf16x8, u); }
__device__ __forceinline__ f32x4 mfma16(bf16x8 a, bf16x8 b, f32x4 c) { return __builtin_amdgcn_mfma_f32_16x16x32_bf16(a, b, c, 0, 0, 0); }
__device__ __forceinline__ float silu_f(float x) { return x * __builtin_amdgcn_rcpf(1.f + __expf(-x)); }
__device__ __forceinline__ float sigm_f(float x) { return __builtin_amdgcn_rcpf(1.f + __expf(-x)); }
__device__ __forceinline__ float gelu_tanh(float x) {
    const float u = 0.7978845608028654f * (x + 0.044715f * x * x * x);
    const float t = 1.f - 2.f * __builtin_amdgcn_rcpf(1.f + __expf(2.f * u));
    return 0.5f * x * (1.f + t);
}
__device__ __forceinline__ bf16x8 tr_pair(LAS bf16_t* base, int stride, int row0, int row1, int col0, int li) {
    const int q = li >> 2, pq = li & 3;
    s16x4 a = __builtin_amdgcn_ds_read_tr16_b64_v4i16((LAS s16x4*)(base + (row0 + q) * stride + col0 + 4 * pq));
    s16x4 b = __builtin_amdgcn_ds_read_tr16_b64_v4i16((LAS s16x4*)(base + (row1 + q) * stride + col0 + 4 * pq));
    bf16x8 r = {a[0], a[1], a[2], a[3], b[0], b[1], b[2], b[3]};
    return r;
}
__device__ __forceinline__ int tid_opaque() { int t = threadIdx.x; asm volatile("" : "+v"(t)); return t; }
__device__ __forceinline__ int vblock() { const int G = gridDim.x, bx = blockIdx.x; return (G % 8 == 0) ? (bx % 8) * (G / 8) + bx / 8 : bx; }
__device__ __forceinline__ void wave_lds_fence() { asm volatile("s_waitcnt lgkmcnt(0)" ::: "memory"); __builtin_amdgcn_wave_barrier(); }


__device__ __forceinline__ void grid_barrier(unsigned* w, unsigned& gen) {
    asm volatile("s_waitcnt vmcnt(0) lgkmcnt(0)" ::: "memory");
    __syncthreads();
    if (threadIdx.x == 0) {
        __builtin_amdgcn_fence(__ATOMIC_RELEASE, "agent");
        asm volatile("s_waitcnt vmcnt(0) lgkmcnt(0)" ::: "memory");
        const unsigned G = gridDim.x, grp = blockIdx.x & 7u, ngrp = (G - grp + 7u) / 8u, ngroups = G < 8u ? G : 8u;
        const unsigned old = __hip_atomic_fetch_add(w + 32 * grp, 1u, __ATOMIC_RELAXED, __HIP_MEMORY_SCOPE_AGENT);
        if (old + 1u == ngrp * (gen + 1u)) {
            const unsigned old2 = __hip_atomic_fetch_add(w + 256, 1u, __ATOMIC_RELAXED, __HIP_MEMORY_SCOPE_AGENT);
            if (old2 + 1u == ngroups * (gen + 1u)) __hip_atomic_fetch_add(w + 288, 1u, __ATOMIC_RELAXED, __HIP_MEMORY_SCOPE_AGENT);
        }
        while (__hip_atomic_load(w + 288, __ATOMIC_RELAXED, __HIP_MEMORY_SCOPE_AGENT) == gen) __builtin_amdgcn_s_sleep(2);
        __builtin_amdgcn_fence(__ATOMIC_ACQUIRE, "agent");
        asm volatile("s_waitcnt vmcnt(0) lgkmcnt(0)" ::: "memory");
    }
    ++gen;
    __syncthreads();
}

namespace pg8 {
constexpr int BM = 256, BK = 64, HALF = 128, HTB = HALF * BK * 2, STAGE_BYTES = 8 * HTB, NXCD = 8, WGM = 8;
__device__ __forceinline__ int lds_byte(int r, int c) { const int st = (r >> 4) * 2 + (c >> 5), rr = r & 15, cc = c & 31, ob = rr * 64 + cc * 2; return st * 1024 + (ob ^ (((ob >> 9) & 1) << 5)); }
__device__ __forceinline__ void stage_rc(int b, int& R, int& C) { const int st = b / 1024, sb = b % 1024, swz = sb ^ (((sb >> 9) & 1) << 5); R = (st >> 1) * 16 + swz / 64; C = (st & 1) * 32 + (swz % 64) / 2; }
__device__ __forceinline__ int perm32(int rho) { const int n = rho >> 4, i = rho & 15; return 8 * (i >> 2) + 4 * n + (i & 3); }
struct Unit { int pm, pn; };
struct Gemm { const bf16_t* A; const bf16_t* Bt; int M, N, K; };
struct StaticOrder {
    int nM, nN, nwg, G, c;
    __device__ void init(int M, int N, int G_, int c_) { nM = M / BM; nN = N / BM; nwg = nM * nN; G = G_; c = c_; }
    __device__ bool next(int i, Unit& u) const {
        const long L = (long)i * G + c; if (L >= nwg) return false;
        int wgid = (int)L; { const int q = nwg / NXCD, r = nwg % NXCD, xcd = wgid % NXCD, off = wgid / NXCD; wgid = (xcd < r ? xcd * (q + 1) : r * (q + 1) + (xcd - r) * q) + off; }
        const int nig = WGM * nN, gid = wgid / nig, fm = gid * WGM, gsz = (nM - fm) < WGM ? (nM - fm) : WGM;
        u.pm = fm + ((wgid % nig) % gsz); u.pn = (wgid % nig) / gsz; return true;
    }
};

template <class Epi>
__device__ __forceinline__ void gemm_phase(LAS unsigned char* lds, const Gemm g, const StaticOrder& S, const Epi& E) {
    const int tid = tid_opaque(), wid = __builtin_amdgcn_readfirstlane(tid >> 6), lane = tid & 63, wr = wid >> 2, wc = wid & 3, fr = lane & 15, fq = lane >> 4;
    const int K = g.K, nt = K / BK;
    unsigned voffA[2], voffB[2];
#pragma unroll
    for (int i = 0; i < 2; ++i) { int R, C; stage_rc(tid * 16 + i * 8192, R, C); const int Rb = Epi::PERM ? ((R & ~31) + perm32(R & 31)) : R;
        voffA[i] = (unsigned)(R * K + C) * 2u; voffB[i] = (unsigned)(Rb * K + C) * 2u; }
    const size_t kstep = (size_t)(BK * 2);
    const size_t hstep = (size_t)HALF * K * 2;
    const size_t tstep = 2 * hstep;
    const unsigned ldsw = (unsigned)wid * 1024u;
    const int aoff = lds_byte(wr * 64 + fr, fq * 8), boff = lds_byte(wc * 32 + fr, fq * 8);
#define PG8_SA(b, h) (((b) * 2 + (h)) * HTB)
#define PG8_SB(b, h) ((4 + (b) * 2 + (h)) * HTB)
#define PG8_STAGE(bufoff, gbase, voff) do { _Pragma("unroll") for (int _i = 0; _i < 2; ++_i) \
        __builtin_amdgcn_global_load_lds((const unsigned*)((const char*)(gbase) + (voff)[_i]), (LAS unsigned*)(lds + (bufoff) + ldsw + _i * 8192), 16, 0, 0); } while (0)
#define PG8_LDA(dst, b, h) do { _Pragma("unroll") for (int m = 0; m < 4; ++m) _Pragma("unroll") for (int k = 0; k < 2; ++k) dst[m][k] = *(const LAS bf16x8*)(lds + PG8_SA(b, h) + aoff + m * 2048 + k * 1024); } while (0)
#define PG8_LDB(dst, b, h) do { _Pragma("unroll") for (int n = 0; n < 2; ++n) _Pragma("unroll") for (int k = 0; k < 2; ++k) dst[n][k] = *(const LAS bf16x8*)(lds + PG8_SB(b, h) + boff + n * 2048 + k * 1024); } while (0)
#define PG8_MMA(ai, bj, At, Bt) do { __builtin_amdgcn_s_setprio(1); _Pragma("unroll") for (int m = 0; m < 4; ++m) _Pragma("unroll") for (int n = 0; n < 2; ++n) _Pragma("unroll") for (int k = 0; k < 2; ++k) \
        acc[ai][bj][m][n] = __builtin_amdgcn_mfma_f32_16x16x32_bf16(Bt[n][k], At[m][k], acc[ai][bj][m][n], 0, 0, 0); __builtin_amdgcn_s_setprio(0); } while (0)
#define PG8_WAIT_V(n) asm volatile("s_waitcnt vmcnt(" #n ")" ::: "memory")
#define PG8_WAIT_L(n) asm volatile("s_waitcnt lgkmcnt(" #n ")" ::: "memory")
#define PG8_BAR __builtin_amdgcn_s_barrier()
#define PG8_SCHED __builtin_amdgcn_sched_barrier(0)
    Unit cur, nxt; int ui = 0;
    if (!S.next(0, cur)) return;
    f32x4 acc[2][2][4][2];
#pragma unroll
    for (int a = 0; a < 2; ++a)
#pragma unroll
        for (int b = 0; b < 2; ++b)
#pragma unroll
            for (int m = 0; m < 4; ++m)
#pragma unroll
                for (int n = 0; n < 2; ++n) acc[a][b][m][n] = (f32x4){0.f, 0.f, 0.f, 0.f};
    bf16x8 At[4][2], B0[2][2], B1[2][2];
    const char* cA = (const char*)g.A + (size_t)cur.pm * tstep; const char* cB = (const char*)g.Bt + (size_t)cur.pn * tstep;
    PG8_STAGE(PG8_SB(0, 0), cB, voffB); PG8_STAGE(PG8_SA(0, 0), cA, voffA); PG8_STAGE(PG8_SB(0, 1), cB + hstep, voffB); PG8_STAGE(PG8_SA(0, 1), cA + hstep, voffA);
    if (wr == 1) PG8_BAR;
    PG8_WAIT_V(4); PG8_BAR;
    PG8_STAGE(PG8_SB(1, 0), cB + kstep, voffB); PG8_STAGE(PG8_SA(1, 0), cA + kstep, voffA); PG8_STAGE(PG8_SB(1, 1), cB + hstep + kstep, voffB);
    PG8_WAIT_V(6); PG8_BAR;
    for (;;) {
        const bool has_next = S.next(ui + 1, nxt);
        const char* nA = has_next ? (const char*)g.A + (size_t)nxt.pm * tstep : cA; const char* nB = has_next ? (const char*)g.Bt + (size_t)nxt.pn * tstep : cB;
        for (int t = 0; t < nt; t += 2) {
            const bool last = (t == nt - 2);
            const char* a1 = cA + (size_t)(t + 1) * kstep;
            const char* a2 = last ? nA : cA + (size_t)(t + 2) * kstep; const char* b2 = last ? nB : cB + (size_t)(t + 2) * kstep;
            const char* a3 = a2 + kstep; const char* b3 = b2 + kstep;
            PG8_LDB(B0, 0, 0); PG8_SCHED; PG8_LDA(At, 0, 0); PG8_STAGE(PG8_SA(1, 1), a1 + hstep, voffA);
            PG8_WAIT_L(8); PG8_BAR; PG8_WAIT_L(0); PG8_MMA(0, 0, At, B0); PG8_BAR; PG8_SCHED;
            PG8_LDB(B1, 0, 1); PG8_STAGE(PG8_SB(0, 0), b2, voffB);
            PG8_BAR; PG8_WAIT_L(0); PG8_MMA(0, 1, At, B1); PG8_BAR;
            PG8_LDA(At, 0, 1); PG8_STAGE(PG8_SA(0, 0), a2, voffA);
            PG8_BAR; PG8_WAIT_L(0); PG8_MMA(1, 0, At, B0); PG8_BAR; PG8_SCHED;
            PG8_STAGE(PG8_SB(0, 1), b2 + hstep, voffB);
            PG8_WAIT_V(6); PG8_BAR; PG8_MMA(1, 1, At, B1); PG8_BAR;
            PG8_LDB(B0, 1, 0); PG8_SCHED; PG8_LDA(At, 1, 0); PG8_STAGE(PG8_SA(0, 1), a2 + hstep, voffA);
            PG8_WAIT_L(8); PG8_BAR; PG8_WAIT_L(0); PG8_MMA(0, 0, At, B0); PG8_BAR; PG8_SCHED;
            PG8_LDB(B1, 1, 1); PG8_STAGE(PG8_SB(1, 0), b3, voffB);
            PG8_BAR; PG8_WAIT_L(0); PG8_MMA(0, 1, At, B1); PG8_BAR;
            PG8_LDA(At, 1, 1); PG8_STAGE(PG8_SA(1, 0), a3, voffA);
            PG8_BAR; PG8_WAIT_L(0); PG8_MMA(1, 0, At, B0); PG8_BAR; PG8_SCHED;
            PG8_STAGE(PG8_SB(1, 1), b3 + hstep, voffB);
            PG8_WAIT_V(6); PG8_BAR; PG8_MMA(1, 1, At, B1); PG8_BAR;
        }
        E(acc, cur, wr, wc, fr, fq);
        if (!has_next) break;
#pragma unroll
        for (int a = 0; a < 2; ++a)
#pragma unroll
            for (int b = 0; b < 2; ++b)
#pragma unroll
                for (int m = 0; m < 4; ++m)
#pragma unroll
                    for (int n = 0; n < 2; ++n) acc[a][b][m][n] = (f32x4){0.f, 0.f, 0.f, 0.f};
        cur = nxt; cA = nA; cB = nB; ++ui;
    }
    PG8_WAIT_V(0);
    if (wr == 0) PG8_BAR;
    PG8_BAR;
#undef PG8_SA
#undef PG8_SB
#undef PG8_STAGE
#undef PG8_LDA
#undef PG8_LDB
#undef PG8_MMA
#undef PG8_WAIT_V
#undef PG8_WAIT_L
#undef PG8_BAR
#undef PG8_SCHED
}

struct EpiStore {
    static constexpr bool PERM = true;
    bf16_t* O; int ldc;
    __device__ __forceinline__ void operator()(const f32x4 (&acc)[2][2][4][2], const Unit& u, int wr, int wc, int fr, int fq) const {
        const int row0 = u.pm * BM + wr * 64 + fr, col0 = u.pn * BM + wc * 32 + 8 * fq;
#pragma unroll
        for (int ai = 0; ai < 2; ++ai)
#pragma unroll
            for (int m = 0; m < 4; ++m) { bf16_t* rowp = O + (size_t)(row0 + ai * HALF + m * 16) * ldc + col0;
#pragma unroll
                for (int bj = 0; bj < 2; ++bj) { const f32x4 v0 = acc[ai][bj][m][0], v1 = acc[ai][bj][m][1];
                    u32x4 w; w.x = pk2(v0[0], v0[1]); w.y = pk2(v0[2], v0[3]); w.z = pk2(v1[0], v1[1]); w.w = pk2(v1[2], v1[3]);
                    __builtin_nontemporal_store(w, (u32x4*)(rowp + bj * HALF)); } }
    }
};
struct EpiStoreQK {
    static constexpr bool PERM = true;
    bf16_t* O; const float* qg; const float* kg;
    __device__ __forceinline__ void operator()(const f32x4 (&acc)[2][2][4][2], const Unit& u, int wr, int wc, int fr, int fq) const {
        const int row0 = u.pm * BM + wr * 64 + fr;
        if (u.pn >= 4) {
            const int col0 = u.pn * BM + wc * 32 + 8 * fq;
#pragma unroll
            for (int ai = 0; ai < 2; ++ai)
#pragma unroll
                for (int m = 0; m < 4; ++m) { bf16_t* rowp = O + (size_t)(row0 + ai * HALF + m * 16) * 2048 + col0;
#pragma unroll
                    for (int bj = 0; bj < 2; ++bj) { const f32x4 v0 = acc[ai][bj][m][0], v1 = acc[ai][bj][m][1];
                        u32x4 w; w.x = pk2(v0[0], v0[1]); w.y = pk2(v0[2], v0[3]); w.z = pk2(v1[0], v1[1]); w.w = pk2(v1[2], v1[3]);
                        __builtin_nontemporal_store(w, (u32x4*)(rowp + bj * HALF)); } }
        } else {
            const float* gp = u.pn < 2 ? qg : kg; const float scl = u.pn < 2 ? 0.125f * 1.4426950408889634f : 1.f;
            f32x4 gn[2][2];
#pragma unroll
            for (int bj = 0; bj < 2; ++bj)
#pragma unroll
                for (int n = 0; n < 2; ++n) gn[bj][n] = *(const f32x4*)(gp + 32 * bj + 8 * fq + 4 * n);
            const int col0 = u.pn * BM + wc * 64 + 8 * fq;
#pragma unroll
            for (int ai = 0; ai < 2; ++ai)
#pragma unroll
                for (int m = 0; m < 4; ++m) { bf16_t* rowp = O + (size_t)(row0 + ai * HALF + m * 16) * 2048 + col0;
                    float ss = 0.f;
#pragma unroll
                    for (int bj = 0; bj < 2; ++bj)
#pragma unroll
                        for (int n = 0; n < 2; ++n) { const f32x4 a = acc[ai][bj][m][n]; ss += a[0] * a[0] + a[1] * a[1] + a[2] * a[2] + a[3] * a[3]; }
                    ss += __shfl_xor(ss, 16); ss += __shfl_xor(ss, 32);
                    const float r = rsqrtf(ss * (1.f / 64.f) + 1e-6f) * scl;
#pragma unroll
                    for (int bj = 0; bj < 2; ++bj) { const f32x4 v0 = acc[ai][bj][m][0] * r * gn[bj][0], v1 = acc[ai][bj][m][1] * r * gn[bj][1];
                        u32x4 w; w.x = pk2(v0[0], v0[1]); w.y = pk2(v0[2], v0[3]); w.z = pk2(v1[0], v1[1]); w.w = pk2(v1[2], v1[3]);
                        __builtin_nontemporal_store(w, (u32x4*)(rowp + 32 * bj)); } }
        }
    }
};
struct EpiSwiglu {
    static constexpr bool PERM = true;
    bf16_t* O;
    __device__ __forceinline__ void operator()(const f32x4 (&acc)[2][2][4][2], const Unit& u, int wr, int wc, int fr, int fq) const {
        const int row0 = u.pm * BM + wr * 64 + fr, col0 = u.pn * HALF + wc * 32 + 8 * fq;
#pragma unroll
        for (int ai = 0; ai < 2; ++ai)
#pragma unroll
            for (int m = 0; m < 4; ++m) { bf16_t* rowp = O + (size_t)(row0 + ai * HALF + m * 16) * FFH + col0;
                float r[8];
#pragma unroll
                for (int n = 0; n < 2; ++n)
#pragma unroll
                    for (int j = 0; j < 4; ++j) r[n * 4 + j] = silu_f(acc[ai][0][m][n][j]) * acc[ai][1][m][n][j];
                u32x4 w; w.x = pk2(r[0], r[1]); w.y = pk2(r[2], r[3]); w.z = pk2(r[4], r[5]); w.w = pk2(r[6], r[7]);
                __builtin_nontemporal_store(w, (u32x4*)rowp); }
    }
};
struct EpiGlu {
    static constexpr bool PERM = true;
    const bf16_t* Y; const float* bias; bf16_t* O;
    __device__ __forceinline__ void operator()(const f32x4 (&acc)[2][2][4][2], const Unit& u, int wr, int wc, int fr, int fq) const {
        const int row0 = u.pm * BM + wr * 64 + fr, col0 = u.pn * BM + wc * 32 + 8 * fq;
#pragma unroll
        for (int bj = 0; bj < 2; ++bj) {
            const int col = col0 + bj * HALF;
            const f32x4 b0 = *(const f32x4*)(bias + col), b1 = *(const f32x4*)(bias + col + 4);
            u32x4 yv[2][4];
#pragma unroll
            for (int ai = 0; ai < 2; ++ai)
#pragma unroll
                for (int m = 0; m < 4; ++m) yv[ai][m] = *(const u32x4*)(Y + (size_t)(row0 + ai * HALF + m * 16) * 512 + col);
#pragma unroll
            for (int ai = 0; ai < 2; ++ai)
#pragma unroll
                for (int m = 0; m < 4; ++m) { const size_t row = (size_t)(row0 + ai * HALF + m * 16);
                    const u32x4 y4 = yv[ai][m];
                    const f32x4 v0 = acc[ai][bj][m][0] + b0, v1 = acc[ai][bj][m][1] + b1;
                    float r[8];
                    r[0] = lo_f(y4.x) * sigm_f(v0[0]); r[1] = hi_f(y4.x) * sigm_f(v0[1]); r[2] = lo_f(y4.y) * sigm_f(v0[2]); r[3] = hi_f(y4.y) * sigm_f(v0[3]);
                    r[4] = lo_f(y4.z) * sigm_f(v1[0]); r[5] = hi_f(y4.z) * sigm_f(v1[1]); r[6] = lo_f(y4.w) * sigm_f(v1[2]); r[7] = hi_f(y4.w) * sigm_f(v1[3]);
                    u32x4 w; w.x = pk2(r[0], r[1]); w.y = pk2(r[2], r[3]); w.z = pk2(r[4], r[5]); w.w = pk2(r[6], r[7]);
                    __builtin_nontemporal_store(w, (u32x4*)(O + row * 1024 + 512 + col)); }
        }
    }
};
struct EpiResid {
    static constexpr bool PERM = false;
    const float* res; float* out; const float* gate;
    __device__ __forceinline__ void operator()(const f32x4 (&acc)[2][2][4][2], const Unit& u, int wr, int wc, int fr, int fq) const {
        const int row0 = u.pm * BM + wr * 64 + fr, col0 = u.pn * BM + wc * 32 + 4 * fq;
        const int bidx = (u.pm * BM) >> 12;
        f32x4 gv[2][2];
#pragma unroll
        for (int bj = 0; bj < 2; ++bj)
#pragma unroll
            for (int n = 0; n < 2; ++n) gv[bj][n] = *(const f32x4*)(gate + (size_t)bidx * 6144 + col0 + bj * HALF + n * 16);
        f32x4 rv[2][2][2][2];
#define EPR_LOAD(buf, q) do { _Pragma("unroll") for (int mm = 0; mm < 2; ++mm) _Pragma("unroll") for (int bj = 0; bj < 2; ++bj) _Pragma("unroll") for (int n = 0; n < 2; ++n) \
            rv[buf][mm][bj][n] = *(const f32x4*)(res + (size_t)(row0 + ((q) >> 1) * HALF + (((q) & 1) * 2 + mm) * 16) * 1024 + col0 + bj * HALF + n * 16); } while (0)
#define EPR_STORE(buf, q) do { _Pragma("unroll") for (int mm = 0; mm < 2; ++mm) _Pragma("unroll") for (int bj = 0; bj < 2; ++bj) _Pragma("unroll") for (int n = 0; n < 2; ++n) \
            __builtin_nontemporal_store(rv[buf][mm][bj][n] + gv[bj][n] * acc[(q) >> 1][bj][((q) & 1) * 2 + mm][n], (f32x4*)(out + (size_t)(row0 + ((q) >> 1) * HALF + (((q) & 1) * 2 + mm) * 16) * 1024 + col0 + bj * HALF + n * 16)); } while (0)
        EPR_LOAD(0, 0); EPR_LOAD(1, 1); EPR_STORE(0, 0); EPR_LOAD(0, 2); EPR_STORE(1, 1); EPR_LOAD(1, 3); EPR_STORE(0, 2); EPR_STORE(1, 3);
#undef EPR_LOAD
#undef EPR_STORE
    }
};
}

__device__ __forceinline__ int wt_src_col(int n, int mode) {
    if (mode == 1) { const int tt = n >> 8, r = n & 255; return r < 128 ? tt * 128 + r : FFH + tt * 128 + (r - 128); }
    if (mode == 2 && n < 1024) { const int lc = n & 255; return (n & ~255) + ((lc >> 5) & 3) * 64 + 32 * (lc >> 7) + (lc & 31); }
    return n;
}
__device__ __forceinline__ void transpose_cvt(LAS float* tile, const float* __restrict__ W, int K, int N, bf16_t* __restrict__ Wt, int mode) {
    const int tid = tid_opaque();
    const int tilesN = N / 64, tilesK = K / 64, ntl = tilesN * tilesK;
    float cur[8];
    if ((int)blockIdx.x < ntl) { const int tn = blockIdx.x % tilesN, tk = blockIdx.x / tilesN; const int nsrc = wt_src_col(tn * 64 + (tid & 63), mode);
#pragma unroll
        for (int r = 0; r < 8; ++r) cur[r] = W[(size_t)(tk * 64 + (tid >> 6) + 8 * r) * N + nsrc]; }
    for (int t = blockIdx.x; t < ntl; t += gridDim.x) {
        const int tn = t % tilesN, tk = t / tilesN;
        const int n0d = tn * 64, k0 = tk * 64;
#pragma unroll
        for (int r = 0; r < 8; ++r) { const int kk = (tid >> 6) + 8 * r; tile[kk * 65 + (tid & 63)] = cur[r]; }
        const int t2 = t + gridDim.x;
        if (t2 < ntl) { const int tn2 = t2 % tilesN, tk2 = t2 / tilesN; const int nsrc = wt_src_col(tn2 * 64 + (tid & 63), mode);
#pragma unroll
            for (int r = 0; r < 8; ++r) cur[r] = W[(size_t)(tk2 * 64 + (tid >> 6) + 8 * r) * N + nsrc]; }
        __syncthreads();
        { const int nn = tid >> 3, kc = (tid & 7) * 8; float v[8];
#pragma unroll
          for (int j = 0; j < 8; ++j) v[j] = tile[(kc + j) * 65 + nn];
          u32x4 w; w.x = pk2(v[0], v[1]); w.y = pk2(v[2], v[3]); w.z = pk2(v[4], v[5]); w.w = pk2(v[6], v[7]);
          *(u32x4*)(Wt + (size_t)(n0d + nn) * K + k0 + kc) = w; }
        __syncthreads();
    }
}

struct S5gp { float lrdt, lidt, fre, fim; };
__device__ __forceinline__ S5gp s5_gp(const Params& p, int g, int pp) {
    S5gp r; const float dt = expf(p.in[15][g]); const float lr = p.in[13][g * 64 + pp], li = p.in[14][g * 64 + pp];
    r.lrdt = lr * dt; r.lidt = li * dt;
    const float mag = expf(r.lrdt), are = mag * cosf(r.lidt), aim = mag * sinf(r.lidt), den = lr * lr + li * li;
    r.fre = ((are - 1.f) * lr + aim * li) / den; r.fim = (aim * lr - (are - 1.f) * li) / den;
    return r;
}
__device__ __forceinline__ f32x2 s5_apow(const S5gp& q, float n) { const float m = expf(n * q.lrdt), a = n * q.lidt; return (f32x2){m * cosf(a), m * sinf(a)}; }

__device__ __forceinline__ void prep_phase(const Params& p, LAS unsigned char* lds) {
    const int tid = tid_opaque();
    unsigned char* ws = p.ws;
    LAS float* tile = (LAS float*)lds;
    transpose_cvt(tile, p.in[8], 1024, 2048, (bf16_t*)(ws + WS_W_ABIN), 2);
    transpose_cvt(tile, p.in[9], 1024, 1024, (bf16_t*)(ws + WS_W_ABOUT), 0);
    transpose_cvt(tile, p.in[21], 512, 512, (bf16_t*)(ws + WS_W_GLU), 0);
    for (int l = 0; l < 2; ++l) {
        transpose_cvt(tile, p.in[6] + (size_t)l * 1024 * 5632, 1024, 5632, (bf16_t*)(ws + WS_W_FFIN) + (size_t)l * 5632 * 1024, 1);
        transpose_cvt(tile, p.in[7] + (size_t)l * FFH * 1024, FFH, 1024, (bf16_t*)(ws + WS_W_FFOUT) + (size_t)l * 1024 * FFH, 0);
    }
    transpose_cvt(tile, p.in[23], 1024, 3584, (bf16_t*)(ws + WS_W_CDIN), 0);
    transpose_cvt(tile, p.in[24], 1024, 1024, (bf16_t*)(ws + WS_W_CDOUT), 0);
    if (blockIdx.x < 192) {
        LAS float* sc = (LAS float*)lds; LAS float* red = (LAS float*)(lds + 65536);
        for (int idx = tid; idx < 16384; idx += NTHR) { const float v = p.in[1][idx]; sc[idx] = v / (1.f + expf(-v)); }
        __syncthreads();
        for (int item = blockIdx.x; item < 192; item += gridDim.x) {
            const int l = item / 96, cb = item % 96, cl = tid & 63, ksl = tid >> 6;
            float acc[16];
#pragma unroll
            for (int b = 0; b < 16; ++b) acc[b] = 0.f;
            const float* w = p.in[2] + (size_t)l * 1024 * 6144 + cb * 64 + cl;
            for (int k0 = ksl * 128; k0 < ksl * 128 + 128; k0 += 8) {
                float wv[8];
#pragma unroll
                for (int j = 0; j < 8; ++j) wv[j] = w[(size_t)(k0 + j) * 6144];
#pragma unroll
                for (int b = 0; b < 16; ++b) { const f32x4 s0 = *(const LAS f32x4*)(sc + b * 1024 + k0), s1 = *(const LAS f32x4*)(sc + b * 1024 + k0 + 4);
                    acc[b] += s0[0] * wv[0] + s0[1] * wv[1] + s0[2] * wv[2] + s0[3] * wv[3] + s1[0] * wv[4] + s1[1] * wv[5] + s1[2] * wv[6] + s1[3] * wv[7]; }
            }
#pragma unroll
            for (int b = 0; b < 16; ++b) red[(ksl * 16 + b) * 64 + cl] = acc[b];
            __syncthreads();
            for (int o = tid; o < 1024; o += NTHR) { const int b = o >> 6, cc = o & 63; float s = 0.f;
#pragma unroll
                for (int k8 = 0; k8 < 8; ++k8) s += red[(k8 * 16 + b) * 64 + cc];
                ((float*)(ws + WS_MOD))[(size_t)(l * 16 + b) * 6144 + cb * 64 + cc] = s + p.in[3][l * 6144 + cb * 64 + cc]; }
            __syncthreads();
        }
    }
    __syncthreads();
    const int gtid = blockIdx.x * NTHR + tid, nthr = gridDim.x * NTHR;
    for (int idx = gtid; idx < 4096 * 64; idx += nthr) { const int pos = idx >> 6, f = idx & 63;
        const float freq = powf(10000.f, -(float)f / 64.f), ang = (float)pos * freq;
        ((f32x2*)(ws + WS_ROPE))[idx] = (f32x2){cosf(ang), sinf(ang)}; }
    { bf16_t* Mt = (bf16_t*)(ws + WS_S5M); bf16_t* Gt = (bf16_t*)(ws + WS_S5G);
      for (int idx = gtid; idx < 32 * 64 * 64; idx += nthr) { const int g = idx >> 12, pp = (idx >> 6) & 63, s = idx & 63;
          const S5gp q = s5_gp(p, g, pp);
          { const f32x2 a = s5_apow(q, (float)(63 - s));
            unsigned wr_[8], wi_[8];
#pragma unroll
            for (int h2 = 0; h2 < 8; ++h2) { float vr[2], vi[2];
#pragma unroll
                for (int e = 0; e < 2; ++e) { const int h = h2 * 2 + e; const float br = p.in[16][(g * 64 + pp) * 16 + h], bi = p.in[17][(g * 64 + pp) * 16 + h];
                    const float bbr = q.fre * br - q.fim * bi, bbi = q.fre * bi + q.fim * br;
                    vr[e] = a.x * bbr - a.y * bbi; vi[e] = a.x * bbi + a.y * bbr; }
                wr_[h2] = pk2(vr[0], vr[1]); wi_[h2] = pk2(vi[0], vi[1]); }
            u32x4* dr = (u32x4*)(Mt + (size_t)(g * 128 + 2 * pp) * 1024 + s * 16); u32x4* di = (u32x4*)(Mt + (size_t)(g * 128 + 2 * pp + 1) * 1024 + s * 16);
            dr[0] = (u32x4){wr_[0], wr_[1], wr_[2], wr_[3]}; dr[1] = (u32x4){wr_[4], wr_[5], wr_[6], wr_[7]};
            di[0] = (u32x4){wi_[0], wi_[1], wi_[2], wi_[3]}; di[1] = (u32x4){wi_[4], wi_[5], wi_[6], wi_[7]}; }
          { const int t = s; const f32x2 a = s5_apow(q, (float)(t + 1));
#pragma unroll
            for (int h = 0; h < 16; ++h) { const float cr = p.in[18][(g * 16 + h) * 64 + pp], ci = p.in[19][(g * 16 + h) * 64 + pp];
                const float gr = cr * a.x - ci * a.y, gi = cr * a.y + ci * a.x;
                *(unsigned*)(Gt + (size_t)(g * 1024 + t * 16 + h) * 128 + 2 * pp) = pk2(gr, -gi); } }
          if (s == 0) ((f32x2*)(ws + WS_A64))[g * 64 + pp] = s5_apow(q, 64.f);
      }
      LAS f32x2* tp = (LAS f32x2*)lds;
      bf16_t* Kt = (bf16_t*)(ws + WS_KERN);
      for (int item = blockIdx.x; item < 32 * 64; item += gridDim.x) { const int g = item >> 6, tau = item & 63;
          if (tid < 64) { const S5gp q = s5_gp(p, g, tid); const f32x2 a = s5_apow(q, (float)tau); tp[tid] = (f32x2){a.x * q.fre - a.y * q.fim, a.x * q.fim + a.y * q.fre}; }
          __syncthreads();
          if (tid < 256) { const int h = tid >> 4, h2 = tid & 15; float acc = 0.f;
#pragma unroll 8
              for (int pp = 0; pp < 64; ++pp) { const f32x2 t = tp[pp]; const float cr = p.in[18][(g * 16 + h) * 64 + pp], ci = p.in[19][(g * 16 + h) * 64 + pp];
                  const float ur = cr * t.x - ci * t.y, ui = cr * t.y + ci * t.x;
                  acc += ur * p.in[16][(g * 64 + pp) * 16 + h2] - ui * p.in[17][(g * 64 + pp) * 16 + h2]; }
              Kt[(size_t)((g * 64 + tau) * 16 + h) * 16 + h2] = f2bf(acc); }
          __syncthreads();
      }
    }
}

__device__ __forceinline__ void norm_phase(const float* __restrict__ x, const float* __restrict__ gw, const float* __restrict__ shift, const float* __restrict__ scale, bf16_t* __restrict__ H) {
    const int tid = tid_opaque(); const int lane = tid & 63, wv = blockIdx.x * 8 + (tid >> 6), nw = gridDim.x * 8;
    constexpr int NR = 8;
    for (int row0 = wv * NR; row0 < MTOK; row0 += nw * NR) {
        const int b = row0 >> 12;
        f32x4 v[NR][4]; float ss[NR];
#pragma unroll
        for (int r = 0; r < NR; ++r)
#pragma unroll
            for (int c4 = 0; c4 < 4; ++c4) v[r][c4] = __builtin_nontemporal_load((const f32x4*)(x + (size_t)(row0 + r) * 1024 + c4 * 256 + lane * 4));
#pragma unroll
        for (int r = 0; r < NR; ++r) { float s = 0.f;
#pragma unroll
            for (int c4 = 0; c4 < 4; ++c4) s += v[r][c4][0] * v[r][c4][0] + v[r][c4][1] * v[r][c4][1] + v[r][c4][2] * v[r][c4][2] + v[r][c4][3] * v[r][c4][3];
            ss[r] = s; }
#pragma unroll
        for (int o = 1; o < 64; o <<= 1)
#pragma unroll
            for (int r = 0; r < NR; ++r) ss[r] += __shfl_xor(ss[r], o);
#pragma unroll
        for (int c4 = 0; c4 < 4; ++c4) { const int col = c4 * 256 + lane * 4;
            const f32x4 g = *(const f32x4*)(gw + col), sc = *(const f32x4*)(scale + (size_t)b * 6144 + col), sh = *(const f32x4*)(shift + (size_t)b * 6144 + col);
            const f32x4 gm = g * (sc + 1.f);
#pragma unroll
            for (int r = 0; r < NR; ++r) { const float rr = rsqrtf(ss[r] * (1.f / 1024.f) + 1e-6f);
                const f32x4 o = v[r][c4] * rr * gm + sh;
                *(u32x2*)(H + (size_t)(row0 + r) * 1024 + col) = (u32x2){pk2(o[0], o[1]), pk2(o[2], o[3])}; } }
    }
}

constexpr int VS = 72;
constexpr int VL_BYTES = 64 * VS * 2;

__device__ __forceinline__ void s5a_phase(const Params& p);
__device__ __forceinline__ void attnA_phase(const Params& p, LAS unsigned char* lds) {
    const int tid = tid_opaque(), wid = __builtin_amdgcn_readfirstlane(tid >> 6), lane = tid & 63, li = lane & 15, g4 = lane >> 4;
    const bf16_t* QKV = (const bf16_t*)(p.ws + WS_R1);
    bf16_t* MIX = (bf16_t*)(p.ws + WS_MIX);
    LAS bf16_t* Vl = (LAS bf16_t*)(lds + wid * VL_BYTES);
    LAS float* bl = (LAS float*)(lds + 8 * VL_BYTES);
    for (int idx = tid; idx < 8 * 257; idx += NTHR) bl[(idx / 257) * 260 + (idx % 257)] = (p.in[12][idx] - p.in[12][(idx / 257) * 257 + 256]) * 1.4426950408889634f;
    __syncthreads();
    if (wid >= 4) s5a_phase(p);
    const int h = wid;
    LAS float* bh = bl + h * 260;
    const int vrow = lane >> 3, vc8 = (lane & 7) * 8;
    for (int item2 = vblock(); item2 < 2048; item2 += gridDim.x) {
        const int kq = item2 >> 8, rq = item2 & 255, qh = rq & 1;
        const int b = 2 * kq + (rq >> 7), ci = (((rq >> 1) & 63) + 9 * kq) & 63;
        const size_t rowbase = (size_t)b * SEQ + ci * 64 + qh * 32;
        bf16x8 qf[2][2];
#pragma unroll
        for (int qt = 0; qt < 2; ++qt)
#pragma unroll
            for (int ks = 0; ks < 2; ++ks) qf[qt][ks] = *(const bf16x8*)(QKV + (rowbase + qt * 16 + li) * 2048 + h * 64 + 32 * ks + 8 * g4);
        f32x4 o[4][2]; float mrun[2], lsum[2];
#pragma unroll
        for (int qt = 0; qt < 2; ++qt) { mrun[qt] = -1e30f; lsum[qt] = 0.f;
#pragma unroll
            for (int dt = 0; dt < 4; ++dt) o[dt][qt] = (f32x4){0.f, 0.f, 0.f, 0.f}; }
        const int kb0 = ci >= 8 ? 0 : 8 - ci;
        bf16x8 kf[4][2]; u32x4 vr[8];
        { const bf16_t* kbase = QKV + ((size_t)b * SEQ + (size_t)(ci - 8 + kb0) * 64) * 2048 + h * 64;
#pragma unroll
          for (int kt = 0; kt < 4; ++kt)
#pragma unroll
              for (int ks = 0; ks < 2; ++ks) kf[kt][ks] = *(const bf16x8*)(kbase + (size_t)(kt * 16 + li) * 2048 + 512 + 32 * ks + 8 * g4);
#pragma unroll
          for (int r = 0; r < 8; ++r) vr[r] = *(const u32x4*)(kbase + (size_t)(r * 8 + vrow) * 2048 + 1024 + vc8);
          wave_lds_fence();
#pragma unroll
          for (int r = 0; r < 8; ++r) *(LAS u32x4*)(Vl + (r * 8 + vrow) * VS + vc8) = vr[r];
          wave_lds_fence(); }
        for (int kb = kb0; kb <= 8; ++kb) {
            f32x4 s[4][2];
#pragma unroll
            for (int kt = 0; kt < 4; ++kt)
#pragma unroll
                for (int qt = 0; qt < 2; ++qt) { f32x4 z = (f32x4){0.f, 0.f, 0.f, 0.f}; z = mfma16(kf[kt][0], qf[qt][0], z); z = mfma16(kf[kt][1], qf[qt][1], z); s[kt][qt] = z; }
            const bool more = kb < 8;
            if (more) {
                const bf16_t* kbase = QKV + ((size_t)b * SEQ + (size_t)(ci - 8 + kb + 1) * 64) * 2048 + h * 64;
#pragma unroll
                for (int kt = 0; kt < 4; ++kt)
#pragma unroll
                    for (int ks = 0; ks < 2; ++ks) kf[kt][ks] = *(const bf16x8*)(kbase + (size_t)(kt * 16 + li) * 2048 + 512 + 32 * ks + 8 * g4);
#pragma unroll
                for (int r = 0; r < 8; ++r) vr[r] = *(const u32x4*)(kbase + (size_t)(r * 8 + vrow) * 2048 + 1024 + vc8);
            }
            const bool nearb = kb >= 6;
            bf16x8 pfr[2][2];
#pragma unroll
            for (int qt = 0; qt < 2; ++qt) {
                float mx = -1e30f;
                if (nearb) {
#pragma unroll
                    for (int kt = 0; kt < 4; ++kt)
#pragma unroll
                        for (int jj = 0; jj < 4; ++jj) { int rel = 512 + qh * 32 + qt * 16 + li - kb * 64 - (kt * 16 + 4 * g4 + jj); rel = rel > 128 ? 128 : (rel < -128 ? -128 : rel);
                            const float v = s[kt][qt][jj] + bh[rel + 128]; s[kt][qt][jj] = v; mx = fmaxf(mx, v); }
                } else {
#pragma unroll
                    for (int kt = 0; kt < 4; ++kt)
#pragma unroll
                        for (int jj = 0; jj < 4; ++jj) mx = fmaxf(mx, s[kt][qt][jj]);
                }
                mx = fmaxf(mx, __shfl_xor(mx, 16)); mx = fmaxf(mx, __shfl_xor(mx, 32));
                const float mnew = fmaxf(mrun[qt], mx), alpha = __builtin_amdgcn_exp2f(mrun[qt] - mnew);
                mrun[qt] = mnew; float ps = 0.f;
#pragma unroll
                for (int kt = 0; kt < 4; ++kt)
#pragma unroll
                    for (int jj = 0; jj < 4; ++jj) { const float e = __builtin_amdgcn_exp2f(s[kt][qt][jj] - mnew); s[kt][qt][jj] = e; ps += e; }
                lsum[qt] = lsum[qt] * alpha + ps;
#pragma unroll
                for (int dt = 0; dt < 4; ++dt) o[dt][qt] *= alpha;
#pragma unroll
                for (int kk = 0; kk < 2; ++kk) { u32x4 w; w.x = pk2(s[2 * kk][qt][0], s[2 * kk][qt][1]); w.y = pk2(s[2 * kk][qt][2], s[2 * kk][qt][3]);
                    w.z = pk2(s[2 * kk + 1][qt][0], s[2 * kk + 1][qt][1]); w.w = pk2(s[2 * kk + 1][qt][2], s[2 * kk + 1][qt][3]); pfr[qt][kk] = as_frag(w); }
            }
            { bf16x8 vf[2][4];
#pragma unroll
              for (int kk = 0; kk < 2; ++kk)
#pragma unroll
                  for (int dt = 0; dt < 4; ++dt) vf[kk][dt] = tr_pair(Vl, VS, 32 * kk + 4 * g4, 32 * kk + 16 + 4 * g4, dt * 16, li);
#pragma unroll
              for (int kk = 0; kk < 2; ++kk)
#pragma unroll
                  for (int dt = 0; dt < 4; ++dt)
#pragma unroll
                      for (int qt = 0; qt < 2; ++qt) o[dt][qt] = mfma16(vf[kk][dt], pfr[qt][kk], o[dt][qt]); }
            wave_lds_fence();
            if (more) {
#pragma unroll
                for (int r = 0; r < 8; ++r) *(LAS u32x4*)(Vl + (r * 8 + vrow) * VS + vc8) = vr[r];
                wave_lds_fence();
            }
        }
#pragma unroll
        for (int qt = 0; qt < 2; ++qt) { float l = lsum[qt]; l += __shfl_xor(l, 16); l += __shfl_xor(l, 32); const float inv = 1.f / l;
#pragma unroll
            for (int dt = 0; dt < 4; ++dt) { const f32x4 v = o[dt][qt] * inv;
                *(u32x2*)(MIX + (rowbase + qt * 16 + li) * 1024 + h * 64 + dt * 16 + 4 * g4) = (u32x2){pk2(v[0], v[1]), pk2(v[2], v[3])}; } }
    }
    if (wid < 4) s5a_phase(p);
}

__device__ __forceinline__ void s5a_phase(const Params& p) {
    const int tid = tid_opaque(); const int lane = tid & 63, li = lane & 15, g4 = lane >> 4;
    const bf16_t* QKV = (const bf16_t*)(p.ws + WS_R1);
    const bf16_t* Mt = (const bf16_t*)(p.ws + WS_S5M);
    float* E = (float*)(p.ws + WS_S5E);
    const int wv = blockIdx.x * 8 + (tid >> 6), nw = gridDim.x * 8;
    for (int item = wv; item < 2048; item += nw) {
        const int g = item & 31, c = item >> 5;
        f32x4 acc[8];
#pragma unroll
        for (int pt = 0; pt < 8; ++pt) acc[pt] = (f32x4){0.f, 0.f, 0.f, 0.f};
        const bf16_t* ub = QKV + ((size_t)li * SEQ + c * 64 + (g4 >> 1)) * 2048 + 1536 + g * 16 + 8 * (g4 & 1);
        const bf16_t* mb = Mt + (size_t)(g * 128 + li) * 1024 + 8 * g4;
#pragma unroll 4
        for (int ks = 0; ks < 32; ++ks) {
            const bf16x8 bfr = *(const bf16x8*)(ub + (size_t)(2 * ks) * 2048);
#pragma unroll
            for (int pt = 0; pt < 8; ++pt) { const bf16x8 afr = *(const bf16x8*)(mb + (size_t)pt * 16 * 1024 + 32 * ks); acc[pt] = mfma16(afr, bfr, acc[pt]); }
        }
#pragma unroll
        for (int pt = 0; pt < 8; ++pt) *(f32x4*)(E + ((size_t)(c * 32 + g) * 16 + li) * 128 + pt * 16 + 4 * g4) = acc[pt];
    }
}
__device__ __forceinline__ void s5scan_phase(const Params& p) {
    const float* E = (const float*)(p.ws + WS_S5E);
    bf16_t* X = (bf16_t*)(p.ws + WS_S5X);
    const f32x2* A64 = (const f32x2*)(p.ws + WS_A64);
    const int gtid = blockIdx.x * NTHR + tid_opaque();
    if (gtid < 32 * 16 * 64) {
        const int pp = gtid & 63, b = (gtid >> 6) & 15, g = gtid >> 10;
        const f32x2 a = A64[g * 64 + pp];
        float xr = 0.f, xi = 0.f;
        for (int c0 = 0; c0 < 64; c0 += 8) {
            f32x2 e[8];
#pragma unroll
            for (int k = 0; k < 8; ++k) e[k] = *(const f32x2*)(E + ((size_t)((c0 + k) * 32 + g) * 16 + b) * 128 + 2 * pp);
#pragma unroll
            for (int k = 0; k < 8; ++k) {
                *(unsigned*)(X + ((size_t)((c0 + k) * 32 + g) * 16 + b) * 128 + 2 * pp) = pk2(xr, xi);
                const float nr = a.x * xr - a.y * xi + e[k].x, ni = a.x * xi + a.y * xr + e[k].y; xr = nr; xi = ni; }
        }
    }
}
__device__ __forceinline__ int s5c_item(int vb, int k) {
    if (gridDim.x != 256) return vb + k * (int)gridDim.x;
    const int x = vb >> 5, l = vb & 31; const int g = 8 * (x & 3) + (l & 7), c = 8 * k + 4 * (x >> 2) + (l >> 3);
    return c * 32 + g;
}
__device__ __forceinline__ void s5c_phase(const Params& p, LAS unsigned char* lds) {
    const int tid = tid_opaque(), wid = __builtin_amdgcn_readfirstlane(tid >> 6), lane = tid & 63, li = lane & 15, g4 = lane >> 4;
    const bf16_t* QKV = (const bf16_t*)(p.ws + WS_R1);
    const bf16_t* Kt = (const bf16_t*)(p.ws + WS_KERN);
    const bf16_t* Gt = (const bf16_t*)(p.ws + WS_S5G);
    const bf16_t* X = (const bf16_t*)(p.ws + WS_S5X);
    bf16_t* Y5 = (bf16_t*)(p.ws + WS_Y5);
    LAS bf16_t* kl = (LAS bf16_t*)lds;
    LAS bf16_t* ul = (LAS bf16_t*)(lds + 32768);
    int gl = -1;
    u32x4 ur[4];
    const int vb = vblock(), nrounds = (2048 + (int)gridDim.x - 1) / (int)gridDim.x;
    { const int item = s5c_item(vb, 0); if (item < 2048) { const int g = item & 31, c = item >> 5;
#pragma unroll
        for (int q = 0; q < 4; ++q) { const int idx = tid + q * NTHR, hh = idx & 1, b = (idx >> 1) & 15, sq = idx >> 5;
            ur[q] = *(const u32x4*)(QKV + ((size_t)b * SEQ + c * 64 + sq) * 2048 + 1536 + g * 16 + hh * 8); } } }
    for (int rk = 0; rk < nrounds; ++rk) {
        const int item = s5c_item(vb, rk); if (item >= 2048) break;
        const int g = item & 31, c = item >> 5;
        __syncthreads();
        if (g != gl) { for (int idx = tid; idx < 2048; idx += NTHR) *(LAS u32x4*)(kl + idx * 8) = *(const u32x4*)(Kt + (size_t)g * 16384 + idx * 8); gl = g; }
#pragma unroll
        for (int q = 0; q < 4; ++q) { const int idx = tid + q * NTHR, hh = idx & 1, b = (idx >> 1) & 15, sq = idx >> 5;
            *(LAS u32x4*)(ul + (sq * 16 + b) * 16 + hh * 8) = ur[q]; }
        { const int nx = (rk + 1 < nrounds) ? s5c_item(vb, rk + 1) : 2048; if (nx < 2048) { const int g2 = nx & 31, c2 = nx >> 5;
#pragma unroll
            for (int q = 0; q < 4; ++q) { const int idx = tid + q * NTHR, hh = idx & 1, b = (idx >> 1) & 15, sq = idx >> 5;
                ur[q] = *(const u32x4*)(QKV + ((size_t)b * SEQ + c2 * 64 + sq) * 2048 + 1536 + g2 * 16 + hh * 8); } } }
        bf16x8 xf[4];
#pragma unroll
        for (int ks = 0; ks < 4; ++ks) xf[ks] = *(const bf16x8*)(X + ((size_t)(c * 32 + g) * 16 + li) * 128 + 32 * ks + 8 * g4);
        bf16x8 gf[8][4];
#pragma unroll
        for (int tt = 0; tt < 8; ++tt)
#pragma unroll
            for (int ks = 0; ks < 4; ++ks) gf[tt][ks] = *(const bf16x8*)(Gt + (size_t)(g * 1024 + (wid + 8 * tt) * 16 + li) * 128 + 32 * ks + 8 * g4);
        __syncthreads();
        const f32x4 dsk = *(const f32x4*)(p.in[20] + g * 16 + 4 * g4);
#pragma unroll
        for (int tt = 0; tt < 8; ++tt) {
            const int t = wid + 8 * tt;
            f32x4 acc = (f32x4){0.f, 0.f, 0.f, 0.f};
#pragma unroll
            for (int ks = 0; ks < 4; ++ks) acc = mfma16(gf[tt][ks], xf[ks], acc);
            const int nks = ((t >> 1) + 4) & ~3;
            for (int ks0 = 0; ks0 < nks; ks0 += 4) {
                u32x4 av[4]; bf16x8 bv[4];
#pragma unroll
                for (int q = 0; q < 4; ++q) { const int s = 2 * (ks0 + q) + (g4 >> 1); int tau = t - s; const bool ok = tau >= 0; tau = ok ? tau : 0;
                    av[q] = *(const LAS u32x4*)(kl + (tau * 16 + li) * 16 + 8 * (g4 & 1));
                    if (!ok) av[q] = (u32x4){0u, 0u, 0u, 0u};
                    bv[q] = *(const LAS bf16x8*)(ul + (s * 16 + li) * 16 + 8 * (g4 & 1)); }
#pragma unroll
                for (int q = 0; q < 4; ++q) acc = mfma16(as_frag(av[q]), bv[q], acc);
            }
            const u32x2 uu = *(const LAS u32x2*)(ul + (t * 16 + li) * 16 + 4 * g4);
            float y0 = acc[0] + dsk[0] * lo_f(uu.x), y1 = acc[1] + dsk[1] * hi_f(uu.x), y2 = acc[2] + dsk[2] * lo_f(uu.y), y3 = acc[3] + dsk[3] * hi_f(uu.y);
            y0 = gelu_tanh(y0); y1 = gelu_tanh(y1); y2 = gelu_tanh(y2); y3 = gelu_tanh(y3);
            *(u32x2*)(Y5 + ((size_t)li * SEQ + c * 64 + t) * 512 + g * 16 + 4 * g4) = (u32x2){pk2(y0, y1), pk2(y2, y3)};
        }
    }
}

#ifndef SB_EARLY_EXIT
#define SB_EARLY_EXIT 1
#endif
template <bool MASKED>
__device__ __forceinline__ void sb_qtile(const bf16x8 (&kf)[4][2], const bf16x8 (&qf)[2], float& R, bf16x8 (&pfr)[2], int li, int g4, int kpos0, int qpos, u32x2 dpat) {
    const unsigned ONES = 0x3F803F80u;
    const float SC = 0.125f * 1.4426950408889634f;
    f32x4 z[4];
#pragma unroll
    for (int kt = 0; kt < 4; ++kt) { f32x4 a = (f32x4){0.f, 0.f, 0.f, 0.f}; a = mfma16(kf[kt][0], qf[0], a); a = mfma16(kf[kt][1], qf[1], a); z[kt] = a; }
    float T = 0.f; unsigned hi[4][2];
#pragma unroll
    for (int kt = 0; kt < 4; ++kt) { float Lv[4];
#pragma unroll
        for (int jj = 0; jj < 4; ++jj) { const float zz = z[kt][jj] * SC;
            const float sp = fmaxf(zz, 0.f) + __builtin_amdgcn_logf(1.f + __builtin_amdgcn_exp2f(-fabsf(zz)));
            if (MASKED) { const bool valid = kpos0 + kt * 16 + jj < qpos; Lv[jj] = valid ? -sp : 0.f; z[kt][jj] = valid ? (zz - sp) : -1e30f; }
            else { Lv[jj] = -sp; z[kt][jj] = zz - sp; }
            T += Lv[jj]; }
        hi[kt][0] = pk2(Lv[0], Lv[1]); hi[kt][1] = pk2(Lv[2], Lv[3]); }
    T += __shfl_xor(T, 16); T += __shfl_xor(T, 32);
    bf16x8 Lh[2];
#pragma unroll
    for (int kk = 0; kk < 2; ++kk) Lh[kk] = as_frag((u32x4){hi[2 * kk][0], hi[2 * kk][1], hi[2 * kk + 1][0], hi[2 * kk + 1][1]});
    unsigned pw[4][2];
#pragma unroll
    for (int st = 0; st < 4; ++st) { f32x4 ce = (f32x4){0.f, 0.f, 0.f, 0.f};
#pragma unroll
        for (int kk = 0; kk < 2; ++kk) { if (2 * kk + 1 >= st) {
            u32x4 ua;
            { const int k0 = 2 * kk, k1 = 2 * kk + 1;
              ua.x = k0 > st ? ONES : (k0 == st ? dpat.x : 0u); ua.y = k0 > st ? ONES : (k0 == st ? dpat.y : 0u);
              ua.z = k1 > st ? ONES : (k1 == st ? dpat.x : 0u); ua.w = k1 > st ? ONES : (k1 == st ? dpat.y : 0u); }
            ce = mfma16(as_frag(ua), Lh[kk], ce); } }
        float w[4];
#pragma unroll
        for (int jj = 0; jj < 4; ++jj) w[jj] = __builtin_amdgcn_exp2f(z[st][jj] + R + ce[jj]);
        pw[st][0] = pk2(w[0], w[1]); pw[st][1] = pk2(w[2], w[3]); }
    R += T;
#pragma unroll
    for (int kk = 0; kk < 2; ++kk) pfr[kk] = as_frag((u32x4){pw[2 * kk][0], pw[2 * kk][1], pw[2 * kk + 1][0], pw[2 * kk + 1][1]});
}
__device__ __forceinline__ void sb_phase(const Params& p, LAS unsigned char* lds) {
    const int tid = tid_opaque(), wid = __builtin_amdgcn_readfirstlane(tid >> 6), lane = tid & 63, li = lane & 15, g4 = lane >> 4;
    const bf16_t* QKV = (const bf16_t*)(p.ws + WS_R1);
    bf16_t* MIX = (bf16_t*)(p.ws + WS_MIX);
    LAS bf16_t* Vl = (LAS bf16_t*)(lds + wid * VL_BYTES);
    const int wv = blockIdx.x * 8 + wid, nw = gridDim.x * 8;
    u32x2 dpat; dpat.x = ((4 * g4 + 0 > li) ? 0x3F80u : 0u) | ((4 * g4 + 1 > li) ? 0x3F800000u : 0u); dpat.y = ((4 * g4 + 2 > li) ? 0x3F80u : 0u) | ((4 * g4 + 3 > li) ? 0x3F800000u : 0u);
    for (int it = wv; it < 8192; it += nw) {
        const int bh = it >> 6, pr = it & 63, b = bh >> 3, h = bh & 7;
        for (int half = 0; half < 2; ++half) {
            const int qtile = half ? 127 - pr : pr, t0 = qtile * 32, kbd = t0 >> 6;
            const bf16_t* qb = QKV + ((size_t)b * SEQ + t0) * 3584 + 2048 + h * 64;
            bf16x8 qf[2][2];
#pragma unroll
            for (int qt = 0; qt < 2; ++qt)
#pragma unroll
                for (int ks = 0; ks < 2; ++ks) qf[qt][ks] = *(const bf16x8*)(qb + (size_t)(qt * 16 + li) * 3584 + 32 * ks + 8 * g4);
            f32x4 o[2][4]; float R[2];
#pragma unroll
            for (int qt = 0; qt < 2; ++qt) { R[qt] = 0.f;
#pragma unroll
                for (int dt = 0; dt < 4; ++dt) o[qt][dt] = (f32x4){0.f, 0.f, 0.f, 0.f}; }
            for (int kb = kbd; kb >= 0; --kb) {
                const bf16_t* kbase = QKV + ((size_t)b * SEQ + kb * 64) * 3584 + 2560 + h * 64;
#pragma unroll
                for (int r = 0; r < 8; ++r) { const int row = r * 8 + (lane >> 3), c8 = lane & 7;
                    *(LAS u32x4*)(Vl + row * VS + c8 * 8) = *(const u32x4*)(kbase + (size_t)row * 3584 + 512 + c8 * 8); }
                bf16x8 kf[4][2];
#pragma unroll
                for (int kt = 0; kt < 4; ++kt)
#pragma unroll
                    for (int ks = 0; ks < 2; ++ks) kf[kt][ks] = *(const bf16x8*)(kbase + (size_t)(kt * 16 + li) * 3584 + 32 * ks + 8 * g4);
                wave_lds_fence();
                const int kpos0 = kb * 64 + 4 * g4;
                bf16x8 pfr[2][2];
                if (kb == kbd) {
#pragma unroll
                    for (int qt = 0; qt < 2; ++qt) sb_qtile<true>(kf, qf[qt], R[qt], pfr[qt], li, g4, kpos0, t0 + qt * 16 + li, dpat);
                } else {
#pragma unroll
                    for (int qt = 0; qt < 2; ++qt) sb_qtile<false>(kf, qf[qt], R[qt], pfr[qt], li, g4, kpos0, t0 + qt * 16 + li, dpat);
                }
                { bf16x8 vf[2][4];
#pragma unroll
                  for (int kk = 0; kk < 2; ++kk)
#pragma unroll
                      for (int dt = 0; dt < 4; ++dt) vf[kk][dt] = tr_pair(Vl, VS, 32 * kk + 4 * g4, 32 * kk + 16 + 4 * g4, dt * 16, li);
#pragma unroll
                  for (int kk = 0; kk < 2; ++kk)
#pragma unroll
                      for (int dt = 0; dt < 4; ++dt)
#pragma unroll
                          for (int qt = 0; qt < 2; ++qt) o[qt][dt] = mfma16(vf[kk][dt], pfr[qt][kk], o[qt][dt]); }
                wave_lds_fence();
#if SB_EARLY_EXIT
                { const float rm = fmaxf(R[0], R[1]); if (__all(rm < -152.f)) break; }
#endif
            }
#pragma unroll
            for (int qt = 0; qt < 2; ++qt)
#pragma unroll
                for (int dt = 0; dt < 4; ++dt) { const f32x4 v = o[qt][dt];
                    *(u32x2*)(MIX + ((size_t)b * SEQ + t0 + qt * 16 + li) * 1024 + 512 + h * 64 + dt * 16 + 4 * g4) = (u32x2){pk2(v[0], v[1]), pk2(v[2], v[3])}; }
        }
    }
}

constexpr int RS = 136;
__device__ __forceinline__ float ret_log_gamma(int h) { return logf(1.f - exp2f(-5.f - (float)h)); }
struct RotRegs { u32x4 a, b; };
struct RopeRegs { f32x2 cs[8]; };
struct PlainRegs { u32x4 a, b; };
__device__ __forceinline__ void rot_ld(RotRegs& r, const bf16_t* src  , int j, int part) { r.a = *(const u32x4*)(src + (size_t)j * 3584 + part * 8); r.b = *(const u32x4*)(src + (size_t)j * 3584 + 64 + part * 8); }
__device__ __forceinline__ void rope_ld(RopeRegs& r, const f32x2* rope, int pos, int part) {
#pragma unroll
    for (int e = 0; e < 8; ++e) r.cs[e] = rope[(size_t)pos * 64 + part * 8 + e]; }
__device__ __forceinline__ void plain_ld(PlainRegs& r, const bf16_t* src, int j, int part) { r.a = *(const u32x4*)(src + (size_t)j * 3584 + part * 16); r.b = *(const u32x4*)(src + (size_t)j * 3584 + part * 16 + 8); }
__device__ __forceinline__ void rot_st(const RotRegs& r, const RopeRegs& c, LAS bf16_t* dst, int j, int part, float rsc) {
    const float x1[8] = {lo_f(r.a.x), hi_f(r.a.x), lo_f(r.a.y), hi_f(r.a.y), lo_f(r.a.z), hi_f(r.a.z), lo_f(r.a.w), hi_f(r.a.w)};
    const float x2[8] = {lo_f(r.b.x), hi_f(r.b.x), lo_f(r.b.y), hi_f(r.b.y), lo_f(r.b.z), hi_f(r.b.z), lo_f(r.b.w), hi_f(r.b.w)};
    float o1[8], o2[8];
#pragma unroll
    for (int e = 0; e < 8; ++e) { const f32x2 cc = c.cs[e]; o1[e] = (x1[e] * cc.x - x2[e] * cc.y) * rsc; o2[e] = (x1[e] * cc.y + x2[e] * cc.x) * rsc; }
    *(LAS u32x4*)(dst + j * RS + part * 8) = (u32x4){pk2(o1[0], o1[1]), pk2(o1[2], o1[3]), pk2(o1[4], o1[5]), pk2(o1[6], o1[7])};
    *(LAS u32x4*)(dst + j * RS + 64 + part * 8) = (u32x4){pk2(o2[0], o2[1]), pk2(o2[2], o2[3]), pk2(o2[4], o2[5]), pk2(o2[6], o2[7])};
}
__device__ __forceinline__ void plain_st(const PlainRegs& r, LAS bf16_t* dst, int j, int part) { *(LAS u32x4*)(dst + j * RS + part * 16) = r.a; *(LAS u32x4*)(dst + j * RS + part * 16 + 8) = r.b; }

__device__ __forceinline__ void reta_phase(const Params& p, LAS unsigned char* lds) {
    const int tid = tid_opaque(), wid = __builtin_amdgcn_readfirstlane(tid >> 6), lane = tid & 63, li = lane & 15, g4 = lane >> 4;
    const int j = tid >> 3, part = tid & 7;
    const bf16_t* QKV = (const bf16_t*)(p.ws + WS_R1);
    const f32x2* rope = (const f32x2*)(p.ws + WS_ROPE);
    bf16_t* RET = (bf16_t*)(p.ws + WS_H);
    LAS bf16_t* Kl = (LAS bf16_t*)lds; LAS bf16_t* Vl = (LAS bf16_t*)(lds + 64 * RS * 2);
    RotRegs kr; RopeRegs cr; PlainRegs vr;
    { const int item = blockIdx.x; if (item < 4096) { const int c = item & 63, hh = (item >> 6) & 3, b = item >> 8; const bf16_t* base = QKV + ((size_t)b * SEQ + c * 64) * 3584 + hh * 128;
        rot_ld(kr, base + 512, j, part); rope_ld(cr, rope, c * 64 + j, part); plain_ld(vr, base + 1024, j, part); } }
    for (int item = blockIdx.x; item < 4096; item += gridDim.x) {
        const int c = item & 63, hh = (item >> 6) & 3, b = item >> 8;
        const float lg = ret_log_gamma(hh);
        __syncthreads();
        rot_st(kr, cr, Kl, j, part, 0.08838834764831845f * __expf(lg * (63.f - (float)j)));
        plain_st(vr, Vl, j, part);
        { const int nx = item + gridDim.x; if (nx < 4096) { const int c2 = nx & 63, h2 = (nx >> 6) & 3, b2 = nx >> 8; const bf16_t* base = QKV + ((size_t)b2 * SEQ + c2 * 64) * 3584 + h2 * 128;
            rot_ld(kr, base + 512, j, part); rope_ld(cr, rope, c2 * 64 + j, part); plain_ld(vr, base + 1024, j, part); } }
        __syncthreads();
        f32x4 acc[8];
#pragma unroll
        for (int et = 0; et < 8; ++et) acc[et] = (f32x4){0.f, 0.f, 0.f, 0.f};
#pragma unroll
        for (int kk = 0; kk < 2; ++kk) { const bf16x8 af = tr_pair(Kl, RS, 32 * kk + 8 * g4, 32 * kk + 8 * g4 + 4, wid * 16, li);
#pragma unroll
            for (int et = 0; et < 8; ++et) { const bf16x8 bfr = tr_pair(Vl, RS, 32 * kk + 8 * g4, 32 * kk + 8 * g4 + 4, et * 16, li); acc[et] = mfma16(af, bfr, acc[et]); } }
        const size_t sid = (size_t)((b * 4 + hh) * 64 + c);
#pragma unroll
        for (int et = 0; et < 8; ++et) *(u32x2*)(RET + (sid * 128 + et * 16 + li) * 128 + wid * 16 + 4 * g4) = (u32x2){pk2(acc[et][0], acc[et][1]), pk2(acc[et][2], acc[et][3])};
    }
}
__device__ __forceinline__ void retscan_phase(const Params& p) {
    bf16_t* RET = (bf16_t*)(p.ws + WS_H);
    const int gtid = blockIdx.x * NTHR + tid_opaque(), nthr = gridDim.x * NTHR;
    for (int w = gtid; w < 64 * 2048; w += nthr) {
        const int bhh = w >> 11, e8 = w & 2047, hh = bhh & 3;
        const float cd = __expf(64.f * ret_log_gamma(hh));
        float S[8];
#pragma unroll
        for (int e = 0; e < 8; ++e) S[e] = 0.f;
        bf16_t* base = RET + (size_t)bhh * 64 * 16384 + e8 * 8;
        for (int c0 = 0; c0 < 64; c0 += 4) {
            u32x4 kv[4];
#pragma unroll
            for (int k = 0; k < 4; ++k) kv[k] = *(const u32x4*)(base + (size_t)(c0 + k) * 16384);
#pragma unroll
            for (int k = 0; k < 4; ++k) {
                *(u32x4*)(base + (size_t)(c0 + k) * 16384) = (u32x4){pk2(S[0], S[1]), pk2(S[2], S[3]), pk2(S[4], S[5]), pk2(S[6], S[7])};
                S[0] = S[0] * cd + lo_f(kv[k].x); S[1] = S[1] * cd + hi_f(kv[k].x); S[2] = S[2] * cd + lo_f(kv[k].y); S[3] = S[3] * cd + hi_f(kv[k].y);
                S[4] = S[4] * cd + lo_f(kv[k].z); S[5] = S[5] * cd + hi_f(kv[k].z); S[6] = S[6] * cd + lo_f(kv[k].w); S[7] = S[7] * cd + hi_f(kv[k].w); }
        }
    }
}
__device__ __forceinline__ void retc_phase(const Params& p, LAS unsigned char* lds) {
    const int tid = tid_opaque(), wid = __builtin_amdgcn_readfirstlane(tid >> 6), lane = tid & 63, li = lane & 15, g4 = lane >> 4;
    const bf16_t* QKV = (const bf16_t*)(p.ws + WS_R1);
    const f32x2* rope = (const f32x2*)(p.ws + WS_ROPE);
    const bf16_t* RET = (const bf16_t*)(p.ws + WS_H);
    bf16_t* MIX = (bf16_t*)(p.ws + WS_MIX);
    LAS bf16_t* Ql = (LAS bf16_t*)lds; LAS bf16_t* Kl = (LAS bf16_t*)(lds + 17408); LAS bf16_t* Vl = (LAS bf16_t*)(lds + 34816);
    LAS bf16_t* Sl = (LAS bf16_t*)(lds + 52224);
    LAS f32x2* stl = (LAS f32x2*)(lds + 61440);
    const int j = tid >> 3, part = tid & 7;
    RotRegs qr, kr; RopeRegs cr; PlainRegs vr;
    { const int item = blockIdx.x; if (item < 4096) { const int c = item & 63, hh = (item >> 6) & 3, b = item >> 8; const bf16_t* base = QKV + ((size_t)b * SEQ + c * 64) * 3584 + hh * 128;
        rot_ld(qr, base, j, part); rot_ld(kr, base + 512, j, part); rope_ld(cr, rope, c * 64 + j, part); plain_ld(vr, base + 1024, j, part); } }
    for (int item = blockIdx.x; item < 4096; item += gridDim.x) {
        const int c = item & 63, hh = (item >> 6) & 3, b = item >> 8;
        const float lg = ret_log_gamma(hh);
        const size_t row0 = (size_t)b * SEQ + c * 64;
        const size_t sid = (size_t)((b * 4 + hh) * 64 + c);
        bf16x8 stf[4]; u32x2 gg[4];
#pragma unroll
        for (int ks = 0; ks < 4; ++ks) stf[ks] = *(const bf16x8*)(RET + (sid * 128 + wid * 16 + li) * 128 + 32 * ks + 8 * g4);
#pragma unroll
        for (int itq = 0; itq < 4; ++itq) gg[itq] = *(const u32x2*)(QKV + (row0 + itq * 16 + li) * 3584 + 1536 + hh * 128 + wid * 16 + 4 * g4);
        __syncthreads();
        rot_st(qr, cr, Ql, j, part, 1.f);
        rot_st(kr, cr, Kl, j, part, 0.08838834764831845f);
        plain_st(vr, Vl, j, part);
        { const int nx = item + gridDim.x; if (nx < 4096) { const int c2 = nx & 63, h2 = (nx >> 6) & 3, b2 = nx >> 8; const bf16_t* base = QKV + ((size_t)b2 * SEQ + c2 * 64) * 3584 + h2 * 128;
            rot_ld(qr, base, j, part); rot_ld(kr, base + 512, j, part); rope_ld(cr, rope, c2 * 64 + j, part); plain_ld(vr, base + 1024, j, part); } }
        __syncthreads();
        { const int jt = wid >> 1;
#pragma unroll
          for (int e2 = 0; e2 < 2; ++e2) { const int itq = 2 * (wid & 1) + e2; f32x4 sacc = (f32x4){0.f, 0.f, 0.f, 0.f};
#pragma unroll
              for (int ks = 0; ks < 4; ++ks) { const bf16x8 af = *(const LAS bf16x8*)(Kl + (jt * 16 + li) * RS + 32 * ks + 8 * g4); const bf16x8 bfr = *(const LAS bf16x8*)(Ql + (itq * 16 + li) * RS + 32 * ks + 8 * g4); sacc = mfma16(af, bfr, sacc); }
              float sv[4];
#pragma unroll
              for (int jj = 0; jj < 4; ++jj) { const int j = jt * 16 + 4 * g4 + jj, iq = itq * 16 + li; const int dd = iq > j ? iq - j : j - iq; sv[jj] = sacc[jj] * __expf(lg * (float)dd); }
              *(LAS u32x2*)(Sl + (itq * 16 + li) * VS + jt * 16 + 4 * g4) = (u32x2){pk2(sv[0], sv[1]), pk2(sv[2], sv[3])}; } }
        __syncthreads();
        f32x4 oa[4];
#pragma unroll
        for (int itq = 0; itq < 4; ++itq) oa[itq] = (f32x4){0.f, 0.f, 0.f, 0.f};
#pragma unroll
        for (int ks = 0; ks < 4; ++ks) { const bf16x8 af = stf[ks];
#pragma unroll
            for (int itq = 0; itq < 4; ++itq) { const bf16x8 bfr = *(const LAS bf16x8*)(Ql + (itq * 16 + li) * RS + 32 * ks + 8 * g4); oa[itq] = mfma16(af, bfr, oa[itq]); } }
#pragma unroll
        for (int itq = 0; itq < 4; ++itq) oa[itq] *= __expf(lg * (float)(itq * 16 + li + 1));
#pragma unroll
        for (int kk = 0; kk < 2; ++kk) { const bf16x8 af = tr_pair(Vl, RS, 32 * kk + 8 * g4, 32 * kk + 8 * g4 + 4, wid * 16, li);
#pragma unroll
            for (int itq = 0; itq < 4; ++itq) { const bf16x8 bfr = *(const LAS bf16x8*)(Sl + (itq * 16 + li) * VS + 32 * kk + 8 * g4); oa[itq] = mfma16(af, bfr, oa[itq]); } }
#pragma unroll
        for (int itq = 0; itq < 4; ++itq) { float s1 = oa[itq][0] + oa[itq][1] + oa[itq][2] + oa[itq][3];
            float s2 = oa[itq][0] * oa[itq][0] + oa[itq][1] * oa[itq][1] + oa[itq][2] * oa[itq][2] + oa[itq][3] * oa[itq][3];
            s1 += __shfl_xor(s1, 16); s1 += __shfl_xor(s1, 32); s2 += __shfl_xor(s2, 16); s2 += __shfl_xor(s2, 32);
            if (g4 == 0) stl[wid * 64 + itq * 16 + li] = (f32x2){s1, s2}; }
        __syncthreads();
        const f32x4 ng = *(const f32x4*)(p.in[25] + hh * 128 + wid * 16 + 4 * g4);
#pragma unroll
        for (int itq = 0; itq < 4; ++itq) { float s1 = 0.f, s2 = 0.f;
#pragma unroll
            for (int w8 = 0; w8 < 8; ++w8) { const f32x2 t = stl[w8 * 64 + itq * 16 + li]; s1 += t.x; s2 += t.y; }
            const float mu = s1 * (1.f / 128.f), var = fmaxf(s2 * (1.f / 128.f) - mu * mu, 0.f), rs = rsqrtf(var + 1e-6f);
            const size_t row = row0 + itq * 16 + li;
            const float r0 = (oa[itq][0] - mu) * rs * ng[0] * silu_f(lo_f(gg[itq].x)), r1 = (oa[itq][1] - mu) * rs * ng[1] * silu_f(hi_f(gg[itq].x));
            const float r2 = (oa[itq][2] - mu) * rs * ng[2] * silu_f(lo_f(gg[itq].y)), r3 = (oa[itq][3] - mu) * rs * ng[3] * silu_f(hi_f(gg[itq].y));
            *(u32x2*)(MIX + row * 1024 + hh * 128 + wid * 16 + 4 * g4) = (u32x2){pk2(r0, r1), pk2(r2, r3)}; }
    }
}

constexpr int N_PHASES = 20;
__global__ void __launch_bounds__(NTHR, 2) mega_fwd(Params p) {
    extern __shared__ __attribute__((aligned(16))) unsigned char lds_raw[];
    LAS unsigned char* lds = (LAS unsigned char*)lds_raw;
    cg::grid_group grid = cg::this_grid();
    unsigned char* ws = p.ws;
    const float* MOD = (const float*)(ws + WS_MOD);
    bf16_t* H = (bf16_t*)(ws + WS_H); bf16_t* MIX = (bf16_t*)(ws + WS_MIX); bf16_t* R1 = (bf16_t*)(ws + WS_R1);
    float* XA = p.out;
    pg8::StaticOrder S;
#ifndef PROBE_MASK
#define PROBE_MASK 0u
#endif
    unsigned long long probe_acc = 0ull;
    unsigned bar_gen = 0u;
    for (int ph = p.ph_lo; ph < p.ph_hi; ++ph) {
        const unsigned long long probe_t0 = PROBE_MASK ? __builtin_amdgcn_s_memrealtime() : 0ull;
        const int layer = ph >= 11 ? 1 : 0;
        const float* modl = MOD + (size_t)layer * 16 * 6144;
        switch (ph) {
        case 0: prep_phase(p, lds); break;
        case 1: case 8: case 11: case 17: {
            const bool ffn = (ph == 8 || ph == 17);
            const float* xin = (ph == 1) ? p.in[0] : XA;
            norm_phase(xin, (ffn ? p.in[5] : p.in[4]) + layer * 1024, modl + (ffn ? 3072 : 0), modl + (ffn ? 4096 : 1024), H);
        } break;
        case 2: {
            pg8::Gemm g{H, (const bf16_t*)(ws + WS_W_ABIN), MTOK, 2048, 1024};
            S.init(MTOK, 2048, gridDim.x, blockIdx.x);
            pg8::EpiStoreQK E{R1, p.in[10], p.in[11]};
            pg8::gemm_phase(lds, g, S, E);
        } break;
        case 12: {
            pg8::Gemm g{H, (const bf16_t*)(ws + WS_W_CDIN), MTOK, 3584, 1024};
            S.init(MTOK, 3584, gridDim.x, blockIdx.x);
            pg8::EpiStore E{R1, 3584};
            pg8::gemm_phase(lds, g, S, E);
        } break;
        case 3: attnA_phase(p, lds); break;
        case 4: s5scan_phase(p); break;
        case 5: s5c_phase(p, lds); break;
        case 6: {
            pg8::Gemm g{(const bf16_t*)(ws + WS_Y5), (const bf16_t*)(ws + WS_W_GLU), MTOK, 512, 512};
            S.init(MTOK, 512, gridDim.x, blockIdx.x);
            pg8::EpiGlu E{(const bf16_t*)(ws + WS_Y5), p.in[22], MIX};
            pg8::gemm_phase(lds, g, S, E);
        } break;
        case 7: case 16: case 10: case 19: {
            const bool ffn = (ph == 10 || ph == 19);
            const bf16_t* A = ffn ? R1 : MIX;
            const bf16_t* Bt = ffn ? (const bf16_t*)(ws + WS_W_FFOUT) + (size_t)layer * 1024 * FFH : (const bf16_t*)(ws + (layer ? WS_W_CDOUT : WS_W_ABOUT));
            pg8::Gemm g{A, Bt, MTOK, 1024, ffn ? FFH : 1024};
            S.init(MTOK, 1024, gridDim.x, blockIdx.x);
            pg8::EpiResid E{(ph == 7) ? p.in[0] : XA, XA, modl + (ffn ? 5120 : 2048)};
            pg8::gemm_phase(lds, g, S, E);
        } break;
        case 9: case 18: {
            pg8::Gemm g{H, (const bf16_t*)(ws + WS_W_FFIN) + (size_t)layer * 5632 * 1024, MTOK, 5632, 1024};
            S.init(MTOK, 5632, gridDim.x, blockIdx.x);
            pg8::EpiSwiglu E{R1};
            pg8::gemm_phase(lds, g, S, E);
        } break;
        case 13: reta_phase(p, lds); __syncthreads(); sb_phase(p, lds); break;
        case 14: retscan_phase(p); break;
        case 15: retc_phase(p, lds); break;
        default: break;
        }
        unsigned long long probe_t1 = 0ull;
        if (PROBE_MASK) { __syncthreads(); probe_t1 = __builtin_amdgcn_s_memrealtime(); if ((PROBE_MASK >> ph) & 1u) probe_acc += probe_t1 - probe_t0; }
        if (ph + 1 < p.ph_hi) {
            if (p.ph_hi > 1000) grid.sync();
            grid_barrier((unsigned*)(ws + WS_CTL), bar_gen);
        }
        if (PROBE_MASK && ((PROBE_MASK >> 20) & 1u)) probe_acc += __builtin_amdgcn_s_memrealtime() - probe_t1;
    }
    if (PROBE_MASK && blockIdx.x == 0 && threadIdx.x == 0) { const unsigned long long st = __builtin_amdgcn_s_memrealtime(); while (__builtin_amdgcn_s_memrealtime() - st < probe_acc) __builtin_amdgcn_s_sleep(8); }
}


#ifndef DIAG
#define DIAG 0
#endif
#if DIAG
__global__ void diag_fold(Params p) {
    const size_t n = (size_t)MTOK * 1024; unsigned char* ws = p.ws;
    for (size_t i = (size_t)blockIdx.x * blockDim.x + threadIdx.x; i < n; i += (size_t)gridDim.x * blockDim.x) {
        const size_t row = i >> 10; const int col = (int)(i & 1023); float v = 0.f;
#if DIAG == 30
        v = col < 512 ? bf2f(((const bf16_t*)(ws + WS_MIX))[i]) : 0.f;
#elif DIAG == 31
        v = ((const float*)(ws + WS_S5E))[i & 4194303];
#elif DIAG == 3
        v = col < 512 ? bf2f(((const bf16_t*)(ws + WS_MIX))[i]) : ((const float*)(ws + WS_S5E))[(row * 512 + col - 512) & 4194303];
#elif DIAG == 2
        v = bf2f(((const bf16_t*)(ws + WS_R1))[2 * i]) + bf2f(((const bf16_t*)(ws + WS_R1))[2 * i + 1]);
#elif DIAG == 1
        v = bf2f(((const bf16_t*)(ws + WS_H))[i]);
#elif DIAG == 5
        v = bf2f(((const bf16_t*)(ws + WS_Y5))[i >> 1]);
#elif DIAG == 6
        v = bf2f(((const bf16_t*)(ws + WS_MIX))[i]);
#endif
        p.out[i] = v;
    }
}
#endif
#ifndef MK_MULTI
#define MK_MULTI 0
#endif
extern "C" void kernel_launch(void* const* d_in, const int* in_sizes, int n_in, void* d_out, int out_size, void* d_ws, size_t ws_size, hipStream_t stream) {
    static int grid = 0;
    if (grid == 0) {
        if (n_in != 26 || out_size != MTOK * DM || ws_size < WS_END) { fprintf(stderr, "kernel_launch: unexpected shapes (n_in %d out %d ws %zu need %zu)\n", n_in, out_size, ws_size, (size_t)WS_END); grid = -1; return; }
        int dev = 0, cus = 0, per_cu = 0;
        hipGetDevice(&dev); hipDeviceGetAttribute(&cus, hipDeviceAttributeMultiprocessorCount, dev);
        if (hipFuncSetAttribute((const void*)mega_fwd, hipFuncAttributeMaxDynamicSharedMemorySize, LDS_BYTES) != hipSuccess) { fprintf(stderr, "kernel_launch: hipFuncSetAttribute failed\n"); grid = -1; return; }
        if (hipOccupancyMaxActiveBlocksPerMultiprocessor(&per_cu, (const void*)mega_fwd, NTHR, LDS_BYTES) != hipSuccess || per_cu < 1) { fprintf(stderr, "kernel_launch: occupancy query says %d\n", per_cu); per_cu = 1; }
        (void)hipGetLastError();
        grid = cus * 1;
    }
    if (grid < 0) return;
    Params p{};
    for (int i = 0; i < 26; ++i) p.in[i] = (const float*)d_in[i];
    p.out = (float*)d_out; p.ws = (unsigned char*)d_ws;
#if MK_MULTI
#if DIAG
    for (int ph = 0; ph <= (DIAG >= 30 ? DIAG / 10 : DIAG); ++ph) { p.ph_lo = ph; p.ph_hi = ph + 1; hipLaunchKernelGGL(mega_fwd, dim3(grid), dim3(NTHR), LDS_BYTES, stream, p); }
    hipLaunchKernelGGL(diag_fold, dim3(2048), dim3(256), 0, stream, p);
#else
    for (int ph = 0; ph < N_PHASES; ++ph) { p.ph_lo = ph; p.ph_hi = ph + 1; hipLaunchKernelGGL(mega_fwd, dim3(grid), dim3(NTHR), LDS_BYTES, stream, p); }
#endif
#else
    p.ph_lo = 0; p.ph_hi = N_PHASES;
    (void)hipMemsetAsync((char*)d_ws + WS_CTL, 0, 4096, stream);
    void* args[] = {&p};
    hipError_t e = hipLaunchCooperativeKernel((const void*)mega_fwd, dim3(grid), dim3(NTHR), args, LDS_BYTES, stream);
    if (e != hipSuccess) fprintf(stderr, "cooperative launch failed: %s (grid %d)\n", hipGetErrorString(e), grid);
#endif
}
```

```cpp
#include <hip/hip_runtime.h>
#include <hip/hip_cooperative_groups.h>
#include <cstdio>
namespace cg = cooperative_groups;

#define LAS __attribute__((address_space(3)))
typedef unsigned short bf16_t;
typedef short bf16x8 __attribute__((ext_vector_type(8)));
typedef short s16x4 __attribute__((ext_vector_type(4)));
typedef float f32x4 __attribute__((ext_vector_type(4)));
typedef float f32x2 __attribute__((ext_vector_type(2)));
typedef unsigned u32x4 __attribute__((ext_vector_type(4)));
typedef unsigned u32x2 __attribute__((ext_vector_type(2)));

constexpr int NB = 16, SEQ = 4096, DM = 1024, MTOK = NB * SEQ, FFH = 2816;
constexpr int NTHR = 512;
constexpr int LDS_BYTES = 135168;

constexpr size_t al256(size_t x) { return (x + 255) & ~(size_t)255; }
constexpr size_t WS_CTL = 0;
constexpr size_t WS_W_ABIN = 4096;
constexpr size_t WS_W_ABOUT = WS_W_ABIN + (size_t)2048 * 1024 * 2;
constexpr size_t WS_W_GLU = WS_W_ABOUT + (size_t)1024 * 1024 * 2;
constexpr size_t WS_W_FFIN = WS_W_GLU + (size_t)512 * 512 * 2;
constexpr size_t WS_W_FFOUT = WS_W_FFIN + (size_t)2 * 5632 * 1024 * 2;
constexpr size_t WS_W_CDIN = WS_W_FFOUT + (size_t)2 * 1024 * 2816 * 2;
constexpr size_t WS_W_CDOUT = WS_W_CDIN + (size_t)3584 * 1024 * 2;
constexpr size_t WS_MOD = WS_W_CDOUT + (size_t)1024 * 1024 * 2;
constexpr size_t WS_ROPE = WS_MOD + (size_t)2 * 16 * 6144 * 4;
constexpr size_t WS_KERN = WS_ROPE + (size_t)4096 * 64 * 8;
constexpr size_t WS_S5M = WS_KERN + (size_t)32 * 64 * 256 * 2;
constexpr size_t WS_S5G = WS_S5M + (size_t)32 * 128 * 1024 * 2;
constexpr size_t WS_A64 = WS_S5G + (size_t)32 * 1024 * 128 * 2;
constexpr size_t WS_S5E = WS_A64 + (size_t)32 * 64 * 8;
constexpr size_t WS_S5X = WS_S5E + (size_t)64 * 32 * 16 * 128 * 4;
constexpr size_t WS_Y5 = WS_S5X + (size_t)64 * 32 * 16 * 128 * 2;
constexpr size_t WS_H = WS_Y5 + (size_t)MTOK * 512 * 2;
constexpr size_t WS_MIX = WS_H + (size_t)MTOK * 1024 * 2;
constexpr size_t WS_R1 = WS_MIX + (size_t)MTOK * 1024 * 2;
constexpr size_t WS_END = WS_R1 + (size_t)MTOK * 3584 * 2;

struct Params {
    const float* in[26];
    float* out;
    unsigned char* ws;
    int ph_lo, ph_hi;
};

__device__ __forceinline__ float bf2f(unsigned short b) { return __uint_as_float(((unsigned)b) << 16); }
typedef __bf16 bf16x2_t __attribute__((ext_vector_type(2)));
__device__ __forceinline__ unsigned pk2(float lo, float hi) { const f32x2 v = {lo, hi}; return __builtin_bit_cast(unsigned, __builtin_convertvector(v, bf16x2_t)); }
__device__ __forceinline__ bf16_t f2bf(float f) { return (bf16_t)(pk2(f, 0.f) & 0xffffu); }
__device__ __forceinline__ float lo_f(unsigned u) { return __uint_as_float(u << 16); }
__device__ __forceinline__ float hi_f(unsigned u) { return __uint_as_float(u & 0xffff0000u); }
__device__ __forceinline__ bf16x8 as_frag(u32x4 u) { return __builtin_bit_cast(bf16x8, u); }
__device__ __forceinline__ f32x4 mfma16(bf16x8 a, bf16x8 b, f32x4 c) { return __builtin_amdgcn_mfma_f32_16x16x32_bf16(a, b, c, 0, 0, 0); }
__device__ __forceinline__ float silu_f(float x) { return x * __builtin_amdgcn_rcpf(1.f + __expf(-x)); }
__device__ __forceinline__ float sigm_f(float x) { return __builtin_amdgcn_rcpf(1.f + __expf(-x)); }
__device__ __forceinline__ float gelu_tanh(float x) {
    const float u = 0.7978845608028654f * (x + 0.044715f * x * x * x);
    const float t = 1.f - 2.f * __builtin_amdgcn_rcpf(1.f + __expf(2.f * u));
    return 0.5f * x * (1.f + t);
}
__device__ __forceinline__ bf16x8 tr_pair(LAS bf16_t* base, int stride, int row0, int row1, int col0, int li) {
    const int q = li >> 2, pq = li & 3;
    s16x4 a = __builtin_amdgcn_ds_read_tr16_b64_v4i16((LAS s16x4*)(base + (row0 + q) * stride + col0 + 4 * pq));
    s16x4 b = __builtin_amdgcn_ds_read_tr16_b64_v4i16((LAS s16x4*)(base + (row1 + q) * stride + col0 + 4 * pq));
    bf16x8 r = {a[0], a[1], a[2], a[3], b[0], b[1], b[2], b[3]};
    return r;
}
__device__ __forceinline__ int tid_opaque() { int t = threadIdx.x; asm volatile("" : "+v"(t)); return t; }
__device__ __forceinline__ int vblock() { const int G = gridDim.x, bx = blockIdx.x; return (G % 8 == 0) ? (bx % 8) * (G / 8) + bx / 8 : bx; }
__device__ __forceinline__ void wave_lds_fence() { asm volatile("s_waitcnt lgkmcnt(0)" ::: "memory"); __builtin_amdgcn_wave_barrier(); }


__device__ __forceinline__ void grid_barrier(unsigned* w, unsigned& gen) {
    asm volatile("s_waitcnt vmcnt(0) lgkmcnt(0)" ::: "memory");
    __syncthreads();
    if (threadIdx.x == 0) {
        __builtin_amdgcn_fence(__ATOMIC_RELEASE, "agent");
        asm volatile("s_waitcnt vmcnt(0) lgkmcnt(0)" ::: "memory");
        const unsigned G = gridDim.x, grp = blockIdx.x & 7u, ngrp = (G - grp + 7u) / 8u, ngroups = G < 8u ? G : 8u;
        const unsigned old = __hip_atomic_fetch_add(w + 32 * grp, 1u, __ATOMIC_RELAXED, __HIP_MEMORY_SCOPE_AGENT);
        if (old + 1u == ngrp * (gen + 1u)) {
            const unsigned old2 = __hip_atomic_fetch_add(w + 256, 1u, __ATOMIC_RELAXED, __HIP_MEMORY_SCOPE_AGENT);
            if (old2 + 1u == ngroups * (gen + 1u)) __hip_atomic_fetch_add(w + 288, 1u, __ATOMIC_RELAXED, __HIP_MEMORY_SCOPE_AGENT);
        }
        while (__hip_atomic_load(w + 288, __ATOMIC_RELAXED, __HIP_MEMORY_SCOPE_AGENT) == gen) __builtin_amdgcn_s_sleep(2);
        __builtin_amdgcn_fence(__ATOMIC_ACQUIRE, "agent");
        asm volatile("s_waitcnt vmcnt(0) lgkmcnt(0)" ::: "memory");
    }
    ++gen;
    __syncthreads();
}

namespace pg8 {
constexpr int BM = 256, BK = 64, HALF = 128, HTB = HALF * BK * 2, STAGE_BYTES = 8 * HTB, NXCD = 8, WGM = 8;
__device__ __forceinline__ int lds_byte(int r, int c) { const int st = (r >> 4) * 2 + (c >> 5), rr = r & 15, cc = c & 31, ob = rr * 64 + cc * 2; return st * 1024 + (ob ^ (((ob >> 9) & 1) << 5)); }
__device__ __forceinline__ void stage_rc(int b, int& R, int& C) { const int st = b / 1024, sb = b % 1024, swz = sb ^ (((sb >> 9) & 1) << 5); R = (st >> 1) * 16 + swz / 64; C = (st & 1) * 32 + (swz % 64) / 2; }
__device__ __forceinline__ int perm32(int rho) { const int n = rho >> 4, i = rho & 15; return 8 * (i >> 2) + 4 * n + (i & 3); }
struct Unit { int pm, pn; };
struct Gemm { const bf16_t* A; const bf16_t* Bt; int M, N, K; };
struct StaticOrder {
    int nM, nN, nwg, G, c;
    __device__ void init(int M, int N, int G_, int c_) { nM = M / BM; nN = N / BM; nwg = nM * nN; G = G_; c = c_; }
    __device__ bool next(int i, Unit& u) const {
        const long L = (long)i * G + c; if (L >= nwg) return false;
        int wgid = (int)L; { const int q = nwg / NXCD, r = nwg % NXCD, xcd = wgid % NXCD, off = wgid / NXCD; wgid = (xcd < r ? xcd * (q + 1) : r * (q + 1) + (xcd - r) * q) + off; }
        const int nig = WGM * nN, gid = wgid / nig, fm = gid * WGM, gsz = (nM - fm) < WGM ? (nM - fm) : WGM;
        u.pm = fm + ((wgid % nig) % gsz); u.pn = (wgid % nig) / gsz; return true;
    }
};

template <class Epi>
__device__ __forceinline__ void gemm_phase(LAS unsigned char* lds, const Gemm g, const StaticOrder& S, const Epi& E) {
    const int tid = tid_opaque(), wid = __builtin_amdgcn_readfirstlane(tid >> 6), lane = tid & 63, wr = wid >> 2, wc = wid & 3, fr = lane & 15, fq = lane >> 4;
    const int K = g.K, nt = K / BK;
    unsigned voffA[2], voffB[2];
#pragma unroll
    for (int i = 0; i < 2; ++i) { int R, C; stage_rc(tid * 16 + i * 8192, R, C); const int Rb = Epi::PERM ? ((R & ~31) + perm32(R & 31)) : R;
        voffA[i] = (unsigned)(R * K + C) * 2u; voffB[i] = (unsigned)(Rb * K + C) * 2u; }
    const size_t kstep = (size_t)(BK * 2);
    const size_t hstep = (size_t)HALF * K * 2;
    const size_t tstep = 2 * hstep;
    const unsigned ldsw = (unsigned)wid * 1024u;
    const int aoff = lds_byte(wr * 64 + fr, fq * 8), boff = lds_byte(wc * 32 + fr, fq * 8);
#define PG8_SA(b, h) (((b) * 2 + (h)) * HTB)
#define PG8_SB(b, h) ((4 + (b) * 2 + (h)) * HTB)
#define PG8_STAGE(bufoff, gbase, voff) do { _Pragma("unroll") for (int _i = 0; _i < 2; ++_i) \
        __builtin_amdgcn_global_load_lds((const unsigned*)((const char*)(gbase) + (voff)[_i]), (LAS unsigned*)(lds + (bufoff) + ldsw + _i * 8192), 16, 0, 0); } while (0)
#define PG8_LDA(dst, b, h) do { _Pragma("unroll") for (int m = 0; m < 4; ++m) _Pragma("unroll") for (int k = 0; k < 2; ++k) dst[m][k] = *(const LAS bf16x8*)(lds + PG8_SA(b, h) + aoff + m * 2048 + k * 1024); } while (0)
#define PG8_LDB(dst, b, h) do { _Pragma("unroll") for (int n = 0; n < 2; ++n) _Pragma("unroll") for (int k = 0; k < 2; ++k) dst[n][k] = *(const LAS bf16x8*)(lds + PG8_SB(b, h) + boff + n * 2048 + k * 1024); } while (0)
#define PG8_MMA(ai, bj, At, Bt) do { __builtin_amdgcn_s_setprio(1); _Pragma("unroll") for (int m = 0; m < 4; ++m) _Pragma("unroll") for (int n = 0; n < 2; ++n) _Pragma("unroll") for (int k = 0; k < 2; ++k) \
        acc[ai][bj][m][n] = __builtin_amdgcn_mfma_f32_16x16x32_bf16(Bt[n][k], At[m][k], acc[ai][bj][m][n], 0, 0, 0); __builtin_amdgcn_s_setprio(0); } while (0)
#define PG8_WAIT_V(n) asm volatile("s_waitcnt vmcnt(" #n ")" ::: "memory")
#define PG8_WAIT_L(n) asm volatile("s_waitcnt lgkmcnt(" #n ")" ::: "memory")
#define PG8_BAR __builtin_amdgcn_s_barrier()
#define PG8_SCHED __builtin_amdgcn_sched_barrier(0)
    Unit cur, nxt; int ui = 0;
    if (!S.next(0, cur)) return;
    f32x4 acc[2][2][4][2];
#pragma unroll
    for (int a = 0; a < 2; ++a)
#pragma unroll
        for (int b = 0; b < 2; ++b)
#pragma unroll
            for (int m = 0; m < 4; ++m)
#pragma unroll
                for (int n = 0; n < 2; ++n) acc[a][b][m][n] = (f32x4){0.f, 0.f, 0.f, 0.f};
    bf16x8 At[4][2], B0[2][2], B1[2][2];
    const char* cA = (const char*)g.A + (size_t)cur.pm * tstep; const char* cB = (const char*)g.Bt + (size_t)cur.pn * tstep;
    PG8_STAGE(PG8_SB(0, 0), cB, voffB); PG8_STAGE(PG8_SA(0, 0), cA, voffA); PG8_STAGE(PG8_SB(0, 1), cB + hstep, voffB); PG8_STAGE(PG8_SA(0, 1), cA + hstep, voffA);
    if (wr == 1) PG8_BAR;
    PG8_WAIT_V(4); PG8_BAR;
    PG8_STAGE(PG8_SB(1, 0), cB + kstep, voffB); PG8_STAGE(PG8_SA(1, 0), cA + kstep, voffA); PG8_STAGE(PG8_SB(1, 1), cB + hstep + kstep, voffB);
    PG8_WAIT_V(6); PG8_BAR;
    for (;;) {
        const bool has_next = S.next(ui + 1, nxt);
        const char* nA = has_next ? (const char*)g.A + (size_t)nxt.pm * tstep : cA; const char* nB = has_next ? (const char*)g.Bt + (size_t)nxt.pn * tstep : cB;
        for (int t = 0; t < nt; t += 2) {
            const bool last = (t == nt - 2);
            const char* a1 = cA + (size_t)(t + 1) * kstep;
            const char* a2 = last ? nA : cA + (size_t)(t + 2) * kstep; const char* b2 = last ? nB : cB + (size_t)(t + 2) * kstep;
            const char* a3 = a2 + kstep; const char* b3 = b2 + kstep;
            PG8_LDB(B0, 0, 0); PG8_SCHED; PG8_LDA(At, 0, 0); PG8_STAGE(PG8_SA(1, 1), a1 + hstep, voffA);
            PG8_WAIT_L(8); PG8_BAR; PG8_WAIT_L(0); PG8_MMA(0, 0, At, B0); PG8_BAR; PG8_SCHED;
            PG8_LDB(B1, 0, 1); PG8_STAGE(PG8_SB(0, 0), b2, voffB);
            PG8_BAR; PG8_WAIT_L(0); PG8_MMA(0, 1, At, B1); PG8_BAR;
            PG8_LDA(At, 0, 1); PG8_STAGE(PG8_SA(0, 0), a2, voffA);
            PG8_BAR; PG8_WAIT_L(0); PG8_MMA(1, 0, At, B0); PG8_BAR; PG8_SCHED;
            PG8_STAGE(PG8_SB(0, 1), b2 + hstep, voffB);
            PG8_WAIT_V(6); PG8_BAR; PG8_MMA(1, 1, At, B1); PG8_BAR;
            PG8_LDB(B0, 1, 0); PG8_SCHED; PG8_LDA(At, 1, 0); PG8_STAGE(PG8_SA(0, 1), a2 + hstep, voffA);
            PG8_WAIT_L(8); PG8_BAR; PG8_WAIT_L(0); PG8_MMA(0, 0, At, B0); PG8_BAR; PG8_SCHED;
            PG8_LDB(B1, 1, 1); PG8_STAGE(PG8_SB(1, 0), b3, voffB);
            PG8_BAR; PG8_WAIT_L(0); PG8_MMA(0, 1, At, B1); PG8_BAR;
            PG8_LDA(At, 1, 1); PG8_STAGE(PG8_SA(1, 0), a3, voffA);
            PG8_BAR; PG8_WAIT_L(0); PG8_MMA(1, 0, At, B0); PG8_BAR; PG8_SCHED;
            PG8_STAGE(PG8_SB(1, 1), b3 + hstep, voffB);
            PG8_WAIT_V(6); PG8_BAR; PG8_MMA(1, 1, At, B1); PG8_BAR;
        }
        E(acc, cur, wr, wc, fr, fq);
        if (!has_next) break;
#pragma unroll
        for (int a = 0; a < 2; ++a)
#pragma unroll
            for (int b = 0; b < 2; ++b)
#pragma unroll
                for (int m = 0; m < 4; ++m)
#pragma unroll
                    for (int n = 0; n < 2; ++n) acc[a][b][m][n] = (f32x4){0.f, 0.f, 0.f, 0.f};
        cur = nxt; cA = nA; cB = nB; ++ui;
    }
    PG8_WAIT_V(0);
    if (wr == 0) PG8_BAR;
    PG8_BAR;
#undef PG8_SA
#undef PG8_SB
#undef PG8_STAGE
#undef PG8_LDA
#undef PG8_LDB
#undef PG8_MMA
#undef PG8_WAIT_V
#undef PG8_WAIT_L
#undef PG8_BAR
#undef PG8_SCHED
}

struct EpiStore {
    static constexpr bool PERM = true;
    bf16_t* O; int ldc;
    __device__ __forceinline__ void operator()(const f32x4 (&acc)[2][2][4][2], const Unit& u, int wr, int wc, int fr, int fq) const {
        const int row0 = u.pm * BM + wr * 64 + fr, col0 = u.pn * BM + wc * 32 + 8 * fq;
#pragma unroll
        for (int ai = 0; ai < 2; ++ai)
#pragma unroll
            for (int m = 0; m < 4; ++m) { bf16_t* rowp = O + (size_t)(row0 + ai * HALF + m * 16) * ldc + col0;
#pragma unroll
                for (int bj = 0; bj < 2; ++bj) { const f32x4 v0 = acc[ai][bj][m][0], v1 = acc[ai][bj][m][1];
                    u32x4 w; w.x = pk2(v0[0], v0[1]); w.y = pk2(v0[2], v0[3]); w.z = pk2(v1[0], v1[1]); w.w = pk2(v1[2], v1[3]);
                    __builtin_nontemporal_store(w, (u32x4*)(rowp + bj * HALF)); } }
    }
};
struct EpiStoreQK {
    static constexpr bool PERM = true;
    bf16_t* O; const float* qg; const float* kg;
    __device__ __forceinline__ void operator()(const f32x4 (&acc)[2][2][4][2], const Unit& u, int wr, int wc, int fr, int fq) const {
        const int row0 = u.pm * BM + wr * 64 + fr;
        if (u.pn >= 4) {
            const int col0 = u.pn * BM + wc * 32 + 8 * fq;
#pragma unroll
            for (int ai = 0; ai < 2; ++ai)
#pragma unroll
                for (int m = 0; m < 4; ++m) { bf16_t* rowp = O + (size_t)(row0 + ai * HALF + m * 16) * 2048 + col0;
#pragma unroll
                    for (int bj = 0; bj < 2; ++bj) { const f32x4 v0 = acc[ai][bj][m][0], v1 = acc[ai][bj][m][1];
                        u32x4 w; w.x = pk2(v0[0], v0[1]); w.y = pk2(v0[2], v0[3]); w.z = pk2(v1[0], v1[1]); w.w = pk2(v1[2], v1[3]);
                        __builtin_nontemporal_store(w, (u32x4*)(rowp + bj * HALF)); } }
        } else {
            const float* gp = u.pn < 2 ? qg : kg; const float scl = u.pn < 2 ? 0.125f * 1.4426950408889634f : 1.f;
            f32x4 gn[2][2];
#pragma unroll
            for (int bj = 0; bj < 2; ++bj)
#pragma unroll
                for (int n = 0; n < 2; ++n) gn[bj][n] = *(const f32x4*)(gp + 32 * bj + 8 * fq + 4 * n);
            const int col0 = u.pn * BM + wc * 64 + 8 * fq;
#pragma unroll
            for (int ai = 0; ai < 2; ++ai)
#pragma unroll
                for (int m = 0; m < 4; ++m) { bf16_t* rowp = O + (size_t)(row0 + ai * HALF + m * 16) * 2048 + col0;
                    float ss = 0.f;
#pragma unroll
                    for (int bj = 0; bj < 2; ++bj)
#pragma unroll
                        for (int n = 0; n < 2; ++n) { const f32x4 a = acc[ai][bj][m][n]; ss += a[0] * a[0] + a[1] * a[1] + a[2] * a[2] + a[3] * a[3]; }
                    ss += __shfl_xor(ss, 16); ss += __shfl_xor(ss, 32);
                    const float r = rsqrtf(ss * (1.f / 64.f) + 1e-6f) * scl;
#pragma unroll
                    for (int bj = 0; bj < 2; ++bj) { const f32x4 v0 = acc[ai][bj][m][0] * r * gn[bj][0], v1 = acc[ai][bj][m][1] * r * gn[bj][1];
                        u32x4 w; w.x = pk2(v0[0], v0[1]); w.y = pk2(v0[2], v0[3]); w.z = pk2(v1[0], v1[1]); w.w = pk2(v1[2], v1[3]);
                        __builtin_nontemporal_store(w, (u32x4*)(rowp + 32 * bj)); } }
        }
    }
};
struct EpiSwiglu {
    static constexpr bool PERM = true;
    bf16_t* O;
    __device__ __forceinline__ void operator()(const f32x4 (&acc)[2][2][4][2], const Unit& u, int wr, int wc, int fr, int fq) const {
        const int row0 = u.pm * BM + wr * 64 + fr, col0 = u.pn * HALF + wc * 32 + 8 * fq;
#pragma unroll
        for (int ai = 0; ai < 2; ++ai)
#pragma unroll
            for (int m = 0; m < 4; ++m) { bf16_t* rowp = O + (size_t)(row0 + ai * HALF + m * 16) * FFH + col0;
                float r[8];
#pragma unroll
                for (int n = 0; n < 2; ++n)
#pragma unroll
                    for (int j = 0; j < 4; ++j) r[n * 4 + j] = silu_f(acc[ai][0][m][n][j]) * acc[ai][1][m][n][j];
                u32x4 w; w.x = pk2(r[0], r[1]); w.y = pk2(r[2], r[3]); w.z = pk2(r[4], r[5]); w.w = pk2(r[6], r[7]);
                __builtin_nontemporal_store(w, (u32x4*)rowp); }
    }
};
struct EpiGlu {
    static constexpr bool PERM = true;
    const bf16_t* Y; const float* bias; bf16_t* O;
    __device__ __forceinline__ void operator()(const f32x4 (&acc)[2][2][4][2], const Unit& u, int wr, int wc, int fr, int fq) const {
        const int row0 = u.pm * BM + wr * 64 + fr, col0 = u.pn * BM + wc * 32 + 8 * fq;
#pragma unroll
        for (int bj = 0; bj < 2; ++bj) {
            const int col = col0 + bj * HALF;
            const f32x4 b0 = *(const f32x4*)(bias + col), b1 = *(const f32x4*)(bias + col + 4);
            u32x4 yv[2][4];
#pragma unroll
            for (int ai = 0; ai < 2; ++ai)
#pragma unroll
                for (int m = 0; m < 4; ++m) yv[ai][m] = *(const u32x4*)(Y + (size_t)(row0 + ai * HALF + m * 16) * 512 + col);
#pragma unroll
            for (int ai = 0; ai < 2; ++ai)
#pragma unroll
                for (int m = 0; m < 4; ++m) { const size_t row = (size_t)(row0 + ai * HALF + m * 16);
                    const u32x4 y4 = yv[ai][m];
                    const f32x4 v0 = acc[ai][bj][m][0] + b0, v1 = acc[ai][bj][m][1] + b1;
                    float r[8];
                    r[0] = lo_f(y4.x) * sigm_f(v0[0]); r[1] = hi_f(y4.x) * sigm_f(v0[1]); r[2] = lo_f(y4.y) * sigm_f(v0[2]); r[3] = hi_f(y4.y) * sigm_f(v0[3]);
                    r[4] = lo_f(y4.z) * sigm_f(v1[0]); r[5] = hi_f(y4.z) * sigm_f(v1[1]); r[6] = lo_f(y4.w) * sigm_f(v1[2]); r[7] = hi_f(y4.w) * sigm_f(v1[3]);
                    u32x4 w; w.x = pk2(r[0], r[1]); w.y = pk2(r[2], r[3]); w.z = pk2(r[4], r[5]); w.w = pk2(r[6], r[7]);
                    __builtin_nontemporal_store(w, (u32x4*)(O + row * 1024 + 512 + col)); }
        }
    }
};
struct EpiResid {
    static constexpr bool PERM = false;
    const float* res; float* out; const float* gate;
    __device__ __forceinline__ void operator()(const f32x4 (&acc)[2][2][4][2], const Unit& u, int wr, int wc, int fr, int fq) const {
        const int row0 = u.pm * BM + wr * 64 + fr, col0 = u.pn * BM + wc * 32 + 4 * fq;
        const int bidx = (u.pm * BM) >> 12;
        f32x4 gv[2][2];
#pragma unroll
        for (int bj = 0; bj < 2; ++bj)
#pragma unroll
            for (int n = 0; n < 2; ++n) gv[bj][n] = *(const f32x4*)(gate + (size_t)bidx * 6144 + col0 + bj * HALF + n * 16);
        f32x4 rv[2][2][2][2];
#define EPR_LOAD(buf, q) do { _Pragma("unroll") for (int mm = 0; mm < 2; ++mm) _Pragma("unroll") for (int bj = 0; bj < 2; ++bj) _Pragma("unroll") for (int n = 0; n < 2; ++n) \
            rv[buf][mm][bj][n] = *(const f32x4*)(res + (size_t)(row0 + ((q) >> 1) * HALF + (((q) & 1) * 2 + mm) * 16) * 1024 + col0 + bj * HALF + n * 16); } while (0)
#define EPR_STORE(buf, q) do { _Pragma("unroll") for (int mm = 0; mm < 2; ++mm) _Pragma("unroll") for (int bj = 0; bj < 2; ++bj) _Pragma("unroll") for (int n = 0; n < 2; ++n) \
            __builtin_nontemporal_store(rv[buf][mm][bj][n] + gv[bj][n] * acc[(q) >> 1][bj][((q) & 1) * 2 + mm][n], (f32x4*)(out + (size_t)(row0 + ((q) >> 1) * HALF + (((q) & 1) * 2 + mm) * 16) * 1024 + col0 + bj * HALF + n * 16)); } while (0)
        EPR_LOAD(0, 0); EPR_LOAD(1, 1); EPR_STORE(0, 0); EPR_LOAD(0, 2); EPR_STORE(1, 1); EPR_LOAD(1, 3); EPR_STORE(0, 2); EPR_STORE(1, 3);
#undef EPR_LOAD
#undef EPR_STORE
    }
};
}

__device__ __forceinline__ int wt_src_col(int n, int mode) {
    if (mode == 1) { const int tt = n >> 8, r = n & 255; return r < 128 ? tt * 128 + r : FFH + tt * 128 + (r - 128); }
    if (mode == 2 && n < 1024) { const int lc = n & 255; return (n & ~255) + ((lc >> 5) & 3) * 64 + 32 * (lc >> 7) + (lc & 31); }
    return n;
}
__device__ __forceinline__ void transpose_cvt(LAS float* tile, const float* __restrict__ W, int K, int N, bf16_t* __restrict__ Wt, int mode) {
    const int tid = tid_opaque();
    const int tilesN = N / 64, tilesK = K / 64, ntl = tilesN * tilesK;
    float cur[8];
    if ((int)blockIdx.x < ntl) { const int tn = blockIdx.x % tilesN, tk = blockIdx.x / tilesN; const int nsrc = wt_src_col(tn * 64 + (tid & 63), mode);
#pragma unroll
        for (int r = 0; r < 8; ++r) cur[r] = W[(size_t)(tk * 64 + (tid >> 6) + 8 * r) * N + nsrc]; }
    for (int t = blockIdx.x; t < ntl; t += gridDim.x) {
        const int tn = t % tilesN, tk = t / tilesN;
        const int n0d = tn * 64, k0 = tk * 64;
#pragma unroll
        for (int r = 0; r < 8; ++r) { const int kk = (tid >> 6) + 8 * r; tile[kk * 65 + (tid & 63)] = cur[r]; }
        const int t2 = t + gridDim.x;
        if (t2 < ntl) { const int tn2 = t2 % tilesN, tk2 = t2 / tilesN; const int nsrc = wt_src_col(tn2 * 64 + (tid & 63), mode);
#pragma unroll
            for (int r = 0; r < 8; ++r) cur[r] = W[(size_t)(tk2 * 64 + (tid >> 6) + 8 * r) * N + nsrc]; }
        __syncthreads();
        { const int nn = tid >> 3, kc = (tid & 7) * 8; float v[8];
#pragma unroll
          for (int j = 0; j < 8; ++j) v[j] = tile[(kc + j) * 65 + nn];
          u32x4 w; w.x = pk2(v[0], v[1]); w.y = pk2(v[2], v[3]); w.z = pk2(v[4], v[5]); w.w = pk2(v[6], v[7]);
          *(u32x4*)(Wt + (size_t)(n0d + nn) * K + k0 + kc) = w; }
        __syncthreads();
    }
}

struct S5gp { float lrdt, lidt, fre, fim; };
__device__ __forceinline__ S5gp s5_gp(const Params& p, int g, int pp) {
    S5gp r; const float dt = expf(p.in[15][g]); const float lr = p.in[13][g * 64 + pp], li = p.in[14][g * 64 + pp];
    r.lrdt = lr * dt; r.lidt = li * dt;
    const float mag = expf(r.lrdt), are = mag * cosf(r.lidt), aim = mag * sinf(r.lidt), den = lr * lr + li * li;
    r.fre = ((are - 1.f) * lr + aim * li) / den; r.fim = (aim * lr - (are - 1.f) * li) / den;
    return r;
}
__device__ __forceinline__ f32x2 s5_apow(const S5gp& q, float n) { const float m = expf(n * q.lrdt), a = n * q.lidt; return (f32x2){m * cosf(a), m * sinf(a)}; }

__device__ __forceinline__ void prep_phase(const Params& p, LAS unsigned char* lds) {
    const int tid = tid_opaque();
    unsigned char* ws = p.ws;
    LAS float* tile = (LAS float*)lds;
    transpose_cvt(tile, p.in[8], 1024, 2048, (bf16_t*)(ws + WS_W_ABIN), 2);
    transpose_cvt(tile, p.in[9], 1024, 1024, (bf16_t*)(ws + WS_W_ABOUT), 0);
    transpose_cvt(tile, p.in[21], 512, 512, (bf16_t*)(ws + WS_W_GLU), 0);
    for (int l = 0; l < 2; ++l) {
        transpose_cvt(tile, p.in[6] + (size_t)l * 1024 * 5632, 1024, 5632, (bf16_t*)(ws + WS_W_FFIN) + (size_t)l * 5632 * 1024, 1);
        transpose_cvt(tile, p.in[7] + (size_t)l * FFH * 1024, FFH, 1024, (bf16_t*)(ws + WS_W_FFOUT) + (size_t)l * 1024 * FFH, 0);
    }
    transpose_cvt(tile, p.in[23], 1024, 3584, (bf16_t*)(ws + WS_W_CDIN), 0);
    transpose_cvt(tile, p.in[24], 1024, 1024, (bf16_t*)(ws + WS_W_CDOUT), 0);
    if (blockIdx.x < 192) {
        LAS float* sc = (LAS float*)lds; LAS float* red = (LAS float*)(lds + 65536);
        for (int idx = tid; idx < 16384; idx += NTHR) { const float v = p.in[1][idx]; sc[idx] = v / (1.f + expf(-v)); }
        __syncthreads();
        for (int item = blockIdx.x; item < 192; item += gridDim.x) {
            const int l = item / 96, cb = item % 96, cl = tid & 63, ksl = tid >> 6;
            float acc[16];
#pragma unroll
            for (int b = 0; b < 16; ++b) acc[b] = 0.f;
            const float* w = p.in[2] + (size_t)l * 1024 * 6144 + cb * 64 + cl;
            for (int k0 = ksl * 128; k0 < ksl * 128 + 128; k0 += 8) {
                float wv[8];
#pragma unroll
                for (int j = 0; j < 8; ++j) wv[j] = w[(size_t)(k0 + j) * 6144];
#pragma unroll
                for (int b = 0; b < 16; ++b) { const f32x4 s0 = *(const LAS f32x4*)(sc + b * 1024 + k0), s1 = *(const LAS f32x4*)(sc + b * 1024 + k0 + 4);
                    acc[b] += s0[0] * wv[0] + s0[1] * wv[1] + s0[2] * wv[2] + s0[3] * wv[3] + s1[0] * wv[4] + s1[1] * wv[5] + s1[2] * wv[6] + s1[3] * wv[7]; }
            }
#pragma unroll
            for (int b = 0; b < 16; ++b) red[(ksl * 16 + b) * 64 + cl] = acc[b];
            __syncthreads();
            for (int o = tid; o < 1024; o += NTHR) { const int b = o >> 6, cc = o & 63; float s = 0.f;
#pragma unroll
                for (int k8 = 0; k8 < 8; ++k8) s += red[(k8 * 16 + b) * 64 + cc];
                ((float*)(ws + WS_MOD))[(size_t)(l * 16 + b) * 6144 + cb * 64 + cc] = s + p.in[3][l * 6144 + cb * 64 + cc]; }
            __syncthreads();
        }
    }
    __syncthreads();
    const int gtid = blockIdx.x * NTHR + tid, nthr = gridDim.x * NTHR;
    for (int idx = gtid; idx < 4096 * 64; idx += nthr) { const int pos = idx >> 6, f = idx & 63;
        const float freq = powf(10000.f, -(float)f / 64.f), ang = (float)pos * freq;
        ((f32x2*)(ws + WS_ROPE))[idx] = (f32x2){cosf(ang), sinf(ang)}; }
    { bf16_t* Mt = (bf16_t*)(ws + WS_S5M); bf16_t* Gt = (bf16_t*)(ws + WS_S5G);
      for (int idx = gtid; idx < 32 * 64 * 64; idx += nthr) { const int g = idx >> 12, pp = (idx >> 6) & 63, s = idx & 63;
          const S5gp q = s5_gp(p, g, pp);
          { const f32x2 a = s5_apow(q, (float)(63 - s));
            unsigned wr_[8], wi_[8];
#pragma unroll
            for (int h2 = 0; h2 < 8; ++h2) { float vr[2], vi[2];
#pragma unroll
                for (int e = 0; e < 2; ++e) { const int h = h2 * 2 + e; const float br = p.in[16][(g * 64 + pp) * 16 + h], bi = p.in[17][(g * 64 + pp) * 16 + h];
                    const float bbr = q.fre * br - q.fim * bi, bbi = q.fre * bi + q.fim * br;
                    vr[e] = a.x * bbr - a.y * bbi; vi[e] = a.x * bbi + a.y * bbr; }
                wr_[h2] = pk2(vr[0], vr[1]); wi_[h2] = pk2(vi[0], vi[1]); }
            u32x4* dr = (u32x4*)(Mt + (size_t)(g * 128 + 2 * pp) * 1024 + s * 16); u32x4* di = (u32x4*)(Mt + (size_t)(g * 128 + 2 * pp + 1) * 1024 + s * 16);
            dr[0] = (u32x4){wr_[0], wr_[1], wr_[2], wr_[3]}; dr[1] = (u32x4){wr_[4], wr_[5], wr_[6], wr_[7]};
            di[0] = (u32x4){wi_[0], wi_[1], wi_[2], wi_[3]}; di[1] = (u32x4){wi_[4], wi_[5], wi_[6], wi_[7]}; }
          { const int t = s; const f32x2 a = s5_apow(q, (float)(t + 1));
#pragma unroll
            for (int h = 0; h < 16; ++h) { const float cr = p.in[18][(g * 16 + h) * 64 + pp], ci = p.in[19][(g * 16 + h) * 64 + pp];
                const float gr = cr * a.x - ci * a.y, gi = cr * a.y + ci * a.x;
                *(unsigned*)(Gt + (size_t)(g * 1024 + t * 16 + h) * 128 + 2 * pp) = pk2(gr, -gi); } }
          if (s == 0) ((f32x2*)(ws + WS_A64))[g * 64 + pp] = s5_apow(q, 64.f);
      }
      LAS f32x2* tp = (LAS f32x2*)lds;
      bf16_t* Kt = (bf16_t*)(ws + WS_KERN);
      for (int item = blockIdx.x; item < 32 * 64; item += gridDim.x) { const int g = item >> 6, tau = item & 63;
          if (tid < 64) { const S5gp q = s5_gp(p, g, tid); const f32x2 a = s5_apow(q, (float)tau); tp[tid] = (f32x2){a.x * q.fre - a.y * q.fim, a.x * q.fim + a.y * q.fre}; }
          __syncthreads();
          if (tid < 256) { const int h = tid >> 4, h2 = tid & 15; float acc = 0.f;
#pragma unroll 8
              for (int pp = 0; pp < 64; ++pp) { const f32x2 t = tp[pp]; const float cr = p.in[18][(g * 16 + h) * 64 + pp], ci = p.in[19][(g * 16 + h) * 64 + pp];
                  const float ur = cr * t.x - ci * t.y, ui = cr * t.y + ci * t.x;
                  acc += ur * p.in[16][(g * 64 + pp) * 16 + h2] - ui * p.in[17][(g * 64 + pp) * 16 + h2]; }
              Kt[(size_t)((g * 64 + tau) * 16 + h) * 16 + h2] = f2bf(acc); }
          __syncthreads();
      }
    }
}

__device__ __forceinline__ void norm_phase(const float* __restrict__ x, const float* __restrict__ gw, const float* __restrict__ shift, const float* __restrict__ scale, bf16_t* __restrict__ H) {
    const int tid = tid_opaque(); const int lane = tid & 63, wv = blockIdx.x * 8 + (tid >> 6), nw = gridDim.x * 8;
    constexpr int NR = 8;
    for (int row0 = wv * NR; row0 < MTOK; row0 += nw * NR) {
        const int b = row0 >> 12;
        f32x4 v[NR][4]; float ss[NR];
#pragma unroll
        for (int r = 0; r < NR; ++r)
#pragma unroll
            for (int c4 = 0; c4 < 4; ++c4) v[r][c4] = __builtin_nontemporal_load((const f32x4*)(x + (size_t)(row0 + r) * 1024 + c4 * 256 + lane * 4));
#pragma unroll
        for (int r = 0; r < NR; ++r) { float s = 0.f;
#pragma unroll
            for (int c4 = 0; c4 < 4; ++c4) s += v[r][c4][0] * v[r][c4][0] + v[r][c4][1] * v[r][c4][1] + v[r][c4][2] * v[r][c4][2] + v[r][c4][3] * v[r][c4][3];
            ss[r] = s; }
#pragma unroll
        for (int o = 1; o < 64; o <<= 1)
#pragma unroll
            for (int r = 0; r < NR; ++r) ss[r] += __shfl_xor(ss[r], o);
#pragma unroll
        for (int c4 = 0; c4 < 4; ++c4) { const int col = c4 * 256 + lane * 4;
            const f32x4 g = *(const f32x4*)(gw + col), sc = *(const f32x4*)(scale + (size_t)b * 6144 + col), sh = *(const f32x4*)(shift + (size_t)b * 6144 + col);
            const f32x4 gm = g * (sc + 1.f);
#pragma unroll
            for (int r = 0; r < NR; ++r) { const float rr = rsqrtf(ss[r] * (1.f / 1024.f) + 1e-6f);
                const f32x4 o = v[r][c4] * rr * gm + sh;
                *(u32x2*)(H + (size_t)(row0 + r) * 1024 + col) = (u32x2){pk2(o[0], o[1]), pk2(o[2], o[3])}; } }
    }
}

constexpr int VS = 72;
constexpr int VL_BYTES = 64 * VS * 2;

__device__ __forceinline__ void s5a_phase(const Params& p);
__device__ __forceinline__ void attnA_phase(const Params& p, LAS unsigned char* lds) {
    const int tid = tid_opaque(), wid = __builtin_amdgcn_readfirstlane(tid >> 6), lane = tid & 63, li = lane & 15, g4 = lane >> 4;
    const bf16_t* QKV = (const bf16_t*)(p.ws + WS_R1);
    bf16_t* MIX = (bf16_t*)(p.ws + WS_MIX);
    LAS bf16_t* Vl = (LAS bf16_t*)(lds + wid * VL_BYTES);
    LAS float* bl = (LAS float*)(lds + 8 * VL_BYTES);
    for (int idx = tid; idx < 8 * 257; idx += NTHR) bl[(idx / 257) * 260 + (idx % 257)] = (p.in[12][idx] - p.in[12][(idx / 257) * 257 + 256]) * 1.4426950408889634f;
    __syncthreads();
    if (wid >= 4) s5a_phase(p);
    const int h = wid;
    LAS float* bh = bl + h * 260;
    const int vrow = lane >> 3, vc8 = (lane & 7) * 8;
    for (int item2 = vblock(); item2 < 2048; item2 += gridDim.x) {
        const int kq = item2 >> 8, rq = item2 & 255, qh = rq & 1;
        const int b = 2 * kq + (rq >> 7), ci = (((rq >> 1) & 63) + 9 * kq) & 63;
        const size_t rowbase = (size_t)b * SEQ + ci * 64 + qh * 32;
        bf16x8 qf[2][2];
#pragma unroll
        for (int qt = 0; qt < 2; ++qt)
#pragma unroll
            for (int ks = 0; ks < 2; ++ks) qf[qt][ks] = *(const bf16x8*)(QKV + (rowbase + qt * 16 + li) * 2048 + h * 64 + 32 * ks + 8 * g4);
        f32x4 o[4][2]; float mrun[2], lsum[2];
#pragma unroll
        for (int qt = 0; qt < 2; ++qt) { mrun[qt] = -1e30f; lsum[qt] = 0.f;
#pragma unroll
            for (int dt = 0; dt < 4; ++dt) o[dt][qt] = (f32x4){0.f, 0.f, 0.f, 0.f}; }
        const int kb0 = ci >= 8 ? 0 : 8 - ci;
        bf16x8 kf[4][2]; u32x4 vr[8];
        { const bf16_t* kbase = QKV + ((size_t)b * SEQ + (size_t)(ci - 8 + kb0) * 64) * 2048 + h * 64;
#pragma unroll
          for (int kt = 0; kt < 4; ++kt)
#pragma unroll
              for (int ks = 0; ks < 2; ++ks) kf[kt][ks] = *(const bf16x8*)(kbase + (size_t)(kt * 16 + li) * 2048 + 512 + 32 * ks + 8 * g4);
#pragma unroll
          for (int r = 0; r < 8; ++r) vr[r] = *(const u32x4*)(kbase + (size_t)(r * 8 + vrow) * 2048 + 1024 + vc8);
          wave_lds_fence();
#pragma unroll
          for (int r = 0; r < 8; ++r) *(LAS u32x4*)(Vl + (r * 8 + vrow) * VS + vc8) = vr[r];
          wave_lds_fence(); }
        for (int kb = kb0; kb <= 8; ++kb) {
            f32x4 s[4][2];
#pragma unroll
            for (int kt = 0; kt < 4; ++kt)
#pragma unroll
                for (int qt = 0; qt < 2; ++qt) { f32x4 z = (f32x4){0.f, 0.f, 0.f, 0.f}; z = mfma16(kf[kt][0], qf[qt][0], z); z = mfma16(kf[kt][1], qf[qt][1], z); s[kt][qt] = z; }
            const bool more = kb < 8;
            if (more) {
                const bf16_t* kbase = QKV + ((size_t)b * SEQ + (size_t)(ci - 8 + kb + 1) * 64) * 2048 + h * 64;
#pragma unroll
                for (int kt = 0; kt < 4; ++kt)
#pragma unroll
                    for (int ks = 0; ks < 2; ++ks) kf[kt][ks] = *(const bf16x8*)(kbase + (size_t)(kt * 16 + li) * 2048 + 512 + 32 * ks + 8 * g4);
#pragma unroll
                for (int r = 0; r < 8; ++r) vr[r] = *(const u32x4*)(kbase + (size_t)(r * 8 + vrow) * 2048 + 1024 + vc8);
            }
            const bool nearb = kb >= 6;
            bf16x8 pfr[2][2];
#pragma unroll
            for (int qt = 0; qt < 2; ++qt) {
                float mx = -1e30f;
                if (nearb) {
#pragma unroll
                    for (int kt = 0; kt < 4; ++kt)
#pragma unroll
                        for (int jj = 0; jj < 4; ++jj) { int rel = 512 + qh * 32 + qt * 16 + li - kb * 64 - (kt * 16 + 4 * g4 + jj); rel = rel > 128 ? 128 : (rel < -128 ? -128 : rel);
                            const float v = s[kt][qt][jj] + bh[rel + 128]; s[kt][qt][jj] = v; mx = fmaxf(mx, v); }
                } else {
#pragma unroll
                    for (int kt = 0; kt < 4; ++kt)
#pragma unroll
                        for (int jj = 0; jj < 4; ++jj) mx = fmaxf(mx, s[kt][qt][jj]);
                }
                mx = fmaxf(mx, __shfl_xor(mx, 16)); mx = fmaxf(mx, __shfl_xor(mx, 32));
                const float mnew = fmaxf(mrun[qt], mx), alpha = __builtin_amdgcn_exp2f(mrun[qt] - mnew);
                mrun[qt] = mnew; float ps = 0.f;
#pragma unroll
                for (int kt = 0; kt < 4; ++kt)
#pragma unroll
                    for (int jj = 0; jj < 4; ++jj) { const float e = __builtin_amdgcn_exp2f(s[kt][qt][jj] - mnew); s[kt][qt][jj] = e; ps += e; }
                lsum[qt] = lsum[qt] * alpha + ps;
#pragma unroll
                for (int dt = 0; dt < 4; ++dt) o[dt][qt] *= alpha;
#pragma unroll
                for (int kk = 0; kk < 2; ++kk) { u32x4 w; w.x = pk2(s[2 * kk][qt][0], s[2 * kk][qt][1]); w.y = pk2(s[2 * kk][qt][2], s[2 * kk][qt][3]);
                    w.z = pk2(s[2 * kk + 1][qt][0], s[2 * kk + 1][qt][1]); w.w = pk2(s[2 * kk + 1][qt][2], s[2 * kk + 1][qt][3]); pfr[qt][kk] = as_frag(w); }
            }
            { bf16x8 vf[2][4];
#pragma unroll
              for (int kk = 0; kk < 2; ++kk)
#pragma unroll
                  for (int dt = 0; dt < 4; ++dt) vf[kk][dt] = tr_pair(Vl, VS, 32 * kk + 4 * g4, 32 * kk + 16 + 4 * g4, dt * 16, li);
#pragma unroll
              for (int kk = 0; kk < 2; ++kk)
#pragma unroll
                  for (int dt = 0; dt < 4; ++dt)
#pragma unroll
                      for (int qt = 0; qt < 2; ++qt) o[dt][qt] = mfma16(vf[kk][dt], pfr[qt][kk], o[dt][qt]); }
            wave_lds_fence();
            if (more) {
#pragma unroll
                for (int r = 0; r < 8; ++r) *(LAS u32x4*)(Vl + (r * 8 + vrow) * VS + vc8) = vr[r];
                wave_lds_fence();
            }
        }
#pragma unroll
        for (int qt = 0; qt < 2; ++qt) { float l = lsum[qt]; l += __shfl_xor(l, 16); l += __shfl_xor(l, 32); const float inv = 1.f / l;
#pragma unroll
            for (int dt = 0; dt < 4; ++dt) { const f32x4 v = o[dt][qt] * inv;
                *(u32x2*)(MIX + (rowbase + qt * 16 + li) * 1024 + h * 64 + dt * 16 + 4 * g4) = (u32x2){pk2(v[0], v[1]), pk2(v[2], v[3])}; } }
    }
    if (wid < 4) s5a_phase(p);
}

__device__ __forceinline__ void s5a_phase(const Params& p) {
    const int tid = tid_opaque(); const int lane = tid & 63, li = lane & 15, g4 = lane >> 4;
    const bf16_t* QKV = (const bf16_t*)(p.ws + WS_R1);
    const bf16_t* Mt = (const bf16_t*)(p.ws + WS_S5M);
    float* E = (float*)(p.ws + WS_S5E);
    const int wv = blockIdx.x * 8 + (tid >> 6), nw = gridDim.x * 8;
    for (int item = wv; item < 2048; item += nw) {
        const int g = item & 31, c = item >> 5;
        f32x4 acc[8];
#pragma unroll
        for (int pt = 0; pt < 8; ++pt) acc[pt] = (f32x4){0.f, 0.f, 0.f, 0.f};
        const bf16_t* ub = QKV + ((size_t)li * SEQ + c * 64 + (g4 >> 1)) * 2048 + 1536 + g * 16 + 8 * (g4 & 1);
        const bf16_t* mb = Mt + (size_t)(g * 128 + li) * 1024 + 8 * g4;
#pragma unroll 4
        for (int ks = 0; ks < 32; ++ks) {
            const bf16x8 bfr = *(const bf16x8*)(ub + (size_t)(2 * ks) * 2048);
#pragma unroll
            for (int pt = 0; pt < 8; ++pt) { const bf16x8 afr = *(const bf16x8*)(mb + (size_t)pt * 16 * 1024 + 32 * ks); acc[pt] = mfma16(afr, bfr, acc[pt]); }
        }
#pragma unroll
        for (int pt = 0; pt < 8; ++pt) *(f32x4*)(E + ((size_t)(c * 32 + g) * 16 + li) * 128 + pt * 16 + 4 * g4) = acc[pt];
    }
}
__device__ __forceinline__ void s5scan_phase(const Params& p) {
    const float* E = (const float*)(p.ws + WS_S5E);
    bf16_t* X = (bf16_t*)(p.ws + WS_S5X);
    const f32x2* A64 = (const f32x2*)(p.ws + WS_A64);
    const int gtid = blockIdx.x * NTHR + tid_opaque();
    if (gtid < 32 * 16 * 64) {
        const int pp = gtid & 63, b = (gtid >> 6) & 15, g = gtid >> 10;
        const f32x2 a = A64[g * 64 + pp];
        float xr = 0.f, xi = 0.f;
        for (int c0 = 0; c0 < 64; c0 += 8) {
            f32x2 e[8];
#pragma unroll
            for (int k = 0; k < 8; ++k) e[k] = *(const f32x2*)(E + ((size_t)((c0 + k) * 32 + g) * 16 + b) * 128 + 2 * pp);
#pragma unroll
            for (int k = 0; k < 8; ++k) {
                *(unsigned*)(X + ((size_t)((c0 + k) * 32 + g) * 16 + b) * 128 + 2 * pp) = pk2(xr, xi);
                const float nr = a.x * xr - a.y * xi + e[k].x, ni = a.x * xi + a.y * xr + e[k].y; xr = nr; xi = ni; }
        }
    }
}
__device__ __forceinline__ int s5c_item(int vb, int k) {
    if (gridDim.x != 256) return vb + k * (int)gridDim.x;
    const int x = vb >> 5, l = vb & 31; const int g = 8 * (x & 3) + (l & 7), c = 8 * k + 4 * (x >> 2) + (l >> 3);
    return c * 32 + g;
}
__device__ __forceinline__ void s5c_phase(const Params& p, LAS unsigned char* lds) {
    const int tid = tid_opaque(), wid = __builtin_amdgcn_readfirstlane(tid >> 6), lane = tid & 63, li = lane & 15, g4 = lane >> 4;
    const bf16_t* QKV = (const bf16_t*)(p.ws + WS_R1);
    const bf16_t* Kt = (const bf16_t*)(p.ws + WS_KERN);
    const bf16_t* Gt = (const bf16_t*)(p.ws + WS_S5G);
    const bf16_t* X = (const bf16_t*)(p.ws + WS_S5X);
    bf16_t* Y5 = (bf16_t*)(p.ws + WS_Y5);
    LAS bf16_t* kl = (LAS bf16_t*)lds;
    LAS bf16_t* ul = (LAS bf16_t*)(lds + 32768);
    int gl = -1;
    bf16x8 gf[8][4];
    u32x4 ur[4];
    const int vb = vblock(), nrounds = (2048 + (int)gridDim.x - 1) / (int)gridDim.x;
    { const int item = s5c_item(vb, 0); if (item < 2048) { const int g = item & 31, c = item >> 5;
#pragma unroll
        for (int q = 0; q < 4; ++q) { const int idx = tid + q * NTHR, hh = idx & 1, b = (idx >> 1) & 15, sq = idx >> 5;
            ur[q] = *(const u32x4*)(QKV + ((size_t)b * SEQ + c * 64 + sq) * 2048 + 1536 + g * 16 + hh * 8); } } }
    for (int rk = 0; rk < nrounds; ++rk) {
        const int item = s5c_item(vb, rk); if (item >= 2048) break;
        const int g = item & 31, c = item >> 5;
        __syncthreads();
        if (g != gl) { for (int idx = tid; idx < 2048; idx += NTHR) *(LAS u32x4*)(kl + idx * 8) = *(const u32x4*)(Kt + (size_t)g * 16384 + idx * 8); gl = g;
#pragma unroll
            for (int tt = 0; tt < 8; ++tt)
#pragma unroll
                for (int ks = 0; ks < 4; ++ks) gf[tt][ks] = *(const bf16x8*)(Gt + (size_t)(g * 1024 + (wid + 8 * tt) * 16 + li) * 128 + 32 * ks + 8 * g4); }
#pragma unroll
        for (int q = 0; q < 4; ++q) { const int idx = tid + q * NTHR, hh = idx & 1, b = (idx >> 1) & 15, sq = idx >> 5;
            *(LAS u32x4*)(ul + (sq * 16 + b) * 16 + hh * 8) = ur[q]; }
        { const int nx = (rk + 1 < nrounds) ? s5c_item(vb, rk + 1) : 2048; if (nx < 2048) { const int g2 = nx & 31, c2 = nx >> 5;
#pragma unroll
            for (int q = 0; q < 4; ++q) { const int idx = tid + q * NTHR, hh = idx & 1, b = (idx >> 1) & 15, sq = idx >> 5;
                ur[q] = *(const u32x4*)(QKV + ((size_t)b * SEQ + c2 * 64 + sq) * 2048 + 1536 + g2 * 16 + hh * 8); } } }
        bf16x8 xf[4];
#pragma unroll
        for (int ks = 0; ks < 4; ++ks) xf[ks] = *(const bf16x8*)(X + ((size_t)(c * 32 + g) * 16 + li) * 128 + 32 * ks + 8 * g4);
        __syncthreads();
        const f32x4 dsk = *(const f32x4*)(p.in[20] + g * 16 + 4 * g4);
#pragma unroll
        for (int tt = 0; tt < 8; ++tt) {
            const int t = wid + 8 * tt;
            f32x4 acc = (f32x4){0.f, 0.f, 0.f, 0.f};
#pragma unroll
            for (int ks = 0; ks < 4; ++ks) acc = mfma16(gf[tt][ks], xf[ks], acc);
            const int nks = ((t >> 1) + 2) & ~1;
            for (int ks0 = 0; ks0 < nks; ks0 += 2) {
                u32x4 av[2]; bf16x8 bv[2];
#pragma unroll
                for (int q = 0; q < 2; ++q) { const int s = 2 * (ks0 + q) + (g4 >> 1); int tau = t - s; const bool ok = tau >= 0; tau = ok ? tau : 0;
                    av[q] = *(const LAS u32x4*)(kl + (tau * 16 + li) * 16 + 8 * (g4 & 1));
                    if (!ok) av[q] = (u32x4){0u, 0u, 0u, 0u};
                    bv[q] = *(const LAS bf16x8*)(ul + (s * 16 + li) * 16 + 8 * (g4 & 1)); }
#pragma unroll
                for (int q = 0; q < 2; ++q) acc = mfma16(as_frag(av[q]), bv[q], acc);
            }
            const u32x2 uu = *(const LAS u32x2*)(ul + (t * 16 + li) * 16 + 4 * g4);
            float y0 = acc[0] + dsk[0] * lo_f(uu.x), y1 = acc[1] + dsk[1] * hi_f(uu.x), y2 = acc[2] + dsk[2] * lo_f(uu.y), y3 = acc[3] + dsk[3] * hi_f(uu.y);
            y0 = gelu_tanh(y0); y1 = gelu_tanh(y1); y2 = gelu_tanh(y2); y3 = gelu_tanh(y3);
            *(u32x2*)(Y5 + ((size_t)li * SEQ + c * 64 + t) * 512 + g * 16 + 4 * g4) = (u32x2){pk2(y0, y1), pk2(y2, y3)};
        }
    }
}

#ifndef SB_EARLY_EXIT
#define SB_EARLY_EXIT 1
#endif
template <bool MASKED>
__device__ __forceinline__ void sb_qtile(const bf16x8 (&kf)[4][2], const bf16x8 (&qf)[2], float& R, bf16x8 (&pfr)[2], int li, int g4, int kpos0, int qpos, u32x2 dpat) {
    const unsigned ONES = 0x3F803F80u;
    const float SC = 0.125f * 1.4426950408889634f;
    f32x4 z[4];
#pragma unroll
    for (int kt = 0; kt < 4; ++kt) { f32x4 a = (f32x4){0.f, 0.f, 0.f, 0.f}; a = mfma16(kf[kt][0], qf[0], a); a = mfma16(kf[kt][1], qf[1], a); z[kt] = a; }
    float T = 0.f; unsigned hi[4][2];
#pragma unroll
    for (int kt = 0; kt < 4; ++kt) { float Lv[4];
#pragma unroll
        for (int jj = 0; jj < 4; ++jj) { const float zz = z[kt][jj] * SC;
            const float sp = fmaxf(zz, 0.f) + __builtin_amdgcn_logf(1.f + __builtin_amdgcn_exp2f(-fabsf(zz)));
            if (MASKED) { const bool valid = kpos0 + kt * 16 + jj < qpos; Lv[jj] = valid ? -sp : 0.f; z[kt][jj] = valid ? (zz - sp) : -1e30f; }
            else { Lv[jj] = -sp; z[kt][jj] = zz - sp; }
            T += Lv[jj]; }
        hi[kt][0] = pk2(Lv[0], Lv[1]); hi[kt][1] = pk2(Lv[2], Lv[3]); }
    T += __shfl_xor(T, 16); T += __shfl_xor(T, 32);
    bf16x8 Lh[2];
#pragma unroll
    for (int kk = 0; kk < 2; ++kk) Lh[kk] = as_frag((u32x4){hi[2 * kk][0], hi[2 * kk][1], hi[2 * kk + 1][0], hi[2 * kk + 1][1]});
    unsigned pw[4][2];
#pragma unroll
    for (int st = 0; st < 4; ++st) { f32x4 ce = (f32x4){0.f, 0.f, 0.f, 0.f};
#pragma unroll
        for (int kk = 0; kk < 2; ++kk) { if (2 * kk + 1 >= st) {
            u32x4 ua;
            { const int k0 = 2 * kk, k1 = 2 * kk + 1;
              ua.x = k0 > st ? ONES : (k0 == st ? dpat.x : 0u); ua.y = k0 > st ? ONES : (k0 == st ? dpat.y : 0u);
              ua.z = k1 > st ? ONES : (k1 == st ? dpat.x : 0u); ua.w = k1 > st ? ONES : (k1 == st ? dpat.y : 0u); }
            ce = mfma16(as_frag(ua), Lh[kk], ce); } }
        float w[4];
#pragma unroll
        for (int jj = 0; jj < 4; ++jj) w[jj] = __builtin_amdgcn_exp2f(z[st][jj] + R + ce[jj]);
        pw[st][0] = pk2(w[0], w[1]); pw[st][1] = pk2(w[2], w[3]); }
    R += T;
#pragma unroll
    for (int kk = 0; kk < 2; ++kk) pfr[kk] = as_frag((u32x4){pw[2 * kk][0], pw[2 * kk][1], pw[2 * kk + 1][0], pw[2 * kk + 1][1]});
}
__device__ __forceinline__ void sb_phase(const Params& p, LAS unsigned char* lds) {
    const int tid = tid_opaque(), wid = __builtin_amdgcn_readfirstlane(tid >> 6), lane = tid & 63, li = lane & 15, g4 = lane >> 4;
    const bf16_t* QKV = (const bf16_t*)(p.ws + WS_R1);
    bf16_t* MIX = (bf16_t*)(p.ws + WS_MIX);
    LAS bf16_t* Vl = (LAS bf16_t*)(lds + wid * VL_BYTES);
    const int wv = blockIdx.x * 8 + wid, nw = gridDim.x * 8;
    u32x2 dpat; dpat.x = ((4 * g4 + 0 > li) ? 0x3F80u : 0u) | ((4 * g4 + 1 > li) ? 0x3F800000u : 0u); dpat.y = ((4 * g4 + 2 > li) ? 0x3F80u : 0u) | ((4 * g4 + 3 > li) ? 0x3F800000u : 0u);
    for (int it = wv; it < 8192; it += nw) {
        const int bh = it >> 6, pr = it & 63, b = bh >> 3, h = bh & 7;
        for (int half = 0; half < 2; ++half) {
            const int qtile = half ? 127 - pr : pr, t0 = qtile * 32, kbd = t0 >> 6;
            const bf16_t* qb = QKV + ((size_t)b * SEQ + t0) * 3584 + 2048 + h * 64;
            bf16x8 qf[2][2];
#pragma unroll
            for (int qt = 0; qt < 2; ++qt)
#pragma unroll
                for (int ks = 0; ks < 2; ++ks) qf[qt][ks] = *(const bf16x8*)(qb + (size_t)(qt * 16 + li) * 3584 + 32 * ks + 8 * g4);
            f32x4 o[2][4]; float R[2];
#pragma unroll
            for (int qt = 0; qt < 2; ++qt) { R[qt] = 0.f;
#pragma unroll
                for (int dt = 0; dt < 4; ++dt) o[qt][dt] = (f32x4){0.f, 0.f, 0.f, 0.f}; }
            for (int kb = kbd; kb >= 0; --kb) {
                const bf16_t* kbase = QKV + ((size_t)b * SEQ + kb * 64) * 3584 + 2560 + h * 64;
#pragma unroll
                for (int r = 0; r < 8; ++r) { const int row = r * 8 + (lane >> 3), c8 = lane & 7;
                    *(LAS u32x4*)(Vl + row * VS + c8 * 8) = *(const u32x4*)(kbase + (size_t)row * 3584 + 512 + c8 * 8); }
                bf16x8 kf[4][2];
#pragma unroll
                for (int kt = 0; kt < 4; ++kt)
#pragma unroll
                    for (int ks = 0; ks < 2; ++ks) kf[kt][ks] = *(const bf16x8*)(kbase + (size_t)(kt * 16 + li) * 3584 + 32 * ks + 8 * g4);
                wave_lds_fence();
                const int kpos0 = kb * 64 + 4 * g4;
                bf16x8 pfr[2][2];
                if (kb == kbd) {
#pragma unroll
                    for (int qt = 0; qt < 2; ++qt) sb_qtile<true>(kf, qf[qt], R[qt], pfr[qt], li, g4, kpos0, t0 + qt * 16 + li, dpat);
                } else {
#pragma unroll
                    for (int qt = 0; qt < 2; ++qt) sb_qtile<false>(kf, qf[qt], R[qt], pfr[qt], li, g4, kpos0, t0 + qt * 16 + li, dpat);
                }
                { bf16x8 vf[2][4];
#pragma unroll
                  for (int kk = 0; kk < 2; ++kk)
#pragma unroll
                      for (int dt = 0; dt < 4; ++dt) vf[kk][dt] = tr_pair(Vl, VS, 32 * kk + 4 * g4, 32 * kk + 16 + 4 * g4, dt * 16, li);
#pragma unroll
                  for (int kk = 0; kk < 2; ++kk)
#pragma unroll
                      for (int dt = 0; dt < 4; ++dt)
#pragma unroll
                          for (int qt = 0; qt < 2; ++qt) o[qt][dt] = mfma16(vf[kk][dt], pfr[qt][kk], o[qt][dt]); }
                wave_lds_fence();
#if SB_EARLY_EXIT
                { const float rm = fmaxf(R[0], R[1]); if (__all(rm < -152.f)) break; }
#endif
            }
#pragma unroll
            for (int qt = 0; qt < 2; ++qt)
#pragma unroll
                for (int dt = 0; dt < 4; ++dt) { const f32x4 v = o[qt][dt];
                    *(u32x2*)(MIX + ((size_t)b * SEQ + t0 + qt * 16 + li) * 1024 + 512 + h * 64 + dt * 16 + 4 * g4) = (u32x2){pk2(v[0], v[1]), pk2(v[2], v[3])}; }
        }
    }
}

constexpr int RS = 136;
__device__ __forceinline__ float ret_log_gamma(int h) { return logf(1.f - exp2f(-5.f - (float)h)); }
struct RotRegs { u32x4 a, b; };
struct RopeRegs { f32x2 cs[8]; };
struct PlainRegs { u32x4 a, b; };
__device__ __forceinline__ void rot_ld(RotRegs& r, const bf16_t* src  , int j, int part) { r.a = *(const u32x4*)(src + (size_t)j * 3584 + part * 8); r.b = *(const u32x4*)(src + (size_t)j * 3584 + 64 + part * 8); }
__device__ __forceinline__ void rope_ld(RopeRegs& r, const f32x2* rope, int pos, int part) {
#pragma unroll
    for (int e = 0; e < 8; ++e) r.cs[e] = rope[(size_t)pos * 64 + part * 8 + e]; }
__device__ __forceinline__ void plain_ld(PlainRegs& r, const bf16_t* src, int j, int part) { r.a = *(const u32x4*)(src + (size_t)j * 3584 + part * 16); r.b = *(const u32x4*)(src + (size_t)j * 3584 + part * 16 + 8); }
__device__ __forceinline__ void rot_st(const RotRegs& r, const RopeRegs& c, LAS bf16_t* dst, int j, int part, float rsc) {
    const float x1[8] = {lo_f(r.a.x), hi_f(r.a.x), lo_f(r.a.y), hi_f(r.a.y), lo_f(r.a.z), hi_f(r.a.z), lo_f(r.a.w), hi_f(r.a.w)};
    const float x2[8] = {lo_f(r.b.x), hi_f(r.b.x), lo_f(r.b.y), hi_f(r.b.y), lo_f(r.b.z), hi_f(r.b.z), lo_f(r.b.w), hi_f(r.b.w)};
    float o1[8], o2[8];
#pragma unroll
    for (int e = 0; e < 8; ++e) { const f32x2 cc = c.cs[e]; o1[e] = (x1[e] * cc.x - x2[e] * cc.y) * rsc; o2[e] = (x1[e] * cc.y + x2[e] * cc.x) * rsc; }
    *(LAS u32x4*)(dst + j * RS + part * 8) = (u32x4){pk2(o1[0], o1[1]), pk2(o1[2], o1[3]), pk2(o1[4], o1[5]), pk2(o1[6], o1[7])};
    *(LAS u32x4*)(dst + j * RS + 64 + part * 8) = (u32x4){pk2(o2[0], o2[1]), pk2(o2[2], o2[3]), pk2(o2[4], o2[5]), pk2(o2[6], o2[7])};
}
__device__ __forceinline__ void plain_st(const PlainRegs& r, LAS bf16_t* dst, int j, int part) { *(LAS u32x4*)(dst + j * RS + part * 16) = r.a; *(LAS u32x4*)(dst + j * RS + part * 16 + 8) = r.b; }

__device__ __forceinline__ void reta_phase(const Params& p, LAS unsigned char* lds) {
    const int tid = tid_opaque(), wid = __builtin_amdgcn_readfirstlane(tid >> 6), lane = tid & 63, li = lane & 15, g4 = lane >> 4;
    const int j = tid >> 3, part = tid & 7;
    const bf16_t* QKV = (const bf16_t*)(p.ws + WS_R1);
    const f32x2* rope = (const f32x2*)(p.ws + WS_ROPE);
    bf16_t* RET = (bf16_t*)(p.ws + WS_H);
    LAS bf16_t* Kl = (LAS bf16_t*)lds; LAS bf16_t* Vl = (LAS bf16_t*)(lds + 64 * RS * 2);
    RotRegs kr; RopeRegs cr; PlainRegs vr;
    { const int item = blockIdx.x; if (item < 4096) { const int c = item & 63, hh = (item >> 6) & 3, b = item >> 8; const bf16_t* base = QKV + ((size_t)b * SEQ + c * 64) * 3584 + hh * 128;
        rot_ld(kr, base + 512, j, part); rope_ld(cr, rope, c * 64 + j, part); plain_ld(vr, base + 1024, j, part); } }
    for (int item = blockIdx.x; item < 4096; item += gridDim.x) {
        const int c = item & 63, hh = (item >> 6) & 3, b = item >> 8;
        const float lg = ret_log_gamma(hh);
        __syncthreads();
        rot_st(kr, cr, Kl, j, part, 0.08838834764831845f * __expf(lg * (63.f - (float)j)));
        plain_st(vr, Vl, j, part);
        { const int nx = item + gridDim.x; if (nx < 4096) { const int c2 = nx & 63, h2 = (nx >> 6) & 3, b2 = nx >> 8; const bf16_t* base = QKV + ((size_t)b2 * SEQ + c2 * 64) * 3584 + h2 * 128;
            rot_ld(kr, base + 512, j, part); rope_ld(cr, rope, c2 * 64 + j, part); plain_ld(vr, base + 1024, j, part); } }
        __syncthreads();
        f32x4 acc[8];
#pragma unroll
        for (int et = 0; et < 8; ++et) acc[et] = (f32x4){0.f, 0.f, 0.f, 0.f};
#pragma unroll
        for (int kk = 0; kk < 2; ++kk) { const bf16x8 af = tr_pair(Kl, RS, 32 * kk + 8 * g4, 32 * kk + 8 * g4 + 4, wid * 16, li);
#pragma unroll
            for (int et = 0; et < 8; ++et) { const bf16x8 bfr = tr_pair(Vl, RS, 32 * kk + 8 * g4, 32 * kk + 8 * g4 + 4, et * 16, li); acc[et] = mfma16(af, bfr, acc[et]); } }
        const size_t sid = (size_t)((b * 4 + hh) * 64 + c);
#pragma unroll
        for (int et = 0; et < 8; ++et) *(u32x2*)(RET + (sid * 128 + et * 16 + li) * 128 + wid * 16 + 4 * g4) = (u32x2){pk2(acc[et][0], acc[et][1]), pk2(acc[et][2], acc[et][3])};
    }
}
__device__ __forceinline__ void retscan_phase(const Params& p) {
    bf16_t* RET = (bf16_t*)(p.ws + WS_H);
    const int gtid = blockIdx.x * NTHR + tid_opaque(), nthr = gridDim.x * NTHR;
    for (int w = gtid; w < 64 * 2048; w += nthr) {
        const int bhh = w >> 11, e8 = w & 2047, hh = bhh & 3;
        const float cd = __expf(64.f * ret_log_gamma(hh));
        float S[8];
#pragma unroll
        for (int e = 0; e < 8; ++e) S[e] = 0.f;
        bf16_t* base = RET + (size_t)bhh * 64 * 16384 + e8 * 8;
        for (int c0 = 0; c0 < 64; c0 += 4) {
            u32x4 kv[4];
#pragma unroll
            for (int k = 0; k < 4; ++k) kv[k] = *(const u32x4*)(base + (size_t)(c0 + k) * 16384);
#pragma unroll
            for (int k = 0; k < 4; ++k) {
                *(u32x4*)(base + (size_t)(c0 + k) * 16384) = (u32x4){pk2(S[0], S[1]), pk2(S[2], S[3]), pk2(S[4], S[5]), pk2(S[6], S[7])};
                S[0] = S[0] * cd + lo_f(kv[k].x); S[1] = S[1] * cd + hi_f(kv[k].x); S[2] = S[2] * cd + lo_f(kv[k].y); S[3] = S[3] * cd + hi_f(kv[k].y);
                S[4] = S[4] * cd + lo_f(kv[k].z); S[5] = S[5] * cd + hi_f(kv[k].z); S[6] = S[6] * cd + lo_f(kv[k].w); S[7] = S[7] * cd + hi_f(kv[k].w); }
        }
    }
}
__device__ __forceinline__ void retc_phase(const Params& p, LAS unsigned char* lds) {
    const int tid = tid_opaque(), wid = __builtin_amdgcn_readfirstlane(tid >> 6), lane = tid & 63, li = lane & 15, g4 = lane >> 4;
    const bf16_t* QKV = (const bf16_t*)(p.ws + WS_R1);
    const f32x2* rope = (const f32x2*)(p.ws + WS_ROPE);
    const bf16_t* RET = (const bf16_t*)(p.ws + WS_H);
    bf16_t* MIX = (bf16_t*)(p.ws + WS_MIX);
    LAS bf16_t* Ql = (LAS bf16_t*)lds; LAS bf16_t* Kl = (LAS bf16_t*)(lds + 17408); LAS bf16_t* Vl = (LAS bf16_t*)(lds + 34816);
    LAS bf16_t* Sl = (LAS bf16_t*)(lds + 52224);
    LAS f32x2* stl = (LAS f32x2*)(lds + 61440);
    const int j = tid >> 3, part = tid & 7;
    RotRegs qr, kr; RopeRegs cr; PlainRegs vr;
    { const int item = blockIdx.x; if (item < 4096) { const int c = item & 63, hh = (item >> 6) & 3, b = item >> 8; const bf16_t* base = QKV + ((size_t)b * SEQ + c * 64) * 3584 + hh * 128;
        rot_ld(qr, base, j, part); rot_ld(kr, base + 512, j, part); rope_ld(cr, rope, c * 64 + j, part); plain_ld(vr, base + 1024, j, part); } }
    for (int item = blockIdx.x; item < 4096; item += gridDim.x) {
        const int c = item & 63, hh = (item >> 6) & 3, b = item >> 8;
        const float lg = ret_log_gamma(hh);
        const size_t row0 = (size_t)b * SEQ + c * 64;
        const size_t sid = (size_t)((b * 4 + hh) * 64 + c);
        bf16x8 stf[4]; u32x2 gg[4];
#pragma unroll
        for (int ks = 0; ks < 4; ++ks) stf[ks] = *(const bf16x8*)(RET + (sid * 128 + wid * 16 + li) * 128 + 32 * ks + 8 * g4);
#pragma unroll
        for (int itq = 0; itq < 4; ++itq) gg[itq] = *(const u32x2*)(QKV + (row0 + itq * 16 + li) * 3584 + 1536 + hh * 128 + wid * 16 + 4 * g4);
        __syncthreads();
        rot_st(qr, cr, Ql, j, part, 1.f);
        rot_st(kr, cr, Kl, j, part, 0.08838834764831845f);
        plain_st(vr, Vl, j, part);
        { const int nx = item + gridDim.x; if (nx < 4096) { const int c2 = nx & 63, h2 = (nx >> 6) & 3, b2 = nx >> 8; const bf16_t* base = QKV + ((size_t)b2 * SEQ + c2 * 64) * 3584 + h2 * 128;
            rot_ld(qr, base, j, part); rot_ld(kr, base + 512, j, part); rope_ld(cr, rope, c2 * 64 + j, part); plain_ld(vr, base + 1024, j, part); } }
        __syncthreads();
        { const int jt = wid >> 1;
#pragma unroll
          for (int e2 = 0; e2 < 2; ++e2) { const int itq = 2 * (wid & 1) + e2; f32x4 sacc = (f32x4){0.f, 0.f, 0.f, 0.f};
#pragma unroll
              for (int ks = 0; ks < 4; ++ks) { const bf16x8 af = *(const LAS bf16x8*)(Kl + (jt * 16 + li) * RS + 32 * ks + 8 * g4); const bf16x8 bfr = *(const LAS bf16x8*)(Ql + (itq * 16 + li) * RS + 32 * ks + 8 * g4); sacc = mfma16(af, bfr, sacc); }
              float sv[4];
#pragma unroll
              for (int jj = 0; jj < 4; ++jj) { const int j = jt * 16 + 4 * g4 + jj, iq = itq * 16 + li; const int dd = iq > j ? iq - j : j - iq; sv[jj] = sacc[jj] * __expf(lg * (float)dd); }
              *(LAS u32x2*)(Sl + (itq * 16 + li) * VS + jt * 16 + 4 * g4) = (u32x2){pk2(sv[0], sv[1]), pk2(sv[2], sv[3])}; } }
        __syncthreads();
        f32x4 oa[4];
#pragma unroll
        for (int itq = 0; itq < 4; ++itq) oa[itq] = (f32x4){0.f, 0.f, 0.f, 0.f};
#pragma unroll
        for (int ks = 0; ks < 4; ++ks) { const bf16x8 af = stf[ks];
#pragma unroll
            for (int itq = 0; itq < 4; ++itq) { const bf16x8 bfr = *(const LAS bf16x8*)(Ql + (itq * 16 + li) * RS + 32 * ks + 8 * g4); oa[itq] = mfma16(af, bfr, oa[itq]); } }
#pragma unroll
        for (int itq = 0; itq < 4; ++itq) oa[itq] *= __expf(lg * (float)(itq * 16 + li + 1));
#pragma unroll
        for (int kk = 0; kk < 2; ++kk) { const bf16x8 af = tr_pair(Vl, RS, 32 * kk + 8 * g4, 32 * kk + 8 * g4 + 4, wid * 16, li);
#pragma unroll
            for (int itq = 0; itq < 4; ++itq) { const bf16x8 bfr = *(const LAS bf16x8*)(Sl + (itq * 16 + li) * VS + 32 * kk + 8 * g4); oa[itq] = mfma16(af, bfr, oa[itq]); } }
#pragma unroll
        for (int itq = 0; itq < 4; ++itq) { float s1 = oa[itq][0] + oa[itq][1] + oa[itq][2] + oa[itq][3];
            float s2 = oa[itq][0] * oa[itq][0] + oa[itq][1] * oa[itq][1] + oa[itq][2] * oa[itq][2] + oa[itq][3] * oa[itq][3];
            s1 += __shfl_xor(s1, 16); s1 += __shfl_xor(s1, 32); s2 += __shfl_xor(s2, 16); s2 += __shfl_xor(s2, 32);
            if (g4 == 0) stl[wid * 64 + itq * 16 + li] = (f32x2){s1, s2}; }
        __syncthreads();
        const f32x4 ng = *(const f32x4*)(p.in[25] + hh * 128 + wid * 16 + 4 * g4);
#pragma unroll
        for (int itq = 0; itq < 4; ++itq) { float s1 = 0.f, s2 = 0.f;
#pragma unroll
            for (int w8 = 0; w8 < 8; ++w8) { const f32x2 t = stl[w8 * 64 + itq * 16 + li]; s1 += t.x; s2 += t.y; }
            const float mu = s1 * (1.f / 128.f), var = fmaxf(s2 * (1.f / 128.f) - mu * mu, 0.f), rs = rsqrtf(var + 1e-6f);
            const size_t row = row0 + itq * 16 + li;
            const float r0 = (oa[itq][0] - mu) * rs * ng[0] * silu_f(lo_f(gg[itq].x)), r1 = (oa[itq][1] - mu) * rs * ng[1] * silu_f(hi_f(gg[itq].x));
            const float r2 = (oa[itq][2] - mu) * rs * ng[2] * silu_f(lo_f(gg[itq].y)), r3 = (oa[itq][3] - mu) * rs * ng[3] * silu_f(hi_f(gg[itq].y));
            *(u32x2*)(MIX + row * 1024 + hh * 128 + wid * 16 + 4 * g4) = (u32x2){pk2(r0, r1), pk2(r2, r3)}; }
    }
}

constexpr int N_PHASES = 20;
__global__ void __launch_bounds__(NTHR, 2) mega_fwd(Params p) {
    extern __shared__ __attribute__((aligned(16))) unsigned char lds_raw[];
    LAS unsigned char* lds = (LAS unsigned char*)lds_raw;
    cg::grid_group grid = cg::this_grid();
    unsigned char* ws = p.ws;
    const float* MOD = (const float*)(ws + WS_MOD);
    bf16_t* H = (bf16_t*)(ws + WS_H); bf16_t* MIX = (bf16_t*)(ws + WS_MIX); bf16_t* R1 = (bf16_t*)(ws + WS_R1);
    float* XA = p.out;
    pg8::StaticOrder S;
#ifndef PROBE_MASK
#define PROBE_MASK 0u
#endif
    unsigned long long probe_acc = 0ull;
    unsigned bar_gen = 0u;
    for (int ph = p.ph_lo; ph < p.ph_hi; ++ph) {
        const unsigned long long probe_t0 = PROBE_MASK ? __builtin_amdgcn_s_memrealtime() : 0ull;
        const int layer = ph >= 11 ? 1 : 0;
        const float* modl = MOD + (size_t)layer * 16 * 6144;
        switch (ph) {
        case 0: prep_phase(p, lds); break;
        case 1: case 8: case 11: case 17: {
            const bool ffn = (ph == 8 || ph == 17);
            const float* xin = (ph == 1) ? p.in[0] : XA;
            norm_phase(xin, (ffn ? p.in[5] : p.in[4]) + layer * 1024, modl + (ffn ? 3072 : 0), modl + (ffn ? 4096 : 1024), H);
        } break;
        case 2: {
            pg8::Gemm g{H, (const bf16_t*)(ws + WS_W_ABIN), MTOK, 2048, 1024};
            S.init(MTOK, 2048, gridDim.x, blockIdx.x);
            pg8::EpiStoreQK E{R1, p.in[10], p.in[11]};
            pg8::gemm_phase(lds, g, S, E);
        } break;
        case 12: {
            pg8::Gemm g{H, (const bf16_t*)(ws + WS_W_CDIN), MTOK, 3584, 1024};
            S.init(MTOK, 3584, gridDim.x, blockIdx.x);
            pg8::EpiStore E{R1, 3584};
            pg8::gemm_phase(lds, g, S, E);
        } break;
        case 3: attnA_phase(p, lds); break;
        case 4: s5scan_phase(p); break;
        case 5: s5c_phase(p, lds); break;
        case 6: {
            pg8::Gemm g{(const bf16_t*)(ws + WS_Y5), (const bf16_t*)(ws + WS_W_GLU), MTOK, 512, 512};
            S.init(MTOK, 512, gridDim.x, blockIdx.x);
            pg8::EpiGlu E{(const bf16_t*)(ws + WS_Y5), p.in[22], MIX};
            pg8::gemm_phase(lds, g, S, E);
        } break;
        case 7: case 16: case 10: case 19: {
            const bool ffn = (ph == 10 || ph == 19);
            const bf16_t* A = ffn ? R1 : MIX;
            const bf16_t* Bt = ffn ? (const bf16_t*)(ws + WS_W_FFOUT) + (size_t)layer * 1024 * FFH : (const bf16_t*)(ws + (layer ? WS_W_CDOUT : WS_W_ABOUT));
            pg8::Gemm g{A, Bt, MTOK, 1024, ffn ? FFH : 1024};
            S.init(MTOK, 1024, gridDim.x, blockIdx.x);
            pg8::EpiResid E{(ph == 7) ? p.in[0] : XA, XA, modl + (ffn ? 5120 : 2048)};
            pg8::gemm_phase(lds, g, S, E);
        } break;
        case 9: case 18: {
            pg8::Gemm g{H, (const bf16_t*)(ws + WS_W_FFIN) + (size_t)layer * 5632 * 1024, MTOK, 5632, 1024};
            S.init(MTOK, 5632, gridDim.x, blockIdx.x);
            pg8::EpiSwiglu E{R1};
            pg8::gemm_phase(lds, g, S, E);
        } break;
        case 13: reta_phase(p, lds); __syncthreads(); sb_phase(p, lds); break;
        case 14: retscan_phase(p); break;
        case 15: retc_phase(p, lds); break;
        default: break;
        }
        unsigned long long probe_t1 = 0ull;
        if (PROBE_MASK) { __syncthreads(); probe_t1 = __builtin_amdgcn_s_memrealtime(); if ((PROBE_MASK >> ph) & 1u) probe_acc += probe_t1 - probe_t0; }
        if (ph + 1 < p.ph_hi) {
            if (p.ph_hi > 1000) grid.sync();
            grid_barrier((unsigned*)(ws + WS_CTL), bar_gen);
        }
        if (PROBE_MASK && ((PROBE_MASK >> 20) & 1u)) probe_acc += __builtin_amdgcn_s_memrealtime() - probe_t1;
    }
    if (PROBE_MASK && blockIdx.x == 0 && threadIdx.x == 0) { const unsigned long long st = __builtin_amdgcn_s_memrealtime(); while (__builtin_amdgcn_s_memrealtime() - st < probe_acc) __builtin_amdgcn_s_sleep(8); }
}


#ifndef DIAG
#define DIAG 0
#endif
#if DIAG
__global__ void diag_fold(Params p) {
    const size_t n = (size_t)MTOK * 1024; unsigned char* ws = p.ws;
    for (size_t i = (size_t)blockIdx.x * blockDim.x + threadIdx.x; i < n; i += (size_t)gridDim.x * blockDim.x) {
        const size_t row = i >> 10; const int col = (int)(i & 1023); float v = 0.f;
#if DIAG == 30
        v = col < 512 ? bf2f(((const bf16_t*)(ws + WS_MIX))[i]) : 0.f;
#elif DIAG == 31
        v = ((const float*)(ws + WS_S5E))[i & 4194303];
#elif DIAG == 3
        v = col < 512 ? bf2f(((const bf16_t*)(ws + WS_MIX))[i]) : ((const float*)(ws + WS_S5E))[(row * 512 + col - 512) & 4194303];
#elif DIAG == 2
        v = bf2f(((const bf16_t*)(ws + WS_R1))[2 * i]) + bf2f(((const bf16_t*)(ws + WS_R1))[2 * i + 1]);
#elif DIAG == 1
        v = bf2f(((const bf16_t*)(ws + WS_H))[i]);
#elif DIAG == 5
        v = bf2f(((const bf16_t*)(ws + WS_Y5))[i >> 1]);
#elif DIAG == 6
        v = bf2f(((const bf16_t*)(ws + WS_MIX))[i]);
#endif
        p.out[i] = v;
    }
}
#endif
#ifndef MK_MULTI
#define MK_MULTI 0
#endif
extern "C" void kernel_launch(void* const* d_in, const int* in_sizes, int n_in, void* d_out, int out_size, void* d_ws, size_t ws_size, hipStream_t stream) {
    static int grid = 0;
    if (grid == 0) {
        if (n_in != 26 || out_size != MTOK * DM || ws_size < WS_END) { fprintf(stderr, "kernel_launch: unexpected shapes (n_in %d out %d ws %zu need %zu)\n", n_in, out_size, ws_size, (size_t)WS_END); grid = -1; return; }
        int dev = 0, cus = 0, per_cu = 0;
        hipGetDevice(&dev); hipDeviceGetAttribute(&cus, hipDeviceAttributeMultiprocessorCount, dev);
        if (hipFuncSetAttribute((const void*)mega_fwd, hipFuncAttributeMaxDynamicSharedMemorySize, LDS_BYTES) != hipSuccess) { fprintf(stderr, "kernel_launch: hipFuncSetAttribute failed\n"); grid = -1; return; }
        if (hipOccupancyMaxActiveBlocksPerMultiprocessor(&per_cu, (const void*)mega_fwd, NTHR, LDS_BYTES) != hipSuccess || per_cu < 1) { fprintf(stderr, "kernel_launch: occupancy query says %d\n", per_cu); per_cu = 1; }
        (void)hipGetLastError();
        grid = cus * 1;
    }
    if (grid < 0) return;
    Params p{};
    for (int i = 0; i < 26; ++i) p.in[i] = (const float*)d_in[i];
    p.out = (float*)d_out; p.ws = (unsigned char*)d_ws;
#if MK_MULTI
#if DIAG
    for (int ph = 0; ph <= (DIAG >= 30 ? DIAG / 10 : DIAG); ++ph) { p.ph_lo = ph; p.ph_hi = ph + 1; hipLaunchKernelGGL(mega_fwd, dim3(grid), dim3(NTHR), LDS_BYTES, stream, p); }
    hipLaunchKernelGGL(diag_fold, dim3(2048), dim3(256), 0, stream, p);
#else
    for (int ph = 0; ph < N_PHASES; ++ph) { p.ph_lo = ph; p.ph_hi = ph + 1; hipLaunchKernelGGL(mega_fwd, dim3(grid), dim3(NTHR), LDS_BYTES, stream, p); }
#endif
#else
    p.ph_lo = 0; p.ph_hi = N_PHASES;
    (void)hipMemsetAsync((char*)d_ws + WS_CTL, 0, 4096, stream);
    void* args[] = {&p};
    hipError_t e = hipLaunchCooperativeKernel((const void*)mega_fwd, dim3(grid), dim3(NTHR), args, LDS_BYTES, stream);
    if (e != hipSuccess) fprintf(stderr, "cooperative launch failed: %s (grid %d)\n", hipGetErrorString(e), grid);
#endif
}
```

```cpp
#include <hip/hip_runtime.h>
#include <hip/hip_cooperative_groups.h>
#include <cstdio>
namespace cg = cooperative_groups;

#define LAS __attribute__((address_space(3)))
typedef unsigned short bf16_t;
typedef short bf16x8 __attribute__((ext_vector_type(8)));
typedef short s16x4 __attribute__((ext_vector_type(4)));
typedef float f32x4 __attribute__((ext_vector_type(4)));
typedef float f32x2 __attribute__((ext_vector_type(2)));
typedef unsigned u32x4 __attribute__((ext_vector_type(4)));
typedef unsigned u32x2 __attribute__((ext_vector_type(2)));

constexpr int NB = 16, SEQ = 4096, DM = 1024, MTOK = NB * SEQ, FFH = 2816;
constexpr int NTHR = 512;
constexpr int LDS_BYTES = 135168;

constexpr size_t al256(size_t x) { return (x + 255) & ~(size_t)255; }
constexpr size_t WS_CTL = 0;
constexpr size_t WS_W_ABIN = 4096;
constexpr size_t WS_W_ABOUT = WS_W_ABIN + (size_t)2048 * 1024 * 2;
constexpr size_t WS_W_GLU = WS_W_ABOUT + (size_t)1024 * 1024 * 2;
constexpr size_t WS_W_FFIN = WS_W_GLU + (size_t)512 * 512 * 2;
constexpr size_t WS_W_FFOUT = WS_W_FFIN + (size_t)2 * 5632 * 1024 * 2;
constexpr size_t WS_W_CDIN = WS_W_FFOUT + (size_t)2 * 1024 * 2816 * 2;
constexpr size_t WS_W_CDOUT = WS_W_CDIN + (size_t)3584 * 1024 * 2;
constexpr size_t WS_MOD = WS_W_CDOUT + (size_t)1024 * 1024 * 2;
constexpr size_t WS_ROPE = WS_MOD + (size_t)2 * 16 * 6144 * 4;
constexpr size_t WS_KERN = WS_ROPE + (size_t)4096 * 64 * 8;
constexpr size_t WS_S5M = WS_KERN + (size_t)32 * 64 * 256 * 2;
constexpr size_t WS_S5G = WS_S5M + (size_t)32 * 128 * 1024 * 2;
constexpr size_t WS_A64 = WS_S5G + (size_t)32 * 1024 * 128 * 2;
constexpr size_t WS_S5E = WS_A64 + (size_t)32 * 64 * 8;
constexpr size_t WS_S5X = WS_S5E + (size_t)64 * 32 * 16 * 128 * 4;
constexpr size_t WS_Y5 = WS_S5X + (size_t)64 * 32 * 16 * 128 * 2;
constexpr size_t WS_H = WS_Y5 + (size_t)MTOK * 512 * 2;
constexpr size_t WS_MIX = WS_H + (size_t)MTOK * 1024 * 2;
constexpr size_t WS_R1 = WS_MIX + (size_t)MTOK * 1024 * 2;
constexpr size_t WS_END = WS_R1 + (size_t)MTOK * 3584 * 2;

struct Params {
    const float* in[26];
    float* out;
    unsigned char* ws;
    int ph_lo, ph_hi;
};

__device__ __forceinline__ float bf2f(unsigned short b) { return __uint_as_float(((unsigned)b) << 16); }
typedef __bf16 bf16x2_t __attribute__((ext_vector_type(2)));
__device__ __forceinline__ unsigned pk2(float lo, float hi) { const f32x2 v = {lo, hi}; return __builtin_bit_cast(unsigned, __builtin_convertvector(v, bf16x2_t)); }
__device__ __forceinline__ bf16_t f2bf(float f) { return (bf16_t)(pk2(f, 0.f) & 0xffffu); }
__device__ __forceinline__ float lo_f(unsigned u) { return __uint_as_float(u << 16); }
__device__ __forceinline__ float hi_f(unsigned u) { return __uint_as_float(u & 0xffff0000u); }
__device__ __forceinline__ bf16x8 as_frag(u32x4 u) { return __builtin_bit_cast(bf16x8, u); }
__device__ __forceinline__ f32x4 mfma16(bf16x8 a, bf16x8 b, f32x4 c) { return __builtin_amdgcn_mfma_f32_16x16x32_bf16(a, b, c, 0, 0, 0); }
__device__ __forceinline__ float silu_f(float x) { return x * __builtin_amdgcn_rcpf(1.f + __expf(-x)); }
__device__ __forceinline__ float sigm_f(float x) { return __builtin_amdgcn_rcpf(1.f + __expf(-x)); }
__device__ __forceinline__ float gelu_tanh(float x) {
    const float u = 0.7978845608028654f * (x + 0.044715f * x * x * x);
    const float t = 1.f - 2.f * __builtin_amdgcn_rcpf(1.f + __expf(2.f * u));
    return 0.5f * x * (1.f + t);
}
__device__ __forceinline__ bf16x8 tr_pair(LAS bf16_t* base, int stride, int row0, int row1, int col0, int li) {
    const int q = li >> 2, pq = li & 3;
    s16x4 a = __builtin_amdgcn_ds_read_tr16_b64_v4i16((LAS s16x4*)(base + (row0 + q) * stride + col0 + 4 * pq));
    s16x4 b = __builtin_amdgcn_ds_read_tr16_b64_v4i16((LAS s16x4*)(base + (row1 + q) * stride + col0 + 4 * pq));
    bf16x8 r = {a[0], a[1], a[2], a[3], b[0], b[1], b[2], b[3]};
    return r;
}
__device__ __forceinline__ int tid_opaque() { int t = threadIdx.x; asm volatile("" : "+v"(t)); return t; }
__device__ __forceinline__ int vblock() { const int G = gridDim.x, bx = blockIdx.x; return (G % 8 == 0) ? (bx % 8) * (G / 8) + bx / 8 : bx; }
__device__ __forceinline__ void wave_lds_fence() { asm volatile("s_waitcnt lgkmcnt(0)" ::: "memory"); __builtin_amdgcn_wave_barrier(); }


__device__ __forceinline__ void grid_barrier(unsigned* w, unsigned& gen) {
    asm volatile("s_waitcnt vmcnt(0) lgkmcnt(0)" ::: "memory");
    __syncthreads();
    if (threadIdx.x == 0) {
        __builtin_amdgcn_fence(__ATOMIC_RELEASE, "agent");
        asm volatile("s_waitcnt vmcnt(0) lgkmcnt(0)" ::: "memory");
        const unsigned G = gridDim.x, grp = blockIdx.x & 7u, ngrp = (G - grp + 7u) / 8u, ngroups = G < 8u ? G : 8u;
        const unsigned old = __hip_atomic_fetch_add(w + 32 * grp, 1u, __ATOMIC_RELAXED, __HIP_MEMORY_SCOPE_AGENT);
        if (old + 1u == ngrp * (gen + 1u)) {
            const unsigned old2 = __hip_atomic_fetch_add(w + 256, 1u, __ATOMIC_RELAXED, __HIP_MEMORY_SCOPE_AGENT);
            if (old2 + 1u == ngroups * (gen + 1u)) __hip_atomic_fetch_add(w + 288, 1u, __ATOMIC_RELAXED, __HIP_MEMORY_SCOPE_AGENT);
        }
        while (__hip_atomic_load(w + 288, __ATOMIC_RELAXED, __HIP_MEMORY_SCOPE_AGENT) == gen) __builtin_amdgcn_s_sleep(2);
        __builtin_amdgcn_fence(__ATOMIC_ACQUIRE, "agent");
        asm volatile("s_waitcnt vmcnt(0) lgkmcnt(0)" ::: "memory");
    }
    ++gen;
    __syncthreads();
}

namespace pg8 {
constexpr int BM = 256, BK = 64, HALF = 128, HTB = HALF * BK * 2, STAGE_BYTES = 8 * HTB, NXCD = 8, WGM = 8;
__device__ __forceinline__ int lds_byte(int r, int c) { const int st = (r >> 4) * 2 + (c >> 5), rr = r & 15, cc = c & 31, ob = rr * 64 + cc * 2; return st * 1024 + (ob ^ (((ob >> 9) & 1) << 5)); }
__device__ __forceinline__ void stage_rc(int b, int& R, int& C) { const int st = b / 1024, sb = b % 1024, swz = sb ^ (((sb >> 9) & 1) << 5); R = (st >> 1) * 16 + swz / 64; C = (st & 1) * 32 + (swz % 64) / 2; }
__device__ __forceinline__ int perm32(int rho) { const int n = rho >> 4, i = rho & 15; return 8 * (i >> 2) + 4 * n + (i & 3); }
struct Unit { int pm, pn; };
struct Gemm { const bf16_t* A; const bf16_t* Bt; int M, N, K; };
struct StaticOrder {
    int nM, nN, nwg, G, c;
    __device__ void init(int M, int N, int G_, int c_) { nM = M / BM; nN = N / BM; nwg = nM * nN; G = G_; c = c_; }
    __device__ bool next(int i, Unit& u) const {
        const long L = (long)i * G + c; if (L >= nwg) return false;
        int wgid = (int)L; { const int q = nwg / NXCD, r = nwg % NXCD, xcd = wgid % NXCD, off = wgid / NXCD; wgid = (xcd < r ? xcd * (q + 1) : r * (q + 1) + (xcd - r) * q) + off; }
        const int nig = WGM * nN, gid = wgid / nig, fm = gid * WGM, gsz = (nM - fm) < WGM ? (nM - fm) : WGM;
        u.pm = fm + ((wgid % nig) % gsz); u.pn = (wgid % nig) / gsz; return true;
    }
};

template <class Epi>
__device__ __forceinline__ void gemm_phase(LAS unsigned char* lds, const Gemm g, const StaticOrder& S, const Epi& E) {
    const int tid = tid_opaque(), wid = __builtin_amdgcn_readfirstlane(tid >> 6), lane = tid & 63, wr = wid >> 2, wc = wid & 3, fr = lane & 15, fq = lane >> 4;
    const int K = g.K, nt = K / BK;
    unsigned voffA[2], voffB[2];
#pragma unroll
    for (int i = 0; i < 2; ++i) { int R, C; stage_rc(tid * 16 + i * 8192, R, C); const int Rb = Epi::PERM ? ((R & ~31) + perm32(R & 31)) : R;
        voffA[i] = (unsigned)(R * K + C) * 2u; voffB[i] = (unsigned)(Rb * K + C) * 2u; }
    const size_t kstep = (size_t)(BK * 2);
    const size_t hstep = (size_t)HALF * K * 2;
    const size_t tstep = 2 * hstep;
    const unsigned ldsw = (unsigned)wid * 1024u;
    const int aoff = lds_byte(wr * 64 + fr, fq * 8), boff = lds_byte(wc * 32 + fr, fq * 8);
#define PG8_SA(b, h) (((b) * 2 + (h)) * HTB)
#define PG8_SB(b, h) ((4 + (b) * 2 + (h)) * HTB)
#define PG8_STAGE(bufoff, gbase, voff) do { _Pragma("unroll") for (int _i = 0; _i < 2; ++_i) \
        __builtin_amdgcn_global_load_lds((const unsigned*)((const char*)(gbase) + (voff)[_i]), (LAS unsigned*)(lds + (bufoff) + ldsw + _i * 8192), 16, 0, 0); } while (0)
#define PG8_LDA(dst, b, h) do { _Pragma("unroll") for (int m = 0; m < 4; ++m) _Pragma("unroll") for (int k = 0; k < 2; ++k) dst[m][k] = *(const LAS bf16x8*)(lds + PG8_SA(b, h) + aoff + m * 2048 + k * 1024); } while (0)
#define PG8_LDB(dst, b, h) do { _Pragma("unroll") for (int n = 0; n < 2; ++n) _Pragma("unroll") for (int k = 0; k < 2; ++k) dst[n][k] = *(const LAS bf16x8*)(lds + PG8_SB(b, h) + boff + n * 2048 + k * 1024); } while (0)
#define PG8_MMA(ai, bj, At, Bt) do { __builtin_amdgcn_s_setprio(1); _Pragma("unroll") for (int m = 0; m < 4; ++m) _Pragma("unroll") for (int n = 0; n < 2; ++n) _Pragma("unroll") for (int k = 0; k < 2; ++k) \
        acc[ai][bj][m][n] = __builtin_amdgcn_mfma_f32_16x16x32_bf16(Bt[n][k], At[m][k], acc[ai][bj][m][n], 0, 0, 0); __builtin_amdgcn_s_setprio(0); } while (0)
#define PG8_WAIT_V(n) asm volatile("s_waitcnt vmcnt(" #n ")" ::: "memory")
#define PG8_WAIT_L(n) asm volatile("s_waitcnt lgkmcnt(" #n ")" ::: "memory")
#define PG8_BAR __builtin_amdgcn_s_barrier()
#define PG8_SCHED __builtin_amdgcn_sched_barrier(0)
    Unit cur, nxt; int ui = 0;
    if (!S.next(0, cur)) return;
    f32x4 acc[2][2][4][2];
#pragma unroll
    for (int a = 0; a < 2; ++a)
#pragma unroll
        for (int b = 0; b < 2; ++b)
#pragma unroll
            for (int m = 0; m < 4; ++m)
#pragma unroll
                for (int n = 0; n < 2; ++n) acc[a][b][m][n] = (f32x4){0.f, 0.f, 0.f, 0.f};
    bf16x8 At[4][2], B0[2][2], B1[2][2];
    const char* cA = (const char*)g.A + (size_t)cur.pm * tstep; const char* cB = (const char*)g.Bt + (size_t)cur.pn * tstep;
    PG8_STAGE(PG8_SB(0, 0), cB, voffB); PG8_STAGE(PG8_SA(0, 0), cA, voffA); PG8_STAGE(PG8_SB(0, 1), cB + hstep, voffB); PG8_STAGE(PG8_SA(0, 1), cA + hstep, voffA);
    if (wr == 1) PG8_BAR;
    PG8_WAIT_V(4); PG8_BAR;
    PG8_STAGE(PG8_SB(1, 0), cB + kstep, voffB); PG8_STAGE(PG8_SA(1, 0), cA + kstep, voffA); PG8_STAGE(PG8_SB(1, 1), cB + hstep + kstep, voffB);
    PG8_WAIT_V(6); PG8_BAR;
    for (;;) {
        const bool has_next = S.next(ui + 1, nxt);
        const char* nA = has_next ? (const char*)g.A + (size_t)nxt.pm * tstep : cA; const char* nB = has_next ? (const char*)g.Bt + (size_t)nxt.pn * tstep : cB;
        for (int t = 0; t < nt; t += 2) {
            const bool last = (t == nt - 2);
            const char* a1 = cA + (size_t)(t + 1) * kstep;
            const char* a2 = last ? nA : cA + (size_t)(t + 2) * kstep; const char* b2 = last ? nB : cB + (size_t)(t + 2) * kstep;
            const char* a3 = a2 + kstep; const char* b3 = b2 + kstep;
            PG8_LDB(B0, 0, 0); PG8_SCHED; PG8_LDA(At, 0, 0); PG8_STAGE(PG8_SA(1, 1), a1 + hstep, voffA);
            PG8_WAIT_L(8); PG8_BAR; PG8_WAIT_L(0); PG8_MMA(0, 0, At, B0); PG8_BAR; PG8_SCHED;
            PG8_LDB(B1, 0, 1); PG8_STAGE(PG8_SB(0, 0), b2, voffB);
            PG8_BAR; PG8_WAIT_L(0); PG8_MMA(0, 1, At, B1); PG8_BAR;
            PG8_LDA(At, 0, 1); PG8_STAGE(PG8_SA(0, 0), a2, voffA);
            PG8_BAR; PG8_WAIT_L(0); PG8_MMA(1, 0, At, B0); PG8_BAR; PG8_SCHED;
            PG8_STAGE(PG8_SB(0, 1), b2 + hstep, voffB);
            PG8_WAIT_V(6); PG8_BAR; PG8_MMA(1, 1, At, B1); PG8_BAR;
            PG8_LDB(B0, 1, 0); PG8_SCHED; PG8_LDA(At, 1, 0); PG8_STAGE(PG8_SA(0, 1), a2 + hstep, voffA);
            PG8_WAIT_L(8); PG8_BAR; PG8_WAIT_L(0); PG8_MMA(0, 0, At, B0); PG8_BAR; PG8_SCHED;
            PG8_LDB(B1, 1, 1); PG8_STAGE(PG8_SB(1, 0), b3, voffB);
            PG8_BAR; PG8_WAIT_L(0); PG8_MMA(0, 1, At, B1); PG8_BAR;
            PG8_LDA(At, 1, 1); PG8_STAGE(PG8_SA(1, 0), a3, voffA);
            PG8_BAR; PG8_WAIT_L(0); PG8_MMA(1, 0, At, B0); PG8_BAR; PG8_SCHED;
            PG8_STAGE(PG8_SB(1, 1), b3 + hstep, voffB);
            PG8_WAIT_V(6); PG8_BAR; PG8_MMA(1, 1, At, B1); PG8_BAR;
        }
        E(acc, cur, wr, wc, fr, fq);
        if (!has_next) break;
#pragma unroll
        for (int a = 0; a < 2; ++a)
#pragma unroll
            for (int b = 0; b < 2; ++b)
#pragma unroll
                for (int m = 0; m < 4; ++m)
#pragma unroll
                    for (int n = 0; n < 2; ++n) acc[a][b][m][n] = (f32x4){0.f, 0.f, 0.f, 0.f};
        cur = nxt; cA = nA; cB = nB; ++ui;
    }
    PG8_WAIT_V(0);
    if (wr == 0) PG8_BAR;
    PG8_BAR;
#undef PG8_SA
#undef PG8_SB
#undef PG8_STAGE
#undef PG8_LDA
#undef PG8_LDB
#undef PG8_MMA
#undef PG8_WAIT_V
#undef PG8_WAIT_L
#undef PG8_BAR
#undef PG8_SCHED
}

struct EpiStore {
    static constexpr bool PERM = true;
    bf16_t* O; int ldc;
    __device__ __forceinline__ void operator()(const f32x4 (&acc)[2][2][4][2], const Unit& u, int wr, int wc, int fr, int fq) const {
        const int row0 = u.pm * BM + wr * 64 + fr, col0 = u.pn * BM + wc * 32 + 8 * fq;
#pragma unroll
        for (int ai = 0; ai < 2; ++ai)
#pragma unroll
            for (int m = 0; m < 4; ++m) { bf16_t* rowp = O + (size_t)(row0 + ai * HALF + m * 16) * ldc + col0;
#pragma unroll
                for (int bj = 0; bj < 2; ++bj) { const f32x4 v0 = acc[ai][bj][m][0], v1 = acc[ai][bj][m][1];
                    u32x4 w; w.x = pk2(v0[0], v0[1]); w.y = pk2(v0[2], v0[3]); w.z = pk2(v1[0], v1[1]); w.w = pk2(v1[2], v1[3]);
                    __builtin_nontemporal_store(w, (u32x4*)(rowp + bj * HALF)); } }
    }
};
struct EpiStoreQK {
    static constexpr bool PERM = true;
    bf16_t* O; const float* qg; const float* kg;
    __device__ __forceinline__ void operator()(const f32x4 (&acc)[2][2][4][2], const Unit& u, int wr, int wc, int fr, int fq) const {
        const int row0 = u.pm * BM + wr * 64 + fr;
        if (u.pn >= 4) {
            const int col0 = u.pn * BM + wc * 32 + 8 * fq;
#pragma unroll
            for (int ai = 0; ai < 2; ++ai)
#pragma unroll
                for (int m = 0; m < 4; ++m) { bf16_t* rowp = O + (size_t)(row0 + ai * HALF + m * 16) * 2048 + col0;
#pragma unroll
                    for (int bj = 0; bj < 2; ++bj) { const f32x4 v0 = acc[ai][bj][m][0], v1 = acc[ai][bj][m][1];
                        u32x4 w; w.x = pk2(v0[0], v0[1]); w.y = pk2(v0[2], v0[3]); w.z = pk2(v1[0], v1[1]); w.w = pk2(v1[2], v1[3]);
                        __builtin_nontemporal_store(w, (u32x4*)(rowp + bj * HALF)); } }
        } else {
            const float* gp = u.pn < 2 ? qg : kg; const float scl = u.pn < 2 ? 0.125f * 1.4426950408889634f : 1.f;
            f32x4 gn[2][2];
#pragma unroll
            for (int bj = 0; bj < 2; ++bj)
#pragma unroll
                for (int n = 0; n < 2; ++n) gn[bj][n] = *(const f32x4*)(gp + 32 * bj + 8 * fq + 4 * n);
            const int col0 = u.pn * BM + wc * 64 + 8 * fq;
#pragma unroll
            for (int ai = 0; ai < 2; ++ai)
#pragma unroll
                for (int m = 0; m < 4; ++m) { bf16_t* rowp = O + (size_t)(row0 + ai * HALF + m * 16) * 2048 + col0;
                    float ss = 0.f;
#pragma unroll
                    for (int bj = 0; bj < 2; ++bj)
#pragma unroll
                        for (int n = 0; n < 2; ++n) { const f32x4 a = acc[ai][bj][m][n]; ss += a[0] * a[0] + a[1] * a[1] + a[2] * a[2] + a[3] * a[3]; }
                    ss += __shfl_xor(ss, 16); ss += __shfl_xor(ss, 32);
                    const float r = rsqrtf(ss * (1.f / 64.f) + 1e-6f) * scl;
#pragma unroll
                    for (int bj = 0; bj < 2; ++bj) { const f32x4 v0 = acc[ai][bj][m][0] * r * gn[bj][0], v1 = acc[ai][bj][m][1] * r * gn[bj][1];
                        u32x4 w; w.x = pk2(v0[0], v0[1]); w.y = pk2(v0[2], v0[3]); w.z = pk2(v1[0], v1[1]); w.w = pk2(v1[2], v1[3]);
                        __builtin_nontemporal_store(w, (u32x4*)(rowp + 32 * bj)); } }
        }
    }
};
struct EpiSwiglu {
    static constexpr bool PERM = true;
    bf16_t* O;
    __device__ __forceinline__ void operator()(const f32x4 (&acc)[2][2][4][2], const Unit& u, int wr, int wc, int fr, int fq) const {
        const int row0 = u.pm * BM + wr * 64 + fr, col0 = u.pn * HALF + wc * 32 + 8 * fq;
#pragma unroll
        for (int ai = 0; ai < 2; ++ai)
#pragma unroll
            for (int m = 0; m < 4; ++m) { bf16_t* rowp = O + (size_t)(row0 + ai * HALF + m * 16) * FFH + col0;
                float r[8];
#pragma unroll
                for (int n = 0; n < 2; ++n)
#pragma unroll
                    for (int j = 0; j < 4; ++j) r[n * 4 + j] = silu_f(acc[ai][0][m][n][j]) * acc[ai][1][m][n][j];
                u32x4 w; w.x = pk2(r[0], r[1]); w.y = pk2(r[2], r[3]); w.z = pk2(r[4], r[5]); w.w = pk2(r[6], r[7]);
                __builtin_nontemporal_store(w, (u32x4*)rowp); }
    }
};
struct EpiGlu {
    static constexpr bool PERM = true;
    const bf16_t* Y; const float* bias; bf16_t* O;
    __device__ __forceinline__ void operator()(const f32x4 (&acc)[2][2][4][2], const Unit& u, int wr, int wc, int fr, int fq) const {
        const int row0 = u.pm * BM + wr * 64 + fr, col0 = u.pn * BM + wc * 32 + 8 * fq;
#pragma unroll
        for (int bj = 0; bj < 2; ++bj) {
            const int col = col0 + bj * HALF;
            const f32x4 b0 = *(const f32x4*)(bias + col), b1 = *(const f32x4*)(bias + col + 4);
            u32x4 yv[2][4];
#pragma unroll
            for (int ai = 0; ai < 2; ++ai)
#pragma unroll
                for (int m = 0; m < 4; ++m) yv[ai][m] = *(const u32x4*)(Y + (size_t)(row0 + ai * HALF + m * 16) * 512 + col);
#pragma unroll
            for (int ai = 0; ai < 2; ++ai)
#pragma unroll
                for (int m = 0; m < 4; ++m) { const size_t row = (size_t)(row0 + ai * HALF + m * 16);
                    const u32x4 y4 = yv[ai][m];
                    const f32x4 v0 = acc[ai][bj][m][0] + b0, v1 = acc[ai][bj][m][1] + b1;
                    float r[8];
                    r[0] = lo_f(y4.x) * sigm_f(v0[0]); r[1] = hi_f(y4.x) * sigm_f(v0[1]); r[2] = lo_f(y4.y) * sigm_f(v0[2]); r[3] = hi_f(y4.y) * sigm_f(v0[3]);
                    r[4] = lo_f(y4.z) * sigm_f(v1[0]); r[5] = hi_f(y4.z) * sigm_f(v1[1]); r[6] = lo_f(y4.w) * sigm_f(v1[2]); r[7] = hi_f(y4.w) * sigm_f(v1[3]);
                    u32x4 w; w.x = pk2(r[0], r[1]); w.y = pk2(r[2], r[3]); w.z = pk2(r[4], r[5]); w.w = pk2(r[6], r[7]);
                    __builtin_nontemporal_store(w, (u32x4*)(O + row * 1024 + 512 + col)); }
        }
    }
};
struct EpiResid {
    static constexpr bool PERM = false;
    const float* res; float* out; const float* gate;
    __device__ __forceinline__ void operator()(const f32x4 (&acc)[2][2][4][2], const Unit& u, int wr, int wc, int fr, int fq) const {
        const int row0 = u.pm * BM + wr * 64 + fr, col0 = u.pn * BM + wc * 32 + 4 * fq;
        const int bidx = (u.pm * BM) >> 12;
        f32x4 gv[2][2];
#pragma unroll
        for (int bj = 0; bj < 2; ++bj)
#pragma unroll
            for (int n = 0; n < 2; ++n) gv[bj][n] = *(const f32x4*)(gate + (size_t)bidx * 6144 + col0 + bj * HALF + n * 16);
        f32x4 rv[2][2][2][2];
#define EPR_LOAD(buf, q) do { _Pragma("unroll") for (int mm = 0; mm < 2; ++mm) _Pragma("unroll") for (int bj = 0; bj < 2; ++bj) _Pragma("unroll") for (int n = 0; n < 2; ++n) \
            rv[buf][mm][bj][n] = *(const f32x4*)(res + (size_t)(row0 + ((q) >> 1) * HALF + (((q) & 1) * 2 + mm) * 16) * 1024 + col0 + bj * HALF + n * 16); } while (0)
#define EPR_STORE(buf, q) do { _Pragma("unroll") for (int mm = 0; mm < 2; ++mm) _Pragma("unroll") for (int bj = 0; bj < 2; ++bj) _Pragma("unroll") for (int n = 0; n < 2; ++n) \
            __builtin_nontemporal_store(rv[buf][mm][bj][n] + gv[bj][n] * acc[(q) >> 1][bj][((q) & 1) * 2 + mm][n], (f32x4*)(out + (size_t)(row0 + ((q) >> 1) * HALF + (((q) & 1) * 2 + mm) * 16) * 1024 + col0 + bj * HALF + n * 16)); } while (0)
        EPR_LOAD(0, 0); EPR_LOAD(1, 1); EPR_STORE(0, 0); EPR_LOAD(0, 2); EPR_STORE(1, 1); EPR_LOAD(1, 3); EPR_STORE(0, 2); EPR_STORE(1, 3);
#undef EPR_LOAD
#undef EPR_STORE
    }
};
}

__device__ __forceinline__ int wt_src_col(int n, int mode) {
    if (mode == 1) { const int tt = n >> 8, r = n & 255; return r < 128 ? tt * 128 + r : FFH + tt * 128 + (r - 128); }
    if (mode == 2 && n < 1024) { const int lc = n & 255; return (n & ~255) + ((lc >> 5) & 3) * 64 + 32 * (lc >> 7) + (lc & 31); }
    return n;
}
__device__ __forceinline__ void transpose_cvt(LAS float* tile, const float* __restrict__ W, int K, int N, bf16_t* __restrict__ Wt, int mode) {
    const int tid = tid_opaque();
    const int tilesN = N / 64, tilesK = K / 64, ntl = tilesN * tilesK;
    float cur[8];
    if ((int)blockIdx.x < ntl) { const int tn = blockIdx.x % tilesN, tk = blockIdx.x / tilesN; const int nsrc = wt_src_col(tn * 64 + (tid & 63), mode);
#pragma unroll
        for (int r = 0; r < 8; ++r) cur[r] = W[(size_t)(tk * 64 + (tid >> 6) + 8 * r) * N + nsrc]; }
    for (int t = blockIdx.x; t < ntl; t += gridDim.x) {
        const int tn = t % tilesN, tk = t / tilesN;
        const int n0d = tn * 64, k0 = tk * 64;
#pragma unroll
        for (int r = 0; r < 8; ++r) { const int kk = (tid >> 6) + 8 * r; tile[kk * 65 + (tid & 63)] = cur[r]; }
        const int t2 = t + gridDim.x;
        if (t2 < ntl) { const int tn2 = t2 % tilesN, tk2 = t2 / tilesN; const int nsrc = wt_src_col(tn2 * 64 + (tid & 63), mode);
#pragma unroll
            for (int r = 0; r < 8; ++r) cur[r] = W[(size_t)(tk2 * 64 + (tid >> 6) + 8 * r) * N + nsrc]; }
        __syncthreads();
        { const int nn = tid >> 3, kc = (tid & 7) * 8; float v[8];
#pragma unroll
          for (int j = 0; j < 8; ++j) v[j] = tile[(kc + j) * 65 + nn];
          u32x4 w; w.x = pk2(v[0], v[1]); w.y = pk2(v[2], v[3]); w.z = pk2(v[4], v[5]); w.w = pk2(v[6], v[7]);
          *(u32x4*)(Wt + (size_t)(n0d + nn) * K + k0 + kc) = w; }
        __syncthreads();
    }
}

struct S5gp { float lrdt, lidt, fre, fim; };
__device__ __forceinline__ S5gp s5_gp(const Params& p, int g, int pp) {
    S5gp r; const float dt = expf(p.in[15][g]); const float lr = p.in[13][g * 64 + pp], li = p.in[14][g * 64 + pp];
    r.lrdt = lr * dt; r.lidt = li * dt;
    const float mag = expf(r.lrdt), are = mag * cosf(r.lidt), aim = mag * sinf(r.lidt), den = lr * lr + li * li;
    r.fre = ((are - 1.f) * lr + aim * li) / den; r.fim = (aim * lr - (are - 1.f) * li) / den;
    return r;
}
__device__ __forceinline__ f32x2 s5_apow(const S5gp& q, float n) { const float m = expf(n * q.lrdt), a = n * q.lidt; return (f32x2){m * cosf(a), m * sinf(a)}; }

__device__ __forceinline__ void prep_phase(const Params& p, LAS unsigned char* lds) {
    const int tid = tid_opaque();
    unsigned char* ws = p.ws;
    LAS float* tile = (LAS float*)lds;
    transpose_cvt(tile, p.in[8], 1024, 2048, (bf16_t*)(ws + WS_W_ABIN), 2);
    transpose_cvt(tile, p.in[9], 1024, 1024, (bf16_t*)(ws + WS_W_ABOUT), 0);
    transpose_cvt(tile, p.in[21], 512, 512, (bf16_t*)(ws + WS_W_GLU), 0);
    for (int l = 0; l < 2; ++l) {
        transpose_cvt(tile, p.in[6] + (size_t)l * 1024 * 5632, 1024, 5632, (bf16_t*)(ws + WS_W_FFIN) + (size_t)l * 5632 * 1024, 1);
        transpose_cvt(tile, p.in[7] + (size_t)l * FFH * 1024, FFH, 1024, (bf16_t*)(ws + WS_W_FFOUT) + (size_t)l * 1024 * FFH, 0);
    }
    transpose_cvt(tile, p.in[23], 1024, 3584, (bf16_t*)(ws + WS_W_CDIN), 0);
    transpose_cvt(tile, p.in[24], 1024, 1024, (bf16_t*)(ws + WS_W_CDOUT), 0);
    if (blockIdx.x < 192) {
        LAS float* sc = (LAS float*)lds; LAS float* red = (LAS float*)(lds + 65536);
        for (int idx = tid; idx < 16384; idx += NTHR) { const float v = p.in[1][idx]; sc[idx] = v / (1.f + expf(-v)); }
        __syncthreads();
        for (int item = blockIdx.x; item < 192; item += gridDim.x) {
            const int l = item / 96, cb = item % 96, cl = tid & 63, ksl = tid >> 6;
            float acc[16];
#pragma unroll
            for (int b = 0; b < 16; ++b) acc[b] = 0.f;
            const float* w = p.in[2] + (size_t)l * 1024 * 6144 + cb * 64 + cl;
            for (int k0 = ksl * 128; k0 < ksl * 128 + 128; k0 += 8) {
                float wv[8];
#pragma unroll
                for (int j = 0; j < 8; ++j) wv[j] = w[(size_t)(k0 + j) * 6144];
#pragma unroll
                for (int b = 0; b < 16; ++b) { const f32x4 s0 = *(const LAS f32x4*)(sc + b * 1024 + k0), s1 = *(const LAS f32x4*)(sc + b * 1024 + k0 + 4);
                    acc[b] += s0[0] * wv[0] + s0[1] * wv[1] + s0[2] * wv[2] + s0[3] * wv[3] + s1[0] * wv[4] + s1[1] * wv[5] + s1[2] * wv[6] + s1[3] * wv[7]; }
            }
#pragma unroll
            for (int b = 0; b < 16; ++b) red[(ksl * 16 + b) * 64 + cl] = acc[b];
            __syncthreads();
            for (int o = tid; o < 1024; o += NTHR) { const int b = o >> 6, cc = o & 63; float s = 0.f;
#pragma unroll
                for (int k8 = 0; k8 < 8; ++k8) s += red[(k8 * 16 + b) * 64 + cc];
                ((float*)(ws + WS_MOD))[(size_t)(l * 16 + b) * 6144 + cb * 64 + cc] = s + p.in[3][l * 6144 + cb * 64 + cc]; }
            __syncthreads();
        }
    }
    __syncthreads();
    const int gtid = blockIdx.x * NTHR + tid, nthr = gridDim.x * NTHR;
    for (int idx = gtid; idx < 4096 * 64; idx += nthr) { const int pos = idx >> 6, f = idx & 63;
        const float freq = powf(10000.f, -(float)f / 64.f), ang = (float)pos * freq;
        ((f32x2*)(ws + WS_ROPE))[idx] = (f32x2){cosf(ang), sinf(ang)}; }
    { bf16_t* Mt = (bf16_t*)(ws + WS_S5M); bf16_t* Gt = (bf16_t*)(ws + WS_S5G);
      for (int idx = gtid; idx < 32 * 64 * 64; idx += nthr) { const int g = idx >> 12, pp = (idx >> 6) & 63, s = idx & 63;
          const S5gp q = s5_gp(p, g, pp);
          { const f32x2 a = s5_apow(q, (float)(63 - s));
            unsigned wr_[8], wi_[8];
#pragma unroll
            for (int h2 = 0; h2 < 8; ++h2) { float vr[2], vi[2];
#pragma unroll
                for (int e = 0; e < 2; ++e) { const int h = h2 * 2 + e; const float br = p.in[16][(g * 64 + pp) * 16 + h], bi = p.in[17][(g * 64 + pp) * 16 + h];
                    const float bbr = q.fre * br - q.fim * bi, bbi = q.fre * bi + q.fim * br;
                    vr[e] = a.x * bbr - a.y * bbi; vi[e] = a.x * bbi + a.y * bbr; }
                wr_[h2] = pk2(vr[0], vr[1]); wi_[h2] = pk2(vi[0], vi[1]); }
            u32x4* dr = (u32x4*)(Mt + (size_t)(g * 128 + 2 * pp) * 1024 + s * 16); u32x4* di = (u32x4*)(Mt + (size_t)(g * 128 + 2 * pp + 1) * 1024 + s * 16);
            dr[0] = (u32x4){wr_[0], wr_[1], wr_[2], wr_[3]}; dr[1] = (u32x4){wr_[4], wr_[5], wr_[6], wr_[7]};
            di[0] = (u32x4){wi_[0], wi_[1], wi_[2], wi_[3]}; di[1] = (u32x4){wi_[4], wi_[5], wi_[6], wi_[7]}; }
          { const int t = s; const f32x2 a = s5_apow(q, (float)(t + 1));
#pragma unroll
            for (int h = 0; h < 16; ++h) { const float cr = p.in[18][(g * 16 + h) * 64 + pp], ci = p.in[19][(g * 16 + h) * 64 + pp];
                const float gr = cr * a.x - ci * a.y, gi = cr * a.y + ci * a.x;
                *(unsigned*)(Gt + (size_t)(g * 1024 + t * 16 + h) * 128 + 2 * pp) = pk2(gr, -gi); } }
          if (s == 0) ((f32x2*)(ws + WS_A64))[g * 64 + pp] = s5_apow(q, 64.f);
      }
      LAS f32x2* tp = (LAS f32x2*)lds;
      bf16_t* Kt = (bf16_t*)(ws + WS_KERN);
      for (int item = blockIdx.x; item < 32 * 64; item += gridDim.x) { const int g = item >> 6, tau = item & 63;
          if (tid < 64) { const S5gp q = s5_gp(p, g, tid); const f32x2 a = s5_apow(q, (float)tau); tp[tid] = (f32x2){a.x * q.fre - a.y * q.fim, a.x * q.fim + a.y * q.fre}; }
          __syncthreads();
          if (tid < 256) { const int h = tid >> 4, h2 = tid & 15; float acc = 0.f;
#pragma unroll 8
              for (int pp = 0; pp < 64; ++pp) { const f32x2 t = tp[pp]; const float cr = p.in[18][(g * 16 + h) * 64 + pp], ci = p.in[19][(g * 16 + h) * 64 + pp];
                  const float ur = cr * t.x - ci * t.y, ui = cr * t.y + ci * t.x;
                  acc += ur * p.in[16][(g * 64 + pp) * 16 + h2] - ui * p.in[17][(g * 64 + pp) * 16 + h2]; }
              Kt[(size_t)((g * 64 + tau) * 16 + h) * 16 + h2] = f2bf(acc); }
          __syncthreads();
      }
    }
}

__device__ __forceinline__ void norm_phase(const float* __restrict__ x, const float* __restrict__ gw, const float* __restrict__ shift, const float* __restrict__ scale, bf16_t* __restrict__ H) {
    const int tid = tid_opaque(); const int lane = tid & 63, wv = blockIdx.x * 8 + (tid >> 6), nw = gridDim.x * 8;
    constexpr int NR = 8;
    for (int row0 = wv * NR; row0 < MTOK; row0 += nw * NR) {
        const int b = row0 >> 12;
        f32x4 v[NR][4]; float ss[NR];
#pragma unroll
        for (int r = 0; r < NR; ++r)
#pragma unroll
            for (int c4 = 0; c4 < 4; ++c4) v[r][c4] = __builtin_nontemporal_load((const f32x4*)(x + (size_t)(row0 + r) * 1024 + c4 * 256 + lane * 4));
#pragma unroll
        for (int r = 0; r < NR; ++r) { float s = 0.f;
#pragma unroll
            for (int c4 = 0; c4 < 4; ++c4) s += v[r][c4][0] * v[r][c4][0] + v[r][c4][1] * v[r][c4][1] + v[r][c4][2] * v[r][c4][2] + v[r][c4][3] * v[r][c4][3];
            ss[r] = s; }
#pragma unroll
        for (int o = 1; o < 64; o <<= 1)
#pragma unroll
            for (int r = 0; r < NR; ++r) ss[r] += __shfl_xor(ss[r], o);
#pragma unroll
        for (int c4 = 0; c4 < 4; ++c4) { const int col = c4 * 256 + lane * 4;
            const f32x4 g = *(const f32x4*)(gw + col), sc = *(const f32x4*)(scale + (size_t)b * 6144 + col), sh = *(const f32x4*)(shift + (size_t)b * 6144 + col);
            const f32x4 gm = g * (sc + 1.f);
#pragma unroll
            for (int r = 0; r < NR; ++r) { const float rr = rsqrtf(ss[r] * (1.f / 1024.f) + 1e-6f);
                const f32x4 o = v[r][c4] * rr * gm + sh;
                *(u32x2*)(H + (size_t)(row0 + r) * 1024 + col) = (u32x2){pk2(o[0], o[1]), pk2(o[2], o[3])}; } }
    }
}

constexpr int VS = 72;
constexpr int VL_BYTES = 64 * VS * 2;

__device__ __forceinline__ void s5a_phase(const Params& p);
__device__ __forceinline__ void attnA_phase(const Params& p, LAS unsigned char* lds) {
    const int tid = tid_opaque(), wid = __builtin_amdgcn_readfirstlane(tid >> 6), lane = tid & 63, li = lane & 15, g4 = lane >> 4;
    const bf16_t* QKV = (const bf16_t*)(p.ws + WS_R1);
    bf16_t* MIX = (bf16_t*)(p.ws + WS_MIX);
    LAS bf16_t* Vl = (LAS bf16_t*)(lds + wid * VL_BYTES);
    LAS float* bl = (LAS float*)(lds + 8 * VL_BYTES);
    for (int idx = tid; idx < 8 * 257; idx += NTHR) bl[(idx / 257) * 260 + (idx % 257)] = (p.in[12][idx] - p.in[12][(idx / 257) * 257 + 256]) * 1.4426950408889634f;
    __syncthreads();
    if (wid >= 4) s5a_phase(p);
    const int h = wid;
    LAS float* bh = bl + h * 260;
    const int vrow = lane >> 3, vc8 = (lane & 7) * 8;
    for (int item2 = vblock(); item2 < 2048; item2 += gridDim.x) {
        const int kq = item2 >> 8, rq = item2 & 255, qh = rq & 1;
        const int b = 2 * kq + (rq >> 7), ci = (((rq >> 1) & 63) + 9 * kq) & 63;
        const size_t rowbase = (size_t)b * SEQ + ci * 64 + qh * 32;
        bf16x8 qf[2][2];
#pragma unroll
        for (int qt = 0; qt < 2; ++qt)
#pragma unroll
            for (int ks = 0; ks < 2; ++ks) qf[qt][ks] = *(const bf16x8*)(QKV + (rowbase + qt * 16 + li) * 2048 + h * 64 + 32 * ks + 8 * g4);
        f32x4 o[4][2]; float mrun[2], lsum[2];
#pragma unroll
        for (int qt = 0; qt < 2; ++qt) { mrun[qt] = -1e30f; lsum[qt] = 0.f;
#pragma unroll
            for (int dt = 0; dt < 4; ++dt) o[dt][qt] = (f32x4){0.f, 0.f, 0.f, 0.f}; }
        const int kb0 = ci >= 8 ? 0 : 8 - ci;
        bf16x8 kf[4][2]; u32x4 vr[8];
        { const bf16_t* kbase = QKV + ((size_t)b * SEQ + (size_t)(ci - 8 + kb0) * 64) * 2048 + h * 64;
#pragma unroll
          for (int kt = 0; kt < 4; ++kt)
#pragma unroll
              for (int ks = 0; ks < 2; ++ks) kf[kt][ks] = *(const bf16x8*)(kbase + (size_t)(kt * 16 + li) * 2048 + 512 + 32 * ks + 8 * g4);
#pragma unroll
          for (int r = 0; r < 8; ++r) vr[r] = *(const u32x4*)(kbase + (size_t)(r * 8 + vrow) * 2048 + 1024 + vc8);
          wave_lds_fence();
#pragma unroll
          for (int r = 0; r < 8; ++r) *(LAS u32x4*)(Vl + (r * 8 + vrow) * VS + vc8) = vr[r];
          wave_lds_fence(); }
        for (int kb = kb0; kb <= 8; ++kb) {
            f32x4 s[4][2];
            __builtin_amdgcn_s_setprio(1);
#pragma unroll
            for (int kt = 0; kt < 4; ++kt)
#pragma unroll
                for (int qt = 0; qt < 2; ++qt) { f32x4 z = (f32x4){0.f, 0.f, 0.f, 0.f}; z = mfma16(kf[kt][0], qf[qt][0], z); z = mfma16(kf[kt][1], qf[qt][1], z); s[kt][qt] = z; }
            __builtin_amdgcn_s_setprio(0);
            const bool more = kb < 8;
            if (more) {
                const bf16_t* kbase = QKV + ((size_t)b * SEQ + (size_t)(ci - 8 + kb + 1) * 64) * 2048 + h * 64;
#pragma unroll
                for (int kt = 0; kt < 4; ++kt)
#pragma unroll
                    for (int ks = 0; ks < 2; ++ks) kf[kt][ks] = *(const bf16x8*)(kbase + (size_t)(kt * 16 + li) * 2048 + 512 + 32 * ks + 8 * g4);
#pragma unroll
                for (int r = 0; r < 8; ++r) vr[r] = *(const u32x4*)(kbase + (size_t)(r * 8 + vrow) * 2048 + 1024 + vc8);
            }
            const bool nearb = kb >= 6;
            bf16x8 pfr[2][2];
#pragma unroll
            for (int qt = 0; qt < 2; ++qt) {
                float mx = -1e30f;
                if (nearb) {
#pragma unroll
                    for (int kt = 0; kt < 4; ++kt)
#pragma unroll
                        for (int jj = 0; jj < 4; ++jj) { int rel = 512 + qh * 32 + qt * 16 + li - kb * 64 - (kt * 16 + 4 * g4 + jj); rel = rel > 128 ? 128 : (rel < -128 ? -128 : rel);
                            const float v = s[kt][qt][jj] + bh[rel + 128]; s[kt][qt][jj] = v; mx = fmaxf(mx, v); }
                } else {
#pragma unroll
                    for (int kt = 0; kt < 4; ++kt)
#pragma unroll
                        for (int jj = 0; jj < 4; ++jj) mx = fmaxf(mx, s[kt][qt][jj]);
                }
                mx = fmaxf(mx, __shfl_xor(mx, 16)); mx = fmaxf(mx, __shfl_xor(mx, 32));
                const float mnew = fmaxf(mrun[qt], mx), alpha = __builtin_amdgcn_exp2f(mrun[qt] - mnew);
                mrun[qt] = mnew; float ps = 0.f;
#pragma unroll
                for (int kt = 0; kt < 4; ++kt)
#pragma unroll
                    for (int jj = 0; jj < 4; ++jj) { const float e = __builtin_amdgcn_exp2f(s[kt][qt][jj] - mnew); s[kt][qt][jj] = e; ps += e; }
                lsum[qt] = lsum[qt] * alpha + ps;
#pragma unroll
                for (int dt = 0; dt < 4; ++dt) o[dt][qt] *= alpha;
#pragma unroll
                for (int kk = 0; kk < 2; ++kk) { u32x4 w; w.x = pk2(s[2 * kk][qt][0], s[2 * kk][qt][1]); w.y = pk2(s[2 * kk][qt][2], s[2 * kk][qt][3]);
                    w.z = pk2(s[2 * kk + 1][qt][0], s[2 * kk + 1][qt][1]); w.w = pk2(s[2 * kk + 1][qt][2], s[2 * kk + 1][qt][3]); pfr[qt][kk] = as_frag(w); }
            }
            { bf16x8 vf[2][4];
#pragma unroll
              for (int kk = 0; kk < 2; ++kk)
#pragma unroll
                  for (int dt = 0; dt < 4; ++dt) vf[kk][dt] = tr_pair(Vl, VS, 32 * kk + 4 * g4, 32 * kk + 16 + 4 * g4, dt * 16, li);
#pragma unroll
              for (int kk = 0; kk < 2; ++kk)
#pragma unroll
                  for (int dt = 0; dt < 4; ++dt)
#pragma unroll
                      for (int qt = 0; qt < 2; ++qt) o[dt][qt] = mfma16(vf[kk][dt], pfr[qt][kk], o[dt][qt]); }
            wave_lds_fence();
            if (more) {
#pragma unroll
                for (int r = 0; r < 8; ++r) *(LAS u32x4*)(Vl + (r * 8 + vrow) * VS + vc8) = vr[r];
                wave_lds_fence();
            }
        }
#pragma unroll
        for (int qt = 0; qt < 2; ++qt) { float l = lsum[qt]; l += __shfl_xor(l, 16); l += __shfl_xor(l, 32); const float inv = 1.f / l;
#pragma unroll
            for (int dt = 0; dt < 4; ++dt) { const f32x4 v = o[dt][qt] * inv;
                *(u32x2*)(MIX + (rowbase + qt * 16 + li) * 1024 + h * 64 + dt * 16 + 4 * g4) = (u32x2){pk2(v[0], v[1]), pk2(v[2], v[3])}; } }
    }
    if (wid < 4) s5a_phase(p);
}

__device__ __forceinline__ void s5a_phase(const Params& p) {
    const int tid = tid_opaque(); const int lane = tid & 63, li = lane & 15, g4 = lane >> 4;
    const bf16_t* QKV = (const bf16_t*)(p.ws + WS_R1);
    const bf16_t* Mt = (const bf16_t*)(p.ws + WS_S5M);
    float* E = (float*)(p.ws + WS_S5E);
    const int wv = blockIdx.x * 8 + (tid >> 6), nw = gridDim.x * 8;
    for (int item = wv; item < 2048; item += nw) {
        const int g = item & 31, c = item >> 5;
        f32x4 acc[8];
#pragma unroll
        for (int pt = 0; pt < 8; ++pt) acc[pt] = (f32x4){0.f, 0.f, 0.f, 0.f};
        const bf16_t* ub = QKV + ((size_t)li * SEQ + c * 64 + (g4 >> 1)) * 2048 + 1536 + g * 16 + 8 * (g4 & 1);
        const bf16_t* mb = Mt + (size_t)(g * 128 + li) * 1024 + 8 * g4;
#pragma unroll 4
        for (int ks = 0; ks < 32; ++ks) {
            const bf16x8 bfr = *(const bf16x8*)(ub + (size_t)(2 * ks) * 2048);
#pragma unroll
            for (int pt = 0; pt < 8; ++pt) { const bf16x8 afr = *(const bf16x8*)(mb + (size_t)pt * 16 * 1024 + 32 * ks); acc[pt] = mfma16(afr, bfr, acc[pt]); }
        }
#pragma unroll
        for (int pt = 0; pt < 8; ++pt) *(f32x4*)(E + ((size_t)(c * 32 + g) * 16 + li) * 128 + pt * 16 + 4 * g4) = acc[pt];
    }
}
__device__ __forceinline__ void s5scan_phase(const Params& p) {
    const float* E = (const float*)(p.ws + WS_S5E);
    bf16_t* X = (bf16_t*)(p.ws + WS_S5X);
    const f32x2* A64 = (const f32x2*)(p.ws + WS_A64);
    const int gtid = blockIdx.x * NTHR + tid_opaque();
    if (gtid < 32 * 16 * 64) {
        const int pp = gtid & 63, b = (gtid >> 6) & 15, g = gtid >> 10;
        const f32x2 a = A64[g * 64 + pp];
        float xr = 0.f, xi = 0.f;
        for (int c0 = 0; c0 < 64; c0 += 8) {
            f32x2 e[8];
#pragma unroll
            for (int k = 0; k < 8; ++k) e[k] = *(const f32x2*)(E + ((size_t)((c0 + k) * 32 + g) * 16 + b) * 128 + 2 * pp);
#pragma unroll
            for (int k = 0; k < 8; ++k) {
                *(unsigned*)(X + ((size_t)((c0 + k) * 32 + g) * 16 + b) * 128 + 2 * pp) = pk2(xr, xi);
                const float nr = a.x * xr - a.y * xi + e[k].x, ni = a.x * xi + a.y * xr + e[k].y; xr = nr; xi = ni; }
        }
    }
}
__device__ __forceinline__ int s5c_item(int vb, int k) {
    if (gridDim.x != 256) return vb + k * (int)gridDim.x;
    const int x = vb >> 5, l = vb & 31; const int g = 8 * (x & 3) + (l & 7), c = 8 * k + 4 * (x >> 2) + (l >> 3);
    return c * 32 + g;
}
__device__ __forceinline__ void s5c_phase(const Params& p, LAS unsigned char* lds) {
    const int tid = tid_opaque(), wid = __builtin_amdgcn_readfirstlane(tid >> 6), lane = tid & 63, li = lane & 15, g4 = lane >> 4;
    const bf16_t* QKV = (const bf16_t*)(p.ws + WS_R1);
    const bf16_t* Kt = (const bf16_t*)(p.ws + WS_KERN);
    const bf16_t* Gt = (const bf16_t*)(p.ws + WS_S5G);
    const bf16_t* X = (const bf16_t*)(p.ws + WS_S5X);
    bf16_t* Y5 = (bf16_t*)(p.ws + WS_Y5);
    LAS bf16_t* kl = (LAS bf16_t*)lds;
    LAS bf16_t* ul = (LAS bf16_t*)(lds + 32768);
    int gl = -1;
    bf16x8 gf[8][4];
    u32x4 ur[4];
    const int vb = vblock(), nrounds = (2048 + (int)gridDim.x - 1) / (int)gridDim.x;
    { const int item = s5c_item(vb, 0); if (item < 2048) { const int g = item & 31, c = item >> 5;
#pragma unroll
        for (int q = 0; q < 4; ++q) { const int idx = tid + q * NTHR, hh = idx & 1, b = (idx >> 1) & 15, sq = idx >> 5;
            ur[q] = *(const u32x4*)(QKV + ((size_t)b * SEQ + c * 64 + sq) * 2048 + 1536 + g * 16 + hh * 8); } } }
    for (int rk = 0; rk < nrounds; ++rk) {
        const int item = s5c_item(vb, rk); if (item >= 2048) break;
        const int g = item & 31, c = item >> 5;
        __syncthreads();
        if (g != gl) { for (int idx = tid; idx < 2048; idx += NTHR) *(LAS u32x4*)(kl + idx * 8) = *(const u32x4*)(Kt + (size_t)g * 16384 + idx * 8); gl = g;
#pragma unroll
            for (int tt = 0; tt < 8; ++tt)
#pragma unroll
                for (int ks = 0; ks < 4; ++ks) gf[tt][ks] = *(const bf16x8*)(Gt + (size_t)(g * 1024 + (wid + 8 * tt) * 16 + li) * 128 + 32 * ks + 8 * g4); }
#pragma unroll
        for (int q = 0; q < 4; ++q) { const int idx = tid + q * NTHR, hh = idx & 1, b = (idx >> 1) & 15, sq = idx >> 5;
            *(LAS u32x4*)(ul + (sq * 16 + b) * 16 + hh * 8) = ur[q]; }
        { const int nx = (rk + 1 < nrounds) ? s5c_item(vb, rk + 1) : 2048; if (nx < 2048) { const int g2 = nx & 31, c2 = nx >> 5;
#pragma unroll
            for (int q = 0; q < 4; ++q) { const int idx = tid + q * NTHR, hh = idx & 1, b = (idx >> 1) & 15, sq = idx >> 5;
                ur[q] = *(const u32x4*)(QKV + ((size_t)b * SEQ + c2 * 64 + sq) * 2048 + 1536 + g2 * 16 + hh * 8); } } }
        bf16x8 xf[4];
#pragma unroll
        for (int ks = 0; ks < 4; ++ks) xf[ks] = *(const bf16x8*)(X + ((size_t)(c * 32 + g) * 16 + li) * 128 + 32 * ks + 8 * g4);
        __syncthreads();
        const f32x4 dsk = *(const f32x4*)(p.in[20] + g * 16 + 4 * g4);
#pragma unroll
        for (int tt = 0; tt < 8; ++tt) {
            const int t = wid + 8 * tt;
            f32x4 acc = (f32x4){0.f, 0.f, 0.f, 0.f};
#pragma unroll
            for (int ks = 0; ks < 4; ++ks) acc = mfma16(gf[tt][ks], xf[ks], acc);
            const int nks = ((t >> 1) + 2) & ~1;
            for (int ks0 = 0; ks0 < nks; ks0 += 2) {
                u32x4 av[2]; bf16x8 bv[2];
#pragma unroll
                for (int q = 0; q < 2; ++q) { const int s = 2 * (ks0 + q) + (g4 >> 1); int tau = t - s; const bool ok = tau >= 0; tau = ok ? tau : 0;
                    av[q] = *(const LAS u32x4*)(kl + (tau * 16 + li) * 16 + 8 * (g4 & 1));
                    if (!ok) av[q] = (u32x4){0u, 0u, 0u, 0u};
                    bv[q] = *(const LAS bf16x8*)(ul + (s * 16 + li) * 16 + 8 * (g4 & 1)); }
#pragma unroll
                for (int q = 0; q < 2; ++q) acc = mfma16(as_frag(av[q]), bv[q], acc);
            }
            const u32x2 uu = *(const LAS u32x2*)(ul + (t * 16 + li) * 16 + 4 * g4);
            float y0 = acc[0] + dsk[0] * lo_f(uu.x), y1 = acc[1] + dsk[1] * hi_f(uu.x), y2 = acc[2] + dsk[2] * lo_f(uu.y), y3 = acc[3] + dsk[3] * hi_f(uu.y);
            y0 = gelu_tanh(y0); y1 = gelu_tanh(y1); y2 = gelu_tanh(y2); y3 = gelu_tanh(y3);
            *(u32x2*)(Y5 + ((size_t)li * SEQ + c * 64 + t) * 512 + g * 16 + 4 * g4) = (u32x2){pk2(y0, y1), pk2(y2, y3)};
        }
    }
}

#ifndef SB_EARLY_EXIT
#define SB_EARLY_EXIT 1
#endif
template <bool MASKED>
__device__ __forceinline__ void sb_qtile(const bf16x8 (&kf)[4][2], const bf16x8 (&qf)[2], float& R, bf16x8 (&pfr)[2], int li, int g4, int kpos0, int qpos, u32x2 dpat) {
    const unsigned ONES = 0x3F803F80u;
    const float SC = 0.125f * 1.4426950408889634f;
    f32x4 z[4];
#pragma unroll
    for (int kt = 0; kt < 4; ++kt) { f32x4 a = (f32x4){0.f, 0.f, 0.f, 0.f}; a = mfma16(kf[kt][0], qf[0], a); a = mfma16(kf[kt][1], qf[1], a); z[kt] = a; }
    float T = 0.f; unsigned hi[4][2];
#pragma unroll
    for (int kt = 0; kt < 4; ++kt) { float Lv[4];
#pragma unroll
        for (int jj = 0; jj < 4; ++jj) { const float zz = z[kt][jj] * SC;
            const float sp = fmaxf(zz, 0.f) + __builtin_amdgcn_logf(1.f + __builtin_amdgcn_exp2f(-fabsf(zz)));
            if (MASKED) { const bool valid = kpos0 + kt * 16 + jj < qpos; Lv[jj] = valid ? -sp : 0.f; z[kt][jj] = valid ? (zz - sp) : -1e30f; }
            else { Lv[jj] = -sp; z[kt][jj] = zz - sp; }
            T += Lv[jj]; }
        hi[kt][0] = pk2(Lv[0], Lv[1]); hi[kt][1] = pk2(Lv[2], Lv[3]); }
    T += __shfl_xor(T, 16); T += __shfl_xor(T, 32);
    bf16x8 Lh[2];
#pragma unroll
    for (int kk = 0; kk < 2; ++kk) Lh[kk] = as_frag((u32x4){hi[2 * kk][0], hi[2 * kk][1], hi[2 * kk + 1][0], hi[2 * kk + 1][1]});
    unsigned pw[4][2];
#pragma unroll
    for (int st = 0; st < 4; ++st) { f32x4 ce = (f32x4){0.f, 0.f, 0.f, 0.f};
#pragma unroll
        for (int kk = 0; kk < 2; ++kk) { if (2 * kk + 1 >= st) {
            u32x4 ua;
            { const int k0 = 2 * kk, k1 = 2 * kk + 1;
              ua.x = k0 > st ? ONES : (k0 == st ? dpat.x : 0u); ua.y = k0 > st ? ONES : (k0 == st ? dpat.y : 0u);
              ua.z = k1 > st ? ONES : (k1 == st ? dpat.x : 0u); ua.w = k1 > st ? ONES : (k1 == st ? dpat.y : 0u); }
            ce = mfma16(as_frag(ua), Lh[kk], ce); } }
        float w[4];
#pragma unroll
        for (int jj = 0; jj < 4; ++jj) w[jj] = __builtin_amdgcn_exp2f(z[st][jj] + R + ce[jj]);
        pw[st][0] = pk2(w[0], w[1]); pw[st][1] = pk2(w[2], w[3]); }
    R += T;
#pragma unroll
    for (int kk = 0; kk < 2; ++kk) pfr[kk] = as_frag((u32x4){pw[2 * kk][0], pw[2 * kk][1], pw[2 * kk + 1][0], pw[2 * kk + 1][1]});
}
__device__ __forceinline__ void sb_phase(const Params& p, LAS unsigned char* lds) {
    const int tid = tid_opaque(), wid = __builtin_amdgcn_readfirstlane(tid >> 6), lane = tid & 63, li = lane & 15, g4 = lane >> 4;
    const bf16_t* QKV = (const bf16_t*)(p.ws + WS_R1);
    bf16_t* MIX = (bf16_t*)(p.ws + WS_MIX);
    LAS bf16_t* Vl = (LAS bf16_t*)(lds + wid * VL_BYTES);
    const int wv = blockIdx.x * 8 + wid, nw = gridDim.x * 8;
    u32x2 dpat; dpat.x = ((4 * g4 + 0 > li) ? 0x3F80u : 0u) | ((4 * g4 + 1 > li) ? 0x3F800000u : 0u); dpat.y = ((4 * g4 + 2 > li) ? 0x3F80u : 0u) | ((4 * g4 + 3 > li) ? 0x3F800000u : 0u);
    for (int it = wv; it < 8192; it += nw) {
        const int bh = it >> 6, pr = it & 63, b = bh >> 3, h = bh & 7;
        for (int half = 0; half < 2; ++half) {
            const int qtile = half ? 127 - pr : pr, t0 = qtile * 32, kbd = t0 >> 6;
            const bf16_t* qb = QKV + ((size_t)b * SEQ + t0) * 3584 + 2048 + h * 64;
            bf16x8 qf[2][2];
#pragma unroll
            for (int qt = 0; qt < 2; ++qt)
#pragma unroll
                for (int ks = 0; ks < 2; ++ks) qf[qt][ks] = *(const bf16x8*)(qb + (size_t)(qt * 16 + li) * 3584 + 32 * ks + 8 * g4);
            f32x4 o[2][4]; float R[2];
#pragma unroll
            for (int qt = 0; qt < 2; ++qt) { R[qt] = 0.f;
#pragma unroll
                for (int dt = 0; dt < 4; ++dt) o[qt][dt] = (f32x4){0.f, 0.f, 0.f, 0.f}; }
            for (int kb = kbd; kb >= 0; --kb) {
                const bf16_t* kbase = QKV + ((size_t)b * SEQ + kb * 64) * 3584 + 2560 + h * 64;
#pragma unroll
                for (int r = 0; r < 8; ++r) { const int row = r * 8 + (lane >> 3), c8 = lane & 7;
                    *(LAS u32x4*)(Vl + row * VS + c8 * 8) = *(const u32x4*)(kbase + (size_t)row * 3584 + 512 + c8 * 8); }
                bf16x8 kf[4][2];
#pragma unroll
                for (int kt = 0; kt < 4; ++kt)
#pragma unroll
                    for (int ks = 0; ks < 2; ++ks) kf[kt][ks] = *(const bf16x8*)(kbase + (size_t)(kt * 16 + li) * 3584 + 32 * ks + 8 * g4);
                wave_lds_fence();
                const int kpos0 = kb * 64 + 4 * g4;
                bf16x8 pfr[2][2];
                if (kb == kbd) {
#pragma unroll
                    for (int qt = 0; qt < 2; ++qt) sb_qtile<true>(kf, qf[qt], R[qt], pfr[qt], li, g4, kpos0, t0 + qt * 16 + li, dpat);
                } else {
#pragma unroll
                    for (int qt = 0; qt < 2; ++qt) sb_qtile<false>(kf, qf[qt], R[qt], pfr[qt], li, g4, kpos0, t0 + qt * 16 + li, dpat);
                }
                { bf16x8 vf[2][4];
#pragma unroll
                  for (int kk = 0; kk < 2; ++kk)
#pragma unroll
                      for (int dt = 0; dt < 4; ++dt) vf[kk][dt] = tr_pair(Vl, VS, 32 * kk + 4 * g4, 32 * kk + 16 + 4 * g4, dt * 16, li);
#pragma unroll
                  for (int kk = 0; kk < 2; ++kk)
#pragma unroll
                      for (int dt = 0; dt < 4; ++dt)
#pragma unroll
                          for (int qt = 0; qt < 2; ++qt) o[qt][dt] = mfma16(vf[kk][dt], pfr[qt][kk], o[qt][dt]); }
                wave_lds_fence();
#if SB_EARLY_EXIT
                { const float rm = fmaxf(R[0], R[1]); if (__all(rm < -152.f)) break; }
#endif
            }
#pragma unroll
            for (int qt = 0; qt < 2; ++qt)
#pragma unroll
                for (int dt = 0; dt < 4; ++dt) { const f32x4 v = o[qt][dt];
                    *(u32x2*)(MIX + ((size_t)b * SEQ + t0 + qt * 16 + li) * 1024 + 512 + h * 64 + dt * 16 + 4 * g4) = (u32x2){pk2(v[0], v[1]), pk2(v[2], v[3])}; }
        }
    }
}

constexpr int RS = 136;
__device__ __forceinline__ float ret_log_gamma(int h) { return logf(1.f - exp2f(-5.f - (float)h)); }
struct RotRegs { u32x4 a, b; };
struct RopeRegs { f32x2 cs[8]; };
struct PlainRegs { u32x4 a, b; };
__device__ __forceinline__ void rot_ld(RotRegs& r, const bf16_t* src  , int j, int part) { r.a = *(const u32x4*)(src + (size_t)j * 3584 + part * 8); r.b = *(const u32x4*)(src + (size_t)j * 3584 + 64 + part * 8); }
__device__ __forceinline__ void rope_ld(RopeRegs& r, const f32x2* rope, int pos, int part) {
#pragma unroll
    for (int e = 0; e < 8; ++e) r.cs[e] = rope[(size_t)pos * 64 + part * 8 + e]; }
__device__ __forceinline__ void plain_ld(PlainRegs& r, const bf16_t* src, int j, int part) { r.a = *(const u32x4*)(src + (size_t)j * 3584 + part * 16); r.b = *(const u32x4*)(src + (size_t)j * 3584 + part * 16 + 8); }
__device__ __forceinline__ void rot_st(const RotRegs& r, const RopeRegs& c, LAS bf16_t* dst, int j, int part, float rsc) {
    const float x1[8] = {lo_f(r.a.x), hi_f(r.a.x), lo_f(r.a.y), hi_f(r.a.y), lo_f(r.a.z), hi_f(r.a.z), lo_f(r.a.w), hi_f(r.a.w)};
    const float x2[8] = {lo_f(r.b.x), hi_f(r.b.x), lo_f(r.b.y), hi_f(r.b.y), lo_f(r.b.z), hi_f(r.b.z), lo_f(r.b.w), hi_f(r.b.w)};
    float o1[8], o2[8];
#pragma unroll
    for (int e = 0; e < 8; ++e) { const f32x2 cc = c.cs[e]; o1[e] = (x1[e] * cc.x - x2[e] * cc.y) * rsc; o2[e] = (x1[e] * cc.y + x2[e] * cc.x) * rsc; }
    *(LAS u32x4*)(dst + j * RS + part * 8) = (u32x4){pk2(o1[0], o1[1]), pk2(o1[2], o1[3]), pk2(o1[4], o1[5]), pk2(o1[6], o1[7])};
    *(LAS u32x4*)(dst + j * RS + 64 + part * 8) = (u32x4){pk2(o2[0], o2[1]), pk2(o2[2], o2[3]), pk2(o2[4], o2[5]), pk2(o2[6], o2[7])};
}
__device__ __forceinline__ void plain_st(const PlainRegs& r, LAS bf16_t* dst, int j, int part) { *(LAS u32x4*)(dst + j * RS + part * 16) = r.a; *(LAS u32x4*)(dst + j * RS + part * 16 + 8) = r.b; }

__device__ __forceinline__ void reta_phase(const Params& p, LAS unsigned char* lds) {
    const int tid = tid_opaque(), wid = __builtin_amdgcn_readfirstlane(tid >> 6), lane = tid & 63, li = lane & 15, g4 = lane >> 4;
    const int j = tid >> 3, part = tid & 7;
    const bf16_t* QKV = (const bf16_t*)(p.ws + WS_R1);
    const f32x2* rope = (const f32x2*)(p.ws + WS_ROPE);
    bf16_t* RET = (bf16_t*)(p.ws + WS_H);
    LAS bf16_t* Kl = (LAS bf16_t*)lds; LAS bf16_t* Vl = (LAS bf16_t*)(lds + 64 * RS * 2);
    RotRegs kr; RopeRegs cr; PlainRegs vr;
    { const int item = blockIdx.x; if (item < 4096) { const int c = item & 63, hh = (item >> 6) & 3, b = item >> 8; const bf16_t* base = QKV + ((size_t)b * SEQ + c * 64) * 3584 + hh * 128;
        rot_ld(kr, base + 512, j, part); rope_ld(cr, rope, c * 64 + j, part); plain_ld(vr, base + 1024, j, part); } }
    for (int item = blockIdx.x; item < 4096; item += gridDim.x) {
        const int c = item & 63, hh = (item >> 6) & 3, b = item >> 8;
        const float lg = ret_log_gamma(hh);
        __syncthreads();
        rot_st(kr, cr, Kl, j, part, 0.08838834764831845f * __expf(lg * (63.f - (float)j)));
        plain_st(vr, Vl, j, part);
        { const int nx = item + gridDim.x; if (nx < 4096) { const int c2 = nx & 63, h2 = (nx >> 6) & 3, b2 = nx >> 8; const bf16_t* base = QKV + ((size_t)b2 * SEQ + c2 * 64) * 3584 + h2 * 128;
            rot_ld(kr, base + 512, j, part); rope_ld(cr, rope, c2 * 64 + j, part); plain_ld(vr, base + 1024, j, part); } }
        __syncthreads();
        f32x4 acc[8];
#pragma unroll
        for (int et = 0; et < 8; ++et) acc[et] = (f32x4){0.f, 0.f, 0.f, 0.f};
#pragma unroll
        for (int kk = 0; kk < 2; ++kk) { const bf16x8 af = tr_pair(Kl, RS, 32 * kk + 8 * g4, 32 * kk + 8 * g4 + 4, wid * 16, li);
#pragma unroll
            for (int et = 0; et < 8; ++et) { const bf16x8 bfr = tr_pair(Vl, RS, 32 * kk + 8 * g4, 32 * kk + 8 * g4 + 4, et * 16, li); acc[et] = mfma16(af, bfr, acc[et]); } }
        const size_t sid = (size_t)((b * 4 + hh) * 64 + c);
#pragma unroll
        for (int et = 0; et < 8; ++et) *(u32x2*)(RET + (sid * 128 + et * 16 + li) * 128 + wid * 16 + 4 * g4) = (u32x2){pk2(acc[et][0], acc[et][1]), pk2(acc[et][2], acc[et][3])};
    }
}
__device__ __forceinline__ void retscan_phase(const Params& p) {
    bf16_t* RET = (bf16_t*)(p.ws + WS_H);
    const int gtid = blockIdx.x * NTHR + tid_opaque(), nthr = gridDim.x * NTHR;
    for (int w = gtid; w < 64 * 2048; w += nthr) {
        const int bhh = w >> 11, e8 = w & 2047, hh = bhh & 3;
        const float cd = __expf(64.f * ret_log_gamma(hh));
        float S[8];
#pragma unroll
        for (int e = 0; e < 8; ++e) S[e] = 0.f;
        bf16_t* base = RET + (size_t)bhh * 64 * 16384 + e8 * 8;
        for (int c0 = 0; c0 < 64; c0 += 4) {
            u32x4 kv[4];
#pragma unroll
            for (int k = 0; k < 4; ++k) kv[k] = *(const u32x4*)(base + (size_t)(c0 + k) * 16384);
#pragma unroll
            for (int k = 0; k < 4; ++k) {
                *(u32x4*)(base + (size_t)(c0 + k) * 16384) = (u32x4){pk2(S[0], S[1]), pk2(S[2], S[3]), pk2(S[4], S[5]), pk2(S[6], S[7])};
                S[0] = S[0] * cd + lo_f(kv[k].x); S[1] = S[1] * cd + hi_f(kv[k].x); S[2] = S[2] * cd + lo_f(kv[k].y); S[3] = S[3] * cd + hi_f(kv[k].y);
                S[4] = S[4] * cd + lo_f(kv[k].z); S[5] = S[5] * cd + hi_f(kv[k].z); S[6] = S[6] * cd + lo_f(kv[k].w); S[7] = S[7] * cd + hi_f(kv[k].w); }
        }
    }
}
__device__ __forceinline__ void retc_phase(const Params& p, LAS unsigned char* lds) {
    const int tid = tid_opaque(), wid = __builtin_amdgcn_readfirstlane(tid >> 6), lane = tid & 63, li = lane & 15, g4 = lane >> 4;
    const bf16_t* QKV = (const bf16_t*)(p.ws + WS_R1);
    const f32x2* rope = (const f32x2*)(p.ws + WS_ROPE);
    const bf16_t* RET = (const bf16_t*)(p.ws + WS_H);
    bf16_t* MIX = (bf16_t*)(p.ws + WS_MIX);
    LAS bf16_t* Ql = (LAS bf16_t*)lds; LAS bf16_t* Kl = (LAS bf16_t*)(lds + 17408); LAS bf16_t* Vl = (LAS bf16_t*)(lds + 34816);
    LAS bf16_t* Sl = (LAS bf16_t*)(lds + 52224);
    LAS f32x2* stl = (LAS f32x2*)(lds + 61440);
    const int j = tid >> 3, part = tid & 7;
    RotRegs qr, kr; RopeRegs cr; PlainRegs vr;
    { const int item = blockIdx.x; if (item < 4096) { const int c = item & 63, hh = (item >> 6) & 3, b = item >> 8; const bf16_t* base = QKV + ((size_t)b * SEQ + c * 64) * 3584 + hh * 128;
        rot_ld(qr, base, j, part); rot_ld(kr, base + 512, j, part); rope_ld(cr, rope, c * 64 + j, part); plain_ld(vr, base + 1024, j, part); } }
    for (int item = blockIdx.x; item < 4096; item += gridDim.x) {
        const int c = item & 63, hh = (item >> 6) & 3, b = item >> 8;
        const float lg = ret_log_gamma(hh);
        const size_t row0 = (size_t)b * SEQ + c * 64;
        const size_t sid = (size_t)((b * 4 + hh) * 64 + c);
        bf16x8 stf[4]; u32x2 gg[4];
#pragma unroll
        for (int ks = 0; ks < 4; ++ks) stf[ks] = *(const bf16x8*)(RET + (sid * 128 + wid * 16 + li) * 128 + 32 * ks + 8 * g4);
#pragma unroll
        for (int itq = 0; itq < 4; ++itq) gg[itq] = *(const u32x2*)(QKV + (row0 + itq * 16 + li) * 3584 + 1536 + hh * 128 + wid * 16 + 4 * g4);
        __syncthreads();
        rot_st(qr, cr, Ql, j, part, 1.f);
        rot_st(kr, cr, Kl, j, part, 0.08838834764831845f);
        plain_st(vr, Vl, j, part);
        { const int nx = item + gridDim.x; if (nx < 4096) { const int c2 = nx & 63, h2 = (nx >> 6) & 3, b2 = nx >> 8; const bf16_t* base = QKV + ((size_t)b2 * SEQ + c2 * 64) * 3584 + h2 * 128;
            rot_ld(qr, base, j, part); rot_ld(kr, base + 512, j, part); rope_ld(cr, rope, c2 * 64 + j, part); plain_ld(vr, base + 1024, j, part); } }
        __syncthreads();
        { const int jt = wid >> 1;
#pragma unroll
          for (int e2 = 0; e2 < 2; ++e2) { const int itq = 2 * (wid & 1) + e2; f32x4 sacc = (f32x4){0.f, 0.f, 0.f, 0.f};
#pragma unroll
              for (int ks = 0; ks < 4; ++ks) { const bf16x8 af = *(const LAS bf16x8*)(Kl + (jt * 16 + li) * RS + 32 * ks + 8 * g4); const bf16x8 bfr = *(const LAS bf16x8*)(Ql + (itq * 16 + li) * RS + 32 * ks + 8 * g4); sacc = mfma16(af, bfr, sacc); }
              float sv[4];
#pragma unroll
              for (int jj = 0; jj < 4; ++jj) { const int j = jt * 16 + 4 * g4 + jj, iq = itq * 16 + li; const int dd = iq > j ? iq - j : j - iq; sv[jj] = sacc[jj] * __expf(lg * (float)dd); }
              *(LAS u32x2*)(Sl + (itq * 16 + li) * VS + jt * 16 + 4 * g4) = (u32x2){pk2(sv[0], sv[1]), pk2(sv[2], sv[3])}; } }
        __syncthreads();
        f32x4 oa[4];
#pragma unroll
        for (int itq = 0; itq < 4; ++itq) oa[itq] = (f32x4){0.f, 0.f, 0.f, 0.f};
#pragma unroll
        for (int ks = 0; ks < 4; ++ks) { const bf16x8 af = stf[ks];
#pragma unroll
            for (int itq = 0; itq < 4; ++itq) { const bf16x8 bfr = *(const LAS bf16x8*)(Ql + (itq * 16 + li) * RS + 32 * ks + 8 * g4); oa[itq] = mfma16(af, bfr, oa[itq]); } }
#pragma unroll
        for (int itq = 0; itq < 4; ++itq) oa[itq] *= __expf(lg * (float)(itq * 16 + li + 1));
#pragma unroll
        for (int kk = 0; kk < 2; ++kk) { const bf16x8 af = tr_pair(Vl, RS, 32 * kk + 8 * g4, 32 * kk + 8 * g4 + 4, wid * 16, li);
#pragma unroll
            for (int itq = 0; itq < 4; ++itq) { const bf16x8 bfr = *(const LAS bf16x8*)(Sl + (itq * 16 + li) * VS + 32 * kk + 8 * g4); oa[itq] = mfma16(af, bfr, oa[itq]); } }
#pragma unroll
        for (int itq = 0; itq < 4; ++itq) { float s1 = oa[itq][0] + oa[itq][1] + oa[itq][2] + oa[itq][3];
            float s2 = oa[itq][0] * oa[itq][0] + oa[itq][1] * oa[itq][1] + oa[itq][2] * oa[itq][2] + oa[itq][3] * oa[itq][3];
            s1 += __shfl_xor(s1, 16); s1 += __shfl_xor(s1, 32); s2 += __shfl_xor(s2, 16); s2 += __shfl_xor(s2, 32);
            if (g4 == 0) stl[wid * 64 + itq * 16 + li] = (f32x2){s1, s2}; }
        __syncthreads();
        const f32x4 ng = *(const f32x4*)(p.in[25] + hh * 128 + wid * 16 + 4 * g4);
#pragma unroll
        for (int itq = 0; itq < 4; ++itq) { float s1 = 0.f, s2 = 0.f;
#pragma unroll
            for (int w8 = 0; w8 < 8; ++w8) { const f32x2 t = stl[w8 * 64 + itq * 16 + li]; s1 += t.x; s2 += t.y; }
            const float mu = s1 * (1.f / 128.f), var = fmaxf(s2 * (1.f / 128.f) - mu * mu, 0.f), rs = rsqrtf(var + 1e-6f);
            const size_t row = row0 + itq * 16 + li;
            const float r0 = (oa[itq][0] - mu) * rs * ng[0] * silu_f(lo_f(gg[itq].x)), r1 = (oa[itq][1] - mu) * rs * ng[1] * silu_f(hi_f(gg[itq].x));
            const float r2 = (oa[itq][2] - mu) * rs * ng[2] * silu_f(lo_f(gg[itq].y)), r3 = (oa[itq][3] - mu) * rs * ng[3] * silu_f(hi_f(gg[itq].y));
            *(u32x2*)(MIX + row * 1024 + hh * 128 + wid * 16 + 4 * g4) = (u32x2){pk2(r0, r1), pk2(r2, r3)}; }
    }
}

constexpr int N_PHASES = 20;
__global__ void __launch_bounds__(NTHR, 2) mega_fwd(Params p) {
    extern __shared__ __attribute__((aligned(16))) unsigned char lds_raw[];
    LAS unsigned char* lds = (LAS unsigned char*)lds_raw;
    cg::grid_group grid = cg::this_grid();
    unsigned char* ws = p.ws;
    const float* MOD = (const float*)(ws + WS_MOD);
    bf16_t* H = (bf16_t*)(ws + WS_H); bf16_t* MIX = (bf16_t*)(ws + WS_MIX); bf16_t* R1 = (bf16_t*)(ws + WS_R1);
    float* XA = p.out;
    pg8::StaticOrder S;
#ifndef PROBE_MASK
#define PROBE_MASK 0u
#endif
    unsigned long long probe_acc = 0ull;
    unsigned bar_gen = 0u;
    for (int ph = p.ph_lo; ph < p.ph_hi; ++ph) {
        const unsigned long long probe_t0 = PROBE_MASK ? __builtin_amdgcn_s_memrealtime() : 0ull;
        const int layer = ph >= 11 ? 1 : 0;
        const float* modl = MOD + (size_t)layer * 16 * 6144;
        switch (ph) {
        case 0: prep_phase(p, lds); break;
        case 1: case 8: case 11: case 17: {
            const bool ffn = (ph == 8 || ph == 17);
            const float* xin = (ph == 1) ? p.in[0] : XA;
            norm_phase(xin, (ffn ? p.in[5] : p.in[4]) + layer * 1024, modl + (ffn ? 3072 : 0), modl + (ffn ? 4096 : 1024), H);
        } break;
        case 2: {
            pg8::Gemm g{H, (const bf16_t*)(ws + WS_W_ABIN), MTOK, 2048, 1024};
            S.init(MTOK, 2048, gridDim.x, blockIdx.x);
            pg8::EpiStoreQK E{R1, p.in[10], p.in[11]};
            pg8::gemm_phase(lds, g, S, E);
        } break;
        case 12: {
            pg8::Gemm g{H, (const bf16_t*)(ws + WS_W_CDIN), MTOK, 3584, 1024};
            S.init(MTOK, 3584, gridDim.x, blockIdx.x);
            pg8::EpiStore E{R1, 3584};
            pg8::gemm_phase(lds, g, S, E);
        } break;
        case 3: attnA_phase(p, lds); break;
        case 4: s5scan_phase(p); break;
        case 5: s5c_phase(p, lds); break;
        case 6: {
            pg8::Gemm g{(const bf16_t*)(ws + WS_Y5), (const bf16_t*)(ws + WS_W_GLU), MTOK, 512, 512};
            S.init(MTOK, 512, gridDim.x, blockIdx.x);
            pg8::EpiGlu E{(const bf16_t*)(ws + WS_Y5), p.in[22], MIX};
            pg8::gemm_phase(lds, g, S, E);
        } break;
        case 7: case 16: case 10: case 19: {
            const bool ffn = (ph == 10 || ph == 19);
            const bf16_t* A = ffn ? R1 : MIX;
            const bf16_t* Bt = ffn ? (const bf16_t*)(ws + WS_W_FFOUT) + (size_t)layer * 1024 * FFH : (const bf16_t*)(ws + (layer ? WS_W_CDOUT : WS_W_ABOUT));
            pg8::Gemm g{A, Bt, MTOK, 1024, ffn ? FFH : 1024};
            S.init(MTOK, 1024, gridDim.x, blockIdx.x);
            pg8::EpiResid E{(ph == 7) ? p.in[0] : XA, XA, modl + (ffn ? 5120 : 2048)};
            pg8::gemm_phase(lds, g, S, E);
        } break;
        case 9: case 18: {
            pg8::Gemm g{H, (const bf16_t*)(ws + WS_W_FFIN) + (size_t)layer * 5632 * 1024, MTOK, 5632, 1024};
            S.init(MTOK, 5632, gridDim.x, blockIdx.x);
            pg8::EpiSwiglu E{R1};
            pg8::gemm_phase(lds, g, S, E);
        } break;
        case 13: reta_phase(p, lds); __syncthreads(); sb_phase(p, lds); break;
        case 14: retscan_phase(p); break;
        case 15: retc_phase(p, lds); break;
        default: break;
        }
        unsigned long long probe_t1 = 0ull;
        if (PROBE_MASK) { __syncthreads(); probe_t1 = __builtin_amdgcn_s_memrealtime(); if ((PROBE_MASK >> ph) & 1u) probe_acc += probe_t1 - probe_t0; }
        if (ph + 1 < p.ph_hi) {
            if (p.ph_hi > 1000) grid.sync();
            grid_barrier((unsigned*)(ws + WS_CTL), bar_gen);
        }
        if (PROBE_MASK && ((PROBE_MASK >> 20) & 1u)) probe_acc += __builtin_amdgcn_s_memrealtime() - probe_t1;
    }
    if (PROBE_MASK && blockIdx.x == 0 && threadIdx.x == 0) { const unsigned long long st = __builtin_amdgcn_s_memrealtime(); while (__builtin_amdgcn_s_memrealtime() - st < probe_acc) __builtin_amdgcn_s_sleep(8); }
}


#ifndef DIAG
#define DIAG 0
#endif
#if DIAG
__global__ void diag_fold(Params p) {
    const size_t n = (size_t)MTOK * 1024; unsigned char* ws = p.ws;
    for (size_t i = (size_t)blockIdx.x * blockDim.x + threadIdx.x; i < n; i += (size_t)gridDim.x * blockDim.x) {
        const size_t row = i >> 10; const int col = (int)(i & 1023); float v = 0.f;
#if DIAG == 30
        v = col < 512 ? bf2f(((const bf16_t*)(ws + WS_MIX))[i]) : 0.f;
#elif DIAG == 31
        v = ((const float*)(ws + WS_S5E))[i & 4194303];
#elif DIAG == 3
        v = col < 512 ? bf2f(((const bf16_t*)(ws + WS_MIX))[i]) : ((const float*)(ws + WS_S5E))[(row * 512 + col - 512) & 4194303];
#elif DIAG == 2
        v = bf2f(((const bf16_t*)(ws + WS_R1))[2 * i]) + bf2f(((const bf16_t*)(ws + WS_R1))[2 * i + 1]);
#elif DIAG == 1
        v = bf2f(((const bf16_t*)(ws + WS_H))[i]);
#elif DIAG == 5
        v = bf2f(((const bf16_t*)(ws + WS_Y5))[i >> 1]);
#elif DIAG == 6
        v = bf2f(((const bf16_t*)(ws + WS_MIX))[i]);
#endif
        p.out[i] = v;
    }
}
#endif
#ifndef MK_MULTI
#define MK_MULTI 0
#endif
extern "C" void kernel_launch(void* const* d_in, const int* in_sizes, int n_in, void* d_out, int out_size, void* d_ws, size_t ws_size, hipStream_t stream) {
    static int grid = 0;
    if (grid == 0) {
        if (n_in != 26 || out_size != MTOK * DM || ws_size < WS_END) { fprintf(stderr, "kernel_launch: unexpected shapes (n_in %d out %d ws %zu need %zu)\n", n_in, out_size, ws_size, (size_t)WS_END); grid = -1; return; }
        int dev = 0, cus = 0, per_cu = 0;
        hipGetDevice(&dev); hipDeviceGetAttribute(&cus, hipDeviceAttributeMultiprocessorCount, dev);
        if (hipFuncSetAttribute((const void*)mega_fwd, hipFuncAttributeMaxDynamicSharedMemorySize, LDS_BYTES) != hipSuccess) { fprintf(stderr, "kernel_launch: hipFuncSetAttribute failed\n"); grid = -1; return; }
        if (hipOccupancyMaxActiveBlocksPerMultiprocessor(&per_cu, (const void*)mega_fwd, NTHR, LDS_BYTES) != hipSuccess || per_cu < 1) { fprintf(stderr, "kernel_launch: occupancy query says %d\n", per_cu); per_cu = 1; }
        (void)hipGetLastError();
        grid = cus * 1;
    }
    if (grid < 0) return;
    Params p{};
    for (int i = 0; i < 26; ++i) p.in[i] = (const float*)d_in[i];
    p.out = (float*)d_out; p.ws = (unsigned char*)d_ws;
#if MK_MULTI
#if DIAG
    for (int ph = 0; ph <= (DIAG >= 30 ? DIAG / 10 : DIAG); ++ph) { p.ph_lo = ph; p.ph_hi = ph + 1; hipLaunchKernelGGL(mega_fwd, dim3(grid), dim3(NTHR), LDS_BYTES, stream, p); }
    hipLaunchKernelGGL(diag_fold, dim3(2048), dim3(256), 0, stream, p);
#else
    for (int ph = 0; ph < N_PHASES; ++ph) { p.ph_lo = ph; p.ph_hi = ph + 1; hipLaunchKernelGGL(mega_fwd, dim3(grid), dim3(NTHR), LDS_BYTES, stream, p); }
#endif
#else
    p.ph_lo = 0; p.ph_hi = N_PHASES;
    (void)hipMemsetAsync((char*)d_ws + WS_CTL, 0, 4096, stream);
    void* args[] = {&p};
    hipError_t e = hipLaunchCooperativeKernel((const void*)mega_fwd, dim3(grid), dim3(NTHR), args, LDS_BYTES, stream);
    if (e != hipSuccess) fprintf(stderr, "cooperative launch failed: %s (grid %d)\n", hipGetErrorString(e), grid);
#endif
}
```

```cpp
#include <hip/hip_runtime.h>
#include <hip/hip_cooperative_groups.h>
#include <cstdio>
namespace cg = cooperative_groups;

#define LAS __attribute__((address_space(3)))
typedef unsigned short bf16_t;
typedef short bf16x8 __attribute__((ext_vector_type(8)));
typedef short s16x4 __attribute__((ext_vector_type(4)));
typedef float f32x4 __attribute__((ext_vector_type(4)));
typedef float f32x2 __attribute__((ext_vector_type(2)));
typedef unsigned u32x4 __attribute__((ext_vector_type(4)));
typedef unsigned u32x2 __attribute__((ext_vector_type(2)));

constexpr int NB = 16, SEQ = 4096, DM = 1024, MTOK = NB * SEQ, FFH = 2816;
constexpr int NTHR = 512;
constexpr int LDS_BYTES = 135168;

constexpr size_t al256(size_t x) { return (x + 255) & ~(size_t)255; }
constexpr size_t WS_CTL = 0;
constexpr size_t WS_W_ABIN = 4096;
constexpr size_t WS_W_ABOUT = WS_W_ABIN + (size_t)2048 * 1024 * 2;
constexpr size_t WS_W_GLU = WS_W_ABOUT + (size_t)1024 * 1024 * 2;
constexpr size_t WS_W_FFIN = WS_W_GLU + (size_t)512 * 512 * 2;
constexpr size_t WS_W_FFOUT = WS_W_FFIN + (size_t)2 * 5632 * 1024 * 2;
constexpr size_t WS_W_CDIN = WS_W_FFOUT + (size_t)2 * 1024 * 2816 * 2;
constexpr size_t WS_W_CDOUT = WS_W_CDIN + (size_t)3584 * 1024 * 2;
constexpr size_t WS_MOD = WS_W_CDOUT + (size_t)1024 * 1024 * 2;
constexpr size_t WS_ROPE = WS_MOD + (size_t)2 * 16 * 6144 * 4;
constexpr size_t WS_KERN = WS_ROPE + (size_t)4096 * 64 * 8;
constexpr size_t WS_S5M = WS_KERN + (size_t)32 * 64 * 256 * 2;
constexpr size_t WS_S5G = WS_S5M + (size_t)32 * 128 * 1024 * 2;
constexpr size_t WS_A64 = WS_S5G + (size_t)32 * 1024 * 128 * 2;
constexpr size_t WS_S5E = WS_A64 + (size_t)32 * 64 * 8;
constexpr size_t WS_S5X = WS_S5E + (size_t)64 * 32 * 16 * 128 * 4;
constexpr size_t WS_Y5 = WS_S5X + (size_t)64 * 32 * 16 * 128 * 2;
constexpr size_t WS_H = WS_Y5 + (size_t)MTOK * 512 * 2;
constexpr size_t WS_MIX = WS_H + (size_t)MTOK * 1024 * 2;
constexpr size_t WS_R1 = WS_MIX + (size_t)MTOK * 1024 * 2;
constexpr size_t WS_END = WS_R1 + (size_t)MTOK * 3584 * 2;

struct Params {
    const float* in[26];
    float* out;
    unsigned char* ws;
    int ph_lo, ph_hi;
};

__device__ __forceinline__ float bf2f(unsigned short b) { return __uint_as_float(((unsigned)b) << 16); }
typedef __bf16 bf16x2_t __attribute__((ext_vector_type(2)));
__device__ __forceinline__ unsigned pk2(float lo, float hi) { const f32x2 v = {lo, hi}; return __builtin_bit_cast(unsigned, __builtin_convertvector(v, bf16x2_t)); }
__device__ __forceinline__ bf16_t f2bf(float f) { return (bf16_t)(pk2(f, 0.f) & 0xffffu); }
__device__ __forceinline__ float lo_f(unsigned u) { return __uint_as_float(u << 16); }
__device__ __forceinline__ float hi_f(unsigned u) { return __uint_as_float(u & 0xffff0000u); }
__device__ __forceinline__ bf16x8 as_frag(u32x4 u) { return __builtin_bit_cast(bf16x8, u); }
__device__ __forceinline__ f32x4 mfma16(bf16x8 a, bf16x8 b, f32x4 c) { return __builtin_amdgcn_mfma_f32_16x16x32_bf16(a, b, c, 0, 0, 0); }
__device__ __forceinline__ float silu_f(float x) { return x * __builtin_amdgcn_rcpf(1.f + __expf(-x)); }
__device__ __forceinline__ float sigm_f(float x) { return __builtin_amdgcn_rcpf(1.f + __expf(-x)); }
__device__ __forceinline__ float gelu_tanh(float x) {
    const float u = 0.7978845608028654f * (x + 0.044715f * x * x * x);
    const float t = 1.f - 2.f * __builtin_amdgcn_rcpf(1.f + __expf(2.f * u));
    return 0.5f * x * (1.f + t);
}
__device__ __forceinline__ bf16x8 tr_pair(LAS bf16_t* base, int stride, int row0, int row1, int col0, int li) {
    const int q = li >> 2, pq = li & 3;
    s16x4 a = __builtin_amdgcn_ds_read_tr16_b64_v4i16((LAS s16x4*)(base + (row0 + q) * stride + col0 + 4 * pq));
    s16x4 b = __builtin_amdgcn_ds_read_tr16_b64_v4i16((LAS s16x4*)(base + (row1 + q) * stride + col0 + 4 * pq));
    bf16x8 r = {a[0], a[1], a[2], a[3], b[0], b[1], b[2], b[3]};
    return r;
}
__device__ __forceinline__ int tid_opaque() { int t = threadIdx.x; asm volatile("" : "+v"(t)); return t; }
__device__ __forceinline__ int vblock() { const int G = gridDim.x, bx = blockIdx.x; return (G % 8 == 0) ? (bx % 8) * (G / 8) + bx / 8 : bx; }
__device__ __forceinline__ void wave_lds_fence() { asm volatile("s_waitcnt lgkmcnt(0)" ::: "memory"); __builtin_amdgcn_wave_barrier(); }


__device__ __forceinline__ void grid_barrier(unsigned* w, unsigned& gen) {
    asm volatile("s_waitcnt vmcnt(0) lgkmcnt(0)" ::: "memory");
    __syncthreads();
    if (threadIdx.x == 0) {
        __builtin_amdgcn_fence(__ATOMIC_RELEASE, "agent");
        asm volatile("s_waitcnt vmcnt(0) lgkmcnt(0)" ::: "memory");
        const unsigned G = gridDim.x, grp = blockIdx.x & 7u, ngrp = (G - grp + 7u) / 8u, ngroups = G < 8u ? G : 8u;
        const unsigned old = __hip_atomic_fetch_add(w + 32 * grp, 1u, __ATOMIC_RELAXED, __HIP_MEMORY_SCOPE_AGENT);
        if (old + 1u == ngrp * (gen + 1u)) {
            const unsigned old2 = __hip_atomic_fetch_add(w + 256, 1u, __ATOMIC_RELAXED, __HIP_MEMORY_SCOPE_AGENT);
            if (old2 + 1u == ngroups * (gen + 1u)) __hip_atomic_fetch_add(w + 288, 1u, __ATOMIC_RELAXED, __HIP_MEMORY_SCOPE_AGENT);
        }
        while (__hip_atomic_load(w + 288, __ATOMIC_RELAXED, __HIP_MEMORY_SCOPE_AGENT) == gen) __builtin_amdgcn_s_sleep(2);
        __builtin_amdgcn_fence(__ATOMIC_ACQUIRE, "agent");
        asm volatile("s_waitcnt vmcnt(0) lgkmcnt(0)" ::: "memory");
    }
    ++gen;
    __syncthreads();
}

namespace pg8 {
constexpr int BM = 256, BK = 64, HALF = 128, HTB = HALF * BK * 2, STAGE_BYTES = 8 * HTB, NXCD = 8, WGM = 8;
__device__ __forceinline__ int lds_byte(int r, int c) { const int st = (r >> 4) * 2 + (c >> 5), rr = r & 15, cc = c & 31, ob = rr * 64 + cc * 2; return st * 1024 + (ob ^ (((ob >> 9) & 1) << 5)); }
__device__ __forceinline__ void stage_rc(int b, int& R, int& C) { const int st = b / 1024, sb = b % 1024, swz = sb ^ (((sb >> 9) & 1) << 5); R = (st >> 1) * 16 + swz / 64; C = (st & 1) * 32 + (swz % 64) / 2; }
__device__ __forceinline__ int perm32(int rho) { const int n = rho >> 4, i = rho & 15; return 8 * (i >> 2) + 4 * n + (i & 3); }
struct Unit { int pm, pn; };
struct Gemm { const bf16_t* A; const bf16_t* Bt; int M, N, K; };
struct StaticOrder {
    int nM, nN, nwg, G, c;
    __device__ void init(int M, int N, int G_, int c_) { nM = M / BM; nN = N / BM; nwg = nM * nN; G = G_; c = c_; }
    __device__ bool next(int i, Unit& u) const {
        const long L = (long)i * G + c; if (L >= nwg) return false;
        int wgid = (int)L; { const int q = nwg / NXCD, r = nwg % NXCD, xcd = wgid % NXCD, off = wgid / NXCD; wgid = (xcd < r ? xcd * (q + 1) : r * (q + 1) + (xcd - r) * q) + off; }
        const int nig = WGM * nN, gid = wgid / nig, fm = gid * WGM, gsz = (nM - fm) < WGM ? (nM - fm) : WGM;
        u.pm = fm + ((wgid % nig) % gsz); u.pn = (wgid % nig) / gsz; return true;
    }
};

template <class Epi>
__device__ __forceinline__ void gemm_phase(LAS unsigned char* lds, const Gemm g, const StaticOrder& S, const Epi& E) {
    const int tid = tid_opaque(), wid = __builtin_amdgcn_readfirstlane(tid >> 6), lane = tid & 63, wr = wid >> 2, wc = wid & 3, fr = lane & 15, fq = lane >> 4;
    const int K = g.K, nt = K / BK;
    unsigned voffA[2], voffB[2];
#pragma unroll
    for (int i = 0; i < 2; ++i) { int R, C; stage_rc(tid * 16 + i * 8192, R, C); const int Rb = Epi::PERM ? ((R & ~31) + perm32(R & 31)) : R;
        voffA[i] = (unsigned)(R * K + C) * 2u; voffB[i] = (unsigned)(Rb * K + C) * 2u; }
    const size_t kstep = (size_t)(BK * 2);
    const size_t hstep = (size_t)HALF * K * 2;
    const size_t tstep = 2 * hstep;
    const unsigned ldsw = (unsigned)wid * 1024u;
    const int aoff = lds_byte(wr * 64 + fr, fq * 8), boff = lds_byte(wc * 32 + fr, fq * 8);
#define PG8_SA(b, h) (((b) * 2 + (h)) * HTB)
#define PG8_SB(b, h) ((4 + (b) * 2 + (h)) * HTB)
#define PG8_STAGE(bufoff, gbase, voff) do { _Pragma("unroll") for (int _i = 0; _i < 2; ++_i) \
        __builtin_amdgcn_global_load_lds((const unsigned*)((const char*)(gbase) + (voff)[_i]), (LAS unsigned*)(lds + (bufoff) + ldsw + _i * 8192), 16, 0, 0); } while (0)
#define PG8_LDA(dst, b, h) do { _Pragma("unroll") for (int m = 0; m < 4; ++m) _Pragma("unroll") for (int k = 0; k < 2; ++k) dst[m][k] = *(const LAS bf16x8*)(lds + PG8_SA(b, h) + aoff + m * 2048 + k * 1024); } while (0)
#define PG8_LDB(dst, b, h) do { _Pragma("unroll") for (int n = 0; n < 2; ++n) _Pragma("unroll") for (int k = 0; k < 2; ++k) dst[n][k] = *(const LAS bf16x8*)(lds + PG8_SB(b, h) + boff + n * 2048 + k * 1024); } while (0)
#define PG8_MMA(ai, bj, At, Bt) do { __builtin_amdgcn_s_setprio(1); _Pragma("unroll") for (int m = 0; m < 4; ++m) _Pragma("unroll") for (int n = 0; n < 2; ++n) _Pragma("unroll") for (int k = 0; k < 2; ++k) \
        acc[ai][bj][m][n] = __builtin_amdgcn_mfma_f32_16x16x32_bf16(Bt[n][k], At[m][k], acc[ai][bj][m][n], 0, 0, 0); __builtin_amdgcn_s_setprio(0); } while (0)
#define PG8_WAIT_V(n) asm volatile("s_waitcnt vmcnt(" #n ")" ::: "memory")
#define PG8_WAIT_L(n) asm volatile("s_waitcnt lgkmcnt(" #n ")" ::: "memory")
#define PG8_BAR __builtin_amdgcn_s_barrier()
#define PG8_SCHED __builtin_amdgcn_sched_barrier(0)
    Unit cur, nxt; int ui = 0;
    if (!S.next(0, cur)) return;
    f32x4 acc[2][2][4][2];
#pragma unroll
    for (int a = 0; a < 2; ++a)
#pragma unroll
        for (int b = 0; b < 2; ++b)
#pragma unroll
            for (int m = 0; m < 4; ++m)
#pragma unroll
                for (int n = 0; n < 2; ++n) acc[a][b][m][n] = (f32x4){0.f, 0.f, 0.f, 0.f};
    bf16x8 At[4][2], B0[2][2], B1[2][2];
    const char* cA = (const char*)g.A + (size_t)cur.pm * tstep; const char* cB = (const char*)g.Bt + (size_t)cur.pn * tstep;
    PG8_STAGE(PG8_SB(0, 0), cB, voffB); PG8_STAGE(PG8_SA(0, 0), cA, voffA); PG8_STAGE(PG8_SB(0, 1), cB + hstep, voffB); PG8_STAGE(PG8_SA(0, 1), cA + hstep, voffA);
    if (wr == 1) PG8_BAR;
    PG8_WAIT_V(4); PG8_BAR;
    PG8_STAGE(PG8_SB(1, 0), cB + kstep, voffB); PG8_STAGE(PG8_SA(1, 0), cA + kstep, voffA); PG8_STAGE(PG8_SB(1, 1), cB + hstep + kstep, voffB);
    PG8_WAIT_V(6); PG8_BAR;
    for (;;) {
        const bool has_next = S.next(ui + 1, nxt);
        const char* nA = has_next ? (const char*)g.A + (size_t)nxt.pm * tstep : cA; const char* nB = has_next ? (const char*)g.Bt + (size_t)nxt.pn * tstep : cB;
        for (int t = 0; t < nt; t += 2) {
            const bool last = (t == nt - 2);
            const char* a1 = cA + (size_t)(t + 1) * kstep;
            const char* a2 = last ? nA : cA + (size_t)(t + 2) * kstep; const char* b2 = last ? nB : cB + (size_t)(t + 2) * kstep;
            const char* a3 = a2 + kstep; const char* b3 = b2 + kstep;
            PG8_LDB(B0, 0, 0); PG8_SCHED; PG8_LDA(At, 0, 0); PG8_STAGE(PG8_SA(1, 1), a1 + hstep, voffA);
            PG8_WAIT_L(8); PG8_BAR; PG8_WAIT_L(0); PG8_MMA(0, 0, At, B0); PG8_BAR; PG8_SCHED;
            PG8_LDB(B1, 0, 1); PG8_STAGE(PG8_SB(0, 0), b2, voffB);
            PG8_BAR; PG8_WAIT_L(0); PG8_MMA(0, 1, At, B1); PG8_BAR;
            PG8_LDA(At, 0, 1); PG8_STAGE(PG8_SA(0, 0), a2, voffA);
            PG8_BAR; PG8_WAIT_L(0); PG8_MMA(1, 0, At, B0); PG8_BAR; PG8_SCHED;
            PG8_STAGE(PG8_SB(0, 1), b2 + hstep, voffB);
            PG8_WAIT_V(6); PG8_BAR; PG8_MMA(1, 1, At, B1); PG8_BAR;
            PG8_LDB(B0, 1, 0); PG8_SCHED; PG8_LDA(At, 1, 0); PG8_STAGE(PG8_SA(0, 1), a2 + hstep, voffA);
            PG8_WAIT_L(8); PG8_BAR; PG8_WAIT_L(0); PG8_MMA(0, 0, At, B0); PG8_BAR; PG8_SCHED;
            PG8_LDB(B1, 1, 1); PG8_STAGE(PG8_SB(1, 0), b3, voffB);
            PG8_BAR; PG8_WAIT_L(0); PG8_MMA(0, 1, At, B1); PG8_BAR;
            PG8_LDA(At, 1, 1); PG8_STAGE(PG8_SA(1, 0), a3, voffA);
            PG8_BAR; PG8_WAIT_L(0); PG8_MMA(1, 0, At, B0); PG8_BAR; PG8_SCHED;
            PG8_STAGE(PG8_SB(1, 1), b3 + hstep, voffB);
            PG8_WAIT_V(6); PG8_BAR; PG8_MMA(1, 1, At, B1); PG8_BAR;
        }
        E(acc, cur, wr, wc, fr, fq);
        if (!has_next) break;
#pragma unroll
        for (int a = 0; a < 2; ++a)
#pragma unroll
            for (int b = 0; b < 2; ++b)
#pragma unroll
                for (int m = 0; m < 4; ++m)
#pragma unroll
                    for (int n = 0; n < 2; ++n) acc[a][b][m][n] = (f32x4){0.f, 0.f, 0.f, 0.f};
        cur = nxt; cA = nA; cB = nB; ++ui;
    }
    PG8_WAIT_V(0);
    if (wr == 0) PG8_BAR;
    PG8_BAR;
#undef PG8_SA
#undef PG8_SB
#undef PG8_STAGE
#undef PG8_LDA
#undef PG8_LDB
#undef PG8_MMA
#undef PG8_WAIT_V
#undef PG8_WAIT_L
#undef PG8_BAR
#undef PG8_SCHED
}

struct EpiStore {
    static constexpr bool PERM = true;
    bf16_t* O; int ldc;
    __device__ __forceinline__ void operator()(const f32x4 (&acc)[2][2][4][2], const Unit& u, int wr, int wc, int fr, int fq) const {
        const int row0 = u.pm * BM + wr * 64 + fr, col0 = u.pn * BM + wc * 32 + 8 * fq;
#pragma unroll
        for (int ai = 0; ai < 2; ++ai)
#pragma unroll
            for (int m = 0; m < 4; ++m) { bf16_t* rowp = O + (size_t)(row0 + ai * HALF + m * 16) * ldc + col0;
#pragma unroll
                for (int bj = 0; bj < 2; ++bj) { const f32x4 v0 = acc[ai][bj][m][0], v1 = acc[ai][bj][m][1];
                    u32x4 w; w.x = pk2(v0[0], v0[1]); w.y = pk2(v0[2], v0[3]); w.z = pk2(v1[0], v1[1]); w.w = pk2(v1[2], v1[3]);
                    __builtin_nontemporal_store(w, (u32x4*)(rowp + bj * HALF)); } }
    }
};
struct EpiStoreQK {
    static constexpr bool PERM = true;
    bf16_t* O; const float* qg; const float* kg;
    __device__ __forceinline__ void operator()(const f32x4 (&acc)[2][2][4][2], const Unit& u, int wr, int wc, int fr, int fq) const {
        const int row0 = u.pm * BM + wr * 64 + fr;
        if (u.pn >= 4) {
            const int col0 = u.pn * BM + wc * 32 + 8 * fq;
#pragma unroll
            for (int ai = 0; ai < 2; ++ai)
#pragma unroll
                for (int m = 0; m < 4; ++m) { bf16_t* rowp = O + (size_t)(row0 + ai * HALF + m * 16) * 2048 + col0;
#pragma unroll
                    for (int bj = 0; bj < 2; ++bj) { const f32x4 v0 = acc[ai][bj][m][0], v1 = acc[ai][bj][m][1];
                        u32x4 w; w.x = pk2(v0[0], v0[1]); w.y = pk2(v0[2], v0[3]); w.z = pk2(v1[0], v1[1]); w.w = pk2(v1[2], v1[3]);
                        __builtin_nontemporal_store(w, (u32x4*)(rowp + bj * HALF)); } }
        } else {
            const float* gp = u.pn < 2 ? qg : kg; const float scl = u.pn < 2 ? 0.125f * 1.4426950408889634f : 1.f;
            f32x4 gn[2][2];
#pragma unroll
            for (int bj = 0; bj < 2; ++bj)
#pragma unroll
                for (int n = 0; n < 2; ++n) gn[bj][n] = *(const f32x4*)(gp + 32 * bj + 8 * fq + 4 * n);
            const int col0 = u.pn * BM + wc * 64 + 8 * fq;
#pragma unroll
            for (int ai = 0; ai < 2; ++ai)
#pragma unroll
                for (int m = 0; m < 4; ++m) { bf16_t* rowp = O + (size_t)(row0 + ai * HALF + m * 16) * 2048 + col0;
                    float ss = 0.f;
#pragma unroll
                    for (int bj = 0; bj < 2; ++bj)
#pragma unroll
                        for (int n = 0; n < 2; ++n) { const f32x4 a = acc[ai][bj][m][n]; ss += a[0] * a[0] + a[1] * a[1] + a[2] * a[2] + a[3] * a[3]; }
                    ss += __shfl_xor(ss, 16); ss += __shfl_xor(ss, 32);
                    const float r = rsqrtf(ss * (1.f / 64.f) + 1e-6f) * scl;
#pragma unroll
                    for (int bj = 0; bj < 2; ++bj) { const f32x4 v0 = acc[ai][bj][m][0] * r * gn[bj][0], v1 = acc[ai][bj][m][1] * r * gn[bj][1];
                        u32x4 w; w.x = pk2(v0[0], v0[1]); w.y = pk2(v0[2], v0[3]); w.z = pk2(v1[0], v1[1]); w.w = pk2(v1[2], v1[3]);
                        __builtin_nontemporal_store(w, (u32x4*)(rowp + 32 * bj)); } }
        }
    }
};
struct EpiSwiglu {
    static constexpr bool PERM = true;
    bf16_t* O;
    __device__ __forceinline__ void operator()(const f32x4 (&acc)[2][2][4][2], const Unit& u, int wr, int wc, int fr, int fq) const {
        const int row0 = u.pm * BM + wr * 64 + fr, col0 = u.pn * HALF + wc * 32 + 8 * fq;
#pragma unroll
        for (int ai = 0; ai < 2; ++ai)
#pragma unroll
            for (int m = 0; m < 4; ++m) { bf16_t* rowp = O + (size_t)(row0 + ai * HALF + m * 16) * FFH + col0;
                float r[8];
#pragma unroll
                for (int n = 0; n < 2; ++n)
#pragma unroll
                    for (int j = 0; j < 4; ++j) r[n * 4 + j] = silu_f(acc[ai][0][m][n][j]) * acc[ai][1][m][n][j];
                u32x4 w; w.x = pk2(r[0], r[1]); w.y = pk2(r[2], r[3]); w.z = pk2(r[4], r[5]); w.w = pk2(r[6], r[7]);
                __builtin_nontemporal_store(w, (u32x4*)rowp); }
    }
};
struct EpiGlu {
    static constexpr bool PERM = true;
    const bf16_t* Y; const float* bias; bf16_t* O;
    __device__ __forceinline__ void operator()(const f32x4 (&acc)[2][2][4][2], const Unit& u, int wr, int wc, int fr, int fq) const {
        const int row0 = u.pm * BM + wr * 64 + fr, col0 = u.pn * BM + wc * 32 + 8 * fq;
#pragma unroll
        for (int bj = 0; bj < 2; ++bj) {
            const int col = col0 + bj * HALF;
            const f32x4 b0 = *(const f32x4*)(bias + col), b1 = *(const f32x4*)(bias + col + 4);
            u32x4 yv[2][4];
#pragma unroll
            for (int ai = 0; ai < 2; ++ai)
#pragma unroll
                for (int m = 0; m < 4; ++m) yv[ai][m] = *(const u32x4*)(Y + (size_t)(row0 + ai * HALF + m * 16) * 512 + col);
#pragma unroll
            for (int ai = 0; ai < 2; ++ai)
#pragma unroll
                for (int m = 0; m < 4; ++m) { const size_t row = (size_t)(row0 + ai * HALF + m * 16);
                    const u32x4 y4 = yv[ai][m];
                    const f32x4 v0 = acc[ai][bj][m][0] + b0, v1 = acc[ai][bj][m][1] + b1;
                    float r[8];
                    r[0] = lo_f(y4.x) * sigm_f(v0[0]); r[1] = hi_f(y4.x) * sigm_f(v0[1]); r[2] = lo_f(y4.y) * sigm_f(v0[2]); r[3] = hi_f(y4.y) * sigm_f(v0[3]);
                    r[4] = lo_f(y4.z) * sigm_f(v1[0]); r[5] = hi_f(y4.z) * sigm_f(v1[1]); r[6] = lo_f(y4.w) * sigm_f(v1[2]); r[7] = hi_f(y4.w) * sigm_f(v1[3]);
                    u32x4 w; w.x = pk2(r[0], r[1]); w.y = pk2(r[2], r[3]); w.z = pk2(r[4], r[5]); w.w = pk2(r[6], r[7]);
                    __builtin_nontemporal_store(w, (u32x4*)(O + row * 1024 + 512 + col)); }
        }
    }
};
struct EpiResid {
    static constexpr bool PERM = false;
    const float* res; float* out; const float* gate;
    __device__ __forceinline__ void operator()(const f32x4 (&acc)[2][2][4][2], const Unit& u, int wr, int wc, int fr, int fq) const {
        const int row0 = u.pm * BM + wr * 64 + fr, col0 = u.pn * BM + wc * 32 + 4 * fq;
        const int bidx = (u.pm * BM) >> 12;
        f32x4 gv[2][2];
#pragma unroll
        for (int bj = 0; bj < 2; ++bj)
#pragma unroll
            for (int n = 0; n < 2; ++n) gv[bj][n] = *(const f32x4*)(gate + (size_t)bidx * 6144 + col0 + bj * HALF + n * 16);
        f32x4 rv[2][2][2][2];
#define EPR_LOAD(buf, q) do { _Pragma("unroll") for (int mm = 0; mm < 2; ++mm) _Pragma("unroll") for (int bj = 0; bj < 2; ++bj) _Pragma("unroll") for (int n = 0; n < 2; ++n) \
            rv[buf][mm][bj][n] = *(const f32x4*)(res + (size_t)(row0 + ((q) >> 1) * HALF + (((q) & 1) * 2 + mm) * 16) * 1024 + col0 + bj * HALF + n * 16); } while (0)
#define EPR_STORE(buf, q) do { _Pragma("unroll") for (int mm = 0; mm < 2; ++mm) _Pragma("unroll") for (int bj = 0; bj < 2; ++bj) _Pragma("unroll") for (int n = 0; n < 2; ++n) \
            __builtin_nontemporal_store(rv[buf][mm][bj][n] + gv[bj][n] * acc[(q) >> 1][bj][((q) & 1) * 2 + mm][n], (f32x4*)(out + (size_t)(row0 + ((q) >> 1) * HALF + (((q) & 1) * 2 + mm) * 16) * 1024 + col0 + bj * HALF + n * 16)); } while (0)
        EPR_LOAD(0, 0); EPR_LOAD(1, 1); EPR_STORE(0, 0); EPR_LOAD(0, 2); EPR_STORE(1, 1); EPR_LOAD(1, 3); EPR_STORE(0, 2); EPR_STORE(1, 3);
#undef EPR_LOAD
#undef EPR_STORE
    }
};
}

__device__ __forceinline__ int wt_src_col(int n, int mode) {
    if (mode == 1) { const int tt = n >> 8, r = n & 255; return r < 128 ? tt * 128 + r : FFH + tt * 128 + (r - 128); }
    if (mode == 2 && n < 1024) { const int lc = n & 255; return (n & ~255) + ((lc >> 5) & 3) * 64 + 32 * (lc >> 7) + (lc & 31); }
    return n;
}
__device__ __forceinline__ void transpose_cvt(LAS float* tile, const float* __restrict__ W, int K, int N, bf16_t* __restrict__ Wt, int mode) {
    const int tid = tid_opaque();
    const int tilesN = N / 64, tilesK = K / 64, ntl = tilesN * tilesK;
    float cur[8];
    if ((int)blockIdx.x < ntl) { const int tn = blockIdx.x % tilesN, tk = blockIdx.x / tilesN; const int nsrc = wt_src_col(tn * 64 + (tid & 63), mode);
#pragma unroll
        for (int r = 0; r < 8; ++r) cur[r] = W[(size_t)(tk * 64 + (tid >> 6) + 8 * r) * N + nsrc]; }
    for (int t = blockIdx.x; t < ntl; t += gridDim.x) {
        const int tn = t % tilesN, tk = t / tilesN;
        const int n0d = tn * 64, k0 = tk * 64;
#pragma unroll
        for (int r = 0; r < 8; ++r) { const int kk = (tid >> 6) + 8 * r; tile[kk * 65 + (tid & 63)] = cur[r]; }
        const int t2 = t + gridDim.x;
        if (t2 < ntl) { const int tn2 = t2 % tilesN, tk2 = t2 / tilesN; const int nsrc = wt_src_col(tn2 * 64 + (tid & 63), mode);
#pragma unroll
            for (int r = 0; r < 8; ++r) cur[r] = W[(size_t)(tk2 * 64 + (tid >> 6) + 8 * r) * N + nsrc]; }
        __syncthreads();
        { const int nn = tid >> 3, kc = (tid & 7) * 8; float v[8];
#pragma unroll
          for (int j = 0; j < 8; ++j) v[j] = tile[(kc + j) * 65 + nn];
          u32x4 w; w.x = pk2(v[0], v[1]); w.y = pk2(v[2], v[3]); w.z = pk2(v[4], v[5]); w.w = pk2(v[6], v[7]);
          *(u32x4*)(Wt + (size_t)(n0d + nn) * K + k0 + kc) = w; }
        __syncthreads();
    }
}

struct S5gp { float lrdt, lidt, fre, fim; };
__device__ __forceinline__ S5gp s5_gp(const Params& p, int g, int pp) {
    S5gp r; const float dt = expf(p.in[15][g]); const float lr = p.in[13][g * 64 + pp], li = p.in[14][g * 64 + pp];
    r.lrdt = lr * dt; r.lidt = li * dt;
    const float mag = expf(r.lrdt), are = mag * cosf(r.lidt), aim = mag * sinf(r.lidt), den = lr * lr + li * li;
    r.fre = ((are - 1.f) * lr + aim * li) / den; r.fim = (aim * lr - (are - 1.f) * li) / den;
    return r;
}
__device__ __forceinline__ f32x2 s5_apow(const S5gp& q, float n) { const float m = expf(n * q.lrdt), a = n * q.lidt; return (f32x2){m * cosf(a), m * sinf(a)}; }

__device__ __forceinline__ void prep_phase(const Params& p, LAS unsigned char* lds) {
    const int tid = tid_opaque();
    unsigned char* ws = p.ws;
    LAS float* tile = (LAS float*)lds;
    transpose_cvt(tile, p.in[8], 1024, 2048, (bf16_t*)(ws + WS_W_ABIN), 2);
    transpose_cvt(tile, p.in[9], 1024, 1024, (bf16_t*)(ws + WS_W_ABOUT), 0);
    transpose_cvt(tile, p.in[21], 512, 512, (bf16_t*)(ws + WS_W_GLU), 0);
    for (int l = 0; l < 2; ++l) {
        transpose_cvt(tile, p.in[6] + (size_t)l * 1024 * 5632, 1024, 5632, (bf16_t*)(ws + WS_W_FFIN) + (size_t)l * 5632 * 1024, 1);
        transpose_cvt(tile, p.in[7] + (size_t)l * FFH * 1024, FFH, 1024, (bf16_t*)(ws + WS_W_FFOUT) + (size_t)l * 1024 * FFH, 0);
    }
    transpose_cvt(tile, p.in[23], 1024, 3584, (bf16_t*)(ws + WS_W_CDIN), 0);
    transpose_cvt(tile, p.in[24], 1024, 1024, (bf16_t*)(ws + WS_W_CDOUT), 0);
    if (blockIdx.x < 192) {
        LAS float* sc = (LAS float*)lds; LAS float* red = (LAS float*)(lds + 65536);
        for (int idx = tid; idx < 16384; idx += NTHR) { const float v = p.in[1][idx]; sc[idx] = v / (1.f + expf(-v)); }
        __syncthreads();
        for (int item = blockIdx.x; item < 192; item += gridDim.x) {
            const int l = item / 96, cb = item % 96, cl = tid & 63, ksl = tid >> 6;
            float acc[16];
#pragma unroll
            for (int b = 0; b < 16; ++b) acc[b] = 0.f;
            const float* w = p.in[2] + (size_t)l * 1024 * 6144 + cb * 64 + cl;
            for (int k0 = ksl * 128; k0 < ksl * 128 + 128; k0 += 8) {
                float wv[8];
#pragma unroll
                for (int j = 0; j < 8; ++j) wv[j] = w[(size_t)(k0 + j) * 6144];
#pragma unroll
                for (int b = 0; b < 16; ++b) { const f32x4 s0 = *(const LAS f32x4*)(sc + b * 1024 + k0), s1 = *(const LAS f32x4*)(sc + b * 1024 + k0 + 4);
                    acc[b] += s0[0] * wv[0] + s0[1] * wv[1] + s0[2] * wv[2] + s0[3] * wv[3] + s1[0] * wv[4] + s1[1] * wv[5] + s1[2] * wv[6] + s1[3] * wv[7]; }
            }
#pragma unroll
            for (int b = 0; b < 16; ++b) red[(ksl * 16 + b) * 64 + cl] = acc[b];
            __syncthreads();
            for (int o = tid; o < 1024; o += NTHR) { const int b = o >> 6, cc = o & 63; float s = 0.f;
#pragma unroll
                for (int k8 = 0; k8 < 8; ++k8) s += red[(k8 * 16 + b) * 64 + cc];
                ((float*)(ws + WS_MOD))[(size_t)(l * 16 + b) * 6144 + cb * 64 + cc] = s + p.in[3][l * 6144 + cb * 64 + cc]; }
            __syncthreads();
        }
    }
    __syncthreads();
    const int gtid = blockIdx.x * NTHR + tid, nthr = gridDim.x * NTHR;
    for (int idx = gtid; idx < 4096 * 64; idx += nthr) { const int pos = idx >> 6, f = idx & 63;
        const float freq = powf(10000.f, -(float)f / 64.f), ang = (float)pos * freq;
        ((f32x2*)(ws + WS_ROPE))[idx] = (f32x2){cosf(ang), sinf(ang)}; }
    { bf16_t* Mt = (bf16_t*)(ws + WS_S5M); bf16_t* Gt = (bf16_t*)(ws + WS_S5G);
      for (int idx = gtid; idx < 32 * 64 * 64; idx += nthr) { const int g = idx >> 12, pp = (idx >> 6) & 63, s = idx & 63;
          const S5gp q = s5_gp(p, g, pp);
          { const f32x2 a = s5_apow(q, (float)(63 - s));
            unsigned wr_[8], wi_[8];
#pragma unroll
            for (int h2 = 0; h2 < 8; ++h2) { float vr[2], vi[2];
#pragma unroll
                for (int e = 0; e < 2; ++e) { const int h = h2 * 2 + e; const float br = p.in[16][(g * 64 + pp) * 16 + h], bi = p.in[17][(g * 64 + pp) * 16 + h];
                    const float bbr = q.fre * br - q.fim * bi, bbi = q.fre * bi + q.fim * br;
                    vr[e] = a.x * bbr - a.y * bbi; vi[e] = a.x * bbi + a.y * bbr; }
                wr_[h2] = pk2(vr[0], vr[1]); wi_[h2] = pk2(vi[0], vi[1]); }
            u32x4* dr = (u32x4*)(Mt + (size_t)(g * 128 + 2 * pp) * 1024 + s * 16); u32x4* di = (u32x4*)(Mt + (size_t)(g * 128 + 2 * pp + 1) * 1024 + s * 16);
            dr[0] = (u32x4){wr_[0], wr_[1], wr_[2], wr_[3]}; dr[1] = (u32x4){wr_[4], wr_[5], wr_[6], wr_[7]};
            di[0] = (u32x4){wi_[0], wi_[1], wi_[2], wi_[3]}; di[1] = (u32x4){wi_[4], wi_[5], wi_[6], wi_[7]}; }
          { const int t = s; const f32x2 a = s5_apow(q, (float)(t + 1));
#pragma unroll
            for (int h = 0; h < 16; ++h) { const float cr = p.in[18][(g * 16 + h) * 64 + pp], ci = p.in[19][(g * 16 + h) * 64 + pp];
                const float gr = cr * a.x - ci * a.y, gi = cr * a.y + ci * a.x;
                *(unsigned*)(Gt + (size_t)(g * 1024 + t * 16 + h) * 128 + 2 * pp) = pk2(gr, -gi); } }
          if (s == 0) ((f32x2*)(ws + WS_A64))[g * 64 + pp] = s5_apow(q, 64.f);
      }
      LAS f32x2* tp = (LAS f32x2*)lds;
      bf16_t* Kt = (bf16_t*)(ws + WS_KERN);
      for (int item = blockIdx.x; item < 32 * 64; item += gridDim.x) { const int g = item >> 6, tau = item & 63;
          if (tid < 64) { const S5gp q = s5_gp(p, g, tid); const f32x2 a = s5_apow(q, (float)tau); tp[tid] = (f32x2){a.x * q.fre - a.y * q.fim, a.x * q.fim + a.y * q.fre}; }
          __syncthreads();
          if (tid < 256) { const int h = tid >> 4, h2 = tid & 15; float acc = 0.f;
#pragma unroll 8
              for (int pp = 0; pp < 64; ++pp) { const f32x2 t = tp[pp]; const float cr = p.in[18][(g * 16 + h) * 64 + pp], ci = p.in[19][(g * 16 + h) * 64 + pp];
                  const float ur = cr * t.x - ci * t.y, ui = cr * t.y + ci * t.x;
                  acc += ur * p.in[16][(g * 64 + pp) * 16 + h2] - ui * p.in[17][(g * 64 + pp) * 16 + h2]; }
              Kt[(size_t)((g * 64 + tau) * 16 + h) * 16 + h2] = f2bf(acc); }
          __syncthreads();
      }
    }
}

__device__ __forceinline__ void norm_phase(const float* __restrict__ x, const float* __restrict__ gw, const float* __restrict__ shift, const float* __restrict__ scale, bf16_t* __restrict__ H) {
    const int tid = tid_opaque(); const int lane = tid & 63, wv = blockIdx.x * 8 + (tid >> 6), nw = gridDim.x * 8;
    constexpr int NR = 8;
    for (int row0 = wv * NR; row0 < MTOK; row0 += nw * NR) {
        const int b = row0 >> 12;
        f32x4 v[NR][4]; float ss[NR];
#pragma unroll
        for (int r = 0; r < NR; ++r)
#pragma unroll
            for (int c4 = 0; c4 < 4; ++c4) v[r][c4] = __builtin_nontemporal_load((const f32x4*)(x + (size_t)(row0 + r) * 1024 + c4 * 256 + lane * 4));
#pragma unroll
        for (int r = 0; r < NR; ++r) { float s = 0.f;
#pragma unroll
            for (int c4 = 0; c4 < 4; ++c4) s += v[r][c4][0] * v[r][c4][0] + v[r][c4][1] * v[r][c4][1] + v[r][c4][2] * v[r][c4][2] + v[r][c4][3] * v[r][c4][3];
            ss[r] = s; }
#pragma unroll
        for (int o = 1; o < 64; o <<= 1)
#pragma unroll
            for (int r = 0; r < NR; ++r) ss[r] += __shfl_xor(ss[r], o);
#pragma unroll
        for (int c4 = 0; c4 < 4; ++c4) { const int col = c4 * 256 + lane * 4;
            const f32x4 g = *(const f32x4*)(gw + col), sc = *(const f32x4*)(scale + (size_t)b * 6144 + col), sh = *(const f32x4*)(shift + (size_t)b * 6144 + col);
            const f32x4 gm = g * (sc + 1.f);
#pragma unroll
            for (int r = 0; r < NR; ++r) { const float rr = rsqrtf(ss[r] * (1.f / 1024.f) + 1e-6f);
                const f32x4 o = v[r][c4] * rr * gm + sh;
                *(u32x2*)(H + (size_t)(row0 + r) * 1024 + col) = (u32x2){pk2(o[0], o[1]), pk2(o[2], o[3])}; } }
    }
}

constexpr int VS = 72;
constexpr int VL_BYTES = 64 * VS * 2;

__device__ __forceinline__ void s5a_phase(const Params& p);
__device__ __forceinline__ void attnA_phase(const Params& p, LAS unsigned char* lds) {
    const int tid = tid_opaque(), wid = __builtin_amdgcn_readfirstlane(tid >> 6), lane = tid & 63, li = lane & 15, g4 = lane >> 4;
    const bf16_t* QKV = (const bf16_t*)(p.ws + WS_R1);
    bf16_t* MIX = (bf16_t*)(p.ws + WS_MIX);
    LAS bf16_t* Vl = (LAS bf16_t*)(lds + wid * VL_BYTES);
    LAS float* bl = (LAS float*)(lds + 8 * VL_BYTES);
    for (int idx = tid; idx < 8 * 257; idx += NTHR) bl[(idx / 257) * 260 + (idx % 257)] = (p.in[12][idx] - p.in[12][(idx / 257) * 257 + 256]) * 1.4426950408889634f;
    __syncthreads();
    if (wid >= 4) s5a_phase(p);
    const int h = wid;
    LAS float* bh = bl + h * 260;
    const int vrow = lane >> 3, vc8 = (lane & 7) * 8;
    for (int item2 = vblock(); item2 < 2048; item2 += gridDim.x) {
        const int kq = item2 >> 8, rq = item2 & 255, qh = rq & 1;
        const int b = 2 * kq + (rq >> 7), ci = (((rq >> 1) & 63) + 9 * kq) & 63;
        const size_t rowbase = (size_t)b * SEQ + ci * 64 + qh * 32;
        bf16x8 qf[2][2];
#pragma unroll
        for (int qt = 0; qt < 2; ++qt)
#pragma unroll
            for (int ks = 0; ks < 2; ++ks) qf[qt][ks] = *(const bf16x8*)(QKV + (rowbase + qt * 16 + li) * 2048 + h * 64 + 32 * ks + 8 * g4);
        f32x4 o[4][2]; float mrun[2], lsum[2];
#pragma unroll
        for (int qt = 0; qt < 2; ++qt) { mrun[qt] = -1e30f; lsum[qt] = 0.f;
#pragma unroll
            for (int dt = 0; dt < 4; ++dt) o[dt][qt] = (f32x4){0.f, 0.f, 0.f, 0.f}; }
        const int kb0 = ci >= 8 ? 0 : 8 - ci;
        bf16x8 kf[4][2]; u32x4 vr[8];
        { const bf16_t* kbase = QKV + ((size_t)b * SEQ + (size_t)(ci - 8 + kb0) * 64) * 2048 + h * 64;
#pragma unroll
          for (int kt = 0; kt < 4; ++kt)
#pragma unroll
              for (int ks = 0; ks < 2; ++ks) kf[kt][ks] = *(const bf16x8*)(kbase + (size_t)(kt * 16 + li) * 2048 + 512 + 32 * ks + 8 * g4);
#pragma unroll
          for (int r = 0; r < 8; ++r) vr[r] = *(const u32x4*)(kbase + (size_t)(r * 8 + vrow) * 2048 + 1024 + vc8);
          wave_lds_fence();
#pragma unroll
          for (int r = 0; r < 8; ++r) *(LAS u32x4*)(Vl + (r * 8 + vrow) * VS + vc8) = vr[r];
          wave_lds_fence(); }
        for (int kb = kb0; kb <= 8; ++kb) {
            f32x4 s[4][2];
            __builtin_amdgcn_s_setprio(1);
#pragma unroll
            for (int kt = 0; kt < 4; ++kt)
#pragma unroll
                for (int qt = 0; qt < 2; ++qt) { f32x4 z = (f32x4){0.f, 0.f, 0.f, 0.f}; z = mfma16(kf[kt][0], qf[qt][0], z); z = mfma16(kf[kt][1], qf[qt][1], z); s[kt][qt] = z; }
            __builtin_amdgcn_s_setprio(0);
            const bool more = kb < 8;
            if (more) {
                const bf16_t* kbase = QKV + ((size_t)b * SEQ + (size_t)(ci - 8 + kb + 1) * 64) * 2048 + h * 64;
#pragma unroll
                for (int kt = 0; kt < 4; ++kt)
#pragma unroll
                    for (int ks = 0; ks < 2; ++ks) kf[kt][ks] = *(const bf16x8*)(kbase + (size_t)(kt * 16 + li) * 2048 + 512 + 32 * ks + 8 * g4);
#pragma unroll
                for (int r = 0; r < 8; ++r) vr[r] = *(const u32x4*)(kbase + (size_t)(r * 8 + vrow) * 2048 + 1024 + vc8);
            }
            const bool nearb = kb >= 6;
            bf16x8 pfr[2][2];
#pragma unroll
            for (int qt = 0; qt < 2; ++qt) {
                float mx = -1e30f;
                if (nearb) {
#pragma unroll
                    for (int kt = 0; kt < 4; ++kt)
#pragma unroll
                        for (int jj = 0; jj < 4; ++jj) { int rel = 512 + qh * 32 + qt * 16 + li - kb * 64 - (kt * 16 + 4 * g4 + jj); rel = rel > 128 ? 128 : (rel < -128 ? -128 : rel);
                            const float v = s[kt][qt][jj] + bh[rel + 128]; s[kt][qt][jj] = v; mx = fmaxf(mx, v); }
                } else {
#pragma unroll
                    for (int kt = 0; kt < 4; ++kt)
#pragma unroll
                        for (int jj = 0; jj < 4; ++jj) mx = fmaxf(mx, s[kt][qt][jj]);
                }
                mx = fmaxf(mx, __shfl_xor(mx, 16)); mx = fmaxf(mx, __shfl_xor(mx, 32));
                const float mnew = fmaxf(mrun[qt], mx), alpha = __builtin_amdgcn_exp2f(mrun[qt] - mnew);
                mrun[qt] = mnew; float ps = 0.f;
#pragma unroll
                for (int kt = 0; kt < 4; ++kt)
#pragma unroll
                    for (int jj = 0; jj < 4; ++jj) { const float e = __builtin_amdgcn_exp2f(s[kt][qt][jj] - mnew); s[kt][qt][jj] = e; ps += e; }
                lsum[qt] = lsum[qt] * alpha + ps;
#pragma unroll
                for (int dt = 0; dt < 4; ++dt) o[dt][qt] *= alpha;
#pragma unroll
                for (int kk = 0; kk < 2; ++kk) { u32x4 w; w.x = pk2(s[2 * kk][qt][0], s[2 * kk][qt][1]); w.y = pk2(s[2 * kk][qt][2], s[2 * kk][qt][3]);
                    w.z = pk2(s[2 * kk + 1][qt][0], s[2 * kk + 1][qt][1]); w.w = pk2(s[2 * kk + 1][qt][2], s[2 * kk + 1][qt][3]); pfr[qt][kk] = as_frag(w); }
            }
            { bf16x8 vf[2][4];
#pragma unroll
              for (int kk = 0; kk < 2; ++kk)
#pragma unroll
                  for (int dt = 0; dt < 4; ++dt) vf[kk][dt] = tr_pair(Vl, VS, 32 * kk + 4 * g4, 32 * kk + 16 + 4 * g4, dt * 16, li);
#pragma unroll
              for (int kk = 0; kk < 2; ++kk)
#pragma unroll
                  for (int dt = 0; dt < 4; ++dt)
#pragma unroll
                      for (int qt = 0; qt < 2; ++qt) o[dt][qt] = mfma16(vf[kk][dt], pfr[qt][kk], o[dt][qt]); }
            wave_lds_fence();
            if (more) {
#pragma unroll
                for (int r = 0; r < 8; ++r) *(LAS u32x4*)(Vl + (r * 8 + vrow) * VS + vc8) = vr[r];
                wave_lds_fence();
            }
        }
#pragma unroll
        for (int qt = 0; qt < 2; ++qt) { float l = lsum[qt]; l += __shfl_xor(l, 16); l += __shfl_xor(l, 32); const float inv = 1.f / l;
#pragma unroll
            for (int dt = 0; dt < 4; ++dt) { const f32x4 v = o[dt][qt] * inv;
                *(u32x2*)(MIX + (rowbase + qt * 16 + li) * 1024 + h * 64 + dt * 16 + 4 * g4) = (u32x2){pk2(v[0], v[1]), pk2(v[2], v[3])}; } }
    }
    if (wid < 4) s5a_phase(p);
}

__device__ __forceinline__ void s5a_phase(const Params& p) {
    const int tid = tid_opaque(); const int lane = tid & 63, li = lane & 15, g4 = lane >> 4;
    const bf16_t* QKV = (const bf16_t*)(p.ws + WS_R1);
    const bf16_t* Mt = (const bf16_t*)(p.ws + WS_S5M);
    float* E = (float*)(p.ws + WS_S5E);
    const int wv = blockIdx.x * 8 + (tid >> 6), nw = gridDim.x * 8;
    for (int item = wv; item < 2048; item += nw) {
        const int g = item & 31, c = item >> 5;
        f32x4 acc[8];
#pragma unroll
        for (int pt = 0; pt < 8; ++pt) acc[pt] = (f32x4){0.f, 0.f, 0.f, 0.f};
        const bf16_t* ub = QKV + ((size_t)li * SEQ + c * 64 + (g4 >> 1)) * 2048 + 1536 + g * 16 + 8 * (g4 & 1);
        const bf16_t* mb = Mt + (size_t)(g * 128 + li) * 1024 + 8 * g4;
#pragma unroll 4
        for (int ks = 0; ks < 32; ++ks) {
            const bf16x8 bfr = *(const bf16x8*)(ub + (size_t)(2 * ks) * 2048);
#pragma unroll
            for (int pt = 0; pt < 8; ++pt) { const bf16x8 afr = *(const bf16x8*)(mb + (size_t)pt * 16 * 1024 + 32 * ks); acc[pt] = mfma16(afr, bfr, acc[pt]); }
        }
#pragma unroll
        for (int pt = 0; pt < 8; ++pt) *(f32x4*)(E + ((size_t)(c * 32 + g) * 16 + li) * 128 + pt * 16 + 4 * g4) = acc[pt];
    }
}
__device__ __forceinline__ void s5scan_phase(const Params& p) {
    const float* E = (const float*)(p.ws + WS_S5E);
    bf16_t* X = (bf16_t*)(p.ws + WS_S5X);
    const f32x2* A64 = (const f32x2*)(p.ws + WS_A64);
    const int gtid = blockIdx.x * NTHR + tid_opaque();
    if (gtid < 32 * 16 * 64) {
        const int pp = gtid & 63, b = (gtid >> 6) & 15, g = gtid >> 10;
        const f32x2 a = A64[g * 64 + pp];
        float xr = 0.f, xi = 0.f;
        for (int c0 = 0; c0 < 64; c0 += 8) {
            f32x2 e[8];
#pragma unroll
            for (int k = 0; k < 8; ++k) e[k] = *(const f32x2*)(E + ((size_t)((c0 + k) * 32 + g) * 16 + b) * 128 + 2 * pp);
#pragma unroll
            for (int k = 0; k < 8; ++k) {
                *(unsigned*)(X + ((size_t)((c0 + k) * 32 + g) * 16 + b) * 128 + 2 * pp) = pk2(xr, xi);
                const float nr = a.x * xr - a.y * xi + e[k].x, ni = a.x * xi + a.y * xr + e[k].y; xr = nr; xi = ni; }
        }
    }
}
__device__ __forceinline__ int s5c_item(int vb, int k) {
    if (gridDim.x != 256) return vb + k * (int)gridDim.x;
    const int x = vb >> 5, l = vb & 31; const int g = 8 * (x & 3) + (l & 7), c = 8 * k + 4 * (x >> 2) + (l >> 3);
    return c * 32 + g;
}
__device__ __forceinline__ void s5c_phase(const Params& p, LAS unsigned char* lds) {
    const int tid = tid_opaque(), wid = __builtin_amdgcn_readfirstlane(tid >> 6), lane = tid & 63, li = lane & 15, g4 = lane >> 4;
    const bf16_t* QKV = (const bf16_t*)(p.ws + WS_R1);
    const bf16_t* Kt = (const bf16_t*)(p.ws + WS_KERN);
    const bf16_t* Gt = (const bf16_t*)(p.ws + WS_S5G);
    const bf16_t* X = (const bf16_t*)(p.ws + WS_S5X);
    bf16_t* Y5 = (bf16_t*)(p.ws + WS_Y5);
    LAS bf16_t* kl = (LAS bf16_t*)lds;
    LAS bf16_t* ul = (LAS bf16_t*)(lds + 32768);
    int gl = -1;
    bf16x8 gf[8][4];
    u32x4 ur[4];
    const int vb = vblock(), nrounds = (2048 + (int)gridDim.x - 1) / (int)gridDim.x;
    { const int item = s5c_item(vb, 0); if (item < 2048) { const int g = item & 31, c = item >> 5;
#pragma unroll
        for (int q = 0; q < 4; ++q) { const int idx = tid + q * NTHR, hh = idx & 1, b = (idx >> 1) & 15, sq = idx >> 5;
            ur[q] = *(const u32x4*)(QKV + ((size_t)b * SEQ + c * 64 + sq) * 2048 + 1536 + g * 16 + hh * 8); } } }
    for (int rk = 0; rk < nrounds; ++rk) {
        const int item = s5c_item(vb, rk); if (item >= 2048) break;
        const int g = item & 31, c = item >> 5;
        __syncthreads();
        if (g != gl) { for (int idx = tid; idx < 2048; idx += NTHR) *(LAS u32x4*)(kl + idx * 8) = *(const u32x4*)(Kt + (size_t)g * 16384 + idx * 8); gl = g;
#pragma unroll
            for (int tt = 0; tt < 8; ++tt)
#pragma unroll
                for (int ks = 0; ks < 4; ++ks) gf[tt][ks] = *(const bf16x8*)(Gt + (size_t)(g * 1024 + (wid + 8 * tt) * 16 + li) * 128 + 32 * ks + 8 * g4); }
#pragma unroll
        for (int q = 0; q < 4; ++q) { const int idx = tid + q * NTHR, hh = idx & 1, b = (idx >> 1) & 15, sq = idx >> 5;
            *(LAS u32x4*)(ul + (sq * 16 + b) * 16 + hh * 8) = ur[q]; }
        { const int nx = (rk + 1 < nrounds) ? s5c_item(vb, rk + 1) : 2048; if (nx < 2048) { const int g2 = nx & 31, c2 = nx >> 5;
#pragma unroll
            for (int q = 0; q < 4; ++q) { const int idx = tid + q * NTHR, hh = idx & 1, b = (idx >> 1) & 15, sq = idx >> 5;
                ur[q] = *(const u32x4*)(QKV + ((size_t)b * SEQ + c2 * 64 + sq) * 2048 + 1536 + g2 * 16 + hh * 8); } } }
        bf16x8 xf[4];
#pragma unroll
        for (int ks = 0; ks < 4; ++ks) xf[ks] = *(const bf16x8*)(X + ((size_t)(c * 32 + g) * 16 + li) * 128 + 32 * ks + 8 * g4);
        __syncthreads();
        const f32x4 dsk = *(const f32x4*)(p.in[20] + g * 16 + 4 * g4);
#pragma unroll
        for (int tt = 0; tt < 8; ++tt) {
            const int t = wid + 8 * tt;
            f32x4 acc = (f32x4){0.f, 0.f, 0.f, 0.f};
#pragma unroll
            for (int ks = 0; ks < 4; ++ks) acc = mfma16(gf[tt][ks], xf[ks], acc);
            const int nks = ((t >> 1) + 2) & ~1;
            for (int ks0 = 0; ks0 < nks; ks0 += 2) {
                u32x4 av[2]; bf16x8 bv[2];
#pragma unroll
                for (int q = 0; q < 2; ++q) { const int s = 2 * (ks0 + q) + (g4 >> 1); int tau = t - s; const bool ok = tau >= 0; tau = ok ? tau : 0;
                    av[q] = *(const LAS u32x4*)(kl + (tau * 16 + li) * 16 + 8 * (g4 & 1));
                    if (!ok) av[q] = (u32x4){0u, 0u, 0u, 0u};
                    bv[q] = *(const LAS bf16x8*)(ul + (s * 16 + li) * 16 + 8 * (g4 & 1)); }
#pragma unroll
                for (int q = 0; q < 2; ++q) acc = mfma16(as_frag(av[q]), bv[q], acc);
            }
            const u32x2 uu = *(const LAS u32x2*)(ul + (t * 16 + li) * 16 + 4 * g4);
            float y0 = acc[0] + dsk[0] * lo_f(uu.x), y1 = acc[1] + dsk[1] * hi_f(uu.x), y2 = acc[2] + dsk[2] * lo_f(uu.y), y3 = acc[3] + dsk[3] * hi_f(uu.y);
            y0 = gelu_tanh(y0); y1 = gelu_tanh(y1); y2 = gelu_tanh(y2); y3 = gelu_tanh(y3);
            *(u32x2*)(Y5 + ((size_t)li * SEQ + c * 64 + t) * 512 + g * 16 + 4 * g4) = (u32x2){pk2(y0, y1), pk2(y2, y3)};
        }
    }
}

#ifndef SB_EARLY_EXIT
#define SB_EARLY_EXIT 1
#endif
template <bool MASKED>
__device__ __forceinline__ void sb_qtile(const bf16x8 (&kf)[4][2], const bf16x8 (&qf)[2], float& R, bf16x8 (&pfr)[2], int li, int g4, int kpos0, int qpos, u32x2 dpat) {
    const unsigned ONES = 0x3F803F80u;
    const float SC = 0.125f * 1.4426950408889634f;
    f32x4 z[4];
    __builtin_amdgcn_s_setprio(1);
#pragma unroll
    for (int kt = 0; kt < 4; ++kt) { f32x4 a = (f32x4){0.f, 0.f, 0.f, 0.f}; a = mfma16(kf[kt][0], qf[0], a); a = mfma16(kf[kt][1], qf[1], a); z[kt] = a; }
    __builtin_amdgcn_s_setprio(0);
    float T = 0.f; unsigned hi[4][2];
#pragma unroll
    for (int kt = 0; kt < 4; ++kt) { float Lv[4];
#pragma unroll
        for (int jj = 0; jj < 4; ++jj) { const float zz = z[kt][jj] * SC;
            const float sp = fmaxf(zz, 0.f) + __builtin_amdgcn_logf(1.f + __builtin_amdgcn_exp2f(-fabsf(zz)));
            if (MASKED) { const bool valid = kpos0 + kt * 16 + jj < qpos; Lv[jj] = valid ? -sp : 0.f; z[kt][jj] = valid ? (zz - sp) : -1e30f; }
            else { Lv[jj] = -sp; z[kt][jj] = zz - sp; }
            T += Lv[jj]; }
        hi[kt][0] = pk2(Lv[0], Lv[1]); hi[kt][1] = pk2(Lv[2], Lv[3]); }
    T += __shfl_xor(T, 16); T += __shfl_xor(T, 32);
    bf16x8 Lh[2];
#pragma unroll
    for (int kk = 0; kk < 2; ++kk) Lh[kk] = as_frag((u32x4){hi[2 * kk][0], hi[2 * kk][1], hi[2 * kk + 1][0], hi[2 * kk + 1][1]});
    unsigned pw[4][2];
#pragma unroll
    for (int st = 0; st < 4; ++st) { f32x4 ce = (f32x4){0.f, 0.f, 0.f, 0.f};
#pragma unroll
        for (int kk = 0; kk < 2; ++kk) { if (2 * kk + 1 >= st) {
            u32x4 ua;
            { const int k0 = 2 * kk, k1 = 2 * kk + 1;
              ua.x = k0 > st ? ONES : (k0 == st ? dpat.x : 0u); ua.y = k0 > st ? ONES : (k0 == st ? dpat.y : 0u);
              ua.z = k1 > st ? ONES : (k1 == st ? dpat.x : 0u); ua.w = k1 > st ? ONES : (k1 == st ? dpat.y : 0u); }
            ce = mfma16(as_frag(ua), Lh[kk], ce); } }
        float w[4];
#pragma unroll
        for (int jj = 0; jj < 4; ++jj) w[jj] = __builtin_amdgcn_exp2f(z[st][jj] + R + ce[jj]);
        pw[st][0] = pk2(w[0], w[1]); pw[st][1] = pk2(w[2], w[3]); }
    R += T;
#pragma unroll
    for (int kk = 0; kk < 2; ++kk) pfr[kk] = as_frag((u32x4){pw[2 * kk][0], pw[2 * kk][1], pw[2 * kk + 1][0], pw[2 * kk + 1][1]});
}
__device__ __forceinline__ void sb_phase(const Params& p, LAS unsigned char* lds) {
    const int tid = tid_opaque(), wid = __builtin_amdgcn_readfirstlane(tid >> 6), lane = tid & 63, li = lane & 15, g4 = lane >> 4;
    const bf16_t* QKV = (const bf16_t*)(p.ws + WS_R1);
    bf16_t* MIX = (bf16_t*)(p.ws + WS_MIX);
    LAS bf16_t* Vl = (LAS bf16_t*)(lds + wid * VL_BYTES);
    const int wv = blockIdx.x * 8 + wid, nw = gridDim.x * 8;
    u32x2 dpat; dpat.x = ((4 * g4 + 0 > li) ? 0x3F80u : 0u) | ((4 * g4 + 1 > li) ? 0x3F800000u : 0u); dpat.y = ((4 * g4 + 2 > li) ? 0x3F80u : 0u) | ((4 * g4 + 3 > li) ? 0x3F800000u : 0u);
    for (int it = wv; it < 8192; it += nw) {
        const int bh = it >> 6, pr = it & 63, b = bh >> 3, h = bh & 7;
        for (int half = 0; half < 2; ++half) {
            const int qtile = half ? 127 - pr : pr, t0 = qtile * 32, kbd = t0 >> 6;
            const bf16_t* qb = QKV + ((size_t)b * SEQ + t0) * 3584 + 2048 + h * 64;
            bf16x8 qf[2][2];
#pragma unroll
            for (int qt = 0; qt < 2; ++qt)
#pragma unroll
                for (int ks = 0; ks < 2; ++ks) qf[qt][ks] = *(const bf16x8*)(qb + (size_t)(qt * 16 + li) * 3584 + 32 * ks + 8 * g4);
            f32x4 o[2][4]; float R[2];
#pragma unroll
            for (int qt = 0; qt < 2; ++qt) { R[qt] = 0.f;
#pragma unroll
                for (int dt = 0; dt < 4; ++dt) o[qt][dt] = (f32x4){0.f, 0.f, 0.f, 0.f}; }
            for (int kb = kbd; kb >= 0; --kb) {
                const bf16_t* kbase = QKV + ((size_t)b * SEQ + kb * 64) * 3584 + 2560 + h * 64;
#pragma unroll
                for (int r = 0; r < 8; ++r) { const int row = r * 8 + (lane >> 3), c8 = lane & 7;
                    *(LAS u32x4*)(Vl + row * VS + c8 * 8) = *(const u32x4*)(kbase + (size_t)row * 3584 + 512 + c8 * 8); }
                bf16x8 kf[4][2];
#pragma unroll
                for (int kt = 0; kt < 4; ++kt)
#pragma unroll
                    for (int ks = 0; ks < 2; ++ks) kf[kt][ks] = *(const bf16x8*)(kbase + (size_t)(kt * 16 + li) * 3584 + 32 * ks + 8 * g4);
                wave_lds_fence();
                const int kpos0 = kb * 64 + 4 * g4;
                bf16x8 pfr[2][2];
                if (kb == kbd) {
#pragma unroll
                    for (int qt = 0; qt < 2; ++qt) sb_qtile<true>(kf, qf[qt], R[qt], pfr[qt], li, g4, kpos0, t0 + qt * 16 + li, dpat);
                } else {
#pragma unroll
                    for (int qt = 0; qt < 2; ++qt) sb_qtile<false>(kf, qf[qt], R[qt], pfr[qt], li, g4, kpos0, t0 + qt * 16 + li, dpat);
                }
                { bf16x8 vf[2][4];
#pragma unroll
                  for (int kk = 0; kk < 2; ++kk)
#pragma unroll
                      for (int dt = 0; dt < 4; ++dt) vf[kk][dt] = tr_pair(Vl, VS, 32 * kk + 4 * g4, 32 * kk + 16 + 4 * g4, dt * 16, li);
#pragma unroll
                  for (int kk = 0; kk < 2; ++kk)
#pragma unroll
                      for (int dt = 0; dt < 4; ++dt)
#pragma unroll
                          for (int qt = 0; qt < 2; ++qt) o[qt][dt] = mfma16(vf[kk][dt], pfr[qt][kk], o[qt][dt]); }
                wave_lds_fence();
#if SB_EARLY_EXIT
                { const float rm = fmaxf(R[0], R[1]); if (__all(rm < -152.f)) break; }
#endif
            }
#pragma unroll
            for (int qt = 0; qt < 2; ++qt)
#pragma unroll
                for (int dt = 0; dt < 4; ++dt) { const f32x4 v = o[qt][dt];
                    *(u32x2*)(MIX + ((size_t)b * SEQ + t0 + qt * 16 + li) * 1024 + 512 + h * 64 + dt * 16 + 4 * g4) = (u32x2){pk2(v[0], v[1]), pk2(v[2], v[3])}; }
        }
    }
}

constexpr int RS = 136;
__device__ __forceinline__ float ret_log_gamma(int h) { return logf(1.f - exp2f(-5.f - (float)h)); }
struct RotRegs { u32x4 a, b; };
struct RopeRegs { f32x2 cs[8]; };
struct PlainRegs { u32x4 a, b; };
__device__ __forceinline__ void rot_ld(RotRegs& r, const bf16_t* src  , int j, int part) { r.a = *(const u32x4*)(src + (size_t)j * 3584 + part * 8); r.b = *(const u32x4*)(src + (size_t)j * 3584 + 64 + part * 8); }
__device__ __forceinline__ void rope_ld(RopeRegs& r, const f32x2* rope, int pos, int part) {
#pragma unroll
    for (int e = 0; e < 8; ++e) r.cs[e] = rope[(size_t)pos * 64 + part * 8 + e]; }
__device__ __forceinline__ void plain_ld(PlainRegs& r, const bf16_t* src, int j, int part) { r.a = *(const u32x4*)(src + (size_t)j * 3584 + part * 16); r.b = *(const u32x4*)(src + (size_t)j * 3584 + part * 16 + 8); }
__device__ __forceinline__ void rot_st(const RotRegs& r, const RopeRegs& c, LAS bf16_t* dst, int j, int part, float rsc) {
    const float x1[8] = {lo_f(r.a.x), hi_f(r.a.x), lo_f(r.a.y), hi_f(r.a.y), lo_f(r.a.z), hi_f(r.a.z), lo_f(r.a.w), hi_f(r.a.w)};
    const float x2[8] = {lo_f(r.b.x), hi_f(r.b.x), lo_f(r.b.y), hi_f(r.b.y), lo_f(r.b.z), hi_f(r.b.z), lo_f(r.b.w), hi_f(r.b.w)};
    float o1[8], o2[8];
#pragma unroll
    for (int e = 0; e < 8; ++e) { const f32x2 cc = c.cs[e]; o1[e] = (x1[e] * cc.x - x2[e] * cc.y) * rsc; o2[e] = (x1[e] * cc.y + x2[e] * cc.x) * rsc; }
    *(LAS u32x4*)(dst + j * RS + part * 8) = (u32x4){pk2(o1[0], o1[1]), pk2(o1[2], o1[3]), pk2(o1[4], o1[5]), pk2(o1[6], o1[7])};
    *(LAS u32x4*)(dst + j * RS + 64 + part * 8) = (u32x4){pk2(o2[0], o2[1]), pk2(o2[2], o2[3]), pk2(o2[4], o2[5]), pk2(o2[6], o2[7])};
}
__device__ __forceinline__ void plain_st(const PlainRegs& r, LAS bf16_t* dst, int j, int part) { *(LAS u32x4*)(dst + j * RS + part * 16) = r.a; *(LAS u32x4*)(dst + j * RS + part * 16 + 8) = r.b; }

__device__ __forceinline__ void reta_phase(const Params& p, LAS unsigned char* lds) {
    const int tid = tid_opaque(), wid = __builtin_amdgcn_readfirstlane(tid >> 6), lane = tid & 63, li = lane & 15, g4 = lane >> 4;
    const int j = tid >> 3, part = tid & 7;
    const bf16_t* QKV = (const bf16_t*)(p.ws + WS_R1);
    const f32x2* rope = (const f32x2*)(p.ws + WS_ROPE);
    bf16_t* RET = (bf16_t*)(p.ws + WS_H);
    LAS bf16_t* Kl = (LAS bf16_t*)lds; LAS bf16_t* Vl = (LAS bf16_t*)(lds + 64 * RS * 2);
    RotRegs kr; RopeRegs cr; PlainRegs vr;
    { const int item = blockIdx.x; if (item < 4096) { const int c = item & 63, hh = (item >> 6) & 3, b = item >> 8; const bf16_t* base = QKV + ((size_t)b * SEQ + c * 64) * 3584 + hh * 128;
        rot_ld(kr, base + 512, j, part); rope_ld(cr, rope, c * 64 + j, part); plain_ld(vr, base + 1024, j, part); } }
    for (int item = blockIdx.x; item < 4096; item += gridDim.x) {
        const int c = item & 63, hh = (item >> 6) & 3, b = item >> 8;
        const float lg = ret_log_gamma(hh);
        __syncthreads();
        rot_st(kr, cr, Kl, j, part, 0.08838834764831845f * __expf(lg * (63.f - (float)j)));
        plain_st(vr, Vl, j, part);
        { const int nx = item + gridDim.x; if (nx < 4096) { const int c2 = nx & 63, h2 = (nx >> 6) & 3, b2 = nx >> 8; const bf16_t* base = QKV + ((size_t)b2 * SEQ + c2 * 64) * 3584 + h2 * 128;
            rot_ld(kr, base + 512, j, part); rope_ld(cr, rope, c2 * 64 + j, part); plain_ld(vr, base + 1024, j, part); } }
        __syncthreads();
        f32x4 acc[8];
#pragma unroll
        for (int et = 0; et < 8; ++et) acc[et] = (f32x4){0.f, 0.f, 0.f, 0.f};
#pragma unroll
        for (int kk = 0; kk < 2; ++kk) { const bf16x8 af = tr_pair(Kl, RS, 32 * kk + 8 * g4, 32 * kk + 8 * g4 + 4, wid * 16, li);
#pragma unroll
            for (int et = 0; et < 8; ++et) { const bf16x8 bfr = tr_pair(Vl, RS, 32 * kk + 8 * g4, 32 * kk + 8 * g4 + 4, et * 16, li); acc[et] = mfma16(af, bfr, acc[et]); } }
        const size_t sid = (size_t)((b * 4 + hh) * 64 + c);
#pragma unroll
        for (int et = 0; et < 8; ++et) *(u32x2*)(RET + (sid * 128 + et * 16 + li) * 128 + wid * 16 + 4 * g4) = (u32x2){pk2(acc[et][0], acc[et][1]), pk2(acc[et][2], acc[et][3])};
    }
}
__device__ __forceinline__ void retscan_phase(const Params& p) {
    bf16_t* RET = (bf16_t*)(p.ws + WS_H);
    const int gtid = blockIdx.x * NTHR + tid_opaque(), nthr = gridDim.x * NTHR;
    for (int w = gtid; w < 64 * 2048; w += nthr) {
        const int bhh = w >> 11, e8 = w & 2047, hh = bhh & 3;
        const float cd = __expf(64.f * ret_log_gamma(hh));
        float S[8];
#pragma unroll
        for (int e = 0; e < 8; ++e) S[e] = 0.f;
        bf16_t* base = RET + (size_t)bhh * 64 * 16384 + e8 * 8;
        for (int c0 = 0; c0 < 64; c0 += 4) {
            u32x4 kv[4];
#pragma unroll
            for (int k = 0; k < 4; ++k) kv[k] = *(const u32x4*)(base + (size_t)(c0 + k) * 16384);
#pragma unroll
            for (int k = 0; k < 4; ++k) {
                *(u32x4*)(base + (size_t)(c0 + k) * 16384) = (u32x4){pk2(S[0], S[1]), pk2(S[2], S[3]), pk2(S[4], S[5]), pk2(S[6], S[7])};
                S[0] = S[0] * cd + lo_f(kv[k].x); S[1] = S[1] * cd + hi_f(kv[k].x); S[2] = S[2] * cd + lo_f(kv[k].y); S[3] = S[3] * cd + hi_f(kv[k].y);
                S[4] = S[4] * cd + lo_f(kv[k].z); S[5] = S[5] * cd + hi_f(kv[k].z); S[6] = S[6] * cd + lo_f(kv[k].w); S[7] = S[7] * cd + hi_f(kv[k].w); }
        }
    }
}
__device__ __forceinline__ void retc_phase(const Params& p, LAS unsigned char* lds) {
    const int tid = tid_opaque(), wid = __builtin_amdgcn_readfirstlane(tid >> 6), lane = tid & 63, li = lane & 15, g4 = lane >> 4;
    const bf16_t* QKV = (const bf16_t*)(p.ws + WS_R1);
    const f32x2* rope = (const f32x2*)(p.ws + WS_ROPE);
    const bf16_t* RET = (const bf16_t*)(p.ws + WS_H);
    bf16_t* MIX = (bf16_t*)(p.ws + WS_MIX);
    LAS bf16_t* Ql = (LAS bf16_t*)lds; LAS bf16_t* Kl = (LAS bf16_t*)(lds + 17408); LAS bf16_t* Vl = (LAS bf16_t*)(lds + 34816);
    LAS bf16_t* Sl = (LAS bf16_t*)(lds + 52224);
    LAS f32x2* stl = (LAS f32x2*)(lds + 61440);
    const int j = tid >> 3, part = tid & 7;
    RotRegs qr, kr; RopeRegs cr; PlainRegs vr;
    { const int item = blockIdx.x; if (item < 4096) { const int c = item & 63, hh = (item >> 6) & 3, b = item >> 8; const bf16_t* base = QKV + ((size_t)b * SEQ + c * 64) * 3584 + hh * 128;
        rot_ld(qr, base, j, part); rot_ld(kr, base + 512, j, part); rope_ld(cr, rope, c * 64 + j, part); plain_ld(vr, base + 1024, j, part); } }
    for (int item = blockIdx.x; item < 4096; item += gridDim.x) {
        const int c = item & 63, hh = (item >> 6) & 3, b = item >> 8;
        const float lg = ret_log_gamma(hh);
        const size_t row0 = (size_t)b * SEQ + c * 64;
        const size_t sid = (size_t)((b * 4 + hh) * 64 + c);
        bf16x8 stf[4]; u32x2 gg[4];
#pragma unroll
        for (int ks = 0; ks < 4; ++ks) stf[ks] = *(const bf16x8*)(RET + (sid * 128 + wid * 16 + li) * 128 + 32 * ks + 8 * g4);
#pragma unroll
        for (int itq = 0; itq < 4; ++itq) gg[itq] = *(const u32x2*)(QKV + (row0 + itq * 16 + li) * 3584 + 1536 + hh * 128 + wid * 16 + 4 * g4);
        __syncthreads();
        rot_st(qr, cr, Ql, j, part, 1.f);
        rot_st(kr, cr, Kl, j, part, 0.08838834764831845f);
        plain_st(vr, Vl, j, part);
        { const int nx = item + gridDim.x; if (nx < 4096) { const int c2 = nx & 63, h2 = (nx >> 6) & 3, b2 = nx >> 8; const bf16_t* base = QKV + ((size_t)b2 * SEQ + c2 * 64) * 3584 + h2 * 128;
            rot_ld(qr, base, j, part); rot_ld(kr, base + 512, j, part); rope_ld(cr, rope, c2 * 64 + j, part); plain_ld(vr, base + 1024, j, part); } }
        __syncthreads();
        { const int jt = wid >> 1;
#pragma unroll
          for (int e2 = 0; e2 < 2; ++e2) { const int itq = 2 * (wid & 1) + e2; f32x4 sacc = (f32x4){0.f, 0.f, 0.f, 0.f};
#pragma unroll
              for (int ks = 0; ks < 4; ++ks) { const bf16x8 af = *(const LAS bf16x8*)(Kl + (jt * 16 + li) * RS + 32 * ks + 8 * g4); const bf16x8 bfr = *(const LAS bf16x8*)(Ql + (itq * 16 + li) * RS + 32 * ks + 8 * g4); sacc = mfma16(af, bfr, sacc); }
              float sv[4];
#pragma unroll
              for (int jj = 0; jj < 4; ++jj) { const int j = jt * 16 + 4 * g4 + jj, iq = itq * 16 + li; const int dd = iq > j ? iq - j : j - iq; sv[jj] = sacc[jj] * __expf(lg * (float)dd); }
              *(LAS u32x2*)(Sl + (itq * 16 + li) * VS + jt * 16 + 4 * g4) = (u32x2){pk2(sv[0], sv[1]), pk2(sv[2], sv[3])}; } }
        __syncthreads();
        f32x4 oa[4];
#pragma unroll
        for (int itq = 0; itq < 4; ++itq) oa[itq] = (f32x4){0.f, 0.f, 0.f, 0.f};
#pragma unroll
        for (int ks = 0; ks < 4; ++ks) { const bf16x8 af = stf[ks];
#pragma unroll
            for (int itq = 0; itq < 4; ++itq) { const bf16x8 bfr = *(const LAS bf16x8*)(Ql + (itq * 16 + li) * RS + 32 * ks + 8 * g4); oa[itq] = mfma16(af, bfr, oa[itq]); } }
#pragma unroll
        for (int itq = 0; itq < 4; ++itq) oa[itq] *= __expf(lg * (float)(itq * 16 + li + 1));
#pragma unroll
        for (int kk = 0; kk < 2; ++kk) { const bf16x8 af = tr_pair(Vl, RS, 32 * kk + 8 * g4, 32 * kk + 8 * g4 + 4, wid * 16, li);
#pragma unroll
            for (int itq = 0; itq < 4; ++itq) { const bf16x8 bfr = *(const LAS bf16x8*)(Sl + (itq * 16 + li) * VS + 32 * kk + 8 * g4); oa[itq] = mfma16(af, bfr, oa[itq]); } }
#pragma unroll
        for (int itq = 0; itq < 4; ++itq) { float s1 = oa[itq][0] + oa[itq][1] + oa[itq][2] + oa[itq][3];
            float s2 = oa[itq][0] * oa[itq][0] + oa[itq][1] * oa[itq][1] + oa[itq][2] * oa[itq][2] + oa[itq][3] * oa[itq][3];
            s1 += __shfl_xor(s1, 16); s1 += __shfl_xor(s1, 32); s2 += __shfl_xor(s2, 16); s2 += __shfl_xor(s2, 32);
            if (g4 == 0) stl[wid * 64 + itq * 16 + li] = (f32x2){s1, s2}; }
        __syncthreads();
        const f32x4 ng = *(const f32x4*)(p.in[25] + hh * 128 + wid * 16 + 4 * g4);
#pragma unroll
        for (int itq = 0; itq < 4; ++itq) { float s1 = 0.f, s2 = 0.f;
#pragma unroll
            for (int w8 = 0; w8 < 8; ++w8) { const f32x2 t = stl[w8 * 64 + itq * 16 + li]; s1 += t.x; s2 += t.y; }
            const float mu = s1 * (1.f / 128.f), var = fmaxf(s2 * (1.f / 128.f) - mu * mu, 0.f), rs = rsqrtf(var + 1e-6f);
            const size_t row = row0 + itq * 16 + li;
            const float r0 = (oa[itq][0] - mu) * rs * ng[0] * silu_f(lo_f(gg[itq].x)), r1 = (oa[itq][1] - mu) * rs * ng[1] * silu_f(hi_f(gg[itq].x));
            const float r2 = (oa[itq][2] - mu) * rs * ng[2] * silu_f(lo_f(gg[itq].y)), r3 = (oa[itq][3] - mu) * rs * ng[3] * silu_f(hi_f(gg[itq].y));
            *(u32x2*)(MIX + row * 1024 + hh * 128 + wid * 16 + 4 * g4) = (u32x2){pk2(r0, r1), pk2(r2, r3)}; }
    }
}

constexpr int N_PHASES = 20;
__global__ void __launch_bounds__(NTHR, 2) mega_fwd(Params p) {
    extern __shared__ __attribute__((aligned(16))) unsigned char lds_raw[];
    LAS unsigned char* lds = (LAS unsigned char*)lds_raw;
    cg::grid_group grid = cg::this_grid();
    unsigned char* ws = p.ws;
    const float* MOD = (const float*)(ws + WS_MOD);
    bf16_t* H = (bf16_t*)(ws + WS_H); bf16_t* MIX = (bf16_t*)(ws + WS_MIX); bf16_t* R1 = (bf16_t*)(ws + WS_R1);
    float* XA = p.out;
    pg8::StaticOrder S;
#ifndef PROBE_MASK
#define PROBE_MASK 0u
#endif
    unsigned long long probe_acc = 0ull;
    unsigned bar_gen = 0u;
    for (int ph = p.ph_lo; ph < p.ph_hi; ++ph) {
        const unsigned long long probe_t0 = PROBE_MASK ? __builtin_amdgcn_s_memrealtime() : 0ull;
        const int layer = ph >= 11 ? 1 : 0;
        const float* modl = MOD + (size_t)layer * 16 * 6144;
        switch (ph) {
        case 0: prep_phase(p, lds); break;
        case 1: case 8: case 11: case 17: {
            const bool ffn = (ph == 8 || ph == 17);
            const float* xin = (ph == 1) ? p.in[0] : XA;
            norm_phase(xin, (ffn ? p.in[5] : p.in[4]) + layer * 1024, modl + (ffn ? 3072 : 0), modl + (ffn ? 4096 : 1024), H);
        } break;
        case 2: {
            pg8::Gemm g{H, (const bf16_t*)(ws + WS_W_ABIN), MTOK, 2048, 1024};
            S.init(MTOK, 2048, gridDim.x, blockIdx.x);
            pg8::EpiStoreQK E{R1, p.in[10], p.in[11]};
            pg8::gemm_phase(lds, g, S, E);
        } break;
        case 12: {
            pg8::Gemm g{H, (const bf16_t*)(ws + WS_W_CDIN), MTOK, 3584, 1024};
            S.init(MTOK, 3584, gridDim.x, blockIdx.x);
            pg8::EpiStore E{R1, 3584};
            pg8::gemm_phase(lds, g, S, E);
        } break;
        case 3: attnA_phase(p, lds); break;
        case 4: s5scan_phase(p); break;
        case 5: s5c_phase(p, lds); break;
        case 6: {
            pg8::Gemm g{(const bf16_t*)(ws + WS_Y5), (const bf16_t*)(ws + WS_W_GLU), MTOK, 512, 512};
            S.init(MTOK, 512, gridDim.x, blockIdx.x);
            pg8::EpiGlu E{(const bf16_t*)(ws + WS_Y5), p.in[22], MIX};
            pg8::gemm_phase(lds, g, S, E);
        } break;
        case 7: case 16: case 10: case 19: {
            const bool ffn = (ph == 10 || ph == 19);
            const bf16_t* A = ffn ? R1 : MIX;
            const bf16_t* Bt = ffn ? (const bf16_t*)(ws + WS_W_FFOUT) + (size_t)layer * 1024 * FFH : (const bf16_t*)(ws + (layer ? WS_W_CDOUT : WS_W_ABOUT));
            pg8::Gemm g{A, Bt, MTOK, 1024, ffn ? FFH : 1024};
            S.init(MTOK, 1024, gridDim.x, blockIdx.x);
            pg8::EpiResid E{(ph == 7) ? p.in[0] : XA, XA, modl + (ffn ? 5120 : 2048)};
            pg8::gemm_phase(lds, g, S, E);
        } break;
        case 9: case 18: {
            pg8::Gemm g{H, (const bf16_t*)(ws + WS_W_FFIN) + (size_t)layer * 5632 * 1024, MTOK, 5632, 1024};
            S.init(MTOK, 5632, gridDim.x, blockIdx.x);
            pg8::EpiSwiglu E{R1};
            pg8::gemm_phase(lds, g, S, E);
        } break;
        case 13: reta_phase(p, lds); __syncthreads(); sb_phase(p, lds); break;
        case 14: retscan_phase(p); break;
        case 15: retc_phase(p, lds); break;
        default: break;
        }
        unsigned long long probe_t1 = 0ull;
        if (PROBE_MASK) { __syncthreads(); probe_t1 = __builtin_amdgcn_s_memrealtime(); if ((PROBE_MASK >> ph) & 1u) probe_acc += probe_t1 - probe_t0; }
        if (ph + 1 < p.ph_hi) {
            if (p.ph_hi > 1000) grid.sync();
            grid_barrier((unsigned*)(ws + WS_CTL), bar_gen);
        }
        if (PROBE_MASK && ((PROBE_MASK >> 20) & 1u)) probe_acc += __builtin_amdgcn_s_memrealtime() - probe_t1;
    }
    if (PROBE_MASK && blockIdx.x == 0 && threadIdx.x == 0) { const unsigned long long st = __builtin_amdgcn_s_memrealtime(); while (__builtin_amdgcn_s_memrealtime() - st < probe_acc) __builtin_amdgcn_s_sleep(8); }
}


#ifndef DIAG
#define DIAG 0
#endif
#if DIAG
__global__ void diag_fold(Params p) {
    const size_t n = (size_t)MTOK * 1024; unsigned char* ws = p.ws;
    for (size_t i = (size_t)blockIdx.x * blockDim.x + threadIdx.x; i < n; i += (size_t)gridDim.x * blockDim.x) {
        const size_t row = i >> 10; const int col = (int)(i & 1023); float v = 0.f;
#if DIAG == 30
        v = col < 512 ? bf2f(((const bf16_t*)(ws + WS_MIX))[i]) : 0.f;
#elif DIAG == 31
        v = ((const float*)(ws + WS_S5E))[i & 4194303];
#elif DIAG == 3
        v = col < 512 ? bf2f(((const bf16_t*)(ws + WS_MIX))[i]) : ((const float*)(ws + WS_S5E))[(row * 512 + col - 512) & 4194303];
#elif DIAG == 2
        v = bf2f(((const bf16_t*)(ws + WS_R1))[2 * i]) + bf2f(((const bf16_t*)(ws + WS_R1))[2 * i + 1]);
#elif DIAG == 1
        v = bf2f(((const bf16_t*)(ws + WS_H))[i]);
#elif DIAG == 5
        v = bf2f(((const bf16_t*)(ws + WS_Y5))[i >> 1]);
#elif DIAG == 6
        v = bf2f(((const bf16_t*)(ws + WS_MIX))[i]);
#endif
        p.out[i] = v;
    }
}
#endif
#ifndef MK_MULTI
#define MK_MULTI 0
#endif
extern "C" void kernel_launch(void* const* d_in, const int* in_sizes, int n_in, void* d_out, int out_size, void* d_ws, size_t ws_size, hipStream_t stream) {
    static int grid = 0;
    if (grid == 0) {
        if (n_in != 26 || out_size != MTOK * DM || ws_size < WS_END) { fprintf(stderr, "kernel_launch: unexpected shapes (n_in %d out %d ws %zu need %zu)\n", n_in, out_size, ws_size, (size_t)WS_END); grid = -1; return; }
        int dev = 0, cus = 0, per_cu = 0;
        hipGetDevice(&dev); hipDeviceGetAttribute(&cus, hipDeviceAttributeMultiprocessorCount, dev);
        if (hipFuncSetAttribute((const void*)mega_fwd, hipFuncAttributeMaxDynamicSharedMemorySize, LDS_BYTES) != hipSuccess) { fprintf(stderr, "kernel_launch: hipFuncSetAttribute failed\n"); grid = -1; return; }
        if (hipOccupancyMaxActiveBlocksPerMultiprocessor(&per_cu, (const void*)mega_fwd, NTHR, LDS_BYTES) != hipSuccess || per_cu < 1) { fprintf(stderr, "kernel_launch: occupancy query says %d\n", per_cu); per_cu = 1; }
        (void)hipGetLastError();
        grid = cus * 1;
    }
    if (grid < 0) return;
    Params p{};
    for (int i = 0; i < 26; ++i) p.in[i] = (const float*)d_in[i];
    p.out = (float*)d_out; p.ws = (unsigned char*)d_ws;
#if MK_MULTI
#if DIAG
    for (int ph = 0; ph <= (DIAG >= 30 ? DIAG / 10 : DIAG); ++ph) { p.ph_lo = ph; p.ph_hi = ph + 1; hipLaunchKernelGGL(mega_fwd, dim3(grid), dim3(NTHR), LDS_BYTES, stream, p); }
    hipLaunchKernelGGL(diag_fold, dim3(2048), dim3(256), 0, stream, p);
#else
    for (int ph = 0; ph < N_PHASES; ++ph) { p.ph_lo = ph; p.ph_hi = ph + 1; hipLaunchKernelGGL(mega_fwd, dim3(grid), dim3(NTHR), LDS_BYTES, stream, p); }
#endif
#else
    p.ph_lo = 0; p.ph_hi = N_PHASES;
    (void)hipMemsetAsync((char*)d_ws + WS_CTL, 0, 4096, stream);
    void* args[] = {&p};
    hipError_t e = hipLaunchCooperativeKernel((const void*)mega_fwd, dim3(grid), dim3(NTHR), args, LDS_BYTES, stream);
    if (e != hipSuccess) fprintf(stderr, "cooperative launch failed: %s (grid %d)\n", hipGetErrorString(e), grid);
#endif
}
```
